# Optimizing an MI355X kernel written in HIP

```python
import jax, jax.numpy as jnp
from jax import lax
import numpy as np

D_MODEL = 1024
BATCH = 8
SEQ = 2048
DEPTH = 4

D_MIX = D_MODEL
POOL_WIDTH = D_MIX // 4
POOL_WINDOWS = (2, 4, 8, 16)
POOL_GROUPS = len(POOL_WINDOWS)
POOL_GROUP_DIM = POOL_WIDTH // POOL_GROUPS
HGRN_WIDTH = D_MIX // 4
HGRN_HEAD_DIM = 64
HGRN_HEADS = HGRN_WIDTH // HGRN_HEAD_DIM
HGRN_CHUNK = 64
LOG_F_FLOOR = 1e-30
ATTN_WIDTH = D_MIX - POOL_WIDTH - HGRN_WIDTH
HEAD_DIM = 64
N_HEADS = ATTN_WIDTH // HEAD_DIM
N_KV_HEADS = 2
KV_GROUP = N_HEADS // N_KV_HEADS
KV_WIDTH = N_KV_HEADS * HEAD_DIM
IDX_HEADS = 4
IDX_DIM = 64
TOPK_MAX = 256
Q_BLOCK = 128
MASK_VALUE = -1e30
ROPE_THETA = 500000.0
ROT_DIM = HEAD_DIM // 4
D_FF = 4 * D_MODEL
RMS_EPS = 1e-5
IN_SIZES = (POOL_WIDTH,
            HGRN_WIDTH, HGRN_WIDTH, HGRN_WIDTH, HGRN_WIDTH,
            ATTN_WIDTH, KV_WIDTH, KV_WIDTH,
            IDX_HEADS * IDX_DIM, IDX_DIM, IDX_HEADS)
D_IN = sum(IN_SIZES)

kernel_name = "hybrid_pool_hgrn2_dsa_trunk"


def rms_norm(x, g):
    xf = x.astype(jnp.float32)
    y = xf * lax.rsqrt(jnp.mean(xf * xf, axis=-1, keepdims=True) + RMS_EPS)
    return (y * g.astype(jnp.float32)).astype(x.dtype)


def split_cols(a, sizes):
    outs, start = [], 0
    for s in sizes:
        outs.append(a[..., start:start + s])
        start += s
    return outs


def rope_tables(positions):
    inv_freq = ROPE_THETA ** (-jnp.arange(0, ROT_DIM, 2, dtype=jnp.float32) / ROT_DIM)
    ang = positions.astype(jnp.float32)[..., None] * inv_freq
    return jnp.cos(ang), jnp.sin(ang)


def apply_partial_rope(x, cos, sin):
    half = ROT_DIM // 2
    shape = cos.shape[:2] + (1,) * (x.ndim - 3) + (half,)
    c, s = cos.reshape(shape), sin.reshape(shape)
    xf = x.astype(jnp.float32)
    x1, x2 = xf[..., :half], xf[..., half:ROT_DIM]
    out = jnp.concatenate([x1 * c - x2 * s, x2 * c + x1 * s, xf[..., ROT_DIM:]], axis=-1)
    return out.astype(x.dtype)


def multiscale_pool(u, w, scale):
    B, T, _ = u.shape
    uf = u.astype(jnp.float32).reshape(B, T, POOL_GROUPS, POOL_GROUP_DIM)
    cs = jnp.cumsum(uf, axis=1)
    t_idx = jnp.arange(T)
    means = []
    for g, win in enumerate(POOL_WINDOWS):
        c = cs[:, :, g]
        lag = jnp.pad(c, ((0, 0), (win, 0), (0, 0)))[:, :T]
        count = jnp.minimum(t_idx + 1, win).astype(jnp.float32)[None, :, None]
        means.append((c - lag) / count)
    pooled = jnp.stack(means, axis=2) - uf
    y = jnp.einsum('btgc,gcd->btgd', pooled, w.astype(jnp.float32))
    y = y.reshape(B, T, POOL_WIDTH) * scale.astype(jnp.float32)
    return y.astype(u.dtype)


def hgrn2(q_raw, f_raw, i_raw, g_raw, lb, norm_g):
    B, T, _ = q_raw.shape
    H, dh, C = HGRN_HEADS, HGRN_HEAD_DIM, HGRN_CHUNK
    N = T // C
    lb = lb.astype(jnp.float32)
    z = f_raw.astype(jnp.float32)
    q = jax.nn.silu(q_raw.astype(jnp.float32))
    sig = jax.nn.sigmoid(z)
    f = lb + (1.0 - lb) * sig
    log_f = jnp.log(jnp.maximum(f, LOG_F_FLOOR))
    k = (1.0 - lb) * (1.0 - sig)
    v = i_raw.astype(jnp.float32)

    def to_chunks(a):
        return a.reshape(B, N, C, H, dh).transpose(1, 0, 3, 2, 4)

    causal = jnp.tril(jnp.ones((C, C), dtype=bool))[:, :, None]

    def step(S, xs):
        qc, kc, lfc, vc = xs
        b = jnp.cumsum(lfc, axis=2)
        diff = b[:, :, :, None, :] - b[:, :, None, :, :]
        decay = jnp.where(causal, jnp.exp(jnp.minimum(diff, 0.0)), 0.0)
        scores = jnp.einsum('bhtk,bhtsk,bhsk->bhts', qc, decay, kc)
        o = jnp.einsum('bhts,bhsv->bhtv', scores, vc) \
            + jnp.einsum('bhtk,bhkv->bhtv', qc * jnp.exp(b), S)
        b_last = b[:, :, -1:, :]
        S = jnp.exp(b_last[:, :, 0, :])[..., None] * S \
            + jnp.einsum('bhsk,bhsv->bhkv', kc * jnp.exp(b_last - b), vc)
        return S, o

    S0 = jnp.zeros((B, H, dh, dh), jnp.float32)
    _, o = lax.scan(step, S0, (to_chunks(q), to_chunks(k), to_chunks(log_f), to_chunks(v)))
    o = o.transpose(1, 0, 3, 2, 4).reshape(B, T, H, dh)
    o = o * lax.rsqrt(jnp.mean(o * o, axis=-1, keepdims=True) + RMS_EPS) \
        * norm_g.astype(jnp.float32).reshape(H, dh)
    o = o.reshape(B, T, HGRN_WIDTH) * jax.nn.silu(g_raw.astype(jnp.float32))
    return o.astype(q_raw.dtype)


def dsa_sparse_attention(q, k, v, q_idx, k_idx, w_idx):
    B, T = q.shape[:2]
    nb = T // Q_BLOCK
    top_k = min(TOPK_MAX, T // 4)
    key_pos = jnp.arange(T)
    k_idx32 = k_idx.astype(jnp.float32)
    scale = HEAD_DIM ** -0.5

    def blocks(a):
        return jnp.moveaxis(a.reshape((B, nb, Q_BLOCK) + a.shape[2:]), 1, 0)

    def one_block(args):
        qb, qib, wb, start = args
        qpos = start + jnp.arange(Q_BLOCK)
        s_idx = jnp.einsum('bqhd,bsd->bqhs', qib.astype(jnp.float32), k_idx32)
        I = jnp.einsum('bqhs,bqh->bqs', jax.nn.relu(s_idx), wb.astype(jnp.float32))
        causal = key_pos[None, :] <= qpos[:, None]
        I = jnp.where(causal[None], I, MASK_VALUE)
        _, sel = lax.top_k(I, top_k)
        valid = sel <= qpos[None, :, None]
        kg = jax.vmap(lambda kk, ii: kk[ii])(k, sel)
        vg = jax.vmap(lambda vv, ii: vv[ii])(v, sel)
        sc = jnp.einsum('bqhgd,bqkhd->bqhgk', qb, kg).astype(jnp.float32) * scale
        sc = jnp.where(valid[:, :, None, None, :], sc, MASK_VALUE)
        p = jax.nn.softmax(sc, axis=-1).astype(v.dtype)
        return jnp.einsum('bqhgk,bqkhd->bqhgd', p, vg)

    starts = jnp.arange(nb) * Q_BLOCK
    out = lax.map(one_block, (blocks(q), blocks(q_idx), blocks(w_idx), starts))
    return jnp.moveaxis(out, 0, 1).reshape(B, T, ATTN_WIDTH)


def setup_inputs(seed: int = 0) -> dict:
    key = jax.random.key(seed)
    ks = jax.random.split(key, 14)
    f32 = jnp.float32
    x = jax.random.normal(ks[0], (BATCH, SEQ, D_MODEL), f32)
    offsets = jax.random.randint(ks[1], (BATCH, 1), 0, 4096, dtype=jnp.int32)
    positions = (offsets + jnp.arange(SEQ, dtype=jnp.int32)[None, :]).astype(jnp.int32)
    norm1_g = 1.0 + 0.02 * jax.random.normal(ks[2], (DEPTH, D_MODEL), f32)
    w_in = jax.random.normal(ks[3], (DEPTH, D_MODEL, D_IN), f32) * D_MODEL ** -0.5
    pool_w = jax.random.normal(ks[4], (DEPTH, POOL_GROUPS, POOL_GROUP_DIM, POOL_GROUP_DIM), f32) * POOL_GROUP_DIM ** -0.5
    pool_scale = 1.0 + 0.02 * jax.random.normal(ks[5], (DEPTH, POOL_WIDTH), f32)
    lb_logits = 0.5 * jax.random.normal(ks[6], (DEPTH, HGRN_WIDTH), f32)
    hgrn_norm_g = 1.0 + 0.02 * jax.random.normal(ks[7], (DEPTH, HGRN_WIDTH), f32)
    w_out = jax.random.normal(ks[8], (DEPTH, D_MIX, D_MODEL), f32) * D_MIX ** -0.5
    norm2_g = 1.0 + 0.02 * jax.random.normal(ks[9], (DEPTH, D_MODEL), f32)
    w_ff_in = jax.random.normal(ks[10], (DEPTH, D_MODEL, D_FF), f32) * D_MODEL ** -0.5
    w_ff_out = jax.random.normal(ks[11], (DEPTH, D_FF, D_MODEL), f32) * D_FF ** -0.5
    final_norm_g = 1.0 + 0.02 * jax.random.normal(ks[12], (D_MODEL,), f32)
    return {"x": x, "positions": positions, "norm1_g": norm1_g, "w_in": w_in,
            "pool_w": pool_w, "pool_scale": pool_scale, "lb_logits": lb_logits,
            "hgrn_norm_g": hgrn_norm_g, "w_out": w_out, "norm2_g": norm2_g,
            "w_ff_in": w_ff_in, "w_ff_out": w_ff_out, "final_norm_g": final_norm_g}


def reference(x, positions, norm1_g, w_in, pool_w, pool_scale, lb_logits, hgrn_norm_g,
              w_out, norm2_g, w_ff_in, w_ff_out, final_norm_g):
    B, T, _ = x.shape
    cos, sin = rope_tables(positions)
    p_lb = jax.nn.softmax(lb_logits.astype(jnp.float32), axis=0)
    lower_bounds = jnp.cumsum(p_lb, axis=0) - p_lb[0]
    idx_w_scale = (IDX_HEADS ** -0.5) * (IDX_DIM ** -0.5)
    for layer in range(DEPTH):
        h = rms_norm(x, norm1_g[layer])
        proj = h @ w_in[layer]
        (pool_in, hq, hf, hi, hg, q, k, v, qi, ki, wi) = split_cols(proj, IN_SIZES)
        y_pool = multiscale_pool(pool_in, pool_w[layer], pool_scale[layer])
        y_hgrn = hgrn2(hq, hf, hi, hg, lower_bounds[layer], hgrn_norm_g[layer])
        q = apply_partial_rope(q.reshape(B, T, N_KV_HEADS, KV_GROUP, HEAD_DIM), cos, sin)
        k = apply_partial_rope(k.reshape(B, T, N_KV_HEADS, HEAD_DIM), cos, sin)
        v = v.reshape(B, T, N_KV_HEADS, HEAD_DIM)
        qi = apply_partial_rope(qi.reshape(B, T, IDX_HEADS, IDX_DIM), cos, sin)
        ki = apply_partial_rope(ki, cos, sin)
        y_attn = dsa_sparse_attention(q, k, v, qi, ki, wi * idx_w_scale)
        mixed = jnp.concatenate([y_pool.astype(x.dtype), y_hgrn.astype(x.dtype),
                                 y_attn.astype(x.dtype)], axis=-1)
        x = x + mixed @ w_out[layer]
        h = rms_norm(x, norm2_g[layer])
        x = x + jnp.square(jax.nn.relu(h @ w_ff_in[layer])) @ w_ff_out[layer]
    return rms_norm(x, final_norm_g)
```

```cpp
#include <hip/hip_runtime.h>
#include <cstdio>
#include <cstdint>
namespace pg8 {
#define PG8_LAS __attribute__((address_space(3)))
typedef unsigned short bf16_t;
typedef short bf16x8 __attribute__((ext_vector_type(8)));
typedef float f32x4 __attribute__((ext_vector_type(4)));
typedef unsigned u32x4 __attribute__((ext_vector_type(4)));
constexpr int BM = 256, BK = 64, HALF = 128, HTB = HALF * BK * 2  , STAGE_BYTES = 8 * HTB, NXCD = 8, WGM = 8;

__host__ __device__ __forceinline__ int lds_byte(int r, int c) { const int st = (r >> 4) * 2 + (c >> 5), rr = r & 15, cc = c & 31, ob = rr * 64 + cc * 2; return st * 1024 + (ob ^ (((ob >> 9) & 1) << 5)); }
__host__ __device__ __forceinline__ void stage_rc(int b, int& R, int& C) { const int st = b / 1024, sb = b % 1024, swz = sb ^ (((sb >> 9) & 1) << 5); R = (st >> 1) * 16 + swz / 64; C = (st & 1) * 32 + (swz % 64) / 2; }
__host__ __device__ __forceinline__ int perm32(int rho) { const int n = rho >> 4, i = rho & 15; return 8 * (i >> 2) + 4 * n + (i & 3); }

struct Unit { int pm, pn; };
struct Gemm { const bf16_t* A; const bf16_t* Bt; int M, N, K; };

struct StaticOrder {
    int nM, nN, nwg, G, c;
    __host__ __device__ void init(int M, int N, int G_, int c_) { nM = M / BM; nN = N / BM; nwg = nM * nN; G = G_; c = c_; }
    __host__ __device__ bool next(int i, Unit& u) const {
        const long L = (long)i * G + c; if (L >= nwg) return false;
        int wgid = (int)L; { const int q = nwg / NXCD, r = nwg % NXCD, xcd = wgid % NXCD, off = wgid / NXCD; wgid = (xcd < r ? xcd * (q + 1) : r * (q + 1) + (xcd - r) * q) + off; }
        const int nig = WGM * nN, gid = wgid / nig, fm = gid * WGM, gsz = (nM - fm) < WGM ? (nM - fm) : WGM;
        u.pm = fm + ((wgid % nig) % gsz); u.pn = (wgid % nig) / gsz; return true;
    }
    __device__ __forceinline__ void a_ready(const Unit&) const {}
    __device__ __forceinline__ void done(const Unit&) const {}
};

__device__ __forceinline__ unsigned cvt_pk_bf16(float lo, float hi) { unsigned r; asm volatile("v_cvt_pk_bf16_f32 %0, %1, %2" : "=v"(r) : "v"(lo), "v"(hi)); return r; }
typedef float f32x2 __attribute__((ext_vector_type(2)));

constexpr float RMS_EPS_F = 1e-5f;
__device__ __forceinline__ float row_rstd(const float* ssq, int row) {
    const f32x4* p = (const f32x4*)(ssq + (size_t)row * 16);
    const f32x4 a = p[0], b = p[1], c = p[2], d = p[3];
    const float s = ((a[0] + a[1]) + (a[2] + a[3])) + ((b[0] + b[1]) + (b[2] + b[3])) + ((c[0] + c[1]) + (c[2] + c[3])) + ((d[0] + d[1]) + (d[2] + d[3]));
    return 1.0f / sqrtf(s * (1.0f / 1024.0f) + RMS_EPS_F);
}
struct EpiIn {
    static constexpr bool PERM = true, AFTER_DRAIN = false;
    bf16_t* proj; float* idxf; const float* ssq;
    __device__ __forceinline__ void operator()(const f32x4 (&acc)[2][2][4][2], const Unit& u, int wr, int wc, int fr, int fq) const {
        const int row0 = u.pm * BM + wr * 64 + fr;
        const int colt = u.pn * BM + wc * 32 + 8 * fq;
#pragma unroll
        for (int ai = 0; ai < 2; ++ai)
#pragma unroll
            for (int m = 0; m < 4; ++m) {
                const int row = row0 + ai * HALF + m * 16;
                const float rs = row_rstd(ssq, row);
#pragma unroll
                for (int bj = 0; bj < 2; ++bj) {
                    const f32x4 v0 = acc[ai][bj][m][0] * rs, v1 = acc[ai][bj][m][1] * rs;
                    const int col = colt + bj * HALF;
                    if (u.pn < 8) {
                        u32x4 w; w.x = cvt_pk_bf16(v0[0], v0[1]); w.y = cvt_pk_bf16(v0[2], v0[3]); w.z = cvt_pk_bf16(v1[0], v1[1]); w.w = cvt_pk_bf16(v1[2], v1[3]);
                        *(u32x4*)(proj + (size_t)row * 2048 + col) = w;
                    } else {
                        float* o = idxf + (size_t)row * 512 + (col - 2048);
                        *(f32x4*)o = v0; *(f32x4*)(o + 4) = v1;
                    }
                }
            }
    }
};
struct EpiRes {
    static constexpr bool PERM = true, AFTER_DRAIN = false;
    const float* xin; float* xout; bf16_t* xb; float* ssq;
    __device__ __forceinline__ void operator()(const f32x4 (&acc)[2][2][4][2], const Unit& u, int wr, int wc, int fr, int fq) const {
        const int row0 = u.pm * BM + wr * 64 + fr;
        const int colt = u.pn * BM + wc * 32 + 8 * fq;
#pragma unroll
        for (int ai = 0; ai < 2; ++ai)
#pragma unroll
            for (int m = 0; m < 4; ++m) {
                const int row = row0 + ai * HALF + m * 16;
                float sq = 0.f;
#pragma unroll
                for (int bj = 0; bj < 2; ++bj) {
                    const size_t off = (size_t)row * 1024 + colt + bj * HALF;
                    const f32x4 a0 = *(const f32x4*)(xin + off), a1 = *(const f32x4*)(xin + off + 4);
                    const f32x4 v0 = a0 + acc[ai][bj][m][0], v1 = a1 + acc[ai][bj][m][1];
                    *(f32x4*)(xout + off) = v0; *(f32x4*)(xout + off + 4) = v1;
                    u32x4 w; w.x = cvt_pk_bf16(v0[0], v0[1]); w.y = cvt_pk_bf16(v0[2], v0[3]); w.z = cvt_pk_bf16(v1[0], v1[1]); w.w = cvt_pk_bf16(v1[2], v1[3]);
                    *(u32x4*)(xb + off) = w;
                    sq += (v0[0] * v0[0] + v0[1] * v0[1]) + (v0[2] * v0[2] + v0[3] * v0[3]) + (v1[0] * v1[0] + v1[1] * v1[1]) + (v1[2] * v1[2] + v1[3] * v1[3]);
                }
                sq += __shfl_xor(sq, 16); sq += __shfl_xor(sq, 32);
                if (fq == 0) ssq[(size_t)row * 16 + u.pn * 4 + wc] = sq;
            }
    }
};
struct EpiFfIn {
    static constexpr bool PERM = true, AFTER_DRAIN = false;
    bf16_t* hid; const float* ssq;
    __device__ __forceinline__ void operator()(const f32x4 (&acc)[2][2][4][2], const Unit& u, int wr, int wc, int fr, int fq) const {
        const int row0 = u.pm * BM + wr * 64 + fr;
        const int colt = u.pn * BM + wc * 32 + 8 * fq;
#pragma unroll
        for (int ai = 0; ai < 2; ++ai)
#pragma unroll
            for (int m = 0; m < 4; ++m) {
                const int row = row0 + ai * HALF + m * 16;
                const float rs = row_rstd(ssq, row);
#pragma unroll
                for (int bj = 0; bj < 2; ++bj) {
                    f32x4 v0 = acc[ai][bj][m][0] * rs, v1 = acc[ai][bj][m][1] * rs;
#pragma unroll
                    for (int e = 0; e < 4; ++e) { const float a = fmaxf(v0[e], 0.f), b = fmaxf(v1[e], 0.f); v0[e] = a * a; v1[e] = b * b; }
                    u32x4 w; w.x = cvt_pk_bf16(v0[0], v0[1]); w.y = cvt_pk_bf16(v0[2], v0[3]); w.z = cvt_pk_bf16(v1[0], v1[1]); w.w = cvt_pk_bf16(v1[2], v1[3]);
                    *(u32x4*)(hid + (size_t)row * 4096 + colt + bj * HALF) = w;
                }
            }
    }
};
template <class Epi, class Sched, bool ALIGN_EPI = false, bool SP2 = false>
__device__ __forceinline__ void gemm_phase(PG8_LAS unsigned char* lds, const Gemm g, const Sched& S, const Epi& E) {
    int tid_ = threadIdx.x; asm volatile("" : "+v"(tid_));
    const int tid = tid_, wid = __builtin_amdgcn_readfirstlane(tid >> 6), lane = tid & 63, wr = wid >> 2, wc = wid & 3, fr = lane & 15, fq = lane >> 4;
    const int K = g.K, nt = K / BK;
    unsigned voffA[2], voffB[2];
#pragma unroll
    for (int i = 0; i < 2; ++i) { int R, C; stage_rc(tid * 16 + i * 8192, R, C); const int Rb = Epi::PERM ? ((R & ~31) + perm32(R & 31)) : R;
        voffA[i] = (unsigned)(R * K + C) * 2u; voffB[i] = (unsigned)(Rb * K + C) * 2u; }
    const size_t kstep = (size_t)(BK * 2);
    const size_t hstep = (size_t)HALF * K * 2;
    const size_t tstep = 2 * hstep;
    const unsigned ldsw = (unsigned)wid * 1024u;
    const int aoff = lds_byte(wr * 64 + fr, fq * 8), boff = lds_byte(wc * 32 + fr, fq * 8);
#define PG8_SA(b, h) (((b) * 2 + (h)) * HTB)
#define PG8_SB(b, h) ((4 + (b) * 2 + (h)) * HTB)
#define PG8_STAGE(bufoff, gbase, voff) do { _Pragma("unroll") for (int _i = 0; _i < 2; ++_i) \
        __builtin_amdgcn_global_load_lds((const unsigned*)((const char*)(gbase) + (voff)[_i]), (PG8_LAS unsigned*)(lds + (bufoff) + ldsw + _i * 8192), 16, 0, 0); } while (0)
#define PG8_LDA(dst, b, h) do { _Pragma("unroll") for (int m = 0; m < 4; ++m) _Pragma("unroll") for (int k = 0; k < 2; ++k) dst[m][k] = *(const PG8_LAS bf16x8*)(lds + PG8_SA(b, h) + aoff + m * 2048 + k * 1024); } while (0)
#define PG8_LDB(dst, b, h) do { _Pragma("unroll") for (int n = 0; n < 2; ++n) _Pragma("unroll") for (int k = 0; k < 2; ++k) dst[n][k] = *(const PG8_LAS bf16x8*)(lds + PG8_SB(b, h) + boff + n * 2048 + k * 1024); } while (0)
#define PG8_MMA(ai, bj, At, Bt) do { __builtin_amdgcn_s_setprio(1); _Pragma("unroll") for (int m = 0; m < 4; ++m) _Pragma("unroll") for (int n = 0; n < 2; ++n) _Pragma("unroll") for (int k = 0; k < 2; ++k) \
        acc[ai][bj][m][n] = __builtin_amdgcn_mfma_f32_16x16x32_bf16(Bt[n][k], At[m][k], acc[ai][bj][m][n], 0, 0, 0); __builtin_amdgcn_s_setprio(0); } while (0)
#define PG8_WAIT_V(n) asm volatile("s_waitcnt vmcnt(" #n ")" ::: "memory")
#define PG8_WAIT_L(n) asm volatile("s_waitcnt lgkmcnt(" #n ")" ::: "memory")
#define PG8_BAR __builtin_amdgcn_s_barrier()
#define PG8_SCHED __builtin_amdgcn_sched_barrier(0)
    Unit cur, nxt; int ui = 0;
    if (!S.next(0, cur)) return;
    f32x4 acc[2][2][4][2];
#pragma unroll
    for (int a = 0; a < 2; ++a)
#pragma unroll
        for (int b = 0; b < 2; ++b)
#pragma unroll
            for (int m = 0; m < 4; ++m)
#pragma unroll
                for (int n = 0; n < 2; ++n) acc[a][b][m][n] = (f32x4){0.f, 0.f, 0.f, 0.f};
    bf16x8 At[4][2], B0[2][2], B1[2][2];
    const char* cA = (const char*)g.A + (size_t)cur.pm * tstep; const char* cB = (const char*)g.Bt + (size_t)cur.pn * tstep;
    S.a_ready(cur);
    if constexpr (SP2) {
        PG8_STAGE(PG8_SB(0, 0), cB, voffB); PG8_STAGE(PG8_SB(0, 1), cB + hstep, voffB); PG8_STAGE(PG8_SA(0, 0), cA, voffA); PG8_STAGE(PG8_SA(0, 1), cA + hstep, voffA);
        if (wr == 1) PG8_BAR;
        PG8_WAIT_V(2); PG8_BAR;
        PG8_STAGE(PG8_SB(1, 0), cB + kstep, voffB); PG8_STAGE(PG8_SA(1, 0), cA + kstep, voffA); PG8_STAGE(PG8_SB(1, 1), cB + hstep + kstep, voffB);
        PG8_WAIT_V(6); PG8_BAR;
    } else {
        PG8_STAGE(PG8_SB(0, 0), cB, voffB); PG8_STAGE(PG8_SA(0, 0), cA, voffA); PG8_STAGE(PG8_SB(0, 1), cB + hstep, voffB); PG8_STAGE(PG8_SA(0, 1), cA + hstep, voffA);
        if (wr == 1) PG8_BAR;
        PG8_WAIT_V(4); PG8_BAR;
        PG8_STAGE(PG8_SB(1, 0), cB + kstep, voffB); PG8_STAGE(PG8_SA(1, 0), cA + kstep, voffA); PG8_STAGE(PG8_SB(1, 1), cB + hstep + kstep, voffB);
        PG8_WAIT_V(6); PG8_BAR;
    }
    for (;;) {
        const bool has_next = S.next(ui + 1, nxt);
        const char* nA = has_next ? (const char*)g.A + (size_t)nxt.pm * tstep : cA; const char* nB = has_next ? (const char*)g.Bt + (size_t)nxt.pn * tstep : cB;
        for (int t = 0; t < nt; t += 2) {
            const bool last = (t == nt - 2);
            const char* a1 = cA + (size_t)(t + 1) * kstep;
            const char* a2 = last ? nA : cA + (size_t)(t + 2) * kstep; const char* b2 = last ? nB : cB + (size_t)(t + 2) * kstep;
            const char* a3 = a2 + kstep; const char* b3 = b2 + kstep;
            if (last && has_next) S.a_ready(nxt);
            if constexpr (SP2) {
            PG8_LDB(B0, 0, 0); PG8_LDB(B1, 0, 1); PG8_SCHED; PG8_LDA(At, 0, 0); PG8_STAGE(PG8_SA(1, 1), a1 + hstep, voffA);
            PG8_WAIT_V(8); PG8_WAIT_L(0); PG8_BAR; PG8_MMA(0, 0, At, B0); PG8_MMA(0, 1, At, B1); PG8_BAR; PG8_SCHED;
            PG8_LDA(At, 0, 1); PG8_STAGE(PG8_SB(0, 0), b2, voffB); PG8_STAGE(PG8_SB(0, 1), b2 + hstep, voffB); PG8_STAGE(PG8_SA(0, 0), a2, voffA);
            PG8_WAIT_V(8); PG8_WAIT_L(0); PG8_BAR; PG8_MMA(1, 0, At, B0); PG8_MMA(1, 1, At, B1); PG8_BAR; PG8_SCHED;
            PG8_LDB(B0, 1, 0); PG8_LDB(B1, 1, 1); PG8_SCHED; PG8_LDA(At, 1, 0); PG8_STAGE(PG8_SA(0, 1), a2 + hstep, voffA);
            PG8_WAIT_V(8); PG8_WAIT_L(0); PG8_BAR; PG8_MMA(0, 0, At, B0); PG8_MMA(0, 1, At, B1); PG8_BAR; PG8_SCHED;
            PG8_LDA(At, 1, 1); PG8_STAGE(PG8_SB(1, 0), b3, voffB); PG8_STAGE(PG8_SB(1, 1), b3 + hstep, voffB); PG8_STAGE(PG8_SA(1, 0), a3, voffA);
            PG8_WAIT_V(8); PG8_WAIT_L(0); PG8_BAR; PG8_MMA(1, 0, At, B0); PG8_MMA(1, 1, At, B1); PG8_BAR; PG8_SCHED;
            } else {
            PG8_LDB(B0, 0, 0); PG8_SCHED; PG8_LDA(At, 0, 0); PG8_STAGE(PG8_SA(1, 1), a1 + hstep, voffA);
            PG8_WAIT_L(8); PG8_BAR; PG8_WAIT_L(0); PG8_MMA(0, 0, At, B0); PG8_BAR; PG8_SCHED;
            PG8_LDB(B1, 0, 1); PG8_STAGE(PG8_SB(0, 0), b2, voffB);
            PG8_BAR; PG8_WAIT_L(0); PG8_MMA(0, 1, At, B1); PG8_BAR;
            PG8_LDA(At, 0, 1); PG8_STAGE(PG8_SA(0, 0), a2, voffA);
            PG8_BAR; PG8_WAIT_L(0); PG8_MMA(1, 0, At, B0); PG8_BAR; PG8_SCHED;
            PG8_STAGE(PG8_SB(0, 1), b2 + hstep, voffB);
            PG8_WAIT_V(6); PG8_BAR; PG8_MMA(1, 1, At, B1); PG8_BAR;
            PG8_LDB(B0, 1, 0); PG8_SCHED; PG8_LDA(At, 1, 0); PG8_STAGE(PG8_SA(0, 1), a2 + hstep, voffA);
            PG8_WAIT_L(8); PG8_BAR; PG8_WAIT_L(0); PG8_MMA(0, 0, At, B0); PG8_BAR; PG8_SCHED;
            PG8_LDB(B1, 1, 1); PG8_STAGE(PG8_SB(1, 0), b3, voffB);
            PG8_BAR; PG8_WAIT_L(0); PG8_MMA(0, 1, At, B1); PG8_BAR;
            PG8_LDA(At, 1, 1); PG8_STAGE(PG8_SA(1, 0), a3, voffA);
            PG8_BAR; PG8_WAIT_L(0); PG8_MMA(1, 0, At, B0); PG8_BAR; PG8_SCHED;
            PG8_STAGE(PG8_SB(1, 1), b3 + hstep, voffB);
            PG8_WAIT_V(6); PG8_BAR; PG8_MMA(1, 1, At, B1); PG8_BAR;
            }
        }
        if constexpr (ALIGN_EPI) { if (wr == 0) PG8_BAR; }
        if constexpr (!Epi::AFTER_DRAIN) { E(acc, cur, wr, wc, fr, fq); S.done(cur); }
        if (!has_next) break;
#pragma unroll
        for (int a = 0; a < 2; ++a)
#pragma unroll
            for (int b = 0; b < 2; ++b)
#pragma unroll
                for (int m = 0; m < 4; ++m)
#pragma unroll
                    for (int n = 0; n < 2; ++n) acc[a][b][m][n] = (f32x4){0.f, 0.f, 0.f, 0.f};
        cur = nxt; cA = nA; cB = nB; ++ui;
        if constexpr (ALIGN_EPI) { if (wr == 1) PG8_BAR; }
    }
    PG8_WAIT_V(0);
    if constexpr (!ALIGN_EPI) { if (wr == 0) PG8_BAR; }
    PG8_BAR;
    if constexpr (Epi::AFTER_DRAIN) { E.fused(acc, cur, wr, wc, fr, fq, lds, wid, lane); S.done(cur); }
#undef PG8_SA
#undef PG8_SB
#undef PG8_STAGE
#undef PG8_LDA
#undef PG8_LDB
#undef PG8_MMA
#undef PG8_WAIT_V
#undef PG8_WAIT_L
#undef PG8_BAR
#undef PG8_SCHED
}
}

constexpr int BATCH = 8, SEQ = 2048, DM = 1024, DEPTH = 4, M = BATCH * SEQ, DIN = 2372, DINP = 2560, DFF = 4096;
constexpr int NWAVES = 8, NTHR = NWAVES * 64;
constexpr int TOPK = 256;
constexpr int PC_POOL = 0, PC_HQ = 256, PC_HF = 512, PC_HI = 768, PC_HG = 1024, PC_Q = 1280, PC_K = 1792, PC_V = 1920, PROJ_LD = 2048;
constexpr int IC_QI = 0, IC_KI = 256, IC_WI = 320, IDX_LD = 512;
constexpr int MC_POOL = 0, MC_HGRN = 256, MC_ATTN = 512;

constexpr size_t MiB = 1u << 20;
constexpr size_t WS_CTL = 0, CTL_ZERO_BYTES = 1 * MiB;
constexpr size_t WS_ROPE = 1 * MiB;
constexpr size_t WS_SSQ = 2 * MiB;
constexpr size_t WS_LB = 3 * MiB;
constexpr size_t WS_MASK = 4 * MiB;
constexpr size_t WS_WIN = 8 * MiB;
constexpr size_t WS_WOUT = 13 * MiB;
constexpr size_t WS_WFI = 15 * MiB;
constexpr size_t WS_WFO = 23 * MiB;
constexpr size_t WS_XB = 32 * MiB;
constexpr size_t WS_HID = 64 * MiB;
constexpr size_t WS_PROJ = 64 * MiB;
constexpr size_t WS_MIXED = 128 * MiB;
constexpr size_t WS_IDXF = 192 * MiB;
constexpr size_t WS_END = 256 * MiB;
constexpr int CW_TMO = 0, CW_BAR = 4096;

constexpr int RING_OFF = 0, RING_BYTES = 131072;
constexpr int LDSCTL_OFF = RING_BYTES, MISC_OFF = LDSCTL_OFF + 320;
constexpr int LDS_BYTES = 147456;

#define GAS __attribute__((address_space(1)))
#define LAS __attribute__((address_space(3)))
typedef unsigned short bf16;
typedef unsigned v4u __attribute__((ext_vector_type(4)));
typedef unsigned v2u __attribute__((ext_vector_type(2)));
typedef float f32x4 __attribute__((ext_vector_type(4)));
typedef GAS unsigned gu32;
#define RLX_AGENT __ATOMIC_RELAXED, __HIP_MEMORY_SCOPE_AGENT
#define LDS_WAIT() asm volatile("s_waitcnt lgkmcnt(0)" ::: "memory")
__device__ __forceinline__ unsigned f2bf(float f) { unsigned u = __builtin_bit_cast(unsigned, f); return (u + 0x7fffu + ((u >> 16) & 1u)) >> 16; }
__device__ __forceinline__ unsigned pk2(float lo, float hi) { return f2bf(lo) | (f2bf(hi) << 16); }
__device__ __forceinline__ float bf2f(unsigned short h) { return __builtin_bit_cast(float, (unsigned)h << 16); }
__device__ __forceinline__ float wave_sum(float v) {
#pragma unroll
    for (int o = 1; o < 64; o <<= 1) v += __shfl_xor(v, o);
    return v;
}
__device__ __forceinline__ float wave_max(float v) {
#pragma unroll
    for (int o = 1; o < 64; o <<= 1) v = fmaxf(v, __shfl_xor(v, o));
    return v;
}
#define XB_TMO      128
#define XB_XCNT(j)  (256  + 64 * (j))
#define XB_XSUB(j)  (1280 + 64 * (j))
#define XB_XGEN(j)  (2304 + 64 * (j))
#define XB_TOP      3328
#define XB_TOPGEN   3392
#define XCD_BAR_WORDS 3456
#define XB_SPIN_CAP (1u << 18)

__device__ __forceinline__ unsigned xb_ld(unsigned* p)              { return __hip_atomic_load(p, __ATOMIC_RELAXED, __HIP_MEMORY_SCOPE_AGENT); }
__device__ __forceinline__ unsigned xb_add(unsigned* p, unsigned v) { return __hip_atomic_fetch_add(p, v, __ATOMIC_RELAXED, __HIP_MEMORY_SCOPE_AGENT); }
__device__ __forceinline__ unsigned xb_xcc_id() { return (unsigned)__builtin_amdgcn_s_getreg((3 << 11) | 20) & 0xFu; }
#define XB_SPIN(cond, bar) do { unsigned _sp = 0; while (cond) { __builtin_amdgcn_s_sleep(1); \
    if ((++_sp & 255u) == 0u) { if (xb_ld(&(bar)[XB_TMO])) break; if (_sp > XB_SPIN_CAP) { atomicAdd(&(bar)[XB_TMO], 1u); break; } } } } while (0)

struct XcdBarrier {
    unsigned* bar; unsigned x;
    volatile LAS unsigned* st;
};

__device__ __forceinline__ XcdBarrier xcd_barrier_post(unsigned* bar, volatile LAS unsigned* st) {
    XcdBarrier b; b.bar = bar; b.x = xb_xcc_id(); b.st = st;
    if (threadIdx.x == 0) (void)xb_add(&bar[XB_XCNT(b.x)], 1u);
    return b;
}
__device__ __forceinline__ void xcd_barrier_complete(unsigned* bar, unsigned x, unsigned& nloc, unsigned& nx) {
    const unsigned G = gridDim.x * gridDim.y * gridDim.z;
    unsigned sum, cnt, mine, sp = 0u;
    for (;;) {
        sum = 0u; cnt = 0u; mine = 0u;
#pragma unroll
        for (unsigned j = 0; j < 16; ++j) { const unsigned c = xb_ld(&bar[XB_XCNT(j)]); sum += c; cnt += (c > 0u) ? 1u : 0u; mine = (j == x) ? c : mine; }
        if (sum == G) break;
        __builtin_amdgcn_s_sleep(1);
        if ((++sp & 255u) == 0u) { if (xb_ld(&bar[XB_TMO])) break; if (sp > XB_SPIN_CAP) { atomicAdd(&bar[XB_TMO], 1u); break; } }
    }
    nloc = mine > 0u ? mine : 1u; nx = cnt > 0u ? cnt : 1u;
}

__device__ __forceinline__ void xcd_barrier(const XcdBarrier& b) {
    asm volatile("s_waitcnt vmcnt(0)" ::: "memory");
    __syncthreads();
    if (threadIdx.x == 0) {
        unsigned* bar = b.bar;
        __builtin_amdgcn_s_waitcnt(0);
        unsigned nloc = b.st[0], nx = b.st[1];
        if (nloc == 0u) { xcd_barrier_complete(bar, b.x, nloc, nx); b.st[0] = nloc; b.st[1] = nx; }
        const unsigned old = xb_add(&bar[XB_XSUB(b.x)], 1u);
        const unsigned gen = old / nloc;
        if (old + 1u == (gen + 1u) * nloc) {
            __builtin_amdgcn_fence(__ATOMIC_RELEASE, "agent");
            asm volatile("s_waitcnt vmcnt(0)" ::: "memory");
            const unsigned og = xb_add(&bar[XB_TOP], 1u);
            const unsigned tg = og / nx;
            if (og + 1u == (tg + 1u) * nx) xb_add(&bar[XB_TOPGEN], 1u);
            else XB_SPIN(xb_ld(&bar[XB_TOPGEN]) == tg, bar);
            __builtin_amdgcn_fence(__ATOMIC_ACQUIRE, "agent");
            xb_add(&bar[XB_XGEN(b.x)], 1u);
            asm volatile("s_waitcnt vmcnt(0)" ::: "memory");
        } else {
            XB_SPIN(xb_ld(&bar[XB_XGEN(b.x)]) == gen, bar);
            __builtin_amdgcn_fence(__ATOMIC_ACQUIRE, "agent");
            asm volatile("s_waitcnt vmcnt(0)" ::: "memory");
        }
    }
    __syncthreads();
}


struct Frame {
    LAS unsigned char* lds;
    volatile LAS unsigned* MISC;
    gu32* ctl;
    int tid, lane, wave, G, bid;
    const float* x_in; const int* pos;
    const float *n1g, *w_in, *pool_w, *pool_scale, *lb_logits, *hgrn_g, *w_out, *n2g, *w_ff_in, *w_ff_out, *fng;
    float* xres;
    unsigned char* ws;
};
__constant__ float c_invf[8] = {1.0f, 0.19392274474868576f, 0.03760603093086393f, 0.007292664737217109f, 0.001414213562373095f, 0.0002742481756762073f, 5.318295896944988e-05f, 1.031338537721246e-05f};

__device__ __forceinline__ void cvt_item(const float* W, const float* g, int K, int N, bf16* WT, LAS float* scr, int kb, int nb, int lane) {
    const int k0 = 64 * kb, n0 = 32 * nb;
    const int n = n0 + (lane & 31);
#pragma unroll 8
    for (int i = 0; i < 32; ++i) { const int kk = 2 * i + (lane >> 5); float v = (n < N) ? W[(size_t)(k0 + kk) * N + n] : 0.f; if (g) v *= g[k0 + kk]; scr[kk * 33 + (lane & 31)] = v; }
    LDS_WAIT(); asm volatile("" ::: "memory");
    const int c = lane & 7;
#pragma unroll
    for (int j = 0; j < 4; ++j) { const int nl = (lane >> 3) + 8 * j; const LAS float* s = scr + (8 * c) * 33 + nl;
        v4u o; o.x = pk2(s[0 * 33], s[1 * 33]); o.y = pk2(s[2 * 33], s[3 * 33]); o.z = pk2(s[4 * 33], s[5 * 33]); o.w = pk2(s[6 * 33], s[7 * 33]);
        *(GAS v4u*)(WT + (size_t)(n0 + nl) * K + k0 + 8 * c) = o; }
    LDS_WAIT(); asm volatile("" ::: "memory");
}
__device__ __forceinline__ void cvt_matrix(Frame& F, const float* W, const float* g, int K, int N, int Npad, bf16* WT) {
    LAS float* scr = (LAS float*)(F.lds + RING_OFF + F.wave * 16384);
    const int gw = F.bid * NWAVES + F.wave, NGW = F.G * NWAVES;
    const int nblk = Npad / 32, nitems = (K / 64) * nblk;
    for (int it = gw; it < nitems; it += NGW) cvt_item(W, g, K, N, WT, scr, it / nblk, it % nblk, F.lane);
}
__device__ __forceinline__ void cvt_layer_rest(Frame& F, int layer) {
    cvt_matrix(F, F.w_out + (size_t)layer * DM * DM, nullptr, DM, DM, DM, (bf16*)(F.ws + WS_WOUT));
    cvt_matrix(F, F.w_ff_in + (size_t)layer * DM * DFF, F.n2g + layer * DM, DM, DFF, DFF, (bf16*)(F.ws + WS_WFI));
    cvt_matrix(F, F.w_ff_out + (size_t)layer * DFF * DM, nullptr, DFF, DM, DM, (bf16*)(F.ws + WS_WFO));
    if (layer + 1 < DEPTH) cvt_matrix(F, F.w_in + (size_t)(layer + 1) * DM * DIN, F.n1g + (layer + 1) * DM, DM, DIN, DINP, (bf16*)(F.ws + WS_WIN));
}

__device__ __forceinline__ void p_prologue(Frame& F) {
    const int gtid = F.bid * NTHR + F.tid, NT = F.G * NTHR;
    float* tab = (float*)(F.ws + WS_ROPE);
    for (int idx = gtid; idx < M * 8; idx += NT) {
        const int row = idx >> 3, i = idx & 7;
        const float angf = (float)F.pos[row] * c_invf[i];
        double r = (double)angf * 0.15915494309189535; r -= floor(r);
        const float a = (float)(r * 6.283185307179586);
        tab[row * 16 + i] = cosf(a); tab[row * 16 + 8 + i] = sinf(a);
    }
    if (gtid < 256) {
        const int c = gtid; float* lb = (float*)(F.ws + WS_LB);
        const float l0 = F.lb_logits[c], l1 = F.lb_logits[256 + c], l2 = F.lb_logits[512 + c], l3 = F.lb_logits[768 + c];
        const float mx = fmaxf(fmaxf(l0, l1), fmaxf(l2, l3));
        const float e0 = expf(l0 - mx), e1 = expf(l1 - mx), e2 = expf(l2 - mx), e3 = expf(l3 - mx);
        const float inv = 1.0f / (e0 + e1 + e2 + e3);
        lb[c] = 0.f; lb[256 + c] = e1 * inv; lb[512 + c] = (e1 + e2) * inv; lb[768 + c] = (e1 + e2 + e3) * inv;
    }
    const int gw = F.bid * NWAVES + F.wave, NGW = F.G * NWAVES;
    bf16* xb = (bf16*)(F.ws + WS_XB); float* ssq = (float*)(F.ws + WS_SSQ);
    for (int row = gw; row < M; row += NGW) {
        const f32x4* xr = (const f32x4*)(F.x_in + (size_t)row * DM) + F.lane;
        f32x4 v[4]; float s = 0.f;
#pragma unroll
        for (int j = 0; j < 4; ++j) { v[j] = xr[64 * j]; s += (v[j][0] * v[j][0] + v[j][1] * v[j][1]) + (v[j][2] * v[j][2] + v[j][3] * v[j][3]); }
        s = wave_sum(s);
        unsigned long long* o8 = (unsigned long long*)(xb + (size_t)row * DM) + F.lane;
#pragma unroll
        for (int j = 0; j < 4; ++j) o8[64 * j] = (unsigned long long)pk2(v[j][0], v[j][1]) | ((unsigned long long)pk2(v[j][2], v[j][3]) << 32);
        if (F.lane < 16) ssq[(size_t)row * 16 + F.lane] = (F.lane == 0) ? s : 0.f;
    }
    cvt_matrix(F, F.w_in, F.n1g, DM, DIN, DINP, (bf16*)(F.ws + WS_WIN));
}

__device__ __forceinline__ void p_rope(Frame& F) {
    const int gtid = F.bid * NTHR + F.tid, NT = F.G * NTHR;
    const float* tab = (const float*)(F.ws + WS_ROPE);
    bf16* proj = (bf16*)(F.ws + WS_PROJ); float* idxf = (float*)(F.ws + WS_IDXF);
    for (int idx = gtid; idx < M * 15 * 8; idx += NT) {
        const int i = idx & 7, rh = idx >> 3, hh = rh % 15, row = rh / 15;
        const float c = tab[row * 16 + i], s = tab[row * 16 + 8 + i];
        if (hh < 10) {
            const int col = hh < 8 ? PC_Q + hh * 64 : PC_K + (hh - 8) * 64;
            bf16* p = proj + (size_t)row * PROJ_LD + col;
            const float x1 = bf2f(p[i]), x2 = bf2f(p[8 + i]);
            p[i] = (bf16)f2bf(x1 * c - x2 * s); p[8 + i] = (bf16)f2bf(x2 * c + x1 * s);
        } else {
            const int col = hh < 14 ? IC_QI + (hh - 10) * 64 : IC_KI;
            float* p = idxf + (size_t)row * IDX_LD + col;
            const float x1 = p[i], x2 = p[8 + i];
            p[i] = x1 * c - x2 * s; p[8 + i] = x2 * c + x1 * s;
        }
    }
}

__device__ __forceinline__ void p_pool(Frame& F, int layer) {
    LAS float* P = (LAS float*)(F.lds + RING_OFF);
    const bf16* proj = (const bf16*)(F.ws + WS_PROJ); bf16* mixed = (bf16*)(F.ws + WS_MIXED);
    const float* pw = F.pool_w + (size_t)layer * 4 * 64 * 64; const float* ps = F.pool_scale + layer * 256;
    const int c = F.tid & 255, half = F.tid >> 8, g = c >> 6, win = 2 << g, dd = c & 63;
    for (int unit = F.bid; unit < M / 16; unit += F.G) {
        const int t0 = unit * 16;
        for (int tt = half * 8; tt < half * 8 + 8; ++tt) {
            const int row = t0 + tt, tloc = row & (SEQ - 1); const int cnt = (tloc + 1 < win) ? tloc + 1 : win;
            float s = 0.f;
            for (int j = 0; j < cnt; ++j) s += bf2f(proj[(size_t)(row - j) * PROJ_LD + PC_POOL + c]);
            P[tt * 256 + c] = s / (float)cnt - bf2f(proj[(size_t)row * PROJ_LD + PC_POOL + c]);
        }
        __syncthreads();
        for (int tt = half * 8; tt < half * 8 + 8; ++tt) {
            float y = 0.f;
#pragma unroll 8
            for (int cc = 0; cc < 64; ++cc) y += P[tt * 256 + g * 64 + cc] * pw[(g * 64 + cc) * 64 + dd];
            mixed[(size_t)(t0 + tt) * DM + MC_POOL + c] = (bf16)f2bf(y * ps[c]);
        }
        __syncthreads();
    }
}

__device__ __forceinline__ unsigned sort_key(float v) { if (v == 0.f) v = 0.f; const unsigned u = __builtin_bit_cast(unsigned, v); return (u & 0x80000000u) ? ~u : (u | 0x80000000u); }
__device__ __forceinline__ void p_mask(Frame& F) {
    LAS float* qi_s = (LAS float*)(F.lds + RING_OFF);
    LAS unsigned* red_s = (LAS unsigned*)(F.lds + RING_OFF + 1024);
    const float* idxf = (const float*)(F.ws + WS_IDXF); unsigned* mask = (unsigned*)(F.ws + WS_MASK);
    const int tid = F.tid, lane = F.lane, wave = F.wave;
    for (int row = F.bid; row < M; row += F.G) {
        const int b = row >> 11, t = row & (SEQ - 1), n = t + 1;
        unsigned* mrow = mask + (size_t)row * 64;
        if (n <= TOPK) {
            if (tid < 64) { const int lo = tid * 32; mrow[tid] = (n >= lo + 32) ? 0xffffffffu : (n > lo ? ((1u << (n - lo)) - 1u) : 0u); }
            continue;
        }
        if (tid < 256) qi_s[tid] = idxf[(size_t)row * IDX_LD + IC_QI + tid];
        const f32x4 wv = *(const f32x4*)(idxf + (size_t)row * IDX_LD + IC_WI);
        __syncthreads();
        unsigned key[4];
#pragma unroll
        for (int i = 0; i < 4; ++i) {
            const int s = i * 512 + tid; key[i] = 0u;
            if (s < n) {
                const f32x4* kp = (const f32x4*)(idxf + (size_t)(b * SEQ + s) * IDX_LD + IC_KI);
                float d0 = 0.f, d1 = 0.f, d2 = 0.f, d3 = 0.f;
#pragma unroll 4
                for (int d = 0; d < 16; ++d) {
                    const f32x4 kv = kp[d];
                    const f32x4 q0 = *(const LAS f32x4*)(qi_s + d * 4), q1 = *(const LAS f32x4*)(qi_s + 64 + d * 4), q2 = *(const LAS f32x4*)(qi_s + 128 + d * 4), q3 = *(const LAS f32x4*)(qi_s + 192 + d * 4);
                    d0 += kv[0] * q0[0] + kv[1] * q0[1] + kv[2] * q0[2] + kv[3] * q0[3];
                    d1 += kv[0] * q1[0] + kv[1] * q1[1] + kv[2] * q1[2] + kv[3] * q1[3];
                    d2 += kv[0] * q2[0] + kv[1] * q2[1] + kv[2] * q2[2] + kv[3] * q2[3];
                    d3 += kv[0] * q3[0] + kv[1] * q3[1] + kv[2] * q3[2] + kv[3] * q3[3];
                }
                const float I = wv[0] * fmaxf(d0, 0.f) + wv[1] * fmaxf(d1, 0.f) + wv[2] * fmaxf(d2, 0.f) + wv[3] * fmaxf(d3, 0.f);
                key[i] = sort_key(I);
            }
        }
        unsigned prefix = 0u; int par = 0;
        for (int bit = 31; bit >= 0; --bit) {
            const unsigned cand = prefix | (1u << bit);
            unsigned wc_ = 0u;
#pragma unroll
            for (int i = 0; i < 4; ++i) wc_ += (unsigned)__popcll(__ballot(key[i] >= cand));
            if (lane == 0) red_s[par * 8 + wave] = wc_;
            __syncthreads();
            unsigned tot = 0u;
#pragma unroll
            for (int w = 0; w < 8; ++w) tot += red_s[par * 8 + w];
            if (tot >= (unsigned)TOPK) prefix = cand;
            par ^= 1;
        }
        const unsigned tau = prefix;
        unsigned long long eqb[4]; unsigned gtc = 0u;
#pragma unroll
        for (int i = 0; i < 4; ++i) { eqb[i] = __ballot(key[i] == tau); gtc += (unsigned)__popcll(__ballot(key[i] > tau)); if (lane == 0) red_s[16 + i * 8 + wave] = (unsigned)__popcll(eqb[i]); }
        if (lane == 0) red_s[par * 8 + wave] = gtc;
        __syncthreads();
        unsigned cgt = 0u;
#pragma unroll
        for (int w = 0; w < 8; ++w) cgt += red_s[par * 8 + w];
        const unsigned need = (unsigned)TOPK - cgt;
#pragma unroll
        for (int i = 0; i < 4; ++i) {
            const int g = i * 8 + wave; unsigned base = 0u;
            for (int gg = 0; gg < g; ++gg) base += red_s[16 + gg];
            const unsigned rank = base + (unsigned)__popcll(eqb[i] & ((1ull << lane) - 1ull));
            const bool sel = (key[i] > tau) || ((key[i] == tau) && (rank < need));
            const unsigned long long sb = __ballot(sel);
            if (lane == 0) { mrow[g * 2] = (unsigned)sb; mrow[g * 2 + 1] = (unsigned)(sb >> 32); }
        }
        __syncthreads();
    }
}

__device__ __forceinline__ void p_hgrn_seq(Frame& F, int layer) {
    if (F.wave != 0 || F.bid >= 32) return;
    const int b = F.bid >> 2, h = F.bid & 3, lane = F.lane;
    LAS float* Fs = (LAS float*)(F.lds + RING_OFF); LAS float* Ks = Fs + 4096; LAS float* Qs = Ks + 4096;
    const bf16* proj = (const bf16*)(F.ws + WS_PROJ); bf16* mixed = (bf16*)(F.ws + WS_MIXED);
    const float lbv = ((const float*)(F.ws + WS_LB))[layer * 256 + h * 64 + lane];
    const float ng = F.hgrn_g[layer * 256 + h * 64 + lane];
    float S[64];
#pragma unroll
    for (int k = 0; k < 64; ++k) S[k] = 0.f;
    for (int chunk = 0; chunk < SEQ / 64; ++chunk) {
        const size_t row0 = (size_t)b * SEQ + chunk * 64;
        for (int tt = 0; tt < 64; ++tt) {
            const bf16* pr = proj + (row0 + tt) * PROJ_LD + h * 64 + lane;
            const float z = bf2f(pr[PC_HF]), qr = bf2f(pr[PC_HQ]);
            const float sig = 1.0f / (1.0f + expf(-z));
            float f = lbv + (1.0f - lbv) * sig; f = fmaxf(f, 1e-30f);
            Fs[tt * 64 + lane] = f; Ks[tt * 64 + lane] = (1.0f - lbv) * (1.0f - sig); Qs[tt * 64 + lane] = qr / (1.0f + expf(-qr));
        }
        LDS_WAIT(); asm volatile("" ::: "memory");
        for (int tt = 0; tt < 64; ++tt) {
            const bf16* pr = proj + (row0 + tt) * PROJ_LD + h * 64 + lane;
            const float iv = bf2f(pr[PC_HI]), gr = bf2f(pr[PC_HG]);
            float o = 0.f;
#pragma unroll
            for (int k = 0; k < 64; k += 4) {
                const f32x4 f4 = *(const LAS f32x4*)(Fs + tt * 64 + k), k4 = *(const LAS f32x4*)(Ks + tt * 64 + k), q4 = *(const LAS f32x4*)(Qs + tt * 64 + k);
#pragma unroll
                for (int e = 0; e < 4; ++e) { S[k + e] = f4[e] * S[k + e] + k4[e] * iv; o += q4[e] * S[k + e]; }
            }
            const float ms = wave_sum(o * o) * (1.0f / 64.0f);
            const float y = o * (1.0f / sqrtf(ms + 1e-5f)) * ng * (gr / (1.0f + expf(-gr)));
            mixed[(row0 + tt) * DM + MC_HGRN + h * 64 + lane] = (bf16)f2bf(y);
        }
        LDS_WAIT(); asm volatile("" ::: "memory");
    }
}

__device__ __forceinline__ void p_attn_gather(Frame& F) {
    LAS int* list = (LAS int*)(F.lds + RING_OFF);
    LAS float* qs = (LAS float*)(F.lds + RING_OFF + 1024);
    LAS float* ps = (LAS float*)(F.lds + RING_OFF + 1024 + 2048);
    LAS int* nsel_s = (LAS int*)(F.lds + RING_OFF + 1024 + 2048 + 8192);
    const bf16* proj = (const bf16*)(F.ws + WS_PROJ); bf16* mixed = (bf16*)(F.ws + WS_MIXED); const unsigned* mask = (const unsigned*)(F.ws + WS_MASK);
    const int tid = F.tid, lane = F.lane, wave = F.wave;
    for (int row = F.bid; row < M; row += F.G) {
        const int b = row >> 11;
        if (wave == 0) {
            unsigned w = mask[(size_t)row * 64 + lane];
            const int c = __popc(w); int incl = c;
#pragma unroll
            for (int o = 1; o < 64; o <<= 1) { const int v = __shfl_up(incl, o); if (lane >= o) incl += v; }
            int p = incl - c;
            while (w) { const int bit = __ffs(w) - 1; list[p++] = lane * 32 + bit; w &= w - 1u; }
            if (lane == 63) nsel_s[0] = incl;
        }
        qs[tid] = bf2f(proj[(size_t)row * PROJ_LD + PC_Q + tid]);
        __syncthreads();
        const int nsel = nsel_s[0];
        const int h = wave, kvh = h >> 2;
        float sc[4]; float mx = -3.0e38f;
#pragma unroll
        for (int i = 0; i < 4; ++i) {
            const int j = i * 64 + lane; sc[i] = -3.0e38f;
            if (j < nsel) {
                const int s = list[j];
                const v4u* kp = (const v4u*)(proj + (size_t)(b * SEQ + s) * PROJ_LD + PC_K + kvh * 64);
                float d = 0.f;
#pragma unroll
                for (int c8 = 0; c8 < 8; ++c8) {
                    const v4u kv = kp[c8]; const LAS float* qp = qs + h * 64 + c8 * 8;
                    d += __builtin_bit_cast(float, kv.x << 16) * qp[0] + __builtin_bit_cast(float, kv.x & 0xffff0000u) * qp[1]
                       + __builtin_bit_cast(float, kv.y << 16) * qp[2] + __builtin_bit_cast(float, kv.y & 0xffff0000u) * qp[3]
                       + __builtin_bit_cast(float, kv.z << 16) * qp[4] + __builtin_bit_cast(float, kv.z & 0xffff0000u) * qp[5]
                       + __builtin_bit_cast(float, kv.w << 16) * qp[6] + __builtin_bit_cast(float, kv.w & 0xffff0000u) * qp[7];
                }
                sc[i] = d * 0.125f;
            }
            mx = fmaxf(mx, sc[i]);
        }
        mx = wave_max(mx);
        float e[4]; float sum = 0.f;
#pragma unroll
        for (int i = 0; i < 4; ++i) { const int j = i * 64 + lane; e[i] = (j < nsel) ? expf(sc[i] - mx) : 0.f; sum += e[i]; }
        sum = wave_sum(sum);
        const float inv = 1.0f / sum;
#pragma unroll
        for (int i = 0; i < 4; ++i) ps[h * 256 + i * 64 + lane] = e[i] * inv;
        LDS_WAIT(); asm volatile("" ::: "memory");
        float o = 0.f;
        for (int j = 0; j < nsel; ++j) {
            const int s = list[j];
            o += ps[h * 256 + j] * bf2f(proj[(size_t)(b * SEQ + s) * PROJ_LD + PC_V + kvh * 64 + lane]);
        }
        mixed[(size_t)row * DM + MC_ATTN + h * 64 + lane] = (bf16)f2bf(o);
        __syncthreads();
    }
}

__device__ __forceinline__ void p_final(Frame& F) {
    const int gw = F.bid * NWAVES + F.wave, NGW = F.G * NWAVES;
    for (int row = gw; row < M; row += NGW) {
        f32x4* xr = (f32x4*)(F.xres + (size_t)row * DM) + F.lane;
        const f32x4* gr = (const f32x4*)F.fng + F.lane;
        f32x4 v[4]; float s = 0.f;
#pragma unroll
        for (int j = 0; j < 4; ++j) { v[j] = xr[64 * j]; s += (v[j][0] * v[j][0] + v[j][1] * v[j][1]) + (v[j][2] * v[j][2] + v[j][3] * v[j][3]); }
        s = wave_sum(s);
        const float rs = 1.0f / sqrtf(s * (1.0f / 1024.0f) + 1e-5f);
#pragma unroll
        for (int j = 0; j < 4; ++j) xr[64 * j] = v[j] * rs * gr[64 * j];
    }
}

#ifndef MK_SINGLE
#define MK_SINGLE 0
#endif
constexpr int NPL = 8;
constexpr int NPHASE = 1 + DEPTH * NPL + 1;
struct Args { const float* x; const int* pos; const float *n1g, *w_in, *pool_w, *pool_scale, *lb_logits, *hgrn_g, *w_out, *n2g, *w_ff_in, *w_ff_out, *fng; float* out; unsigned char* ws; int ph_lo, ph_hi; };
static_assert(sizeof(Args) == 15 * 8 + 8, "Args has no padding");


#define PHASE_BEGIN() do { int t_ = threadIdx.x; asm volatile("" : "+v"(t_)); F.tid = t_; F.lane = t_ & 63; F.wave = __builtin_amdgcn_readfirstlane(t_ >> 6); \
    unsigned char* w_ = args.ws; asm volatile("" : "+s"(w_)); F.ws = w_; } while (0)
__global__ void __launch_bounds__(NTHR, 2) fwd(Args args) {
    extern __shared__ __attribute__((aligned(16))) unsigned char lds[];
    Frame F;
    F.lds = (LAS unsigned char*)lds;
    F.MISC = (volatile LAS unsigned*)(F.lds + MISC_OFF);
    F.tid = threadIdx.x; F.lane = F.tid & 63; F.wave = __builtin_amdgcn_readfirstlane(F.tid >> 6);
    F.G = gridDim.x; F.bid = blockIdx.x;
    F.ws = args.ws; F.ctl = (gu32*)(args.ws + WS_CTL);
    F.x_in = args.x; F.pos = args.pos; F.n1g = args.n1g; F.w_in = args.w_in; F.pool_w = args.pool_w; F.pool_scale = args.pool_scale; F.lb_logits = args.lb_logits;
    F.hgrn_g = args.hgrn_g; F.w_out = args.w_out; F.n2g = args.n2g; F.w_ff_in = args.w_ff_in; F.w_ff_out = args.w_ff_out; F.fng = args.fng; F.xres = args.out;
    for (int u = F.tid; u < (LDS_BYTES - LDSCTL_OFF) / 4; u += NTHR) ((LAS unsigned*)(F.lds + LDSCTL_OFF))[u] = 0u;
    __syncthreads();
    XcdBarrier bar; bar.bar = (unsigned*)(F.ctl + CW_BAR); bar.x = 0; bar.st = nullptr;
    if (MK_SINGLE) bar = xcd_barrier_post((unsigned*)(F.ctl + CW_BAR), F.MISC + 8);
    const int lo = args.ph_lo, hi = args.ph_hi;
#define IN(k) (lo <= (k) && (k) < hi)
#define SEAM(k) do { if (MK_SINGLE && IN(k) && IN((k) + 1)) xcd_barrier(bar); } while (0)
    bf16* const xb = (bf16*)(F.ws + WS_XB); float* const ssq = (float*)(F.ws + WS_SSQ);
    bf16* const proj = (bf16*)(F.ws + WS_PROJ); bf16* const mixed = (bf16*)(F.ws + WS_MIXED); bf16* const hid = (bf16*)(F.ws + WS_HID);
    float* const idxf = (float*)(F.ws + WS_IDXF);

    if (IN(0)) { PHASE_BEGIN(); p_prologue(F); } SEAM(0);
    for (int layer = 0; layer < DEPTH; ++layer) {
        const int pb = 1 + layer * NPL;
        if (IN(pb + 0)) {
            pg8::Gemm g{xb, (const bf16*)(F.ws + WS_WIN), M, DINP, DM}; pg8::StaticOrder S; S.init(M, DINP, F.G, F.bid);
            pg8::EpiIn E{proj, idxf, ssq};
            pg8::gemm_phase<pg8::EpiIn, pg8::StaticOrder, true, true>(F.lds + RING_OFF, g, S, E);
        } SEAM(pb + 0);
        if (IN(pb + 1)) { PHASE_BEGIN(); p_rope(F); cvt_layer_rest(F, layer); } SEAM(pb + 1);
        if (IN(pb + 2)) { PHASE_BEGIN(); p_pool(F, layer); PHASE_BEGIN(); p_mask(F); } SEAM(pb + 2);
        if (IN(pb + 3)) { PHASE_BEGIN(); p_hgrn_seq(F, layer); } SEAM(pb + 3);
        if (IN(pb + 4)) { PHASE_BEGIN(); p_attn_gather(F); } SEAM(pb + 4);
        if (IN(pb + 5)) {
            pg8::Gemm g{mixed, (const bf16*)(F.ws + WS_WOUT), M, DM, DM}; pg8::StaticOrder S; S.init(M, DM, F.G, F.bid);
            pg8::EpiRes E{layer == 0 ? F.x_in : (const float*)F.xres, F.xres, xb, ssq};
            pg8::gemm_phase<pg8::EpiRes, pg8::StaticOrder, true, true>(F.lds + RING_OFF, g, S, E);
        } SEAM(pb + 5);
        if (IN(pb + 6)) {
            pg8::Gemm g{xb, (const bf16*)(F.ws + WS_WFI), M, DFF, DM}; pg8::StaticOrder S; S.init(M, DFF, F.G, F.bid);
            pg8::EpiFfIn E{hid, ssq};
            pg8::gemm_phase<pg8::EpiFfIn, pg8::StaticOrder, true, true>(F.lds + RING_OFF, g, S, E);
        } SEAM(pb + 6);
        if (IN(pb + 7)) {
            pg8::Gemm g{hid, (const bf16*)(F.ws + WS_WFO), M, DM, DFF}; pg8::StaticOrder S; S.init(M, DM, F.G, F.bid);
            pg8::EpiRes E{(const float*)F.xres, F.xres, xb, ssq};
            pg8::gemm_phase<pg8::EpiRes, pg8::StaticOrder, true, true>(F.lds + RING_OFF, g, S, E);
        } SEAM(pb + 7);
    }
    if (IN(NPHASE - 1)) { PHASE_BEGIN(); p_final(F); }
#undef IN
#undef SEAM
}

extern "C" void kernel_launch(void* const* d_in, const int* in_sizes, int n_in, void* d_out, int out_size, void* d_ws, size_t ws_size, hipStream_t stream) {
    static int grid = 0;
    if (grid == 0) {
        if (n_in != 13 || out_size != M * DM || ws_size < WS_END) { fprintf(stderr, "kernel_launch: unexpected shapes (n_in %d, out %d, ws %zu)\n", n_in, out_size, ws_size); grid = -1; return; }
        int dev = 0, cus = 0, per_cu = 0;
        if (hipGetDevice(&dev) != hipSuccess || hipDeviceGetAttribute(&cus, hipDeviceAttributeMultiprocessorCount, dev) != hipSuccess) { grid = -1; return; }
        if (hipFuncSetAttribute((const void*)fwd, hipFuncAttributeMaxDynamicSharedMemorySize, LDS_BYTES) != hipSuccess) { fprintf(stderr, "kernel_launch: hipFuncSetAttribute failed\n"); grid = -1; return; }
        if (hipOccupancyMaxActiveBlocksPerMultiprocessor(&per_cu, (const void*)fwd, NTHR, LDS_BYTES) != hipSuccess || per_cu < 1) { fprintf(stderr, "kernel_launch: occupancy query says %d\n", per_cu); }
        (void)hipGetLastError();
        grid = cus;
        if (grid > 256) grid = 256;
        grid -= grid % 8;
    }
    if (grid <= 0) return;
    (void)hipMemsetAsync((char*)d_ws + WS_CTL, 0, CTL_ZERO_BYTES, stream);
    Args a{};
    a.x = (const float*)d_in[0]; a.pos = (const int*)d_in[1]; a.n1g = (const float*)d_in[2]; a.w_in = (const float*)d_in[3]; a.pool_w = (const float*)d_in[4];
    a.pool_scale = (const float*)d_in[5]; a.lb_logits = (const float*)d_in[6]; a.hgrn_g = (const float*)d_in[7]; a.w_out = (const float*)d_in[8]; a.n2g = (const float*)d_in[9];
    a.w_ff_in = (const float*)d_in[10]; a.w_ff_out = (const float*)d_in[11]; a.fng = (const float*)d_in[12];
    a.out = (float*)d_out; a.ws = (unsigned char*)d_ws;
    if (MK_SINGLE) {
        a.ph_lo = 0; a.ph_hi = NPHASE;
        hipLaunchKernelGGL(fwd, dim3(grid), dim3(NTHR), LDS_BYTES, stream, a);
    } else {
        for (int p = 0; p < NPHASE; ++p) { a.ph_lo = p; a.ph_hi = p + 1; hipLaunchKernelGGL(fwd, dim3(grid), dim3(NTHR), LDS_BYTES, stream, a); }
    }
}
```

```cpp
#include <hip/hip_runtime.h>
#include <cstdio>
#include <cstdint>
namespace pg8 {
#define PG8_LAS __attribute__((address_space(3)))
typedef unsigned short bf16_t;
typedef short bf16x8 __attribute__((ext_vector_type(8)));
typedef float f32x4 __attribute__((ext_vector_type(4)));
typedef unsigned u32x4 __attribute__((ext_vector_type(4)));
constexpr int BM = 256, BK = 64, HALF = 128, HTB = HALF * BK * 2  , STAGE_BYTES = 8 * HTB, NXCD = 8, WGM = 8;

__host__ __device__ __forceinline__ int lds_byte(int r, int c) { const int st = (r >> 4) * 2 + (c >> 5), rr = r & 15, cc = c & 31, ob = rr * 64 + cc * 2; return st * 1024 + (ob ^ (((ob >> 9) & 1) << 5)); }
__host__ __device__ __forceinline__ void stage_rc(int b, int& R, int& C) { const int st = b / 1024, sb = b % 1024, swz = sb ^ (((sb >> 9) & 1) << 5); R = (st >> 1) * 16 + swz / 64; C = (st & 1) * 32 + (swz % 64) / 2; }
__host__ __device__ __forceinline__ int perm32(int rho) { const int n = rho >> 4, i = rho & 15; return 8 * (i >> 2) + 4 * n + (i & 3); }

struct Unit { int pm, pn; };
struct Gemm { const bf16_t* A; const bf16_t* Bt; int M, N, K; };

struct StaticOrder {
    int nM, nN, nwg, G, c;
    __host__ __device__ void init(int M, int N, int G_, int c_) { nM = M / BM; nN = N / BM; nwg = nM * nN; G = G_; c = c_; }
    __host__ __device__ bool next(int i, Unit& u) const {
        const long L = (long)i * G + c; if (L >= nwg) return false;
        int wgid = (int)L; { const int q = nwg / NXCD, r = nwg % NXCD, xcd = wgid % NXCD, off = wgid / NXCD; wgid = (xcd < r ? xcd * (q + 1) : r * (q + 1) + (xcd - r) * q) + off; }
        const int nig = WGM * nN, gid = wgid / nig, fm = gid * WGM, gsz = (nM - fm) < WGM ? (nM - fm) : WGM;
        u.pm = fm + ((wgid % nig) % gsz); u.pn = (wgid % nig) / gsz; return true;
    }
    __device__ __forceinline__ void a_ready(const Unit&) const {}
    __device__ __forceinline__ void done(const Unit&) const {}
};

__device__ __forceinline__ unsigned cvt_pk_bf16(float lo, float hi) { unsigned r; asm volatile("v_cvt_pk_bf16_f32 %0, %1, %2" : "=v"(r) : "v"(lo), "v"(hi)); return r; }
typedef float f32x2 __attribute__((ext_vector_type(2)));

constexpr float RMS_EPS_F = 1e-5f;
__device__ __forceinline__ float row_rstd(const float* ssq, int row) {
    const f32x4* p = (const f32x4*)(ssq + (size_t)row * 16);
    const f32x4 a = p[0], b = p[1], c = p[2], d = p[3];
    const float s = ((a[0] + a[1]) + (a[2] + a[3])) + ((b[0] + b[1]) + (b[2] + b[3])) + ((c[0] + c[1]) + (c[2] + c[3])) + ((d[0] + d[1]) + (d[2] + d[3]));
    return 1.0f / sqrtf(s * (1.0f / 1024.0f) + RMS_EPS_F);
}
struct EpiIn {
    static constexpr bool PERM = true, AFTER_DRAIN = false;
    bf16_t* proj; float* idxf; const float* ssq;
    __device__ __forceinline__ void operator()(const f32x4 (&acc)[2][2][4][2], const Unit& u, int wr, int wc, int fr, int fq) const {
        const int row0 = u.pm * BM + wr * 64 + fr;
        const int colt = u.pn * BM + wc * 32 + 8 * fq;
#pragma unroll
        for (int ai = 0; ai < 2; ++ai)
#pragma unroll
            for (int m = 0; m < 4; ++m) {
                const int row = row0 + ai * HALF + m * 16;
                const float rs = row_rstd(ssq, row);
#pragma unroll
                for (int bj = 0; bj < 2; ++bj) {
                    const f32x4 v0 = acc[ai][bj][m][0] * rs, v1 = acc[ai][bj][m][1] * rs;
                    const int col = colt + bj * HALF;
                    if (u.pn < 8) {
                        u32x4 w; w.x = cvt_pk_bf16(v0[0], v0[1]); w.y = cvt_pk_bf16(v0[2], v0[3]); w.z = cvt_pk_bf16(v1[0], v1[1]); w.w = cvt_pk_bf16(v1[2], v1[3]);
                        *(u32x4*)(proj + (size_t)row * 2048 + col) = w;
                    } else {
                        float* o = idxf + (size_t)row * 512 + (col - 2048);
                        *(f32x4*)o = v0; *(f32x4*)(o + 4) = v1;
                    }
                }
            }
    }
};
struct EpiRes {
    static constexpr bool PERM = true, AFTER_DRAIN = false;
    const float* xin; float* xout; bf16_t* xb; float* ssq;
    __device__ __forceinline__ void operator()(const f32x4 (&acc)[2][2][4][2], const Unit& u, int wr, int wc, int fr, int fq) const {
        const int row0 = u.pm * BM + wr * 64 + fr;
        const int colt = u.pn * BM + wc * 32 + 8 * fq;
#pragma unroll
        for (int ai = 0; ai < 2; ++ai)
#pragma unroll
            for (int m = 0; m < 4; ++m) {
                const int row = row0 + ai * HALF + m * 16;
                float sq = 0.f;
#pragma unroll
                for (int bj = 0; bj < 2; ++bj) {
                    const size_t off = (size_t)row * 1024 + colt + bj * HALF;
                    const f32x4 a0 = *(const f32x4*)(xin + off), a1 = *(const f32x4*)(xin + off + 4);
                    const f32x4 v0 = a0 + acc[ai][bj][m][0], v1 = a1 + acc[ai][bj][m][1];
                    *(f32x4*)(xout + off) = v0; *(f32x4*)(xout + off + 4) = v1;
                    u32x4 w; w.x = cvt_pk_bf16(v0[0], v0[1]); w.y = cvt_pk_bf16(v0[2], v0[3]); w.z = cvt_pk_bf16(v1[0], v1[1]); w.w = cvt_pk_bf16(v1[2], v1[3]);
                    *(u32x4*)(xb + off) = w;
                    sq += (v0[0] * v0[0] + v0[1] * v0[1]) + (v0[2] * v0[2] + v0[3] * v0[3]) + (v1[0] * v1[0] + v1[1] * v1[1]) + (v1[2] * v1[2] + v1[3] * v1[3]);
                }
                sq += __shfl_xor(sq, 16); sq += __shfl_xor(sq, 32);
                if (fq == 0) ssq[(size_t)row * 16 + u.pn * 4 + wc] = sq;
            }
    }
};
struct EpiFfIn {
    static constexpr bool PERM = true, AFTER_DRAIN = false;
    bf16_t* hid; const float* ssq;
    __device__ __forceinline__ void operator()(const f32x4 (&acc)[2][2][4][2], const Unit& u, int wr, int wc, int fr, int fq) const {
        const int row0 = u.pm * BM + wr * 64 + fr;
        const int colt = u.pn * BM + wc * 32 + 8 * fq;
#pragma unroll
        for (int ai = 0; ai < 2; ++ai)
#pragma unroll
            for (int m = 0; m < 4; ++m) {
                const int row = row0 + ai * HALF + m * 16;
                const float rs = row_rstd(ssq, row);
#pragma unroll
                for (int bj = 0; bj < 2; ++bj) {
                    f32x4 v0 = acc[ai][bj][m][0] * rs, v1 = acc[ai][bj][m][1] * rs;
#pragma unroll
                    for (int e = 0; e < 4; ++e) { const float a = fmaxf(v0[e], 0.f), b = fmaxf(v1[e], 0.f); v0[e] = a * a; v1[e] = b * b; }
                    u32x4 w; w.x = cvt_pk_bf16(v0[0], v0[1]); w.y = cvt_pk_bf16(v0[2], v0[3]); w.z = cvt_pk_bf16(v1[0], v1[1]); w.w = cvt_pk_bf16(v1[2], v1[3]);
                    *(u32x4*)(hid + (size_t)row * 4096 + colt + bj * HALF) = w;
                }
            }
    }
};
template <class Epi, class Sched, bool ALIGN_EPI = false, bool SP2 = false>
__device__ __forceinline__ void gemm_phase(PG8_LAS unsigned char* lds, const Gemm g, const Sched& S, const Epi& E) {
    int tid_ = threadIdx.x; asm volatile("" : "+v"(tid_));
    const int tid = tid_, wid = __builtin_amdgcn_readfirstlane(tid >> 6), lane = tid & 63, wr = wid >> 2, wc = wid & 3, fr = lane & 15, fq = lane >> 4;
    const int K = g.K, nt = K / BK;
    unsigned voffA[2], voffB[2];
#pragma unroll
    for (int i = 0; i < 2; ++i) { int R, C; stage_rc(tid * 16 + i * 8192, R, C); const int Rb = Epi::PERM ? ((R & ~31) + perm32(R & 31)) : R;
        voffA[i] = (unsigned)(R * K + C) * 2u; voffB[i] = (unsigned)(Rb * K + C) * 2u; }
    const size_t kstep = (size_t)(BK * 2);
    const size_t hstep = (size_t)HALF * K * 2;
    const size_t tstep = 2 * hstep;
    const unsigned ldsw = (unsigned)wid * 1024u;
    const int aoff = lds_byte(wr * 64 + fr, fq * 8), boff = lds_byte(wc * 32 + fr, fq * 8);
#define PG8_SA(b, h) (((b) * 2 + (h)) * HTB)
#define PG8_SB(b, h) ((4 + (b) * 2 + (h)) * HTB)
#define PG8_STAGE(bufoff, gbase, voff) do { _Pragma("unroll") for (int _i = 0; _i < 2; ++_i) \
        __builtin_amdgcn_global_load_lds((const unsigned*)((const char*)(gbase) + (voff)[_i]), (PG8_LAS unsigned*)(lds + (bufoff) + ldsw + _i * 8192), 16, 0, 0); } while (0)
#define PG8_LDA(dst, b, h) do { _Pragma("unroll") for (int m = 0; m < 4; ++m) _Pragma("unroll") for (int k = 0; k < 2; ++k) dst[m][k] = *(const PG8_LAS bf16x8*)(lds + PG8_SA(b, h) + aoff + m * 2048 + k * 1024); } while (0)
#define PG8_LDB(dst, b, h) do { _Pragma("unroll") for (int n = 0; n < 2; ++n) _Pragma("unroll") for (int k = 0; k < 2; ++k) dst[n][k] = *(const PG8_LAS bf16x8*)(lds + PG8_SB(b, h) + boff + n * 2048 + k * 1024); } while (0)
#define PG8_MMA(ai, bj, At, Bt) do { __builtin_amdgcn_s_setprio(1); _Pragma("unroll") for (int m = 0; m < 4; ++m) _Pragma("unroll") for (int n = 0; n < 2; ++n) _Pragma("unroll") for (int k = 0; k < 2; ++k) \
        acc[ai][bj][m][n] = __builtin_amdgcn_mfma_f32_16x16x32_bf16(Bt[n][k], At[m][k], acc[ai][bj][m][n], 0, 0, 0); __builtin_amdgcn_s_setprio(0); } while (0)
#define PG8_WAIT_V(n) asm volatile("s_waitcnt vmcnt(" #n ")" ::: "memory")
#define PG8_WAIT_L(n) asm volatile("s_waitcnt lgkmcnt(" #n ")" ::: "memory")
#define PG8_BAR __builtin_amdgcn_s_barrier()
#define PG8_SCHED __builtin_amdgcn_sched_barrier(0)
    Unit cur, nxt; int ui = 0;
    if (!S.next(0, cur)) return;
    f32x4 acc[2][2][4][2];
#pragma unroll
    for (int a = 0; a < 2; ++a)
#pragma unroll
        for (int b = 0; b < 2; ++b)
#pragma unroll
            for (int m = 0; m < 4; ++m)
#pragma unroll
                for (int n = 0; n < 2; ++n) acc[a][b][m][n] = (f32x4){0.f, 0.f, 0.f, 0.f};
    bf16x8 At[4][2], B0[2][2], B1[2][2];
    const char* cA = (const char*)g.A + (size_t)cur.pm * tstep; const char* cB = (const char*)g.Bt + (size_t)cur.pn * tstep;
    S.a_ready(cur);
    if constexpr (SP2) {
        PG8_STAGE(PG8_SB(0, 0), cB, voffB); PG8_STAGE(PG8_SB(0, 1), cB + hstep, voffB); PG8_STAGE(PG8_SA(0, 0), cA, voffA); PG8_STAGE(PG8_SA(0, 1), cA + hstep, voffA);
        if (wr == 1) PG8_BAR;
        PG8_WAIT_V(2); PG8_BAR;
        PG8_STAGE(PG8_SB(1, 0), cB + kstep, voffB); PG8_STAGE(PG8_SA(1, 0), cA + kstep, voffA); PG8_STAGE(PG8_SB(1, 1), cB + hstep + kstep, voffB);
        PG8_WAIT_V(6); PG8_BAR;
    } else {
        PG8_STAGE(PG8_SB(0, 0), cB, voffB); PG8_STAGE(PG8_SA(0, 0), cA, voffA); PG8_STAGE(PG8_SB(0, 1), cB + hstep, voffB); PG8_STAGE(PG8_SA(0, 1), cA + hstep, voffA);
        if (wr == 1) PG8_BAR;
        PG8_WAIT_V(4); PG8_BAR;
        PG8_STAGE(PG8_SB(1, 0), cB + kstep, voffB); PG8_STAGE(PG8_SA(1, 0), cA + kstep, voffA); PG8_STAGE(PG8_SB(1, 1), cB + hstep + kstep, voffB);
        PG8_WAIT_V(6); PG8_BAR;
    }
    for (;;) {
        const bool has_next = S.next(ui + 1, nxt);
        const char* nA = has_next ? (const char*)g.A + (size_t)nxt.pm * tstep : cA; const char* nB = has_next ? (const char*)g.Bt + (size_t)nxt.pn * tstep : cB;
        for (int t = 0; t < nt; t += 2) {
            const bool last = (t == nt - 2);
            const char* a1 = cA + (size_t)(t + 1) * kstep;
            const char* a2 = last ? nA : cA + (size_t)(t + 2) * kstep; const char* b2 = last ? nB : cB + (size_t)(t + 2) * kstep;
            const char* a3 = a2 + kstep; const char* b3 = b2 + kstep;
            if (last && has_next) S.a_ready(nxt);
            if constexpr (SP2) {
            PG8_LDB(B0, 0, 0); PG8_LDB(B1, 0, 1); PG8_SCHED; PG8_LDA(At, 0, 0); PG8_STAGE(PG8_SA(1, 1), a1 + hstep, voffA);
            PG8_WAIT_V(8); PG8_WAIT_L(0); PG8_BAR; PG8_MMA(0, 0, At, B0); PG8_MMA(0, 1, At, B1); PG8_BAR; PG8_SCHED;
            PG8_LDA(At, 0, 1); PG8_STAGE(PG8_SB(0, 0), b2, voffB); PG8_STAGE(PG8_SB(0, 1), b2 + hstep, voffB); PG8_STAGE(PG8_SA(0, 0), a2, voffA);
            PG8_WAIT_V(8); PG8_WAIT_L(0); PG8_BAR; PG8_MMA(1, 0, At, B0); PG8_MMA(1, 1, At, B1); PG8_BAR; PG8_SCHED;
            PG8_LDB(B0, 1, 0); PG8_LDB(B1, 1, 1); PG8_SCHED; PG8_LDA(At, 1, 0); PG8_STAGE(PG8_SA(0, 1), a2 + hstep, voffA);
            PG8_WAIT_V(8); PG8_WAIT_L(0); PG8_BAR; PG8_MMA(0, 0, At, B0); PG8_MMA(0, 1, At, B1); PG8_BAR; PG8_SCHED;
            PG8_LDA(At, 1, 1); PG8_STAGE(PG8_SB(1, 0), b3, voffB); PG8_STAGE(PG8_SB(1, 1), b3 + hstep, voffB); PG8_STAGE(PG8_SA(1, 0), a3, voffA);
            PG8_WAIT_V(8); PG8_WAIT_L(0); PG8_BAR; PG8_MMA(1, 0, At, B0); PG8_MMA(1, 1, At, B1); PG8_BAR; PG8_SCHED;
            } else {
            PG8_LDB(B0, 0, 0); PG8_SCHED; PG8_LDA(At, 0, 0); PG8_STAGE(PG8_SA(1, 1), a1 + hstep, voffA);
            PG8_WAIT_L(8); PG8_BAR; PG8_WAIT_L(0); PG8_MMA(0, 0, At, B0); PG8_BAR; PG8_SCHED;
            PG8_LDB(B1, 0, 1); PG8_STAGE(PG8_SB(0, 0), b2, voffB);
            PG8_BAR; PG8_WAIT_L(0); PG8_MMA(0, 1, At, B1); PG8_BAR;
            PG8_LDA(At, 0, 1); PG8_STAGE(PG8_SA(0, 0), a2, voffA);
            PG8_BAR; PG8_WAIT_L(0); PG8_MMA(1, 0, At, B0); PG8_BAR; PG8_SCHED;
            PG8_STAGE(PG8_SB(0, 1), b2 + hstep, voffB);
            PG8_WAIT_V(6); PG8_BAR; PG8_MMA(1, 1, At, B1); PG8_BAR;
            PG8_LDB(B0, 1, 0); PG8_SCHED; PG8_LDA(At, 1, 0); PG8_STAGE(PG8_SA(0, 1), a2 + hstep, voffA);
            PG8_WAIT_L(8); PG8_BAR; PG8_WAIT_L(0); PG8_MMA(0, 0, At, B0); PG8_BAR; PG8_SCHED;
            PG8_LDB(B1, 1, 1); PG8_STAGE(PG8_SB(1, 0), b3, voffB);
            PG8_BAR; PG8_WAIT_L(0); PG8_MMA(0, 1, At, B1); PG8_BAR;
            PG8_LDA(At, 1, 1); PG8_STAGE(PG8_SA(1, 0), a3, voffA);
            PG8_BAR; PG8_WAIT_L(0); PG8_MMA(1, 0, At, B0); PG8_BAR; PG8_SCHED;
            PG8_STAGE(PG8_SB(1, 1), b3 + hstep, voffB);
            PG8_WAIT_V(6); PG8_BAR; PG8_MMA(1, 1, At, B1); PG8_BAR;
            }
        }
        if constexpr (ALIGN_EPI) { if (wr == 0) PG8_BAR; }
        if constexpr (!Epi::AFTER_DRAIN) { E(acc, cur, wr, wc, fr, fq); S.done(cur); }
        if (!has_next) break;
#pragma unroll
        for (int a = 0; a < 2; ++a)
#pragma unroll
            for (int b = 0; b < 2; ++b)
#pragma unroll
                for (int m = 0; m < 4; ++m)
#pragma unroll
                    for (int n = 0; n < 2; ++n) acc[a][b][m][n] = (f32x4){0.f, 0.f, 0.f, 0.f};
        cur = nxt; cA = nA; cB = nB; ++ui;
        if constexpr (ALIGN_EPI) { if (wr == 1) PG8_BAR; }
    }
    PG8_WAIT_V(0);
    if constexpr (!ALIGN_EPI) { if (wr == 0) PG8_BAR; }
    PG8_BAR;
    if constexpr (Epi::AFTER_DRAIN) { E.fused(acc, cur, wr, wc, fr, fq, lds, wid, lane); S.done(cur); }
#undef PG8_SA
#undef PG8_SB
#undef PG8_STAGE
#undef PG8_LDA
#undef PG8_LDB
#undef PG8_MMA
#undef PG8_WAIT_V
#undef PG8_WAIT_L
#undef PG8_BAR
#undef PG8_SCHED
}
}

constexpr int BATCH = 8, SEQ = 2048, DM = 1024, DEPTH = 4, M = BATCH * SEQ, DIN = 2372, DINP = 2560, DFF = 4096;
constexpr int NWAVES = 8, NTHR = NWAVES * 64;
constexpr int TOPK = 256;
constexpr int PC_POOL = 0, PC_HQ = 256, PC_HF = 512, PC_HI = 768, PC_HG = 1024, PC_Q = 1280, PC_K = 1792, PC_V = 1920, PROJ_LD = 2048;
constexpr int IC_QI = 0, IC_KI = 256, IC_WI = 320, IDX_LD = 512;
constexpr int MC_POOL = 0, MC_HGRN = 256, MC_ATTN = 512;

constexpr size_t MiB = 1u << 20;
constexpr size_t WS_CTL = 0, CTL_ZERO_BYTES = 1 * MiB;
constexpr size_t WS_ROPE = 1 * MiB;
constexpr size_t WS_SSQ = 2 * MiB;
constexpr size_t WS_LB = 3 * MiB;
constexpr size_t WS_MASK = 4 * MiB;
constexpr size_t WS_WIN = 8 * MiB;
constexpr size_t WS_WOUT = 13 * MiB;
constexpr size_t WS_WFI = 15 * MiB;
constexpr size_t WS_WFO = 23 * MiB;
constexpr size_t WS_XB = 32 * MiB;
constexpr size_t WS_HID = 64 * MiB;
constexpr size_t WS_PROJ = 64 * MiB;
constexpr size_t WS_MIXED = 128 * MiB;
constexpr size_t WS_IDXF = 192 * MiB;
constexpr size_t WS_END = 256 * MiB;
constexpr int CW_TMO = 0, CW_BAR = 4096;

constexpr int RING_OFF = 0, RING_BYTES = 131072;
constexpr int LDSCTL_OFF = RING_BYTES, MISC_OFF = LDSCTL_OFF + 320;
constexpr int LDS_BYTES = 147456;

#define GAS __attribute__((address_space(1)))
#define LAS __attribute__((address_space(3)))
typedef unsigned short bf16;
typedef unsigned v4u __attribute__((ext_vector_type(4)));
typedef unsigned v2u __attribute__((ext_vector_type(2)));
typedef float f32x4 __attribute__((ext_vector_type(4)));
typedef GAS unsigned gu32;
#define RLX_AGENT __ATOMIC_RELAXED, __HIP_MEMORY_SCOPE_AGENT
#define LDS_WAIT() asm volatile("s_waitcnt lgkmcnt(0)" ::: "memory")
__device__ __forceinline__ unsigned f2bf(float f) { unsigned u = __builtin_bit_cast(unsigned, f); return (u + 0x7fffu + ((u >> 16) & 1u)) >> 16; }
__device__ __forceinline__ unsigned pk2(float lo, float hi) { return f2bf(lo) | (f2bf(hi) << 16); }
__device__ __forceinline__ float bf2f(unsigned short h) { return __builtin_bit_cast(float, (unsigned)h << 16); }
__device__ __forceinline__ float wave_sum(float v) {
#pragma unroll
    for (int o = 1; o < 64; o <<= 1) v += __shfl_xor(v, o);
    return v;
}
__device__ __forceinline__ float wave_max(float v) {
#pragma unroll
    for (int o = 1; o < 64; o <<= 1) v = fmaxf(v, __shfl_xor(v, o));
    return v;
}
#define XB_TMO      128
#define XB_XCNT(j)  (256  + 64 * (j))
#define XB_XSUB(j)  (1280 + 64 * (j))
#define XB_XGEN(j)  (2304 + 64 * (j))
#define XB_TOP      3328
#define XB_TOPGEN   3392
#define XCD_BAR_WORDS 3456
#define XB_SPIN_CAP (1u << 18)

__device__ __forceinline__ unsigned xb_ld(unsigned* p)              { return __hip_atomic_load(p, __ATOMIC_RELAXED, __HIP_MEMORY_SCOPE_AGENT); }
__device__ __forceinline__ unsigned xb_add(unsigned* p, unsigned v) { return __hip_atomic_fetch_add(p, v, __ATOMIC_RELAXED, __HIP_MEMORY_SCOPE_AGENT); }
__device__ __forceinline__ unsigned xb_xcc_id() { return (unsigned)__builtin_amdgcn_s_getreg((3 << 11) | 20) & 0xFu; }
#define XB_SPIN(cond, bar) do { unsigned _sp = 0; while (cond) { __builtin_amdgcn_s_sleep(1); \
    if ((++_sp & 255u) == 0u) { if (xb_ld(&(bar)[XB_TMO])) break; if (_sp > XB_SPIN_CAP) { atomicAdd(&(bar)[XB_TMO], 1u); break; } } } } while (0)

struct XcdBarrier {
    unsigned* bar; unsigned x;
    volatile LAS unsigned* st;
};

__device__ __forceinline__ XcdBarrier xcd_barrier_post(unsigned* bar, volatile LAS unsigned* st) {
    XcdBarrier b; b.bar = bar; b.x = xb_xcc_id(); b.st = st;
    if (threadIdx.x == 0) (void)xb_add(&bar[XB_XCNT(b.x)], 1u);
    return b;
}
__device__ __forceinline__ void xcd_barrier_complete(unsigned* bar, unsigned x, unsigned& nloc, unsigned& nx) {
    const unsigned G = gridDim.x * gridDim.y * gridDim.z;
    unsigned sum, cnt, mine, sp = 0u;
    for (;;) {
        sum = 0u; cnt = 0u; mine = 0u;
#pragma unroll
        for (unsigned j = 0; j < 16; ++j) { const unsigned c = xb_ld(&bar[XB_XCNT(j)]); sum += c; cnt += (c > 0u) ? 1u : 0u; mine = (j == x) ? c : mine; }
        if (sum == G) break;
        __builtin_amdgcn_s_sleep(1);
        if ((++sp & 255u) == 0u) { if (xb_ld(&bar[XB_TMO])) break; if (sp > XB_SPIN_CAP) { atomicAdd(&bar[XB_TMO], 1u); break; } }
    }
    nloc = mine > 0u ? mine : 1u; nx = cnt > 0u ? cnt : 1u;
}

__device__ __forceinline__ void xcd_barrier(const XcdBarrier& b) {
    asm volatile("s_waitcnt vmcnt(0)" ::: "memory");
    __syncthreads();
    if (threadIdx.x == 0) {
        unsigned* bar = b.bar;
        __builtin_amdgcn_s_waitcnt(0);
        unsigned nloc = b.st[0], nx = b.st[1];
        if (nloc == 0u) { xcd_barrier_complete(bar, b.x, nloc, nx); b.st[0] = nloc; b.st[1] = nx; }
        const unsigned old = xb_add(&bar[XB_XSUB(b.x)], 1u);
        const unsigned gen = old / nloc;
        if (old + 1u == (gen + 1u) * nloc) {
            __builtin_amdgcn_fence(__ATOMIC_RELEASE, "agent");
            asm volatile("s_waitcnt vmcnt(0)" ::: "memory");
            const unsigned og = xb_add(&bar[XB_TOP], 1u);
            const unsigned tg = og / nx;
            if (og + 1u == (tg + 1u) * nx) xb_add(&bar[XB_TOPGEN], 1u);
            else XB_SPIN(xb_ld(&bar[XB_TOPGEN]) == tg, bar);
            __builtin_amdgcn_fence(__ATOMIC_ACQUIRE, "agent");
            xb_add(&bar[XB_XGEN(b.x)], 1u);
            asm volatile("s_waitcnt vmcnt(0)" ::: "memory");
        } else {
            XB_SPIN(xb_ld(&bar[XB_XGEN(b.x)]) == gen, bar);
            __builtin_amdgcn_fence(__ATOMIC_ACQUIRE, "agent");
            asm volatile("s_waitcnt vmcnt(0)" ::: "memory");
        }
    }
    __syncthreads();
}


struct Frame {
    LAS unsigned char* lds;
    volatile LAS unsigned* MISC;
    gu32* ctl;
    int tid, lane, wave, G, bid;
    const float* x_in; const int* pos;
    const float *n1g, *w_in, *pool_w, *pool_scale, *lb_logits, *hgrn_g, *w_out, *n2g, *w_ff_in, *w_ff_out, *fng;
    float* xres;
    unsigned char* ws;
};
__constant__ float c_invf[8] = {1.0f, 0.19392274474868576f, 0.03760603093086393f, 0.007292664737217109f, 0.001414213562373095f, 0.0002742481756762073f, 5.318295896944988e-05f, 1.031338537721246e-05f};

__device__ __forceinline__ void cvt_item(const float* W, const float* g, int K, int N, bf16* WT, LAS float* scr, int kb, int nb, int lane) {
    const int k0 = 64 * kb, n0 = 32 * nb;
    const int n = n0 + (lane & 31);
#pragma unroll 8
    for (int i = 0; i < 32; ++i) { const int kk = 2 * i + (lane >> 5); float v = (n < N) ? W[(size_t)(k0 + kk) * N + n] : 0.f; if (g) v *= g[k0 + kk]; scr[kk * 33 + (lane & 31)] = v; }
    LDS_WAIT(); asm volatile("" ::: "memory");
    const int c = lane & 7;
#pragma unroll
    for (int j = 0; j < 4; ++j) { const int nl = (lane >> 3) + 8 * j; const LAS float* s = scr + (8 * c) * 33 + nl;
        v4u o; o.x = pk2(s[0 * 33], s[1 * 33]); o.y = pk2(s[2 * 33], s[3 * 33]); o.z = pk2(s[4 * 33], s[5 * 33]); o.w = pk2(s[6 * 33], s[7 * 33]);
        *(GAS v4u*)(WT + (size_t)(n0 + nl) * K + k0 + 8 * c) = o; }
    LDS_WAIT(); asm volatile("" ::: "memory");
}
__device__ __forceinline__ void cvt_matrix(Frame& F, const float* W, const float* g, int K, int N, int Npad, bf16* WT) {
    LAS float* scr = (LAS float*)(F.lds + RING_OFF + F.wave * 16384);
    const int gw = F.bid * NWAVES + F.wave, NGW = F.G * NWAVES;
    const int nblk = Npad / 32, nitems = (K / 64) * nblk;
    for (int it = gw; it < nitems; it += NGW) cvt_item(W, g, K, N, WT, scr, it / nblk, it % nblk, F.lane);
}
__device__ __forceinline__ void cvt_layer_rest(Frame& F, int layer) {
    cvt_matrix(F, F.w_out + (size_t)layer * DM * DM, nullptr, DM, DM, DM, (bf16*)(F.ws + WS_WOUT));
    cvt_matrix(F, F.w_ff_in + (size_t)layer * DM * DFF, F.n2g + layer * DM, DM, DFF, DFF, (bf16*)(F.ws + WS_WFI));
    cvt_matrix(F, F.w_ff_out + (size_t)layer * DFF * DM, nullptr, DFF, DM, DM, (bf16*)(F.ws + WS_WFO));
    if (layer + 1 < DEPTH) cvt_matrix(F, F.w_in + (size_t)(layer + 1) * DM * DIN, F.n1g + (layer + 1) * DM, DM, DIN, DINP, (bf16*)(F.ws + WS_WIN));
}

__device__ __forceinline__ void p_prologue(Frame& F) {
    const int gtid = F.bid * NTHR + F.tid, NT = F.G * NTHR;
    float* tab = (float*)(F.ws + WS_ROPE);
    for (int idx = gtid; idx < M * 8; idx += NT) {
        const int row = idx >> 3, i = idx & 7;
        const float angf = (float)F.pos[row] * c_invf[i];
        double r = (double)angf * 0.15915494309189535; r -= floor(r);
        const float a = (float)(r * 6.283185307179586);
        tab[row * 16 + i] = cosf(a); tab[row * 16 + 8 + i] = sinf(a);
    }
    if (gtid < 256) {
        const int c = gtid; float* lb = (float*)(F.ws + WS_LB);
        const float l0 = F.lb_logits[c], l1 = F.lb_logits[256 + c], l2 = F.lb_logits[512 + c], l3 = F.lb_logits[768 + c];
        const float mx = fmaxf(fmaxf(l0, l1), fmaxf(l2, l3));
        const float e0 = expf(l0 - mx), e1 = expf(l1 - mx), e2 = expf(l2 - mx), e3 = expf(l3 - mx);
        const float inv = 1.0f / (e0 + e1 + e2 + e3);
        lb[c] = 0.f; lb[256 + c] = e1 * inv; lb[512 + c] = (e1 + e2) * inv; lb[768 + c] = (e1 + e2 + e3) * inv;
    }
    const int gw = F.bid * NWAVES + F.wave, NGW = F.G * NWAVES;
    bf16* xb = (bf16*)(F.ws + WS_XB); float* ssq = (float*)(F.ws + WS_SSQ);
    for (int row = gw; row < M; row += NGW) {
        const f32x4* xr = (const f32x4*)(F.x_in + (size_t)row * DM) + F.lane;
        f32x4 v[4]; float s = 0.f;
#pragma unroll
        for (int j = 0; j < 4; ++j) { v[j] = xr[64 * j]; s += (v[j][0] * v[j][0] + v[j][1] * v[j][1]) + (v[j][2] * v[j][2] + v[j][3] * v[j][3]); }
        s = wave_sum(s);
        unsigned long long* o8 = (unsigned long long*)(xb + (size_t)row * DM) + F.lane;
#pragma unroll
        for (int j = 0; j < 4; ++j) o8[64 * j] = (unsigned long long)pk2(v[j][0], v[j][1]) | ((unsigned long long)pk2(v[j][2], v[j][3]) << 32);
        if (F.lane < 16) ssq[(size_t)row * 16 + F.lane] = (F.lane == 0) ? s : 0.f;
    }
    cvt_matrix(F, F.w_in, F.n1g, DM, DIN, DINP, (bf16*)(F.ws + WS_WIN));
}

__device__ __forceinline__ void p_rope(Frame& F) {
    const int gtid = F.bid * NTHR + F.tid, NT = F.G * NTHR;
    const float* tab = (const float*)(F.ws + WS_ROPE);
    bf16* proj = (bf16*)(F.ws + WS_PROJ); float* idxf = (float*)(F.ws + WS_IDXF);
    for (int idx = gtid; idx < M * 15 * 8; idx += NT) {
        const int i = idx & 7, rh = idx >> 3, hh = rh % 15, row = rh / 15;
        const float c = tab[row * 16 + i], s = tab[row * 16 + 8 + i];
        if (hh < 10) {
            const int col = hh < 8 ? PC_Q + hh * 64 : PC_K + (hh - 8) * 64;
            bf16* p = proj + (size_t)row * PROJ_LD + col;
            const float x1 = bf2f(p[i]), x2 = bf2f(p[8 + i]);
            p[i] = (bf16)f2bf(x1 * c - x2 * s); p[8 + i] = (bf16)f2bf(x2 * c + x1 * s);
        } else {
            const int col = hh < 14 ? IC_QI + (hh - 10) * 64 : IC_KI;
            float* p = idxf + (size_t)row * IDX_LD + col;
            const float x1 = p[i], x2 = p[8 + i];
            p[i] = x1 * c - x2 * s; p[8 + i] = x2 * c + x1 * s;
        }
    }
}

__device__ __forceinline__ void p_pool(Frame& F, int layer) {
    LAS float* P = (LAS float*)(F.lds + RING_OFF);
    const bf16* proj = (const bf16*)(F.ws + WS_PROJ); bf16* mixed = (bf16*)(F.ws + WS_MIXED);
    const float* pw = F.pool_w + (size_t)layer * 4 * 64 * 64; const float* ps = F.pool_scale + layer * 256;
    const int c = F.tid & 255, half = F.tid >> 8, g = c >> 6, win = 2 << g, dd = c & 63;
    for (int unit = F.bid; unit < M / 16; unit += F.G) {
        const int t0 = unit * 16;
        for (int tt = half * 8; tt < half * 8 + 8; ++tt) {
            const int row = t0 + tt, tloc = row & (SEQ - 1); const int cnt = (tloc + 1 < win) ? tloc + 1 : win;
            float s = 0.f;
            for (int j = 0; j < cnt; ++j) s += bf2f(proj[(size_t)(row - j) * PROJ_LD + PC_POOL + c]);
            P[tt * 256 + c] = s / (float)cnt - bf2f(proj[(size_t)row * PROJ_LD + PC_POOL + c]);
        }
        __syncthreads();
        for (int tt = half * 8; tt < half * 8 + 8; ++tt) {
            float y = 0.f;
#pragma unroll 8
            for (int cc = 0; cc < 64; ++cc) y += P[tt * 256 + g * 64 + cc] * pw[(g * 64 + cc) * 64 + dd];
            mixed[(size_t)(t0 + tt) * DM + MC_POOL + c] = (bf16)f2bf(y * ps[c]);
        }
        __syncthreads();
    }
}

__device__ __forceinline__ unsigned sort_key(float v) { if (v == 0.f) v = 0.f; const unsigned u = __builtin_bit_cast(unsigned, v); return (u & 0x80000000u) ? ~u : (u | 0x80000000u); }
__device__ __forceinline__ void p_mask(Frame& F) {
    LAS float* qi_s = (LAS float*)(F.lds + RING_OFF);
    LAS unsigned* red_s = (LAS unsigned*)(F.lds + RING_OFF + 1024);
    const float* idxf = (const float*)(F.ws + WS_IDXF); unsigned* mask = (unsigned*)(F.ws + WS_MASK);
    const int tid = F.tid, lane = F.lane, wave = F.wave;
    for (int row = F.bid; row < M; row += F.G) {
        const int b = row >> 11, t = row & (SEQ - 1), n = t + 1;
        unsigned* mrow = mask + (size_t)row * 64;
        if (n <= TOPK) {
            if (tid < 64) { const int lo = tid * 32; mrow[tid] = (n >= lo + 32) ? 0xffffffffu : (n > lo ? ((1u << (n - lo)) - 1u) : 0u); }
            continue;
        }
        if (tid < 256) qi_s[tid] = idxf[(size_t)row * IDX_LD + IC_QI + tid];
        const f32x4 wv = *(const f32x4*)(idxf + (size_t)row * IDX_LD + IC_WI);
        __syncthreads();
        unsigned key[4];
#pragma unroll
        for (int i = 0; i < 4; ++i) {
            const int s = i * 512 + tid; key[i] = 0u;
            if (s < n) {
                const f32x4* kp = (const f32x4*)(idxf + (size_t)(b * SEQ + s) * IDX_LD + IC_KI);
                float d0 = 0.f, d1 = 0.f, d2 = 0.f, d3 = 0.f;
#pragma unroll 4
                for (int d = 0; d < 16; ++d) {
                    const f32x4 kv = kp[d];
                    const f32x4 q0 = *(const LAS f32x4*)(qi_s + d * 4), q1 = *(const LAS f32x4*)(qi_s + 64 + d * 4), q2 = *(const LAS f32x4*)(qi_s + 128 + d * 4), q3 = *(const LAS f32x4*)(qi_s + 192 + d * 4);
                    d0 += kv[0] * q0[0] + kv[1] * q0[1] + kv[2] * q0[2] + kv[3] * q0[3];
                    d1 += kv[0] * q1[0] + kv[1] * q1[1] + kv[2] * q1[2] + kv[3] * q1[3];
                    d2 += kv[0] * q2[0] + kv[1] * q2[1] + kv[2] * q2[2] + kv[3] * q2[3];
                    d3 += kv[0] * q3[0] + kv[1] * q3[1] + kv[2] * q3[2] + kv[3] * q3[3];
                }
                const float I = wv[0] * fmaxf(d0, 0.f) + wv[1] * fmaxf(d1, 0.f) + wv[2] * fmaxf(d2, 0.f) + wv[3] * fmaxf(d3, 0.f);
                key[i] = sort_key(I);
            }
        }
        unsigned prefix = 0u; int par = 0;
        for (int bit = 31; bit >= 0; --bit) {
            const unsigned cand = prefix | (1u << bit);
            unsigned wc_ = 0u;
#pragma unroll
            for (int i = 0; i < 4; ++i) wc_ += (unsigned)__popcll(__ballot(key[i] >= cand));
            if (lane == 0) red_s[par * 8 + wave] = wc_;
            __syncthreads();
            unsigned tot = 0u;
#pragma unroll
            for (int w = 0; w < 8; ++w) tot += red_s[par * 8 + w];
            if (tot >= (unsigned)TOPK) prefix = cand;
            par ^= 1;
        }
        const unsigned tau = prefix;
        unsigned long long eqb[4]; unsigned gtc = 0u;
#pragma unroll
        for (int i = 0; i < 4; ++i) { eqb[i] = __ballot(key[i] == tau); gtc += (unsigned)__popcll(__ballot(key[i] > tau)); if (lane == 0) red_s[16 + i * 8 + wave] = (unsigned)__popcll(eqb[i]); }
        if (lane == 0) red_s[par * 8 + wave] = gtc;
        __syncthreads();
        unsigned cgt = 0u;
#pragma unroll
        for (int w = 0; w < 8; ++w) cgt += red_s[par * 8 + w];
        const unsigned need = (unsigned)TOPK - cgt;
#pragma unroll
        for (int i = 0; i < 4; ++i) {
            const int g = i * 8 + wave; unsigned base = 0u;
            for (int gg = 0; gg < g; ++gg) base += red_s[16 + gg];
            const unsigned rank = base + (unsigned)__popcll(eqb[i] & ((1ull << lane) - 1ull));
            const bool sel = (key[i] > tau) || ((key[i] == tau) && (rank < need));
            const unsigned long long sb = __ballot(sel);
            if (lane == 0) { mrow[g * 2] = (unsigned)sb; mrow[g * 2 + 1] = (unsigned)(sb >> 32); }
        }
        __syncthreads();
    }
}

__device__ __forceinline__ void p_hgrn_seq(Frame& F, int layer) {
    if (F.wave != 0 || F.bid >= 32) return;
    const int b = F.bid >> 2, h = F.bid & 3, lane = F.lane;
    LAS float* Fs = (LAS float*)(F.lds + RING_OFF); LAS float* Ks = Fs + 4096; LAS float* Qs = Ks + 4096;
    const bf16* proj = (const bf16*)(F.ws + WS_PROJ); bf16* mixed = (bf16*)(F.ws + WS_MIXED);
    const float lbv = ((const float*)(F.ws + WS_LB))[layer * 256 + h * 64 + lane];
    const float ng = F.hgrn_g[layer * 256 + h * 64 + lane];
    float S[64];
#pragma unroll
    for (int k = 0; k < 64; ++k) S[k] = 0.f;
    for (int chunk = 0; chunk < SEQ / 64; ++chunk) {
        const size_t row0 = (size_t)b * SEQ + chunk * 64;
        for (int tt = 0; tt < 64; ++tt) {
            const bf16* pr = proj + (row0 + tt) * PROJ_LD + h * 64 + lane;
            const float z = bf2f(pr[PC_HF]), qr = bf2f(pr[PC_HQ]);
            const float sig = 1.0f / (1.0f + expf(-z));
            float f = lbv + (1.0f - lbv) * sig; f = fmaxf(f, 1e-30f);
            Fs[tt * 64 + lane] = f; Ks[tt * 64 + lane] = (1.0f - lbv) * (1.0f - sig); Qs[tt * 64 + lane] = qr / (1.0f + expf(-qr));
        }
        LDS_WAIT(); asm volatile("" ::: "memory");
        for (int tt = 0; tt < 64; ++tt) {
            const bf16* pr = proj + (row0 + tt) * PROJ_LD + h * 64 + lane;
            const float iv = bf2f(pr[PC_HI]), gr = bf2f(pr[PC_HG]);
            float o = 0.f;
#pragma unroll
            for (int k = 0; k < 64; k += 4) {
                const f32x4 f4 = *(const LAS f32x4*)(Fs + tt * 64 + k), k4 = *(const LAS f32x4*)(Ks + tt * 64 + k), q4 = *(const LAS f32x4*)(Qs + tt * 64 + k);
#pragma unroll
                for (int e = 0; e < 4; ++e) { S[k + e] = f4[e] * S[k + e] + k4[e] * iv; o += q4[e] * S[k + e]; }
            }
            const float ms = wave_sum(o * o) * (1.0f / 64.0f);
            const float y = o * (1.0f / sqrtf(ms + 1e-5f)) * ng * (gr / (1.0f + expf(-gr)));
            mixed[(row0 + tt) * DM + MC_HGRN + h * 64 + lane] = (bf16)f2bf(y);
        }
        LDS_WAIT(); asm volatile("" ::: "memory");
    }
}

__device__ __forceinline__ void p_attn_gather(Frame& F) {
    LAS int* list = (LAS int*)(F.lds + RING_OFF);
    LAS float* qs = (LAS float*)(F.lds + RING_OFF + 1024);
    LAS float* ps = (LAS float*)(F.lds + RING_OFF + 1024 + 2048);
    LAS int* nsel_s = (LAS int*)(F.lds + RING_OFF + 1024 + 2048 + 8192);
    const bf16* proj = (const bf16*)(F.ws + WS_PROJ); bf16* mixed = (bf16*)(F.ws + WS_MIXED); const unsigned* mask = (const unsigned*)(F.ws + WS_MASK);
    const int tid = F.tid, lane = F.lane, wave = F.wave;
    for (int row = F.bid; row < M; row += F.G) {
        const int b = row >> 11;
        if (wave == 0) {
            unsigned w = mask[(size_t)row * 64 + lane];
            const int c = __popc(w); int incl = c;
#pragma unroll
            for (int o = 1; o < 64; o <<= 1) { const int v = __shfl_up(incl, o); if (lane >= o) incl += v; }
            int p = incl - c;
            while (w) { const int bit = __ffs(w) - 1; list[p++] = lane * 32 + bit; w &= w - 1u; }
            if (lane == 63) nsel_s[0] = incl;
        }
        qs[tid] = bf2f(proj[(size_t)row * PROJ_LD + PC_Q + tid]);
        __syncthreads();
        const int nsel = nsel_s[0];
        const int h = wave, kvh = h >> 2;
        float sc[4]; float mx = -3.0e38f;
#pragma unroll
        for (int i = 0; i < 4; ++i) {
            const int j = i * 64 + lane; sc[i] = -3.0e38f;
            if (j < nsel) {
                const int s = list[j];
                const v4u* kp = (const v4u*)(proj + (size_t)(b * SEQ + s) * PROJ_LD + PC_K + kvh * 64);
                float d = 0.f;
#pragma unroll
                for (int c8 = 0; c8 < 8; ++c8) {
                    const v4u kv = kp[c8]; const LAS float* qp = qs + h * 64 + c8 * 8;
                    d += __builtin_bit_cast(float, kv.x << 16) * qp[0] + __builtin_bit_cast(float, kv.x & 0xffff0000u) * qp[1]
                       + __builtin_bit_cast(float, kv.y << 16) * qp[2] + __builtin_bit_cast(float, kv.y & 0xffff0000u) * qp[3]
                       + __builtin_bit_cast(float, kv.z << 16) * qp[4] + __builtin_bit_cast(float, kv.z & 0xffff0000u) * qp[5]
                       + __builtin_bit_cast(float, kv.w << 16) * qp[6] + __builtin_bit_cast(float, kv.w & 0xffff0000u) * qp[7];
                }
                sc[i] = d * 0.125f;
            }
            mx = fmaxf(mx, sc[i]);
        }
        mx = wave_max(mx);
        float e[4]; float sum = 0.f;
#pragma unroll
        for (int i = 0; i < 4; ++i) { const int j = i * 64 + lane; e[i] = (j < nsel) ? expf(sc[i] - mx) : 0.f; sum += e[i]; }
        sum = wave_sum(sum);
        const float inv = 1.0f / sum;
#pragma unroll
        for (int i = 0; i < 4; ++i) ps[h * 256 + i * 64 + lane] = e[i] * inv;
        LDS_WAIT(); asm volatile("" ::: "memory");
        float o = 0.f;
        for (int j = 0; j < nsel; ++j) {
            const int s = list[j];
            o += ps[h * 256 + j] * bf2f(proj[(size_t)(b * SEQ + s) * PROJ_LD + PC_V + kvh * 64 + lane]);
        }
        mixed[(size_t)row * DM + MC_ATTN + h * 64 + lane] = (bf16)f2bf(o);
        __syncthreads();
    }
}

__device__ __forceinline__ void p_final(Frame& F) {
    const int gw = F.bid * NWAVES + F.wave, NGW = F.G * NWAVES;
    for (int row = gw; row < M; row += NGW) {
        f32x4* xr = (f32x4*)(F.xres + (size_t)row * DM) + F.lane;
        const f32x4* gr = (const f32x4*)F.fng + F.lane;
        f32x4 v[4]; float s = 0.f;
#pragma unroll
        for (int j = 0; j < 4; ++j) { v[j] = xr[64 * j]; s += (v[j][0] * v[j][0] + v[j][1] * v[j][1]) + (v[j][2] * v[j][2] + v[j][3] * v[j][3]); }
        s = wave_sum(s);
        const float rs = 1.0f / sqrtf(s * (1.0f / 1024.0f) + 1e-5f);
#pragma unroll
        for (int j = 0; j < 4; ++j) xr[64 * j] = v[j] * rs * gr[64 * j];
    }
}

#ifndef MK_SINGLE
#define MK_SINGLE 1
#endif
constexpr int NPL = 8;
constexpr int NPHASE = 1 + DEPTH * NPL + 1;
struct Args { const float* x; const int* pos; const float *n1g, *w_in, *pool_w, *pool_scale, *lb_logits, *hgrn_g, *w_out, *n2g, *w_ff_in, *w_ff_out, *fng; float* out; unsigned char* ws; int ph_lo, ph_hi; };
static_assert(sizeof(Args) == 15 * 8 + 8, "Args has no padding");


#define PHASE_BEGIN() do { int t_ = threadIdx.x; asm volatile("" : "+v"(t_)); F.tid = t_; F.lane = t_ & 63; F.wave = __builtin_amdgcn_readfirstlane(t_ >> 6); \
    unsigned char* w_ = args.ws; asm volatile("" : "+s"(w_)); F.ws = w_; } while (0)
__global__ void __launch_bounds__(NTHR, 2) fwd(Args args) {
    extern __shared__ __attribute__((aligned(16))) unsigned char lds[];
    Frame F;
    F.lds = (LAS unsigned char*)lds;
    F.MISC = (volatile LAS unsigned*)(F.lds + MISC_OFF);
    F.tid = threadIdx.x; F.lane = F.tid & 63; F.wave = __builtin_amdgcn_readfirstlane(F.tid >> 6);
    F.G = gridDim.x; F.bid = blockIdx.x;
    F.ws = args.ws; F.ctl = (gu32*)(args.ws + WS_CTL);
    F.x_in = args.x; F.pos = args.pos; F.n1g = args.n1g; F.w_in = args.w_in; F.pool_w = args.pool_w; F.pool_scale = args.pool_scale; F.lb_logits = args.lb_logits;
    F.hgrn_g = args.hgrn_g; F.w_out = args.w_out; F.n2g = args.n2g; F.w_ff_in = args.w_ff_in; F.w_ff_out = args.w_ff_out; F.fng = args.fng; F.xres = args.out;
    for (int u = F.tid; u < (LDS_BYTES - LDSCTL_OFF) / 4; u += NTHR) ((LAS unsigned*)(F.lds + LDSCTL_OFF))[u] = 0u;
    __syncthreads();
    XcdBarrier bar; bar.bar = (unsigned*)(F.ctl + CW_BAR); bar.x = 0; bar.st = nullptr;
    if (MK_SINGLE) bar = xcd_barrier_post((unsigned*)(F.ctl + CW_BAR), F.MISC + 8);
    const int lo = args.ph_lo, hi = args.ph_hi;
#define IN(k) (lo <= (k) && (k) < hi)
#define SEAM(k) do { if (MK_SINGLE && IN(k) && IN((k) + 1)) xcd_barrier(bar); } while (0)
    bf16* const xb = (bf16*)(F.ws + WS_XB); float* const ssq = (float*)(F.ws + WS_SSQ);
    bf16* const proj = (bf16*)(F.ws + WS_PROJ); bf16* const mixed = (bf16*)(F.ws + WS_MIXED); bf16* const hid = (bf16*)(F.ws + WS_HID);
    float* const idxf = (float*)(F.ws + WS_IDXF);

    if (IN(0)) { PHASE_BEGIN(); p_prologue(F); } SEAM(0);
    for (int layer = 0; layer < DEPTH; ++layer) {
        const int pb = 1 + layer * NPL;
        if (IN(pb + 0)) {
            pg8::Gemm g{xb, (const bf16*)(F.ws + WS_WIN), M, DINP, DM}; pg8::StaticOrder S; S.init(M, DINP, F.G, F.bid);
            pg8::EpiIn E{proj, idxf, ssq};
            pg8::gemm_phase<pg8::EpiIn, pg8::StaticOrder, true, true>(F.lds + RING_OFF, g, S, E);
        } SEAM(pb + 0);
        if (IN(pb + 1)) { PHASE_BEGIN(); p_rope(F); cvt_layer_rest(F, layer); } SEAM(pb + 1);
        if (IN(pb + 2)) { PHASE_BEGIN(); p_pool(F, layer); PHASE_BEGIN(); p_mask(F); } SEAM(pb + 2);
        if (IN(pb + 3)) { PHASE_BEGIN(); p_hgrn_seq(F, layer); } SEAM(pb + 3);
        if (IN(pb + 4)) { PHASE_BEGIN(); p_attn_gather(F); } SEAM(pb + 4);
        if (IN(pb + 5)) {
            pg8::Gemm g{mixed, (const bf16*)(F.ws + WS_WOUT), M, DM, DM}; pg8::StaticOrder S; S.init(M, DM, F.G, F.bid);
            pg8::EpiRes E{layer == 0 ? F.x_in : (const float*)F.xres, F.xres, xb, ssq};
            pg8::gemm_phase<pg8::EpiRes, pg8::StaticOrder, true, true>(F.lds + RING_OFF, g, S, E);
        } SEAM(pb + 5);
        if (IN(pb + 6)) {
            pg8::Gemm g{xb, (const bf16*)(F.ws + WS_WFI), M, DFF, DM}; pg8::StaticOrder S; S.init(M, DFF, F.G, F.bid);
            pg8::EpiFfIn E{hid, ssq};
            pg8::gemm_phase<pg8::EpiFfIn, pg8::StaticOrder, true, true>(F.lds + RING_OFF, g, S, E);
        } SEAM(pb + 6);
        if (IN(pb + 7)) {
            pg8::Gemm g{hid, (const bf16*)(F.ws + WS_WFO), M, DM, DFF}; pg8::StaticOrder S; S.init(M, DM, F.G, F.bid);
            pg8::EpiRes E{(const float*)F.xres, F.xres, xb, ssq};
            pg8::gemm_phase<pg8::EpiRes, pg8::StaticOrder, true, true>(F.lds + RING_OFF, g, S, E);
        } SEAM(pb + 7);
    }
    if (IN(NPHASE - 1)) { PHASE_BEGIN(); p_final(F); }
#undef IN
#undef SEAM
}

extern "C" void kernel_launch(void* const* d_in, const int* in_sizes, int n_in, void* d_out, int out_size, void* d_ws, size_t ws_size, hipStream_t stream) {
    static int grid = 0;
    if (grid == 0) {
        if (n_in != 13 || out_size != M * DM || ws_size < WS_END) { fprintf(stderr, "kernel_launch: unexpected shapes (n_in %d, out %d, ws %zu)\n", n_in, out_size, ws_size); grid = -1; return; }
        int dev = 0, cus = 0, per_cu = 0;
        if (hipGetDevice(&dev) != hipSuccess || hipDeviceGetAttribute(&cus, hipDeviceAttributeMultiprocessorCount, dev) != hipSuccess) { grid = -1; return; }
        if (hipFuncSetAttribute((const void*)fwd, hipFuncAttributeMaxDynamicSharedMemorySize, LDS_BYTES) != hipSuccess) { fprintf(stderr, "kernel_launch: hipFuncSetAttribute failed\n"); grid = -1; return; }
        if (hipOccupancyMaxActiveBlocksPerMultiprocessor(&per_cu, (const void*)fwd, NTHR, LDS_BYTES) != hipSuccess || per_cu < 1) { fprintf(stderr, "kernel_launch: occupancy query says %d\n", per_cu); }
        (void)hipGetLastError();
        grid = cus;
        if (grid > 256) grid = 256;
        grid -= grid % 8;
    }
    if (grid <= 0) return;
    (void)hipMemsetAsync((char*)d_ws + WS_CTL, 0, CTL_ZERO_BYTES, stream);
    Args a{};
    a.x = (const float*)d_in[0]; a.pos = (const int*)d_in[1]; a.n1g = (const float*)d_in[2]; a.w_in = (const float*)d_in[3]; a.pool_w = (const float*)d_in[4];
    a.pool_scale = (const float*)d_in[5]; a.lb_logits = (const float*)d_in[6]; a.hgrn_g = (const float*)d_in[7]; a.w_out = (const float*)d_in[8]; a.n2g = (const float*)d_in[9];
    a.w_ff_in = (const float*)d_in[10]; a.w_ff_out = (const float*)d_in[11]; a.fng = (const float*)d_in[12];
    a.out = (float*)d_out; a.ws = (unsigned char*)d_ws;
    if (MK_SINGLE) {
        a.ph_lo = 0; a.ph_hi = NPHASE;
        hipLaunchKernelGGL(fwd, dim3(grid), dim3(NTHR), LDS_BYTES, stream, a);
    } else {
        for (int p = 0; p < NPHASE; ++p) { a.ph_lo = p; a.ph_hi = p + 1; hipLaunchKernelGGL(fwd, dim3(grid), dim3(NTHR), LDS_BYTES, stream, a); }
    }
}
```

```cpp
#include <hip/hip_runtime.h>
#include <cstdio>
#include <cstdint>
namespace pg8 {
#define PG8_LAS __attribute__((address_space(3)))
typedef unsigned short bf16_t;
typedef short bf16x8 __attribute__((ext_vector_type(8)));
typedef float f32x4 __attribute__((ext_vector_type(4)));
typedef unsigned u32x4 __attribute__((ext_vector_type(4)));
constexpr int BM = 256, BK = 64, HALF = 128, HTB = HALF * BK * 2  , STAGE_BYTES = 8 * HTB, NXCD = 8, WGM = 8;

__host__ __device__ __forceinline__ int lds_byte(int r, int c) { const int st = (r >> 4) * 2 + (c >> 5), rr = r & 15, cc = c & 31, ob = rr * 64 + cc * 2; return st * 1024 + (ob ^ (((ob >> 9) & 1) << 5)); }
__host__ __device__ __forceinline__ void stage_rc(int b, int& R, int& C) { const int st = b / 1024, sb = b % 1024, swz = sb ^ (((sb >> 9) & 1) << 5); R = (st >> 1) * 16 + swz / 64; C = (st & 1) * 32 + (swz % 64) / 2; }
__host__ __device__ __forceinline__ int perm32(int rho) { const int n = rho >> 4, i = rho & 15; return 8 * (i >> 2) + 4 * n + (i & 3); }

struct Unit { int pm, pn; };
struct Gemm { const bf16_t* A; const bf16_t* Bt; int M, N, K; };

struct StaticOrder {
    int nM, nN, nwg, G, c;
    __host__ __device__ void init(int M, int N, int G_, int c_) { nM = M / BM; nN = N / BM; nwg = nM * nN; G = G_; c = c_; }
    __host__ __device__ bool next(int i, Unit& u) const {
        const long L = (long)i * G + c; if (L >= nwg) return false;
        int wgid = (int)L; { const int q = nwg / NXCD, r = nwg % NXCD, xcd = wgid % NXCD, off = wgid / NXCD; wgid = (xcd < r ? xcd * (q + 1) : r * (q + 1) + (xcd - r) * q) + off; }
        const int nig = WGM * nN, gid = wgid / nig, fm = gid * WGM, gsz = (nM - fm) < WGM ? (nM - fm) : WGM;
        u.pm = fm + ((wgid % nig) % gsz); u.pn = (wgid % nig) / gsz; return true;
    }
    __device__ __forceinline__ void a_ready(const Unit&) const {}
    __device__ __forceinline__ void done(const Unit&) const {}
};

__device__ __forceinline__ unsigned cvt_pk_bf16(float lo, float hi) { unsigned r; asm volatile("v_cvt_pk_bf16_f32 %0, %1, %2" : "=v"(r) : "v"(lo), "v"(hi)); return r; }
typedef float f32x2 __attribute__((ext_vector_type(2)));

constexpr float RMS_EPS_F = 1e-5f;
__device__ __forceinline__ float row_rstd(const float* ssq, int row) {
    const f32x4* p = (const f32x4*)(ssq + (size_t)row * 16);
    const f32x4 a = p[0], b = p[1], c = p[2], d = p[3];
    const float s = ((a[0] + a[1]) + (a[2] + a[3])) + ((b[0] + b[1]) + (b[2] + b[3])) + ((c[0] + c[1]) + (c[2] + c[3])) + ((d[0] + d[1]) + (d[2] + d[3]));
    return 1.0f / sqrtf(s * (1.0f / 1024.0f) + RMS_EPS_F);
}
struct EpiIn {
    static constexpr bool PERM = true, AFTER_DRAIN = false;
    bf16_t* proj; float* idxf; const float* ssq;
    __device__ __forceinline__ void operator()(const f32x4 (&acc)[2][2][4][2], const Unit& u, int wr, int wc, int fr, int fq) const {
        const int row0 = u.pm * BM + wr * 64 + fr;
        const int colt = u.pn * BM + wc * 32 + 8 * fq;
#pragma unroll
        for (int ai = 0; ai < 2; ++ai)
#pragma unroll
            for (int m = 0; m < 4; ++m) {
                const int row = row0 + ai * HALF + m * 16;
                const float rs = row_rstd(ssq, row);
#pragma unroll
                for (int bj = 0; bj < 2; ++bj) {
                    const f32x4 v0 = acc[ai][bj][m][0] * rs, v1 = acc[ai][bj][m][1] * rs;
                    const int col = colt + bj * HALF;
                    if (u.pn < 8) {
                        u32x4 w; w.x = cvt_pk_bf16(v0[0], v0[1]); w.y = cvt_pk_bf16(v0[2], v0[3]); w.z = cvt_pk_bf16(v1[0], v1[1]); w.w = cvt_pk_bf16(v1[2], v1[3]);
                        *(u32x4*)(proj + (size_t)row * 2048 + col) = w;
                    } else {
                        float* o = idxf + (size_t)row * 512 + (col - 2048);
                        *(f32x4*)o = v0; *(f32x4*)(o + 4) = v1;
                    }
                }
            }
    }
};
struct EpiRes {
    static constexpr bool PERM = true, AFTER_DRAIN = false;
    const float* xin; float* xout; bf16_t* xb; float* ssq;
    __device__ __forceinline__ void operator()(const f32x4 (&acc)[2][2][4][2], const Unit& u, int wr, int wc, int fr, int fq) const {
        const int row0 = u.pm * BM + wr * 64 + fr;
        const int colt = u.pn * BM + wc * 32 + 8 * fq;
#pragma unroll
        for (int ai = 0; ai < 2; ++ai)
#pragma unroll
            for (int m = 0; m < 4; ++m) {
                const int row = row0 + ai * HALF + m * 16;
                float sq = 0.f;
#pragma unroll
                for (int bj = 0; bj < 2; ++bj) {
                    const size_t off = (size_t)row * 1024 + colt + bj * HALF;
                    const f32x4 a0 = *(const f32x4*)(xin + off), a1 = *(const f32x4*)(xin + off + 4);
                    const f32x4 v0 = a0 + acc[ai][bj][m][0], v1 = a1 + acc[ai][bj][m][1];
                    *(f32x4*)(xout + off) = v0; *(f32x4*)(xout + off + 4) = v1;
                    u32x4 w; w.x = cvt_pk_bf16(v0[0], v0[1]); w.y = cvt_pk_bf16(v0[2], v0[3]); w.z = cvt_pk_bf16(v1[0], v1[1]); w.w = cvt_pk_bf16(v1[2], v1[3]);
                    *(u32x4*)(xb + off) = w;
                    sq += (v0[0] * v0[0] + v0[1] * v0[1]) + (v0[2] * v0[2] + v0[3] * v0[3]) + (v1[0] * v1[0] + v1[1] * v1[1]) + (v1[2] * v1[2] + v1[3] * v1[3]);
                }
                sq += __shfl_xor(sq, 16); sq += __shfl_xor(sq, 32);
                if (fq == 0) ssq[(size_t)row * 16 + u.pn * 4 + wc] = sq;
            }
    }
};
struct EpiFfIn {
    static constexpr bool PERM = true, AFTER_DRAIN = false;
    bf16_t* hid; const float* ssq;
    __device__ __forceinline__ void operator()(const f32x4 (&acc)[2][2][4][2], const Unit& u, int wr, int wc, int fr, int fq) const {
        const int row0 = u.pm * BM + wr * 64 + fr;
        const int colt = u.pn * BM + wc * 32 + 8 * fq;
#pragma unroll
        for (int ai = 0; ai < 2; ++ai)
#pragma unroll
            for (int m = 0; m < 4; ++m) {
                const int row = row0 + ai * HALF + m * 16;
                const float rs = row_rstd(ssq, row);
#pragma unroll
                for (int bj = 0; bj < 2; ++bj) {
                    f32x4 v0 = acc[ai][bj][m][0] * rs, v1 = acc[ai][bj][m][1] * rs;
#pragma unroll
                    for (int e = 0; e < 4; ++e) { const float a = fmaxf(v0[e], 0.f), b = fmaxf(v1[e], 0.f); v0[e] = a * a; v1[e] = b * b; }
                    u32x4 w; w.x = cvt_pk_bf16(v0[0], v0[1]); w.y = cvt_pk_bf16(v0[2], v0[3]); w.z = cvt_pk_bf16(v1[0], v1[1]); w.w = cvt_pk_bf16(v1[2], v1[3]);
                    *(u32x4*)(hid + (size_t)row * 4096 + colt + bj * HALF) = w;
                }
            }
    }
};
template <class Epi, class Sched, bool ALIGN_EPI = false, bool SP2 = false>
__device__ __forceinline__ void gemm_phase(PG8_LAS unsigned char* lds, const Gemm g, const Sched& S, const Epi& E) {
    int tid_ = threadIdx.x; asm volatile("" : "+v"(tid_));
    const int tid = tid_, wid = __builtin_amdgcn_readfirstlane(tid >> 6), lane = tid & 63, wr = wid >> 2, wc = wid & 3, fr = lane & 15, fq = lane >> 4;
    const int K = g.K, nt = K / BK;
    unsigned voffA[2], voffB[2];
#pragma unroll
    for (int i = 0; i < 2; ++i) { int R, C; stage_rc(tid * 16 + i * 8192, R, C); const int Rb = Epi::PERM ? ((R & ~31) + perm32(R & 31)) : R;
        voffA[i] = (unsigned)(R * K + C) * 2u; voffB[i] = (unsigned)(Rb * K + C) * 2u; }
    const size_t kstep = (size_t)(BK * 2);
    const size_t hstep = (size_t)HALF * K * 2;
    const size_t tstep = 2 * hstep;
    const unsigned ldsw = (unsigned)wid * 1024u;
    const int aoff = lds_byte(wr * 64 + fr, fq * 8), boff = lds_byte(wc * 32 + fr, fq * 8);
#define PG8_SA(b, h) (((b) * 2 + (h)) * HTB)
#define PG8_SB(b, h) ((4 + (b) * 2 + (h)) * HTB)
#define PG8_STAGE(bufoff, gbase, voff) do { _Pragma("unroll") for (int _i = 0; _i < 2; ++_i) \
        __builtin_amdgcn_global_load_lds((const unsigned*)((const char*)(gbase) + (voff)[_i]), (PG8_LAS unsigned*)(lds + (bufoff) + ldsw + _i * 8192), 16, 0, 0); } while (0)
#define PG8_LDA(dst, b, h) do { _Pragma("unroll") for (int m = 0; m < 4; ++m) _Pragma("unroll") for (int k = 0; k < 2; ++k) dst[m][k] = *(const PG8_LAS bf16x8*)(lds + PG8_SA(b, h) + aoff + m * 2048 + k * 1024); } while (0)
#define PG8_LDB(dst, b, h) do { _Pragma("unroll") for (int n = 0; n < 2; ++n) _Pragma("unroll") for (int k = 0; k < 2; ++k) dst[n][k] = *(const PG8_LAS bf16x8*)(lds + PG8_SB(b, h) + boff + n * 2048 + k * 1024); } while (0)
#define PG8_MMA(ai, bj, At, Bt) do { __builtin_amdgcn_s_setprio(1); _Pragma("unroll") for (int m = 0; m < 4; ++m) _Pragma("unroll") for (int n = 0; n < 2; ++n) _Pragma("unroll") for (int k = 0; k < 2; ++k) \
        acc[ai][bj][m][n] = __builtin_amdgcn_mfma_f32_16x16x32_bf16(Bt[n][k], At[m][k], acc[ai][bj][m][n], 0, 0, 0); __builtin_amdgcn_s_setprio(0); } while (0)
#define PG8_WAIT_V(n) asm volatile("s_waitcnt vmcnt(" #n ")" ::: "memory")
#define PG8_WAIT_L(n) asm volatile("s_waitcnt lgkmcnt(" #n ")" ::: "memory")
#define PG8_BAR __builtin_amdgcn_s_barrier()
#define PG8_SCHED __builtin_amdgcn_sched_barrier(0)
    Unit cur, nxt; int ui = 0;
    if (!S.next(0, cur)) return;
    f32x4 acc[2][2][4][2];
#pragma unroll
    for (int a = 0; a < 2; ++a)
#pragma unroll
        for (int b = 0; b < 2; ++b)
#pragma unroll
            for (int m = 0; m < 4; ++m)
#pragma unroll
                for (int n = 0; n < 2; ++n) acc[a][b][m][n] = (f32x4){0.f, 0.f, 0.f, 0.f};
    bf16x8 At[4][2], B0[2][2], B1[2][2];
    const char* cA = (const char*)g.A + (size_t)cur.pm * tstep; const char* cB = (const char*)g.Bt + (size_t)cur.pn * tstep;
    S.a_ready(cur);
    if constexpr (SP2) {
        PG8_STAGE(PG8_SB(0, 0), cB, voffB); PG8_STAGE(PG8_SB(0, 1), cB + hstep, voffB); PG8_STAGE(PG8_SA(0, 0), cA, voffA); PG8_STAGE(PG8_SA(0, 1), cA + hstep, voffA);
        if (wr == 1) PG8_BAR;
        PG8_WAIT_V(2); PG8_BAR;
        PG8_STAGE(PG8_SB(1, 0), cB + kstep, voffB); PG8_STAGE(PG8_SA(1, 0), cA + kstep, voffA); PG8_STAGE(PG8_SB(1, 1), cB + hstep + kstep, voffB);
        PG8_WAIT_V(6); PG8_BAR;
    } else {
        PG8_STAGE(PG8_SB(0, 0), cB, voffB); PG8_STAGE(PG8_SA(0, 0), cA, voffA); PG8_STAGE(PG8_SB(0, 1), cB + hstep, voffB); PG8_STAGE(PG8_SA(0, 1), cA + hstep, voffA);
        if (wr == 1) PG8_BAR;
        PG8_WAIT_V(4); PG8_BAR;
        PG8_STAGE(PG8_SB(1, 0), cB + kstep, voffB); PG8_STAGE(PG8_SA(1, 0), cA + kstep, voffA); PG8_STAGE(PG8_SB(1, 1), cB + hstep + kstep, voffB);
        PG8_WAIT_V(6); PG8_BAR;
    }
    for (;;) {
        const bool has_next = S.next(ui + 1, nxt);
        const char* nA = has_next ? (const char*)g.A + (size_t)nxt.pm * tstep : cA; const char* nB = has_next ? (const char*)g.Bt + (size_t)nxt.pn * tstep : cB;
        for (int t = 0; t < nt; t += 2) {
            const bool last = (t == nt - 2);
            const char* a1 = cA + (size_t)(t + 1) * kstep;
            const char* a2 = last ? nA : cA + (size_t)(t + 2) * kstep; const char* b2 = last ? nB : cB + (size_t)(t + 2) * kstep;
            const char* a3 = a2 + kstep; const char* b3 = b2 + kstep;
            if (last && has_next) S.a_ready(nxt);
            if constexpr (SP2) {
            PG8_LDB(B0, 0, 0); PG8_LDB(B1, 0, 1); PG8_SCHED; PG8_LDA(At, 0, 0); PG8_STAGE(PG8_SA(1, 1), a1 + hstep, voffA);
            PG8_WAIT_V(8); PG8_WAIT_L(0); PG8_BAR; PG8_MMA(0, 0, At, B0); PG8_MMA(0, 1, At, B1); PG8_BAR; PG8_SCHED;
            PG8_LDA(At, 0, 1); PG8_STAGE(PG8_SB(0, 0), b2, voffB); PG8_STAGE(PG8_SB(0, 1), b2 + hstep, voffB); PG8_STAGE(PG8_SA(0, 0), a2, voffA);
            PG8_WAIT_V(8); PG8_WAIT_L(0); PG8_BAR; PG8_MMA(1, 0, At, B0); PG8_MMA(1, 1, At, B1); PG8_BAR; PG8_SCHED;
            PG8_LDB(B0, 1, 0); PG8_LDB(B1, 1, 1); PG8_SCHED; PG8_LDA(At, 1, 0); PG8_STAGE(PG8_SA(0, 1), a2 + hstep, voffA);
            PG8_WAIT_V(8); PG8_WAIT_L(0); PG8_BAR; PG8_MMA(0, 0, At, B0); PG8_MMA(0, 1, At, B1); PG8_BAR; PG8_SCHED;
            PG8_LDA(At, 1, 1); PG8_STAGE(PG8_SB(1, 0), b3, voffB); PG8_STAGE(PG8_SB(1, 1), b3 + hstep, voffB); PG8_STAGE(PG8_SA(1, 0), a3, voffA);
            PG8_WAIT_V(8); PG8_WAIT_L(0); PG8_BAR; PG8_MMA(1, 0, At, B0); PG8_MMA(1, 1, At, B1); PG8_BAR; PG8_SCHED;
            } else {
            PG8_LDB(B0, 0, 0); PG8_SCHED; PG8_LDA(At, 0, 0); PG8_STAGE(PG8_SA(1, 1), a1 + hstep, voffA);
            PG8_WAIT_L(8); PG8_BAR; PG8_WAIT_L(0); PG8_MMA(0, 0, At, B0); PG8_BAR; PG8_SCHED;
            PG8_LDB(B1, 0, 1); PG8_STAGE(PG8_SB(0, 0), b2, voffB);
            PG8_BAR; PG8_WAIT_L(0); PG8_MMA(0, 1, At, B1); PG8_BAR;
            PG8_LDA(At, 0, 1); PG8_STAGE(PG8_SA(0, 0), a2, voffA);
            PG8_BAR; PG8_WAIT_L(0); PG8_MMA(1, 0, At, B0); PG8_BAR; PG8_SCHED;
            PG8_STAGE(PG8_SB(0, 1), b2 + hstep, voffB);
            PG8_WAIT_V(6); PG8_BAR; PG8_MMA(1, 1, At, B1); PG8_BAR;
            PG8_LDB(B0, 1, 0); PG8_SCHED; PG8_LDA(At, 1, 0); PG8_STAGE(PG8_SA(0, 1), a2 + hstep, voffA);
            PG8_WAIT_L(8); PG8_BAR; PG8_WAIT_L(0); PG8_MMA(0, 0, At, B0); PG8_BAR; PG8_SCHED;
            PG8_LDB(B1, 1, 1); PG8_STAGE(PG8_SB(1, 0), b3, voffB);
            PG8_BAR; PG8_WAIT_L(0); PG8_MMA(0, 1, At, B1); PG8_BAR;
            PG8_LDA(At, 1, 1); PG8_STAGE(PG8_SA(1, 0), a3, voffA);
            PG8_BAR; PG8_WAIT_L(0); PG8_MMA(1, 0, At, B0); PG8_BAR; PG8_SCHED;
            PG8_STAGE(PG8_SB(1, 1), b3 + hstep, voffB);
            PG8_WAIT_V(6); PG8_BAR; PG8_MMA(1, 1, At, B1); PG8_BAR;
            }
        }
        if constexpr (ALIGN_EPI) { if (wr == 0) PG8_BAR; }
        if constexpr (!Epi::AFTER_DRAIN) { E(acc, cur, wr, wc, fr, fq); S.done(cur); }
        if (!has_next) break;
#pragma unroll
        for (int a = 0; a < 2; ++a)
#pragma unroll
            for (int b = 0; b < 2; ++b)
#pragma unroll
                for (int m = 0; m < 4; ++m)
#pragma unroll
                    for (int n = 0; n < 2; ++n) acc[a][b][m][n] = (f32x4){0.f, 0.f, 0.f, 0.f};
        cur = nxt; cA = nA; cB = nB; ++ui;
        if constexpr (ALIGN_EPI) { if (wr == 1) PG8_BAR; }
    }
    PG8_WAIT_V(0);
    if constexpr (!ALIGN_EPI) { if (wr == 0) PG8_BAR; }
    PG8_BAR;
    if constexpr (Epi::AFTER_DRAIN) { E.fused(acc, cur, wr, wc, fr, fq, lds, wid, lane); S.done(cur); }
#undef PG8_SA
#undef PG8_SB
#undef PG8_STAGE
#undef PG8_LDA
#undef PG8_LDB
#undef PG8_MMA
#undef PG8_WAIT_V
#undef PG8_WAIT_L
#undef PG8_BAR
#undef PG8_SCHED
}
}

constexpr int BATCH = 8, SEQ = 2048, DM = 1024, DEPTH = 4, M = BATCH * SEQ, DIN = 2372, DINP = 2560, DFF = 4096;
constexpr int NWAVES = 8, NTHR = NWAVES * 64;
constexpr int TOPK = 256;
constexpr int PC_POOL = 0, PC_HQ = 256, PC_HF = 512, PC_HI = 768, PC_HG = 1024, PC_Q = 1280, PC_K = 1792, PC_V = 1920, PROJ_LD = 2048;
constexpr int IC_QI = 0, IC_KI = 256, IC_WI = 320, IDX_LD = 512;
constexpr int MC_POOL = 0, MC_HGRN = 256, MC_ATTN = 512;

constexpr size_t MiB = 1u << 20;
constexpr size_t WS_CTL = 0, CTL_ZERO_BYTES = 1 * MiB;
constexpr size_t WS_ROPE = 1 * MiB;
constexpr size_t WS_SSQ = 2 * MiB;
constexpr size_t WS_LB = 3 * MiB;
constexpr size_t WS_MASK = 4 * MiB;
constexpr size_t WS_WIN = 8 * MiB;
constexpr size_t WS_WOUT = 13 * MiB;
constexpr size_t WS_WFI = 15 * MiB;
constexpr size_t WS_WFO = 23 * MiB;
constexpr size_t WS_XB = 32 * MiB;
constexpr size_t WS_HID = 64 * MiB;
constexpr size_t WS_PROJ = 64 * MiB;
constexpr size_t WS_MIXED = 128 * MiB;
constexpr size_t WS_IDXF = 192 * MiB;
constexpr size_t WS_VT = 224 * MiB;
constexpr size_t WS_END = 256 * MiB;
constexpr int CW_TMO = 0, CW_BAR = 4096;

constexpr int RING_OFF = 0, RING_BYTES = 131072;
constexpr int LDSCTL_OFF = RING_BYTES, MISC_OFF = LDSCTL_OFF + 320;
constexpr int LDS_BYTES = 147456;

#define GAS __attribute__((address_space(1)))
#define LAS __attribute__((address_space(3)))
typedef unsigned short bf16;
typedef unsigned v4u __attribute__((ext_vector_type(4)));
typedef unsigned v2u __attribute__((ext_vector_type(2)));
typedef float f32x4 __attribute__((ext_vector_type(4)));
typedef GAS unsigned gu32;
#define RLX_AGENT __ATOMIC_RELAXED, __HIP_MEMORY_SCOPE_AGENT
#define LDS_WAIT() asm volatile("s_waitcnt lgkmcnt(0)" ::: "memory")
__device__ __forceinline__ unsigned f2bf(float f) { unsigned u = __builtin_bit_cast(unsigned, f); return (u + 0x7fffu + ((u >> 16) & 1u)) >> 16; }
__device__ __forceinline__ unsigned pk2(float lo, float hi) { return f2bf(lo) | (f2bf(hi) << 16); }
__device__ __forceinline__ float bf2f(unsigned short h) { return __builtin_bit_cast(float, (unsigned)h << 16); }
__device__ __forceinline__ float wave_sum(float v) {
#pragma unroll
    for (int o = 1; o < 64; o <<= 1) v += __shfl_xor(v, o);
    return v;
}
__device__ __forceinline__ float wave_max(float v) {
#pragma unroll
    for (int o = 1; o < 64; o <<= 1) v = fmaxf(v, __shfl_xor(v, o));
    return v;
}
#define XB_TMO      128
#define XB_XCNT(j)  (256  + 64 * (j))
#define XB_XSUB(j)  (1280 + 64 * (j))
#define XB_XGEN(j)  (2304 + 64 * (j))
#define XB_TOP      3328
#define XB_TOPGEN   3392
#define XCD_BAR_WORDS 3456
#define XB_SPIN_CAP (1u << 18)

__device__ __forceinline__ unsigned xb_ld(unsigned* p)              { return __hip_atomic_load(p, __ATOMIC_RELAXED, __HIP_MEMORY_SCOPE_AGENT); }
__device__ __forceinline__ unsigned xb_add(unsigned* p, unsigned v) { return __hip_atomic_fetch_add(p, v, __ATOMIC_RELAXED, __HIP_MEMORY_SCOPE_AGENT); }
__device__ __forceinline__ unsigned xb_xcc_id() { return (unsigned)__builtin_amdgcn_s_getreg((3 << 11) | 20) & 0xFu; }
#define XB_SPIN(cond, bar) do { unsigned _sp = 0; while (cond) { __builtin_amdgcn_s_sleep(1); \
    if ((++_sp & 255u) == 0u) { if (xb_ld(&(bar)[XB_TMO])) break; if (_sp > XB_SPIN_CAP) { atomicAdd(&(bar)[XB_TMO], 1u); break; } } } } while (0)

struct XcdBarrier {
    unsigned* bar; unsigned x;
    volatile LAS unsigned* st;
};

__device__ __forceinline__ XcdBarrier xcd_barrier_post(unsigned* bar, volatile LAS unsigned* st) {
    XcdBarrier b; b.bar = bar; b.x = xb_xcc_id(); b.st = st;
    if (threadIdx.x == 0) (void)xb_add(&bar[XB_XCNT(b.x)], 1u);
    return b;
}
__device__ __forceinline__ void xcd_barrier_complete(unsigned* bar, unsigned x, unsigned& nloc, unsigned& nx) {
    const unsigned G = gridDim.x * gridDim.y * gridDim.z;
    unsigned sum, cnt, mine, sp = 0u;
    for (;;) {
        sum = 0u; cnt = 0u; mine = 0u;
#pragma unroll
        for (unsigned j = 0; j < 16; ++j) { const unsigned c = xb_ld(&bar[XB_XCNT(j)]); sum += c; cnt += (c > 0u) ? 1u : 0u; mine = (j == x) ? c : mine; }
        if (sum == G) break;
        __builtin_amdgcn_s_sleep(1);
        if ((++sp & 255u) == 0u) { if (xb_ld(&bar[XB_TMO])) break; if (sp > XB_SPIN_CAP) { atomicAdd(&bar[XB_TMO], 1u); break; } }
    }
    nloc = mine > 0u ? mine : 1u; nx = cnt > 0u ? cnt : 1u;
}

__device__ __forceinline__ void xcd_barrier(const XcdBarrier& b) {
    asm volatile("s_waitcnt vmcnt(0)" ::: "memory");
    __syncthreads();
    if (threadIdx.x == 0) {
        unsigned* bar = b.bar;
        __builtin_amdgcn_s_waitcnt(0);
        unsigned nloc = b.st[0], nx = b.st[1];
        if (nloc == 0u) { xcd_barrier_complete(bar, b.x, nloc, nx); b.st[0] = nloc; b.st[1] = nx; }
        const unsigned old = xb_add(&bar[XB_XSUB(b.x)], 1u);
        const unsigned gen = old / nloc;
        if (old + 1u == (gen + 1u) * nloc) {
            __builtin_amdgcn_fence(__ATOMIC_RELEASE, "agent");
            asm volatile("s_waitcnt vmcnt(0)" ::: "memory");
            const unsigned og = xb_add(&bar[XB_TOP], 1u);
            const unsigned tg = og / nx;
            if (og + 1u == (tg + 1u) * nx) xb_add(&bar[XB_TOPGEN], 1u);
            else XB_SPIN(xb_ld(&bar[XB_TOPGEN]) == tg, bar);
            __builtin_amdgcn_fence(__ATOMIC_ACQUIRE, "agent");
            xb_add(&bar[XB_XGEN(b.x)], 1u);
            asm volatile("s_waitcnt vmcnt(0)" ::: "memory");
        } else {
            XB_SPIN(xb_ld(&bar[XB_XGEN(b.x)]) == gen, bar);
            __builtin_amdgcn_fence(__ATOMIC_ACQUIRE, "agent");
            asm volatile("s_waitcnt vmcnt(0)" ::: "memory");
        }
    }
    __syncthreads();
}


struct Frame {
    LAS unsigned char* lds;
    volatile LAS unsigned* MISC;
    gu32* ctl;
    int tid, lane, wave, G, bid;
    const float* x_in; const int* pos;
    const float *n1g, *w_in, *pool_w, *pool_scale, *lb_logits, *hgrn_g, *w_out, *n2g, *w_ff_in, *w_ff_out, *fng;
    float* xres;
    unsigned char* ws;
};
__constant__ float c_invf[8] = {1.0f, 0.19392274474868576f, 0.03760603093086393f, 0.007292664737217109f, 0.001414213562373095f, 0.0002742481756762073f, 5.318295896944988e-05f, 1.031338537721246e-05f};

__device__ __forceinline__ void cvt_item(const float* W, const float* g, int K, int N, bf16* WT, LAS float* scr, int kb, int nb, int lane) {
    const int k0 = 64 * kb, n0 = 32 * nb;
    const int n = n0 + (lane & 31);
#pragma unroll 8
    for (int i = 0; i < 32; ++i) { const int kk = 2 * i + (lane >> 5); float v = (n < N) ? W[(size_t)(k0 + kk) * N + n] : 0.f; if (g) v *= g[k0 + kk]; scr[kk * 33 + (lane & 31)] = v; }
    LDS_WAIT(); asm volatile("" ::: "memory");
    const int c = lane & 7;
#pragma unroll
    for (int j = 0; j < 4; ++j) { const int nl = (lane >> 3) + 8 * j; const LAS float* s = scr + (8 * c) * 33 + nl;
        v4u o; o.x = pk2(s[0 * 33], s[1 * 33]); o.y = pk2(s[2 * 33], s[3 * 33]); o.z = pk2(s[4 * 33], s[5 * 33]); o.w = pk2(s[6 * 33], s[7 * 33]);
        *(GAS v4u*)(WT + (size_t)(n0 + nl) * K + k0 + 8 * c) = o; }
    LDS_WAIT(); asm volatile("" ::: "memory");
}
__device__ __forceinline__ void cvt_matrix(Frame& F, const float* W, const float* g, int K, int N, int Npad, bf16* WT) {
    LAS float* scr = (LAS float*)(F.lds + RING_OFF + F.wave * 16384);
    const int gw = F.bid * NWAVES + F.wave, NGW = F.G * NWAVES;
    const int nblk = Npad / 32, nitems = (K / 64) * nblk;
    for (int it = gw; it < nitems; it += NGW) cvt_item(W, g, K, N, WT, scr, it / nblk, it % nblk, F.lane);
}
__device__ __forceinline__ void cvt_layer_rest(Frame& F, int layer) {
    cvt_matrix(F, F.w_out + (size_t)layer * DM * DM, nullptr, DM, DM, DM, (bf16*)(F.ws + WS_WOUT));
    cvt_matrix(F, F.w_ff_in + (size_t)layer * DM * DFF, F.n2g + layer * DM, DM, DFF, DFF, (bf16*)(F.ws + WS_WFI));
    cvt_matrix(F, F.w_ff_out + (size_t)layer * DFF * DM, nullptr, DFF, DM, DM, (bf16*)(F.ws + WS_WFO));
    if (layer + 1 < DEPTH) cvt_matrix(F, F.w_in + (size_t)(layer + 1) * DM * DIN, F.n1g + (layer + 1) * DM, DM, DIN, DINP, (bf16*)(F.ws + WS_WIN));
}

__device__ __forceinline__ void p_prologue(Frame& F) {
    const int gtid = F.bid * NTHR + F.tid, NT = F.G * NTHR;
    float* tab = (float*)(F.ws + WS_ROPE);
    for (int idx = gtid; idx < M * 8; idx += NT) {
        const int row = idx >> 3, i = idx & 7;
        const float angf = (float)F.pos[row] * c_invf[i];
        double r = (double)angf * 0.15915494309189535; r -= floor(r);
        const float a = (float)(r * 6.283185307179586);
        tab[row * 16 + i] = cosf(a); tab[row * 16 + 8 + i] = sinf(a);
    }
    if (gtid < 256) {
        const int c = gtid; float* lb = (float*)(F.ws + WS_LB);
        const float l0 = F.lb_logits[c], l1 = F.lb_logits[256 + c], l2 = F.lb_logits[512 + c], l3 = F.lb_logits[768 + c];
        const float mx = fmaxf(fmaxf(l0, l1), fmaxf(l2, l3));
        const float e0 = expf(l0 - mx), e1 = expf(l1 - mx), e2 = expf(l2 - mx), e3 = expf(l3 - mx);
        const float inv = 1.0f / (e0 + e1 + e2 + e3);
        lb[c] = 0.f; lb[256 + c] = e1 * inv; lb[512 + c] = (e1 + e2) * inv; lb[768 + c] = (e1 + e2 + e3) * inv;
    }
    const int gw = F.bid * NWAVES + F.wave, NGW = F.G * NWAVES;
    bf16* xb = (bf16*)(F.ws + WS_XB); float* ssq = (float*)(F.ws + WS_SSQ);
    for (int row = gw; row < M; row += NGW) {
        const f32x4* xr = (const f32x4*)(F.x_in + (size_t)row * DM) + F.lane;
        f32x4 v[4]; float s = 0.f;
#pragma unroll
        for (int j = 0; j < 4; ++j) { v[j] = xr[64 * j]; s += (v[j][0] * v[j][0] + v[j][1] * v[j][1]) + (v[j][2] * v[j][2] + v[j][3] * v[j][3]); }
        s = wave_sum(s);
        unsigned long long* o8 = (unsigned long long*)(xb + (size_t)row * DM) + F.lane;
#pragma unroll
        for (int j = 0; j < 4; ++j) o8[64 * j] = (unsigned long long)pk2(v[j][0], v[j][1]) | ((unsigned long long)pk2(v[j][2], v[j][3]) << 32);
        if (F.lane < 16) ssq[(size_t)row * 16 + F.lane] = (F.lane == 0) ? s : 0.f;
    }
    cvt_matrix(F, F.w_in, F.n1g, DM, DIN, DINP, (bf16*)(F.ws + WS_WIN));
}

__device__ __forceinline__ void p_rope(Frame& F) {
    const int gtid = F.bid * NTHR + F.tid, NT = F.G * NTHR;
    const float* tab = (const float*)(F.ws + WS_ROPE);
    bf16* proj = (bf16*)(F.ws + WS_PROJ); float* idxf = (float*)(F.ws + WS_IDXF);
    for (int idx = gtid; idx < M * 15 * 8; idx += NT) {
        const int i = idx & 7, rh = idx >> 3, hh = rh % 15, row = rh / 15;
        const float c = tab[row * 16 + i], s = tab[row * 16 + 8 + i];
        if (hh < 10) {
            const int col = hh < 8 ? PC_Q + hh * 64 : PC_K + (hh - 8) * 64;
            bf16* p = proj + (size_t)row * PROJ_LD + col;
            const float x1 = bf2f(p[i]), x2 = bf2f(p[8 + i]);
            p[i] = (bf16)f2bf(x1 * c - x2 * s); p[8 + i] = (bf16)f2bf(x2 * c + x1 * s);
        } else {
            const int col = hh < 14 ? IC_QI + (hh - 10) * 64 : IC_KI;
            float* p = idxf + (size_t)row * IDX_LD + col;
            const float x1 = p[i], x2 = p[8 + i];
            p[i] = x1 * c - x2 * s; p[8 + i] = x2 * c + x1 * s;
        }
    }
}

__device__ __forceinline__ void p_pool(Frame& F, int layer) {
    LAS float* P = (LAS float*)(F.lds + RING_OFF);
    const bf16* proj = (const bf16*)(F.ws + WS_PROJ); bf16* mixed = (bf16*)(F.ws + WS_MIXED);
    const float* pw = F.pool_w + (size_t)layer * 4 * 64 * 64; const float* ps = F.pool_scale + layer * 256;
    const int c = F.tid & 255, half = F.tid >> 8, g = c >> 6, win = 2 << g, dd = c & 63;
    for (int unit = F.bid; unit < M / 16; unit += F.G) {
        const int t0 = unit * 16;
        for (int tt = half * 8; tt < half * 8 + 8; ++tt) {
            const int row = t0 + tt, tloc = row & (SEQ - 1); const int cnt = (tloc + 1 < win) ? tloc + 1 : win;
            float s = 0.f;
            for (int j = 0; j < cnt; ++j) s += bf2f(proj[(size_t)(row - j) * PROJ_LD + PC_POOL + c]);
            P[tt * 256 + c] = s / (float)cnt - bf2f(proj[(size_t)row * PROJ_LD + PC_POOL + c]);
        }
        __syncthreads();
        for (int tt = half * 8; tt < half * 8 + 8; ++tt) {
            float y = 0.f;
#pragma unroll 8
            for (int cc = 0; cc < 64; ++cc) y += P[tt * 256 + g * 64 + cc] * pw[(g * 64 + cc) * 64 + dd];
            mixed[(size_t)(t0 + tt) * DM + MC_POOL + c] = (bf16)f2bf(y * ps[c]);
        }
        __syncthreads();
    }
}

__device__ __forceinline__ unsigned sort_key(float v) { if (v == 0.f) v = 0.f; const unsigned u = __builtin_bit_cast(unsigned, v); return (u & 0x80000000u) ? ~u : (u | 0x80000000u); }
__device__ __forceinline__ void p_mask(Frame& F) {
    LAS float* qi_s = (LAS float*)(F.lds + RING_OFF);
    LAS unsigned* red_s = (LAS unsigned*)(F.lds + RING_OFF + 1024);
    const float* idxf = (const float*)(F.ws + WS_IDXF); unsigned* mask = (unsigned*)(F.ws + WS_MASK);
    const int tid = F.tid, lane = F.lane, wave = F.wave;
    for (int row = F.bid; row < M; row += F.G) {
        const int b = row >> 11, t = row & (SEQ - 1), n = t + 1;
        unsigned* mrow = mask + (size_t)row * 64;
        if (n <= TOPK) {
            if (tid < 64) { const int lo = tid * 32; mrow[tid] = (n >= lo + 32) ? 0xffffffffu : (n > lo ? ((1u << (n - lo)) - 1u) : 0u); }
            continue;
        }
        if (tid < 256) qi_s[tid] = idxf[(size_t)row * IDX_LD + IC_QI + tid];
        const f32x4 wv = *(const f32x4*)(idxf + (size_t)row * IDX_LD + IC_WI);
        __syncthreads();
        unsigned key[4];
#pragma unroll
        for (int i = 0; i < 4; ++i) {
            const int s = i * 512 + tid; key[i] = 0u;
            if (s < n) {
                const f32x4* kp = (const f32x4*)(idxf + (size_t)(b * SEQ + s) * IDX_LD + IC_KI);
                float d0 = 0.f, d1 = 0.f, d2 = 0.f, d3 = 0.f;
#pragma unroll 4
                for (int d = 0; d < 16; ++d) {
                    const f32x4 kv = kp[d];
                    const f32x4 q0 = *(const LAS f32x4*)(qi_s + d * 4), q1 = *(const LAS f32x4*)(qi_s + 64 + d * 4), q2 = *(const LAS f32x4*)(qi_s + 128 + d * 4), q3 = *(const LAS f32x4*)(qi_s + 192 + d * 4);
                    d0 += kv[0] * q0[0] + kv[1] * q0[1] + kv[2] * q0[2] + kv[3] * q0[3];
                    d1 += kv[0] * q1[0] + kv[1] * q1[1] + kv[2] * q1[2] + kv[3] * q1[3];
                    d2 += kv[0] * q2[0] + kv[1] * q2[1] + kv[2] * q2[2] + kv[3] * q2[3];
                    d3 += kv[0] * q3[0] + kv[1] * q3[1] + kv[2] * q3[2] + kv[3] * q3[3];
                }
                const float I = wv[0] * fmaxf(d0, 0.f) + wv[1] * fmaxf(d1, 0.f) + wv[2] * fmaxf(d2, 0.f) + wv[3] * fmaxf(d3, 0.f);
                key[i] = sort_key(I);
            }
        }
        unsigned prefix = 0u; int par = 0;
        for (int bit = 31; bit >= 0; --bit) {
            const unsigned cand = prefix | (1u << bit);
            unsigned wc_ = 0u;
#pragma unroll
            for (int i = 0; i < 4; ++i) wc_ += (unsigned)__popcll(__ballot(key[i] >= cand));
            if (lane == 0) red_s[par * 8 + wave] = wc_;
            __syncthreads();
            unsigned tot = 0u;
#pragma unroll
            for (int w = 0; w < 8; ++w) tot += red_s[par * 8 + w];
            if (tot >= (unsigned)TOPK) prefix = cand;
            par ^= 1;
        }
        const unsigned tau = prefix;
        unsigned long long eqb[4]; unsigned gtc = 0u;
#pragma unroll
        for (int i = 0; i < 4; ++i) { eqb[i] = __ballot(key[i] == tau); gtc += (unsigned)__popcll(__ballot(key[i] > tau)); if (lane == 0) red_s[16 + i * 8 + wave] = (unsigned)__popcll(eqb[i]); }
        if (lane == 0) red_s[par * 8 + wave] = gtc;
        __syncthreads();
        unsigned cgt = 0u;
#pragma unroll
        for (int w = 0; w < 8; ++w) cgt += red_s[par * 8 + w];
        const unsigned need = (unsigned)TOPK - cgt;
#pragma unroll
        for (int i = 0; i < 4; ++i) {
            const int g = i * 8 + wave; unsigned base = 0u;
            for (int gg = 0; gg < g; ++gg) base += red_s[16 + gg];
            const unsigned rank = base + (unsigned)__popcll(eqb[i] & ((1ull << lane) - 1ull));
            const bool sel = (key[i] > tau) || ((key[i] == tau) && (rank < need));
            const unsigned long long sb = __ballot(sel);
            if (lane == 0) { mrow[g * 2] = (unsigned)sb; mrow[g * 2 + 1] = (unsigned)(sb >> 32); }
        }
        __syncthreads();
    }
}

__device__ __forceinline__ void p_hgrn_seq(Frame& F, int layer) {
    if (F.wave != 0 || F.bid >= 32) return;
    const int b = F.bid >> 2, h = F.bid & 3, lane = F.lane;
    LAS float* Fs = (LAS float*)(F.lds + RING_OFF); LAS float* Ks = Fs + 4096; LAS float* Qs = Ks + 4096;
    const bf16* proj = (const bf16*)(F.ws + WS_PROJ); bf16* mixed = (bf16*)(F.ws + WS_MIXED);
    const float lbv = ((const float*)(F.ws + WS_LB))[layer * 256 + h * 64 + lane];
    const float ng = F.hgrn_g[layer * 256 + h * 64 + lane];
    float S[64];
#pragma unroll
    for (int k = 0; k < 64; ++k) S[k] = 0.f;
    for (int chunk = 0; chunk < SEQ / 64; ++chunk) {
        const size_t row0 = (size_t)b * SEQ + chunk * 64;
        for (int tt = 0; tt < 64; ++tt) {
            const bf16* pr = proj + (row0 + tt) * PROJ_LD + h * 64 + lane;
            const float z = bf2f(pr[PC_HF]), qr = bf2f(pr[PC_HQ]);
            const float sig = 1.0f / (1.0f + expf(-z));
            float f = lbv + (1.0f - lbv) * sig; f = fmaxf(f, 1e-30f);
            Fs[tt * 64 + lane] = f; Ks[tt * 64 + lane] = (1.0f - lbv) * (1.0f - sig); Qs[tt * 64 + lane] = qr / (1.0f + expf(-qr));
        }
        LDS_WAIT(); asm volatile("" ::: "memory");
        for (int tt = 0; tt < 64; ++tt) {
            const bf16* pr = proj + (row0 + tt) * PROJ_LD + h * 64 + lane;
            const float iv = bf2f(pr[PC_HI]), gr = bf2f(pr[PC_HG]);
            float o = 0.f;
#pragma unroll
            for (int k = 0; k < 64; k += 4) {
                const f32x4 f4 = *(const LAS f32x4*)(Fs + tt * 64 + k), k4 = *(const LAS f32x4*)(Ks + tt * 64 + k), q4 = *(const LAS f32x4*)(Qs + tt * 64 + k);
#pragma unroll
                for (int e = 0; e < 4; ++e) { S[k + e] = f4[e] * S[k + e] + k4[e] * iv; o += q4[e] * S[k + e]; }
            }
            const float ms = wave_sum(o * o) * (1.0f / 64.0f);
            const float y = o * (1.0f / sqrtf(ms + 1e-5f)) * ng * (gr / (1.0f + expf(-gr)));
            mixed[(row0 + tt) * DM + MC_HGRN + h * 64 + lane] = (bf16)f2bf(y);
        }
        LDS_WAIT(); asm volatile("" ::: "memory");
    }
}

__device__ __forceinline__ void p_vt(Frame& F) {
    LAS unsigned short* T = (LAS unsigned short*)(F.lds + RING_OFF + F.wave * 16384);
    const bf16* proj = (const bf16*)(F.ws + WS_PROJ); bf16* vT = (bf16*)(F.ws + WS_VT);
    const int gw = F.bid * NWAVES + F.wave, NGW = F.G * NWAVES, lane = F.lane;
    for (int tile = gw; tile < BATCH * 2 * (SEQ / 64); tile += NGW) {
        const int bk = tile >> 5, tb = tile & 31, b = bk >> 1, kvh = bk & 1;
        const bf16* src = proj + (size_t)(b * SEQ + tb * 64) * PROJ_LD + PC_V + kvh * 64 + lane;
#pragma unroll 8
        for (int t = 0; t < 64; ++t) T[t * 66 + lane] = src[(size_t)t * PROJ_LD];
        LDS_WAIT(); asm volatile("" ::: "memory");
        bf16* dst = vT + (size_t)(bk * 64) * SEQ + tb * 64 + lane;
#pragma unroll 8
        for (int d = 0; d < 64; ++d) dst[(size_t)d * SEQ] = T[lane * 66 + d];
        LDS_WAIT(); asm volatile("" ::: "memory");
    }
}

typedef float f32x16 __attribute__((ext_vector_type(16)));
typedef short bf16x8v __attribute__((ext_vector_type(8)));
typedef float f32x2v __attribute__((ext_vector_type(2))); typedef __bf16 bf16x2v __attribute__((ext_vector_type(2)));
__device__ __forceinline__ unsigned cvtpk(float lo, float hi) { f32x2v v = {lo, hi}; bf16x2v b = __builtin_convertvector(v, bf16x2v); return __builtin_bit_cast(unsigned, b); }
constexpr int AT_KROW = 144, AT_VROW = 136, AT_KBYTES = 64 * AT_KROW, AT_VBYTES = 64 * AT_VROW, AT_BUF = AT_KBYTES + AT_VBYTES, AT_SCR = 2 * AT_BUF;
static_assert(AT_BUF % 16 == 0 && AT_SCR % 16 == 0, "attention LDS map alignment");
__device__ __forceinline__ void p_attn_flash(Frame& F) {
    const int tid = F.tid, lane = F.lane, wave = F.wave;
    const int r = lane & 31, hh = lane >> 5, g = wave & 3, qh = wave >> 2;
    LAS unsigned char* L = F.lds + RING_OFF;
    LAS float* scr = (LAS float*)(L + AT_SCR) + wave * 32;
    const bf16* proj = (const bf16*)(F.ws + WS_PROJ); const bf16* vT = (const bf16*)(F.ws + WS_VT); bf16* mixed = (bf16*)(F.ws + WS_MIXED);
    const unsigned* mask = (const unsigned*)(F.ws + WS_MASK);
    const int srow = tid >> 3, sch = tid & 7;
    const float C2 = 0.18033688011112042f, NEG = -1.0e30f;
    for (int pair = F.bid; pair < 256; pair += F.G) {
        const int bk = pair >> 4, b = bk >> 1, kvh = bk & 1, pp = pair & 15, h = kvh * 4 + g;
        for (int half = 0; half < 2; ++half) {
            const int qblk = half == 0 ? 31 - pp : pp;
            const int q0 = qblk * 64, nt = qblk + 1;
            const int tq = q0 + 32 * qh + r;
            bf16x8v qf[4];
            { const bf16* qp = proj + (size_t)(b * SEQ + tq) * PROJ_LD + PC_Q + h * 64 + 8 * hh;
#pragma unroll
              for (int d0 = 0; d0 < 4; ++d0) qf[d0] = *(const bf16x8v*)(qp + 16 * d0); }
            const unsigned* mrow = mask + (size_t)(b * SEQ + tq) * 64;
            const bf16* kg = proj + (size_t)(b * SEQ + srow) * PROJ_LD + PC_K + kvh * 64 + sch * 8;
            const bf16* vg = vT + (size_t)(bk * 64 + srow) * SEQ + sch * 8;
            { const v4u kreg = *(const v4u*)kg; const v4u vreg = *(const v4u*)vg;
              *(LAS v4u*)(L + srow * AT_KROW + sch * 16) = kreg;
              LAS unsigned char* vd = L + AT_KBYTES + srow * AT_VROW + sch * 16;
              *(LAS v2u*)vd = (v2u){vreg.x, vreg.y}; *(LAS v2u*)(vd + 8) = (v2u){vreg.z, vreg.w}; }
            v2u mw = *(const v2u*)mrow;
            __syncthreads();
            f32x16 o0, o1;
#pragma unroll
            for (int i = 0; i < 16; ++i) { o0[i] = 0.f; o1[i] = 0.f; }
            float m = -30000.0f, l = 0.f;
            for (int j = 0; j < nt; ++j) {
                LAS unsigned char* Kb = L + (j & 1) * AT_BUF; LAS unsigned char* Vb = Kb + AT_KBYTES;
                const bool more = (j + 1 < nt);
                v4u kn = (v4u){0u, 0u, 0u, 0u}, vn = (v4u){0u, 0u, 0u, 0u}; v2u mwn = (v2u){0u, 0u};
                if (more) { kn = *(const v4u*)(kg + (size_t)(j + 1) * 64 * PROJ_LD); vn = *(const v4u*)(vg + (j + 1) * 64); mwn = *(const v2u*)(mrow + 2 * (j + 1)); }
                f32x16 p0, p1;
#pragma unroll
                for (int i = 0; i < 16; ++i) { p0[i] = 0.f; p1[i] = 0.f; }
#pragma unroll
                for (int d0 = 0; d0 < 4; ++d0) {
                    const bf16x8v a0 = *(const LAS bf16x8v*)(Kb + r * AT_KROW + d0 * 32 + hh * 16);
                    const bf16x8v a1 = *(const LAS bf16x8v*)(Kb + (32 + r) * AT_KROW + d0 * 32 + hh * 16);
                    p0 = __builtin_amdgcn_mfma_f32_32x32x16_bf16(a0, qf[d0], p0, 0, 0, 0);
                    p1 = __builtin_amdgcn_mfma_f32_32x32x16_bf16(a1, qf[d0], p1, 0, 0, 0);
                }
                const unsigned w0 = mw.x >> (4 * hh), w1 = mw.y >> (4 * hh);
                float mx = NEG;
#pragma unroll
                for (int i = 0; i < 16; ++i) {
                    const int cr = (i & 3) + 8 * (i >> 2);
                    p0[i] = ((w0 >> cr) & 1u) ? p0[i] : NEG; p1[i] = ((w1 >> cr) & 1u) ? p1[i] : NEG;
                    mx = fmaxf(mx, fmaxf(p0[i], p1[i]));
                }
                mx = fmaxf(mx, __shfl_xor(mx, 32));
                const float mnew = fmaxf(m, mx * C2);
                const float alpha = __builtin_amdgcn_exp2f(m - mnew); m = mnew;
                float rs = 0.f;
#pragma unroll
                for (int i = 0; i < 16; ++i) {
                    p0[i] = __builtin_amdgcn_exp2f(__builtin_fmaf(p0[i], C2, -mnew)); p1[i] = __builtin_amdgcn_exp2f(__builtin_fmaf(p1[i], C2, -mnew));
                    rs += p0[i] + p1[i];
                }
                l = l * alpha + rs;
                if (hh == 0) scr[r] = alpha;
#pragma unroll
                for (int gq = 0; gq < 4; ++gq) {
                    const f32x4 a4 = *(const LAS f32x4*)(scr + 8 * gq + 4 * hh);
#pragma unroll
                    for (int e = 0; e < 4; ++e) { o0[4 * gq + e] *= a4[e]; o1[4 * gq + e] *= a4[e]; }
                }
                bf16x8v pf[4];
                { v4u t;
                  t.x = cvtpk(p0[0], p0[1]); t.y = cvtpk(p0[2], p0[3]); t.z = cvtpk(p0[4], p0[5]); t.w = cvtpk(p0[6], p0[7]); pf[0] = __builtin_bit_cast(bf16x8v, t);
                  t.x = cvtpk(p0[8], p0[9]); t.y = cvtpk(p0[10], p0[11]); t.z = cvtpk(p0[12], p0[13]); t.w = cvtpk(p0[14], p0[15]); pf[1] = __builtin_bit_cast(bf16x8v, t);
                  t.x = cvtpk(p1[0], p1[1]); t.y = cvtpk(p1[2], p1[3]); t.z = cvtpk(p1[4], p1[5]); t.w = cvtpk(p1[6], p1[7]); pf[2] = __builtin_bit_cast(bf16x8v, t);
                  t.x = cvtpk(p1[8], p1[9]); t.y = cvtpk(p1[10], p1[11]); t.z = cvtpk(p1[12], p1[13]); t.w = cvtpk(p1[14], p1[15]); pf[3] = __builtin_bit_cast(bf16x8v, t); }
#pragma unroll
                for (int ks = 0; ks < 4; ++ks) {
                    const LAS unsigned char* vp = Vb + r * AT_VROW + (16 * ks + 4 * hh) * 2;
                    const v2u l0 = *(const LAS v2u*)vp, h0 = *(const LAS v2u*)(vp + 16);
                    const v2u l1 = *(const LAS v2u*)(vp + 32 * AT_VROW), h1 = *(const LAS v2u*)(vp + 32 * AT_VROW + 16);
                    const bf16x8v vf0 = __builtin_bit_cast(bf16x8v, (v4u){l0.x, l0.y, h0.x, h0.y});
                    const bf16x8v vf1 = __builtin_bit_cast(bf16x8v, (v4u){l1.x, l1.y, h1.x, h1.y});
                    o0 = __builtin_amdgcn_mfma_f32_32x32x16_bf16(pf[ks], vf0, o0, 0, 0, 0);
                    o1 = __builtin_amdgcn_mfma_f32_32x32x16_bf16(pf[ks], vf1, o1, 0, 0, 0);
                }
                if (more) {
                    LAS unsigned char* Kn = L + ((j + 1) & 1) * AT_BUF;
                    *(LAS v4u*)(Kn + srow * AT_KROW + sch * 16) = kn;
                    LAS unsigned char* vd = Kn + AT_KBYTES + srow * AT_VROW + sch * 16;
                    *(LAS v2u*)vd = (v2u){vn.x, vn.y}; *(LAS v2u*)(vd + 8) = (v2u){vn.z, vn.w};
                    mw = mwn;
                }
                __syncthreads();
            }
            l += __shfl_xor(l, 32);
            if (hh == 0) scr[r] = 1.0f / l;
            bf16* op = mixed + (size_t)(b * SEQ + q0 + 32 * qh) * DM + MC_ATTN + h * 64 + r;
#pragma unroll
            for (int gq = 0; gq < 4; ++gq) {
                const f32x4 a4 = *(const LAS f32x4*)(scr + 8 * gq + 4 * hh);
#pragma unroll
                for (int e = 0; e < 4; ++e) {
                    const int q = 8 * gq + 4 * hh + e;
                    op[(size_t)q * DM] = (bf16)f2bf(o0[4 * gq + e] * a4[e]); op[(size_t)q * DM + 32] = (bf16)f2bf(o1[4 * gq + e] * a4[e]);
                }
            }
        }
    }
}

__device__ __forceinline__ void p_final(Frame& F) {
    const int gw = F.bid * NWAVES + F.wave, NGW = F.G * NWAVES;
    for (int row = gw; row < M; row += NGW) {
        f32x4* xr = (f32x4*)(F.xres + (size_t)row * DM) + F.lane;
        const f32x4* gr = (const f32x4*)F.fng + F.lane;
        f32x4 v[4]; float s = 0.f;
#pragma unroll
        for (int j = 0; j < 4; ++j) { v[j] = xr[64 * j]; s += (v[j][0] * v[j][0] + v[j][1] * v[j][1]) + (v[j][2] * v[j][2] + v[j][3] * v[j][3]); }
        s = wave_sum(s);
        const float rs = 1.0f / sqrtf(s * (1.0f / 1024.0f) + 1e-5f);
#pragma unroll
        for (int j = 0; j < 4; ++j) xr[64 * j] = v[j] * rs * gr[64 * j];
    }
}

#ifndef MK_SINGLE
#define MK_SINGLE 1
#endif
constexpr int NPL = 8;
constexpr int NPHASE = 1 + DEPTH * NPL + 1;
struct Args { const float* x; const int* pos; const float *n1g, *w_in, *pool_w, *pool_scale, *lb_logits, *hgrn_g, *w_out, *n2g, *w_ff_in, *w_ff_out, *fng; float* out; unsigned char* ws; int ph_lo, ph_hi; };
static_assert(sizeof(Args) == 15 * 8 + 8, "Args has no padding");


#define PHASE_BEGIN() do { int t_ = threadIdx.x; asm volatile("" : "+v"(t_)); F.tid = t_; F.lane = t_ & 63; F.wave = __builtin_amdgcn_readfirstlane(t_ >> 6); \
    unsigned char* w_ = args.ws; asm volatile("" : "+s"(w_)); F.ws = w_; } while (0)
__global__ void __launch_bounds__(NTHR, 2) fwd(Args args) {
    extern __shared__ __attribute__((aligned(16))) unsigned char lds[];
    Frame F;
    F.lds = (LAS unsigned char*)lds;
    F.MISC = (volatile LAS unsigned*)(F.lds + MISC_OFF);
    F.tid = threadIdx.x; F.lane = F.tid & 63; F.wave = __builtin_amdgcn_readfirstlane(F.tid >> 6);
    F.G = gridDim.x; F.bid = blockIdx.x;
    F.ws = args.ws; F.ctl = (gu32*)(args.ws + WS_CTL);
    F.x_in = args.x; F.pos = args.pos; F.n1g = args.n1g; F.w_in = args.w_in; F.pool_w = args.pool_w; F.pool_scale = args.pool_scale; F.lb_logits = args.lb_logits;
    F.hgrn_g = args.hgrn_g; F.w_out = args.w_out; F.n2g = args.n2g; F.w_ff_in = args.w_ff_in; F.w_ff_out = args.w_ff_out; F.fng = args.fng; F.xres = args.out;
    for (int u = F.tid; u < (LDS_BYTES - LDSCTL_OFF) / 4; u += NTHR) ((LAS unsigned*)(F.lds + LDSCTL_OFF))[u] = 0u;
    __syncthreads();
    XcdBarrier bar; bar.bar = (unsigned*)(F.ctl + CW_BAR); bar.x = 0; bar.st = nullptr;
    if (MK_SINGLE) bar = xcd_barrier_post((unsigned*)(F.ctl + CW_BAR), F.MISC + 8);
    const int lo = args.ph_lo, hi = args.ph_hi;
#define IN(k) (lo <= (k) && (k) < hi)
#define SEAM(k) do { if (MK_SINGLE && IN(k) && IN((k) + 1)) xcd_barrier(bar); } while (0)
    bf16* const xb = (bf16*)(F.ws + WS_XB); float* const ssq = (float*)(F.ws + WS_SSQ);
    bf16* const proj = (bf16*)(F.ws + WS_PROJ); bf16* const mixed = (bf16*)(F.ws + WS_MIXED); bf16* const hid = (bf16*)(F.ws + WS_HID);
    float* const idxf = (float*)(F.ws + WS_IDXF);

    if (IN(0)) { PHASE_BEGIN(); p_prologue(F); } SEAM(0);
    for (int layer = 0; layer < DEPTH; ++layer) {
        const int pb = 1 + layer * NPL;
        if (IN(pb + 0)) {
            pg8::Gemm g{xb, (const bf16*)(F.ws + WS_WIN), M, DINP, DM}; pg8::StaticOrder S; S.init(M, DINP, F.G, F.bid);
            pg8::EpiIn E{proj, idxf, ssq};
            pg8::gemm_phase<pg8::EpiIn, pg8::StaticOrder, true, true>(F.lds + RING_OFF, g, S, E);
        } SEAM(pb + 0);
        if (IN(pb + 1)) { PHASE_BEGIN(); p_rope(F); p_vt(F); cvt_layer_rest(F, layer); } SEAM(pb + 1);
        if (IN(pb + 2)) { PHASE_BEGIN(); p_pool(F, layer); PHASE_BEGIN(); p_mask(F); } SEAM(pb + 2);
        if (IN(pb + 3)) { PHASE_BEGIN(); p_hgrn_seq(F, layer); } SEAM(pb + 3);
        if (IN(pb + 4)) { PHASE_BEGIN(); p_attn_flash(F); } SEAM(pb + 4);
        if (IN(pb + 5)) {
            pg8::Gemm g{mixed, (const bf16*)(F.ws + WS_WOUT), M, DM, DM}; pg8::StaticOrder S; S.init(M, DM, F.G, F.bid);
            pg8::EpiRes E{layer == 0 ? F.x_in : (const float*)F.xres, F.xres, xb, ssq};
            pg8::gemm_phase<pg8::EpiRes, pg8::StaticOrder, true, true>(F.lds + RING_OFF, g, S, E);
        } SEAM(pb + 5);
        if (IN(pb + 6)) {
            pg8::Gemm g{xb, (const bf16*)(F.ws + WS_WFI), M, DFF, DM}; pg8::StaticOrder S; S.init(M, DFF, F.G, F.bid);
            pg8::EpiFfIn E{hid, ssq};
            pg8::gemm_phase<pg8::EpiFfIn, pg8::StaticOrder, true, true>(F.lds + RING_OFF, g, S, E);
        } SEAM(pb + 6);
        if (IN(pb + 7)) {
            pg8::Gemm g{hid, (const bf16*)(F.ws + WS_WFO), M, DM, DFF}; pg8::StaticOrder S; S.init(M, DM, F.G, F.bid);
            pg8::EpiRes E{(const float*)F.xres, F.xres, xb, ssq};
            pg8::gemm_phase<pg8::EpiRes, pg8::StaticOrder, true, true>(F.lds + RING_OFF, g, S, E);
        } SEAM(pb + 7);
    }
    if (IN(NPHASE - 1)) { PHASE_BEGIN(); p_final(F); }
#undef IN
#undef SEAM
}

extern "C" void kernel_launch(void* const* d_in, const int* in_sizes, int n_in, void* d_out, int out_size, void* d_ws, size_t ws_size, hipStream_t stream) {
    static int grid = 0;
    if (grid == 0) {
        if (n_in != 13 || out_size != M * DM || ws_size < WS_END) { fprintf(stderr, "kernel_launch: unexpected shapes (n_in %d, out %d, ws %zu)\n", n_in, out_size, ws_size); grid = -1; return; }
        int dev = 0, cus = 0, per_cu = 0;
        if (hipGetDevice(&dev) != hipSuccess || hipDeviceGetAttribute(&cus, hipDeviceAttributeMultiprocessorCount, dev) != hipSuccess) { grid = -1; return; }
        if (hipFuncSetAttribute((const void*)fwd, hipFuncAttributeMaxDynamicSharedMemorySize, LDS_BYTES) != hipSuccess) { fprintf(stderr, "kernel_launch: hipFuncSetAttribute failed\n"); grid = -1; return; }
        if (hipOccupancyMaxActiveBlocksPerMultiprocessor(&per_cu, (const void*)fwd, NTHR, LDS_BYTES) != hipSuccess || per_cu < 1) { fprintf(stderr, "kernel_launch: occupancy query says %d\n", per_cu); }
        (void)hipGetLastError();
        grid = cus;
        if (grid > 256) grid = 256;
        grid -= grid % 8;
    }
    if (grid <= 0) return;
    (void)hipMemsetAsync((char*)d_ws + WS_CTL, 0, CTL_ZERO_BYTES, stream);
    Args a{};
    a.x = (const float*)d_in[0]; a.pos = (const int*)d_in[1]; a.n1g = (const float*)d_in[2]; a.w_in = (const float*)d_in[3]; a.pool_w = (const float*)d_in[4];
    a.pool_scale = (const float*)d_in[5]; a.lb_logits = (const float*)d_in[6]; a.hgrn_g = (const float*)d_in[7]; a.w_out = (const float*)d_in[8]; a.n2g = (const float*)d_in[9];
    a.w_ff_in = (const float*)d_in[10]; a.w_ff_out = (const float*)d_in[11]; a.fng = (const float*)d_in[12];
    a.out = (float*)d_out; a.ws = (unsigned char*)d_ws;
    if (MK_SINGLE) {
        a.ph_lo = 0; a.ph_hi = NPHASE;
        hipLaunchKernelGGL(fwd, dim3(grid), dim3(NTHR), LDS_BYTES, stream, a);
    } else {
        for (int p = 0; p < NPHASE; ++p) { a.ph_lo = p; a.ph_hi = p + 1; hipLaunchKernelGGL(fwd, dim3(grid), dim3(NTHR), LDS_BYTES, stream, a); }
    }
}
```

```cpp
#include <hip/hip_runtime.h>
#include <cstdio>
#include <cstdint>
namespace pg8 {
#define PG8_LAS __attribute__((address_space(3)))
typedef unsigned short bf16_t;
typedef short bf16x8 __attribute__((ext_vector_type(8)));
typedef float f32x4 __attribute__((ext_vector_type(4)));
typedef unsigned u32x4 __attribute__((ext_vector_type(4)));
constexpr int BM = 256, BK = 64, HALF = 128, HTB = HALF * BK * 2  , STAGE_BYTES = 8 * HTB, NXCD = 8, WGM = 8;

__host__ __device__ __forceinline__ int lds_byte(int r, int c) { const int st = (r >> 4) * 2 + (c >> 5), rr = r & 15, cc = c & 31, ob = rr * 64 + cc * 2; return st * 1024 + (ob ^ (((ob >> 9) & 1) << 5)); }
__host__ __device__ __forceinline__ void stage_rc(int b, int& R, int& C) { const int st = b / 1024, sb = b % 1024, swz = sb ^ (((sb >> 9) & 1) << 5); R = (st >> 1) * 16 + swz / 64; C = (st & 1) * 32 + (swz % 64) / 2; }
__host__ __device__ __forceinline__ int perm32(int rho) { const int n = rho >> 4, i = rho & 15; return 8 * (i >> 2) + 4 * n + (i & 3); }

struct Unit { int pm, pn; };
struct Gemm { const bf16_t* A; const bf16_t* Bt; int M, N, K; };

struct StaticOrder {
    int nM, nN, nwg, G, c;
    __host__ __device__ void init(int M, int N, int G_, int c_) { nM = M / BM; nN = N / BM; nwg = nM * nN; G = G_; c = c_; }
    __host__ __device__ bool next(int i, Unit& u) const {
        const long L = (long)i * G + c; if (L >= nwg) return false;
        int wgid = (int)L; { const int q = nwg / NXCD, r = nwg % NXCD, xcd = wgid % NXCD, off = wgid / NXCD; wgid = (xcd < r ? xcd * (q + 1) : r * (q + 1) + (xcd - r) * q) + off; }
        const int nig = WGM * nN, gid = wgid / nig, fm = gid * WGM, gsz = (nM - fm) < WGM ? (nM - fm) : WGM;
        u.pm = fm + ((wgid % nig) % gsz); u.pn = (wgid % nig) / gsz; return true;
    }
    __device__ __forceinline__ void a_ready(const Unit&) const {}
    __device__ __forceinline__ void done(const Unit&) const {}
};

__device__ __forceinline__ unsigned cvt_pk_bf16(float lo, float hi) { unsigned r; asm volatile("v_cvt_pk_bf16_f32 %0, %1, %2" : "=v"(r) : "v"(lo), "v"(hi)); return r; }
typedef float f32x2 __attribute__((ext_vector_type(2)));

constexpr float RMS_EPS_F = 1e-5f;
__device__ __forceinline__ float row_rstd(const float* ssq, int row) {
    const f32x4* p = (const f32x4*)(ssq + (size_t)row * 16);
    const f32x4 a = p[0], b = p[1], c = p[2], d = p[3];
    const float s = ((a[0] + a[1]) + (a[2] + a[3])) + ((b[0] + b[1]) + (b[2] + b[3])) + ((c[0] + c[1]) + (c[2] + c[3])) + ((d[0] + d[1]) + (d[2] + d[3]));
    return 1.0f / sqrtf(s * (1.0f / 1024.0f) + RMS_EPS_F);
}
struct EpiIn {
    static constexpr bool PERM = true, AFTER_DRAIN = false;
    bf16_t* proj; float* idxf; const float* ssq;
    __device__ __forceinline__ void operator()(const f32x4 (&acc)[2][2][4][2], const Unit& u, int wr, int wc, int fr, int fq) const {
        const int row0 = u.pm * BM + wr * 64 + fr;
        const int colt = u.pn * BM + wc * 32 + 8 * fq;
#pragma unroll
        for (int ai = 0; ai < 2; ++ai)
#pragma unroll
            for (int m = 0; m < 4; ++m) {
                const int row = row0 + ai * HALF + m * 16;
                const float rs = row_rstd(ssq, row);
#pragma unroll
                for (int bj = 0; bj < 2; ++bj) {
                    const f32x4 v0 = acc[ai][bj][m][0] * rs, v1 = acc[ai][bj][m][1] * rs;
                    const int col = colt + bj * HALF;
                    if (u.pn < 8) {
                        u32x4 w; w.x = cvt_pk_bf16(v0[0], v0[1]); w.y = cvt_pk_bf16(v0[2], v0[3]); w.z = cvt_pk_bf16(v1[0], v1[1]); w.w = cvt_pk_bf16(v1[2], v1[3]);
                        *(u32x4*)(proj + (size_t)row * 2048 + col) = w;
                    } else {
                        float* o = idxf + (size_t)row * 512 + (col - 2048);
                        *(f32x4*)o = v0; *(f32x4*)(o + 4) = v1;
                    }
                }
            }
    }
};
struct EpiRes {
    static constexpr bool PERM = true, AFTER_DRAIN = false;
    const float* xin; float* xout; bf16_t* xb; float* ssq;
    __device__ __forceinline__ void operator()(const f32x4 (&acc)[2][2][4][2], const Unit& u, int wr, int wc, int fr, int fq) const {
        const int row0 = u.pm * BM + wr * 64 + fr;
        const int colt = u.pn * BM + wc * 32 + 8 * fq;
#pragma unroll
        for (int ai = 0; ai < 2; ++ai)
#pragma unroll
            for (int m = 0; m < 4; ++m) {
                const int row = row0 + ai * HALF + m * 16;
                float sq = 0.f;
#pragma unroll
                for (int bj = 0; bj < 2; ++bj) {
                    const size_t off = (size_t)row * 1024 + colt + bj * HALF;
                    const f32x4 a0 = *(const f32x4*)(xin + off), a1 = *(const f32x4*)(xin + off + 4);
                    const f32x4 v0 = a0 + acc[ai][bj][m][0], v1 = a1 + acc[ai][bj][m][1];
                    *(f32x4*)(xout + off) = v0; *(f32x4*)(xout + off + 4) = v1;
                    u32x4 w; w.x = cvt_pk_bf16(v0[0], v0[1]); w.y = cvt_pk_bf16(v0[2], v0[3]); w.z = cvt_pk_bf16(v1[0], v1[1]); w.w = cvt_pk_bf16(v1[2], v1[3]);
                    *(u32x4*)(xb + off) = w;
                    sq += (v0[0] * v0[0] + v0[1] * v0[1]) + (v0[2] * v0[2] + v0[3] * v0[3]) + (v1[0] * v1[0] + v1[1] * v1[1]) + (v1[2] * v1[2] + v1[3] * v1[3]);
                }
                sq += __shfl_xor(sq, 16); sq += __shfl_xor(sq, 32);
                if (fq == 0) ssq[(size_t)row * 16 + u.pn * 4 + wc] = sq;
            }
    }
};
struct EpiFfIn {
    static constexpr bool PERM = true, AFTER_DRAIN = false;
    bf16_t* hid; const float* ssq;
    __device__ __forceinline__ void operator()(const f32x4 (&acc)[2][2][4][2], const Unit& u, int wr, int wc, int fr, int fq) const {
        const int row0 = u.pm * BM + wr * 64 + fr;
        const int colt = u.pn * BM + wc * 32 + 8 * fq;
#pragma unroll
        for (int ai = 0; ai < 2; ++ai)
#pragma unroll
            for (int m = 0; m < 4; ++m) {
                const int row = row0 + ai * HALF + m * 16;
                const float rs = row_rstd(ssq, row);
#pragma unroll
                for (int bj = 0; bj < 2; ++bj) {
                    f32x4 v0 = acc[ai][bj][m][0] * rs, v1 = acc[ai][bj][m][1] * rs;
#pragma unroll
                    for (int e = 0; e < 4; ++e) { const float a = fmaxf(v0[e], 0.f), b = fmaxf(v1[e], 0.f); v0[e] = a * a; v1[e] = b * b; }
                    u32x4 w; w.x = cvt_pk_bf16(v0[0], v0[1]); w.y = cvt_pk_bf16(v0[2], v0[3]); w.z = cvt_pk_bf16(v1[0], v1[1]); w.w = cvt_pk_bf16(v1[2], v1[3]);
                    *(u32x4*)(hid + (size_t)row * 4096 + colt + bj * HALF) = w;
                }
            }
    }
};
template <class Epi, class Sched, bool ALIGN_EPI = false, bool SP2 = false>
__device__ __forceinline__ void gemm_phase(PG8_LAS unsigned char* lds, const Gemm g, const Sched& S, const Epi& E) {
    int tid_ = threadIdx.x; asm volatile("" : "+v"(tid_));
    const int tid = tid_, wid = __builtin_amdgcn_readfirstlane(tid >> 6), lane = tid & 63, wr = wid >> 2, wc = wid & 3, fr = lane & 15, fq = lane >> 4;
    const int K = g.K, nt = K / BK;
    unsigned voffA[2], voffB[2];
#pragma unroll
    for (int i = 0; i < 2; ++i) { int R, C; stage_rc(tid * 16 + i * 8192, R, C); const int Rb = Epi::PERM ? ((R & ~31) + perm32(R & 31)) : R;
        voffA[i] = (unsigned)(R * K + C) * 2u; voffB[i] = (unsigned)(Rb * K + C) * 2u; }
    const size_t kstep = (size_t)(BK * 2);
    const size_t hstep = (size_t)HALF * K * 2;
    const size_t tstep = 2 * hstep;
    const unsigned ldsw = (unsigned)wid * 1024u;
    const int aoff = lds_byte(wr * 64 + fr, fq * 8), boff = lds_byte(wc * 32 + fr, fq * 8);
#define PG8_SA(b, h) (((b) * 2 + (h)) * HTB)
#define PG8_SB(b, h) ((4 + (b) * 2 + (h)) * HTB)
#define PG8_STAGE(bufoff, gbase, voff) do { _Pragma("unroll") for (int _i = 0; _i < 2; ++_i) \
        __builtin_amdgcn_global_load_lds((const unsigned*)((const char*)(gbase) + (voff)[_i]), (PG8_LAS unsigned*)(lds + (bufoff) + ldsw + _i * 8192), 16, 0, 0); } while (0)
#define PG8_LDA(dst, b, h) do { _Pragma("unroll") for (int m = 0; m < 4; ++m) _Pragma("unroll") for (int k = 0; k < 2; ++k) dst[m][k] = *(const PG8_LAS bf16x8*)(lds + PG8_SA(b, h) + aoff + m * 2048 + k * 1024); } while (0)
#define PG8_LDB(dst, b, h) do { _Pragma("unroll") for (int n = 0; n < 2; ++n) _Pragma("unroll") for (int k = 0; k < 2; ++k) dst[n][k] = *(const PG8_LAS bf16x8*)(lds + PG8_SB(b, h) + boff + n * 2048 + k * 1024); } while (0)
#define PG8_MMA(ai, bj, At, Bt) do { __builtin_amdgcn_s_setprio(1); _Pragma("unroll") for (int m = 0; m < 4; ++m) _Pragma("unroll") for (int n = 0; n < 2; ++n) _Pragma("unroll") for (int k = 0; k < 2; ++k) \
        acc[ai][bj][m][n] = __builtin_amdgcn_mfma_f32_16x16x32_bf16(Bt[n][k], At[m][k], acc[ai][bj][m][n], 0, 0, 0); __builtin_amdgcn_s_setprio(0); } while (0)
#define PG8_WAIT_V(n) asm volatile("s_waitcnt vmcnt(" #n ")" ::: "memory")
#define PG8_WAIT_L(n) asm volatile("s_waitcnt lgkmcnt(" #n ")" ::: "memory")
#define PG8_BAR __builtin_amdgcn_s_barrier()
#define PG8_SCHED __builtin_amdgcn_sched_barrier(0)
    Unit cur, nxt; int ui = 0;
    if (!S.next(0, cur)) return;
    f32x4 acc[2][2][4][2];
#pragma unroll
    for (int a = 0; a < 2; ++a)
#pragma unroll
        for (int b = 0; b < 2; ++b)
#pragma unroll
            for (int m = 0; m < 4; ++m)
#pragma unroll
                for (int n = 0; n < 2; ++n) acc[a][b][m][n] = (f32x4){0.f, 0.f, 0.f, 0.f};
    bf16x8 At[4][2], B0[2][2], B1[2][2];
    const char* cA = (const char*)g.A + (size_t)cur.pm * tstep; const char* cB = (const char*)g.Bt + (size_t)cur.pn * tstep;
    S.a_ready(cur);
    if constexpr (SP2) {
        PG8_STAGE(PG8_SB(0, 0), cB, voffB); PG8_STAGE(PG8_SB(0, 1), cB + hstep, voffB); PG8_STAGE(PG8_SA(0, 0), cA, voffA); PG8_STAGE(PG8_SA(0, 1), cA + hstep, voffA);
        if (wr == 1) PG8_BAR;
        PG8_WAIT_V(2); PG8_BAR;
        PG8_STAGE(PG8_SB(1, 0), cB + kstep, voffB); PG8_STAGE(PG8_SA(1, 0), cA + kstep, voffA); PG8_STAGE(PG8_SB(1, 1), cB + hstep + kstep, voffB);
        PG8_WAIT_V(6); PG8_BAR;
    } else {
        PG8_STAGE(PG8_SB(0, 0), cB, voffB); PG8_STAGE(PG8_SA(0, 0), cA, voffA); PG8_STAGE(PG8_SB(0, 1), cB + hstep, voffB); PG8_STAGE(PG8_SA(0, 1), cA + hstep, voffA);
        if (wr == 1) PG8_BAR;
        PG8_WAIT_V(4); PG8_BAR;
        PG8_STAGE(PG8_SB(1, 0), cB + kstep, voffB); PG8_STAGE(PG8_SA(1, 0), cA + kstep, voffA); PG8_STAGE(PG8_SB(1, 1), cB + hstep + kstep, voffB);
        PG8_WAIT_V(6); PG8_BAR;
    }
    for (;;) {
        const bool has_next = S.next(ui + 1, nxt);
        const char* nA = has_next ? (const char*)g.A + (size_t)nxt.pm * tstep : cA; const char* nB = has_next ? (const char*)g.Bt + (size_t)nxt.pn * tstep : cB;
        for (int t = 0; t < nt; t += 2) {
            const bool last = (t == nt - 2);
            const char* a1 = cA + (size_t)(t + 1) * kstep;
            const char* a2 = last ? nA : cA + (size_t)(t + 2) * kstep; const char* b2 = last ? nB : cB + (size_t)(t + 2) * kstep;
            const char* a3 = a2 + kstep; const char* b3 = b2 + kstep;
            if (last && has_next) S.a_ready(nxt);
            if constexpr (SP2) {
            PG8_LDB(B0, 0, 0); PG8_LDB(B1, 0, 1); PG8_SCHED; PG8_LDA(At, 0, 0); PG8_STAGE(PG8_SA(1, 1), a1 + hstep, voffA);
            PG8_WAIT_V(8); PG8_WAIT_L(0); PG8_BAR; PG8_MMA(0, 0, At, B0); PG8_MMA(0, 1, At, B1); PG8_BAR; PG8_SCHED;
            PG8_LDA(At, 0, 1); PG8_STAGE(PG8_SB(0, 0), b2, voffB); PG8_STAGE(PG8_SB(0, 1), b2 + hstep, voffB); PG8_STAGE(PG8_SA(0, 0), a2, voffA);
            PG8_WAIT_V(8); PG8_WAIT_L(0); PG8_BAR; PG8_MMA(1, 0, At, B0); PG8_MMA(1, 1, At, B1); PG8_BAR; PG8_SCHED;
            PG8_LDB(B0, 1, 0); PG8_LDB(B1, 1, 1); PG8_SCHED; PG8_LDA(At, 1, 0); PG8_STAGE(PG8_SA(0, 1), a2 + hstep, voffA);
            PG8_WAIT_V(8); PG8_WAIT_L(0); PG8_BAR; PG8_MMA(0, 0, At, B0); PG8_MMA(0, 1, At, B1); PG8_BAR; PG8_SCHED;
            PG8_LDA(At, 1, 1); PG8_STAGE(PG8_SB(1, 0), b3, voffB); PG8_STAGE(PG8_SB(1, 1), b3 + hstep, voffB); PG8_STAGE(PG8_SA(1, 0), a3, voffA);
            PG8_WAIT_V(8); PG8_WAIT_L(0); PG8_BAR; PG8_MMA(1, 0, At, B0); PG8_MMA(1, 1, At, B1); PG8_BAR; PG8_SCHED;
            } else {
            PG8_LDB(B0, 0, 0); PG8_SCHED; PG8_LDA(At, 0, 0); PG8_STAGE(PG8_SA(1, 1), a1 + hstep, voffA);
            PG8_WAIT_L(8); PG8_BAR; PG8_WAIT_L(0); PG8_MMA(0, 0, At, B0); PG8_BAR; PG8_SCHED;
            PG8_LDB(B1, 0, 1); PG8_STAGE(PG8_SB(0, 0), b2, voffB);
            PG8_BAR; PG8_WAIT_L(0); PG8_MMA(0, 1, At, B1); PG8_BAR;
            PG8_LDA(At, 0, 1); PG8_STAGE(PG8_SA(0, 0), a2, voffA);
            PG8_BAR; PG8_WAIT_L(0); PG8_MMA(1, 0, At, B0); PG8_BAR; PG8_SCHED;
            PG8_STAGE(PG8_SB(0, 1), b2 + hstep, voffB);
            PG8_WAIT_V(6); PG8_BAR; PG8_MMA(1, 1, At, B1); PG8_BAR;
            PG8_LDB(B0, 1, 0); PG8_SCHED; PG8_LDA(At, 1, 0); PG8_STAGE(PG8_SA(0, 1), a2 + hstep, voffA);
            PG8_WAIT_L(8); PG8_BAR; PG8_WAIT_L(0); PG8_MMA(0, 0, At, B0); PG8_BAR; PG8_SCHED;
            PG8_LDB(B1, 1, 1); PG8_STAGE(PG8_SB(1, 0), b3, voffB);
            PG8_BAR; PG8_WAIT_L(0); PG8_MMA(0, 1, At, B1); PG8_BAR;
            PG8_LDA(At, 1, 1); PG8_STAGE(PG8_SA(1, 0), a3, voffA);
            PG8_BAR; PG8_WAIT_L(0); PG8_MMA(1, 0, At, B0); PG8_BAR; PG8_SCHED;
            PG8_STAGE(PG8_SB(1, 1), b3 + hstep, voffB);
            PG8_WAIT_V(6); PG8_BAR; PG8_MMA(1, 1, At, B1); PG8_BAR;
            }
        }
        if constexpr (ALIGN_EPI) { if (wr == 0) PG8_BAR; }
        if constexpr (!Epi::AFTER_DRAIN) { E(acc, cur, wr, wc, fr, fq); S.done(cur); }
        if (!has_next) break;
#pragma unroll
        for (int a = 0; a < 2; ++a)
#pragma unroll
            for (int b = 0; b < 2; ++b)
#pragma unroll
                for (int m = 0; m < 4; ++m)
#pragma unroll
                    for (int n = 0; n < 2; ++n) acc[a][b][m][n] = (f32x4){0.f, 0.f, 0.f, 0.f};
        cur = nxt; cA = nA; cB = nB; ++ui;
        if constexpr (ALIGN_EPI) { if (wr == 1) PG8_BAR; }
    }
    PG8_WAIT_V(0);
    if constexpr (!ALIGN_EPI) { if (wr == 0) PG8_BAR; }
    PG8_BAR;
    if constexpr (Epi::AFTER_DRAIN) { E.fused(acc, cur, wr, wc, fr, fq, lds, wid, lane); S.done(cur); }
#undef PG8_SA
#undef PG8_SB
#undef PG8_STAGE
#undef PG8_LDA
#undef PG8_LDB
#undef PG8_MMA
#undef PG8_WAIT_V
#undef PG8_WAIT_L
#undef PG8_BAR
#undef PG8_SCHED
}
}

constexpr int BATCH = 8, SEQ = 2048, DM = 1024, DEPTH = 4, M = BATCH * SEQ, DIN = 2372, DINP = 2560, DFF = 4096;
constexpr int NWAVES = 8, NTHR = NWAVES * 64;
constexpr int TOPK = 256;
constexpr int PC_POOL = 0, PC_HQ = 256, PC_HF = 512, PC_HI = 768, PC_HG = 1024, PC_Q = 1280, PC_K = 1792, PC_V = 1920, PROJ_LD = 2048;
constexpr int IC_QI = 0, IC_KI = 256, IC_WI = 320, IDX_LD = 512;
constexpr int MC_POOL = 0, MC_HGRN = 256, MC_ATTN = 512;

constexpr size_t MiB = 1u << 20;
constexpr size_t WS_CTL = 0, CTL_ZERO_BYTES = 1 * MiB;
constexpr size_t WS_ROPE = 1 * MiB;
constexpr size_t WS_SSQ = 2 * MiB;
constexpr size_t WS_LB = 3 * MiB;
constexpr size_t WS_MASK = 4 * MiB;
constexpr size_t WS_WIN = 8 * MiB;
constexpr size_t WS_WOUT = 13 * MiB;
constexpr size_t WS_WFI = 15 * MiB;
constexpr size_t WS_WFO = 23 * MiB;
constexpr size_t WS_XB = 32 * MiB;
constexpr size_t WS_HID = 64 * MiB;
constexpr size_t WS_PROJ = 64 * MiB;
constexpr size_t WS_MIXED = 128 * MiB;
constexpr size_t WS_HST = 160 * MiB;
constexpr size_t WS_HDN = 176 * MiB;
constexpr size_t WS_IDXF = 192 * MiB;
constexpr size_t WS_VT = 224 * MiB;
constexpr size_t WS_END = 256 * MiB;
constexpr int CW_TMO = 0, CW_BAR = 4096;

constexpr int RING_OFF = 0, RING_BYTES = 131072;
constexpr int LDSCTL_OFF = RING_BYTES, MISC_OFF = LDSCTL_OFF + 320;
constexpr int LDS_BYTES = 147456;

#define GAS __attribute__((address_space(1)))
#define LAS __attribute__((address_space(3)))
typedef unsigned short bf16;
typedef unsigned v4u __attribute__((ext_vector_type(4)));
typedef unsigned v2u __attribute__((ext_vector_type(2)));
typedef float f32x4 __attribute__((ext_vector_type(4)));
typedef GAS unsigned gu32;
#define RLX_AGENT __ATOMIC_RELAXED, __HIP_MEMORY_SCOPE_AGENT
#define LDS_WAIT() asm volatile("s_waitcnt lgkmcnt(0)" ::: "memory")
__device__ __forceinline__ unsigned f2bf(float f) { unsigned u = __builtin_bit_cast(unsigned, f); return (u + 0x7fffu + ((u >> 16) & 1u)) >> 16; }
__device__ __forceinline__ unsigned pk2(float lo, float hi) { return f2bf(lo) | (f2bf(hi) << 16); }
__device__ __forceinline__ float bf2f(unsigned short h) { return __builtin_bit_cast(float, (unsigned)h << 16); }
__device__ __forceinline__ float wave_sum(float v) {
#pragma unroll
    for (int o = 1; o < 64; o <<= 1) v += __shfl_xor(v, o);
    return v;
}
__device__ __forceinline__ float wave_max(float v) {
#pragma unroll
    for (int o = 1; o < 64; o <<= 1) v = fmaxf(v, __shfl_xor(v, o));
    return v;
}
#define XB_TMO      128
#define XB_XCNT(j)  (256  + 64 * (j))
#define XB_XSUB(j)  (1280 + 64 * (j))
#define XB_XGEN(j)  (2304 + 64 * (j))
#define XB_TOP      3328
#define XB_TOPGEN   3392
#define XCD_BAR_WORDS 3456
#define XB_SPIN_CAP (1u << 18)

__device__ __forceinline__ unsigned xb_ld(unsigned* p)              { return __hip_atomic_load(p, __ATOMIC_RELAXED, __HIP_MEMORY_SCOPE_AGENT); }
__device__ __forceinline__ unsigned xb_add(unsigned* p, unsigned v) { return __hip_atomic_fetch_add(p, v, __ATOMIC_RELAXED, __HIP_MEMORY_SCOPE_AGENT); }
__device__ __forceinline__ unsigned xb_xcc_id() { return (unsigned)__builtin_amdgcn_s_getreg((3 << 11) | 20) & 0xFu; }
#define XB_SPIN(cond, bar) do { unsigned _sp = 0; while (cond) { __builtin_amdgcn_s_sleep(1); \
    if ((++_sp & 255u) == 0u) { if (xb_ld(&(bar)[XB_TMO])) break; if (_sp > XB_SPIN_CAP) { atomicAdd(&(bar)[XB_TMO], 1u); break; } } } } while (0)

struct XcdBarrier {
    unsigned* bar; unsigned x;
    volatile LAS unsigned* st;
};

__device__ __forceinline__ XcdBarrier xcd_barrier_post(unsigned* bar, volatile LAS unsigned* st) {
    XcdBarrier b; b.bar = bar; b.x = xb_xcc_id(); b.st = st;
    if (threadIdx.x == 0) (void)xb_add(&bar[XB_XCNT(b.x)], 1u);
    return b;
}
__device__ __forceinline__ void xcd_barrier_complete(unsigned* bar, unsigned x, unsigned& nloc, unsigned& nx) {
    const unsigned G = gridDim.x * gridDim.y * gridDim.z;
    unsigned sum, cnt, mine, sp = 0u;
    for (;;) {
        sum = 0u; cnt = 0u; mine = 0u;
#pragma unroll
        for (unsigned j = 0; j < 16; ++j) { const unsigned c = xb_ld(&bar[XB_XCNT(j)]); sum += c; cnt += (c > 0u) ? 1u : 0u; mine = (j == x) ? c : mine; }
        if (sum == G) break;
        __builtin_amdgcn_s_sleep(1);
        if ((++sp & 255u) == 0u) { if (xb_ld(&bar[XB_TMO])) break; if (sp > XB_SPIN_CAP) { atomicAdd(&bar[XB_TMO], 1u); break; } }
    }
    nloc = mine > 0u ? mine : 1u; nx = cnt > 0u ? cnt : 1u;
}

__device__ __forceinline__ void xcd_barrier(const XcdBarrier& b) {
    asm volatile("s_waitcnt vmcnt(0)" ::: "memory");
    __syncthreads();
    if (threadIdx.x == 0) {
        unsigned* bar = b.bar;
        __builtin_amdgcn_s_waitcnt(0);
        unsigned nloc = b.st[0], nx = b.st[1];
        if (nloc == 0u) { xcd_barrier_complete(bar, b.x, nloc, nx); b.st[0] = nloc; b.st[1] = nx; }
        const unsigned old = xb_add(&bar[XB_XSUB(b.x)], 1u);
        const unsigned gen = old / nloc;
        if (old + 1u == (gen + 1u) * nloc) {
            __builtin_amdgcn_fence(__ATOMIC_RELEASE, "agent");
            asm volatile("s_waitcnt vmcnt(0)" ::: "memory");
            const unsigned og = xb_add(&bar[XB_TOP], 1u);
            const unsigned tg = og / nx;
            if (og + 1u == (tg + 1u) * nx) xb_add(&bar[XB_TOPGEN], 1u);
            else XB_SPIN(xb_ld(&bar[XB_TOPGEN]) == tg, bar);
            __builtin_amdgcn_fence(__ATOMIC_ACQUIRE, "agent");
            xb_add(&bar[XB_XGEN(b.x)], 1u);
            asm volatile("s_waitcnt vmcnt(0)" ::: "memory");
        } else {
            XB_SPIN(xb_ld(&bar[XB_XGEN(b.x)]) == gen, bar);
            __builtin_amdgcn_fence(__ATOMIC_ACQUIRE, "agent");
            asm volatile("s_waitcnt vmcnt(0)" ::: "memory");
        }
    }
    __syncthreads();
}


struct Frame {
    LAS unsigned char* lds;
    volatile LAS unsigned* MISC;
    gu32* ctl;
    int tid, lane, wave, G, bid;
    const float* x_in; const int* pos;
    const float *n1g, *w_in, *pool_w, *pool_scale, *lb_logits, *hgrn_g, *w_out, *n2g, *w_ff_in, *w_ff_out, *fng;
    float* xres;
    unsigned char* ws;
};
__constant__ float c_invf[8] = {1.0f, 0.19392274474868576f, 0.03760603093086393f, 0.007292664737217109f, 0.001414213562373095f, 0.0002742481756762073f, 5.318295896944988e-05f, 1.031338537721246e-05f};

__device__ __forceinline__ void cvt_item(const float* W, const float* g, int K, int N, bf16* WT, LAS float* scr, int kb, int nb, int lane) {
    const int k0 = 64 * kb, n0 = 32 * nb;
    const int n = n0 + (lane & 31);
#pragma unroll 8
    for (int i = 0; i < 32; ++i) { const int kk = 2 * i + (lane >> 5); float v = (n < N) ? W[(size_t)(k0 + kk) * N + n] : 0.f; if (g) v *= g[k0 + kk]; scr[kk * 33 + (lane & 31)] = v; }
    LDS_WAIT(); asm volatile("" ::: "memory");
    const int c = lane & 7;
#pragma unroll
    for (int j = 0; j < 4; ++j) { const int nl = (lane >> 3) + 8 * j; const LAS float* s = scr + (8 * c) * 33 + nl;
        v4u o; o.x = pk2(s[0 * 33], s[1 * 33]); o.y = pk2(s[2 * 33], s[3 * 33]); o.z = pk2(s[4 * 33], s[5 * 33]); o.w = pk2(s[6 * 33], s[7 * 33]);
        *(GAS v4u*)(WT + (size_t)(n0 + nl) * K + k0 + 8 * c) = o; }
    LDS_WAIT(); asm volatile("" ::: "memory");
}
__device__ __forceinline__ void cvt_matrix(Frame& F, const float* W, const float* g, int K, int N, int Npad, bf16* WT) {
    LAS float* scr = (LAS float*)(F.lds + RING_OFF + F.wave * 16384);
    const int gw = F.bid * NWAVES + F.wave, NGW = F.G * NWAVES;
    const int nblk = Npad / 32, nitems = (K / 64) * nblk;
    for (int it = gw; it < nitems; it += NGW) cvt_item(W, g, K, N, WT, scr, it / nblk, it % nblk, F.lane);
}
__device__ __forceinline__ void cvt_layer_rest(Frame& F, int layer) {
    cvt_matrix(F, F.w_out + (size_t)layer * DM * DM, nullptr, DM, DM, DM, (bf16*)(F.ws + WS_WOUT));
    cvt_matrix(F, F.w_ff_in + (size_t)layer * DM * DFF, F.n2g + layer * DM, DM, DFF, DFF, (bf16*)(F.ws + WS_WFI));
    cvt_matrix(F, F.w_ff_out + (size_t)layer * DFF * DM, nullptr, DFF, DM, DM, (bf16*)(F.ws + WS_WFO));
    if (layer + 1 < DEPTH) cvt_matrix(F, F.w_in + (size_t)(layer + 1) * DM * DIN, F.n1g + (layer + 1) * DM, DM, DIN, DINP, (bf16*)(F.ws + WS_WIN));
}

__device__ __forceinline__ void p_prologue(Frame& F) {
    const int gtid = F.bid * NTHR + F.tid, NT = F.G * NTHR;
    float* tab = (float*)(F.ws + WS_ROPE);
    for (int idx = gtid; idx < M * 8; idx += NT) {
        const int row = idx >> 3, i = idx & 7;
        const float angf = (float)F.pos[row] * c_invf[i];
        double r = (double)angf * 0.15915494309189535; r -= floor(r);
        const float a = (float)(r * 6.283185307179586);
        tab[row * 16 + i] = cosf(a); tab[row * 16 + 8 + i] = sinf(a);
    }
    if (gtid < 256) {
        const int c = gtid; float* lb = (float*)(F.ws + WS_LB);
        const float l0 = F.lb_logits[c], l1 = F.lb_logits[256 + c], l2 = F.lb_logits[512 + c], l3 = F.lb_logits[768 + c];
        const float mx = fmaxf(fmaxf(l0, l1), fmaxf(l2, l3));
        const float e0 = expf(l0 - mx), e1 = expf(l1 - mx), e2 = expf(l2 - mx), e3 = expf(l3 - mx);
        const float inv = 1.0f / (e0 + e1 + e2 + e3);
        lb[c] = 0.f; lb[256 + c] = e1 * inv; lb[512 + c] = (e1 + e2) * inv; lb[768 + c] = (e1 + e2 + e3) * inv;
    }
    const int gw = F.bid * NWAVES + F.wave, NGW = F.G * NWAVES;
    bf16* xb = (bf16*)(F.ws + WS_XB); float* ssq = (float*)(F.ws + WS_SSQ);
    for (int row = gw; row < M; row += NGW) {
        const f32x4* xr = (const f32x4*)(F.x_in + (size_t)row * DM) + F.lane;
        f32x4 v[4]; float s = 0.f;
#pragma unroll
        for (int j = 0; j < 4; ++j) { v[j] = xr[64 * j]; s += (v[j][0] * v[j][0] + v[j][1] * v[j][1]) + (v[j][2] * v[j][2] + v[j][3] * v[j][3]); }
        s = wave_sum(s);
        unsigned long long* o8 = (unsigned long long*)(xb + (size_t)row * DM) + F.lane;
#pragma unroll
        for (int j = 0; j < 4; ++j) o8[64 * j] = (unsigned long long)pk2(v[j][0], v[j][1]) | ((unsigned long long)pk2(v[j][2], v[j][3]) << 32);
        if (F.lane < 16) ssq[(size_t)row * 16 + F.lane] = (F.lane == 0) ? s : 0.f;
    }
    cvt_matrix(F, F.w_in, F.n1g, DM, DIN, DINP, (bf16*)(F.ws + WS_WIN));
}

__device__ __forceinline__ void p_rope(Frame& F) {
    const int gtid = F.bid * NTHR + F.tid, NT = F.G * NTHR;
    const float* tab = (const float*)(F.ws + WS_ROPE);
    bf16* proj = (bf16*)(F.ws + WS_PROJ); float* idxf = (float*)(F.ws + WS_IDXF);
    for (int idx = gtid; idx < M * 15 * 8; idx += NT) {
        const int i = idx & 7, rh = idx >> 3, hh = rh % 15, row = rh / 15;
        const float c = tab[row * 16 + i], s = tab[row * 16 + 8 + i];
        if (hh < 10) {
            const int col = hh < 8 ? PC_Q + hh * 64 : PC_K + (hh - 8) * 64;
            bf16* p = proj + (size_t)row * PROJ_LD + col;
            const float x1 = bf2f(p[i]), x2 = bf2f(p[8 + i]);
            p[i] = (bf16)f2bf(x1 * c - x2 * s); p[8 + i] = (bf16)f2bf(x2 * c + x1 * s);
        } else {
            const int col = hh < 14 ? IC_QI + (hh - 10) * 64 : IC_KI;
            float* p = idxf + (size_t)row * IDX_LD + col;
            const float x1 = p[i], x2 = p[8 + i];
            p[i] = x1 * c - x2 * s; p[8 + i] = x2 * c + x1 * s;
        }
    }
}

__device__ __forceinline__ void p_pool(Frame& F, int layer) {
    LAS float* P = (LAS float*)(F.lds + RING_OFF);
    const bf16* proj = (const bf16*)(F.ws + WS_PROJ); bf16* mixed = (bf16*)(F.ws + WS_MIXED);
    const float* pw = F.pool_w + (size_t)layer * 4 * 64 * 64; const float* ps = F.pool_scale + layer * 256;
    const int c = F.tid & 255, half = F.tid >> 8, g = c >> 6, win = 2 << g, dd = c & 63;
    for (int unit = F.bid; unit < M / 16; unit += F.G) {
        const int t0 = unit * 16;
        for (int tt = half * 8; tt < half * 8 + 8; ++tt) {
            const int row = t0 + tt, tloc = row & (SEQ - 1); const int cnt = (tloc + 1 < win) ? tloc + 1 : win;
            float s = 0.f;
            for (int j = 0; j < cnt; ++j) s += bf2f(proj[(size_t)(row - j) * PROJ_LD + PC_POOL + c]);
            P[tt * 256 + c] = s / (float)cnt - bf2f(proj[(size_t)row * PROJ_LD + PC_POOL + c]);
        }
        __syncthreads();
        for (int tt = half * 8; tt < half * 8 + 8; ++tt) {
            float y = 0.f;
#pragma unroll 8
            for (int cc = 0; cc < 64; ++cc) y += P[tt * 256 + g * 64 + cc] * pw[(g * 64 + cc) * 64 + dd];
            mixed[(size_t)(t0 + tt) * DM + MC_POOL + c] = (bf16)f2bf(y * ps[c]);
        }
        __syncthreads();
    }
}

__device__ __forceinline__ unsigned sort_key(float v) { if (v == 0.f) v = 0.f; const unsigned u = __builtin_bit_cast(unsigned, v); return (u & 0x80000000u) ? ~u : (u | 0x80000000u); }
__device__ __forceinline__ void p_mask(Frame& F) {
    LAS float* qi_s = (LAS float*)(F.lds + RING_OFF);
    LAS unsigned* red_s = (LAS unsigned*)(F.lds + RING_OFF + 1024);
    const float* idxf = (const float*)(F.ws + WS_IDXF); unsigned* mask = (unsigned*)(F.ws + WS_MASK);
    const int tid = F.tid, lane = F.lane, wave = F.wave;
    for (int row = F.bid; row < M; row += F.G) {
        const int b = row >> 11, t = row & (SEQ - 1), n = t + 1;
        unsigned* mrow = mask + (size_t)row * 64;
        if (n <= TOPK) {
            if (tid < 64) { const int lo = tid * 32; mrow[tid] = (n >= lo + 32) ? 0xffffffffu : (n > lo ? ((1u << (n - lo)) - 1u) : 0u); }
            continue;
        }
        if (tid < 256) qi_s[tid] = idxf[(size_t)row * IDX_LD + IC_QI + tid];
        const f32x4 wv = *(const f32x4*)(idxf + (size_t)row * IDX_LD + IC_WI);
        __syncthreads();
        unsigned key[4];
#pragma unroll
        for (int i = 0; i < 4; ++i) {
            const int s = i * 512 + tid; key[i] = 0u;
            if (s < n) {
                const f32x4* kp = (const f32x4*)(idxf + (size_t)(b * SEQ + s) * IDX_LD + IC_KI);
                float d0 = 0.f, d1 = 0.f, d2 = 0.f, d3 = 0.f;
#pragma unroll 4
                for (int d = 0; d < 16; ++d) {
                    const f32x4 kv = kp[d];
                    const f32x4 q0 = *(const LAS f32x4*)(qi_s + d * 4), q1 = *(const LAS f32x4*)(qi_s + 64 + d * 4), q2 = *(const LAS f32x4*)(qi_s + 128 + d * 4), q3 = *(const LAS f32x4*)(qi_s + 192 + d * 4);
                    d0 += kv[0] * q0[0] + kv[1] * q0[1] + kv[2] * q0[2] + kv[3] * q0[3];
                    d1 += kv[0] * q1[0] + kv[1] * q1[1] + kv[2] * q1[2] + kv[3] * q1[3];
                    d2 += kv[0] * q2[0] + kv[1] * q2[1] + kv[2] * q2[2] + kv[3] * q2[3];
                    d3 += kv[0] * q3[0] + kv[1] * q3[1] + kv[2] * q3[2] + kv[3] * q3[3];
                }
                const float I = wv[0] * fmaxf(d0, 0.f) + wv[1] * fmaxf(d1, 0.f) + wv[2] * fmaxf(d2, 0.f) + wv[3] * fmaxf(d3, 0.f);
                key[i] = sort_key(I);
            }
        }
        unsigned prefix = 0u; int par = 0;
        for (int bit = 31; bit >= 0; --bit) {
            const unsigned cand = prefix | (1u << bit);
            unsigned wc_ = 0u;
#pragma unroll
            for (int i = 0; i < 4; ++i) wc_ += (unsigned)__popcll(__ballot(key[i] >= cand));
            if (lane == 0) red_s[par * 8 + wave] = wc_;
            __syncthreads();
            unsigned tot = 0u;
#pragma unroll
            for (int w = 0; w < 8; ++w) tot += red_s[par * 8 + w];
            if (tot >= (unsigned)TOPK) prefix = cand;
            par ^= 1;
        }
        const unsigned tau = prefix;
        unsigned long long eqb[4]; unsigned gtc = 0u;
#pragma unroll
        for (int i = 0; i < 4; ++i) { eqb[i] = __ballot(key[i] == tau); gtc += (unsigned)__popcll(__ballot(key[i] > tau)); if (lane == 0) red_s[16 + i * 8 + wave] = (unsigned)__popcll(eqb[i]); }
        if (lane == 0) red_s[par * 8 + wave] = gtc;
        __syncthreads();
        unsigned cgt = 0u;
#pragma unroll
        for (int w = 0; w < 8; ++w) cgt += red_s[par * 8 + w];
        const unsigned need = (unsigned)TOPK - cgt;
#pragma unroll
        for (int i = 0; i < 4; ++i) {
            const int g = i * 8 + wave; unsigned base = 0u;
            for (int gg = 0; gg < g; ++gg) base += red_s[16 + gg];
            const unsigned rank = base + (unsigned)__popcll(eqb[i] & ((1ull << lane) - 1ull));
            const bool sel = (key[i] > tau) || ((key[i] == tau) && (rank < need));
            const unsigned long long sb = __ballot(sel);
            if (lane == 0) { mrow[g * 2] = (unsigned)sb; mrow[g * 2 + 1] = (unsigned)(sb >> 32); }
        }
        __syncthreads();
    }
}

__device__ __forceinline__ void p_hgrn_local(Frame& F, int layer) {
    const int lane = F.lane;
    LAS float* Fs = (LAS float*)(F.lds + RING_OFF + F.wave * 16384); LAS float* Ks = Fs + 1024;
    const bf16* proj = (const bf16*)(F.ws + WS_PROJ); float* hst = (float*)(F.ws + WS_HST); float* hdn = (float*)(F.ws + WS_HDN);
    for (int unit = F.wave * F.G + F.bid; unit < BATCH * 4 * (SEQ / 64); unit += NWAVES * F.G) {
        const int bh = unit >> 5, chunk = unit & 31, b = bh >> 2, h = bh & 3;
        const float lbv = ((const float*)(F.ws + WS_LB))[layer * 256 + h * 64 + lane];
        const size_t row0 = (size_t)b * SEQ + chunk * 64;
        float S[64]; float dprod = 1.0f;
#pragma unroll
        for (int k = 0; k < 64; ++k) S[k] = 0.f;
        for (int qt = 0; qt < 4; ++qt) {
#pragma unroll 4
            for (int tt = 0; tt < 16; ++tt) {
                const float z = bf2f(proj[(row0 + qt * 16 + tt) * PROJ_LD + PC_HF + h * 64 + lane]);
                const float sig = 1.0f / (1.0f + expf(-z));
                const float f = fmaxf(lbv + (1.0f - lbv) * sig, 1e-30f);
                Fs[tt * 64 + lane] = f; Ks[tt * 64 + lane] = (1.0f - lbv) * (1.0f - sig); dprod *= f;
            }
            LDS_WAIT(); asm volatile("" ::: "memory");
            for (int tt = 0; tt < 16; ++tt) {
                const float iv = bf2f(proj[(row0 + qt * 16 + tt) * PROJ_LD + PC_HI + h * 64 + lane]);
#pragma unroll
                for (int k = 0; k < 64; k += 4) {
                    const f32x4 f4 = *(const LAS f32x4*)(Fs + tt * 64 + k), k4 = *(const LAS f32x4*)(Ks + tt * 64 + k);
#pragma unroll
                    for (int e = 0; e < 4; ++e) S[k + e] = f4[e] * S[k + e] + k4[e] * iv;
                }
            }
            LDS_WAIT(); asm volatile("" ::: "memory");
        }
        float* U = hst + (size_t)unit * 4096 + lane;
#pragma unroll
        for (int k = 0; k < 64; ++k) U[k * 64] = S[k];
        hdn[unit * 64 + lane] = dprod;
    }
}
__device__ __forceinline__ void p_hgrn_scan(Frame& F) {
    float* hst = (float*)(F.ws + WS_HST); const float* hdn = (const float*)(F.ws + WS_HDN);
    for (int e = F.bid * NTHR + F.tid; e < BATCH * 4 * 4096; e += F.G * NTHR) {
        const int bh = e >> 12, kv = e & 4095, k = kv >> 6;
        float S = 0.f;
        for (int n = 0; n < SEQ / 64; ++n) {
            const size_t idx = ((size_t)(bh * 32 + n) << 12) + kv;
            const float u = hst[idx]; hst[idx] = S;
            S = hdn[(bh * 32 + n) * 64 + k] * S + u;
        }
    }
}
constexpr int HG_LDS_OFF = 40960;
__device__ __forceinline__ void p_hgrn_out(Frame& F, int layer) {
    const int lane = F.lane;
    LAS float* Fs = (LAS float*)(F.lds + RING_OFF + HG_LDS_OFF + F.wave * 12288); LAS float* Ks = Fs + 1024; LAS float* Qs = Ks + 1024;
    const bf16* proj = (const bf16*)(F.ws + WS_PROJ); bf16* mixed = (bf16*)(F.ws + WS_MIXED); const float* hst = (const float*)(F.ws + WS_HST);
    for (int unit = F.wave * F.G + F.bid; unit < BATCH * 4 * (SEQ / 64); unit += NWAVES * F.G) {
        const int bh = unit >> 5, chunk = unit & 31, b = bh >> 2, h = bh & 3;
        const float lbv = ((const float*)(F.ws + WS_LB))[layer * 256 + h * 64 + lane];
        const float ng = F.hgrn_g[layer * 256 + h * 64 + lane];
        const size_t row0 = (size_t)b * SEQ + chunk * 64;
        float S[64];
        { const float* U = hst + (size_t)unit * 4096 + lane;
#pragma unroll
          for (int k = 0; k < 64; ++k) S[k] = U[k * 64]; }
        for (int qt = 0; qt < 4; ++qt) {
#pragma unroll 4
            for (int tt = 0; tt < 16; ++tt) {
                const bf16* pr = proj + (row0 + qt * 16 + tt) * PROJ_LD + h * 64 + lane;
                const float z = bf2f(pr[PC_HF]), qr = bf2f(pr[PC_HQ]);
                const float sig = 1.0f / (1.0f + expf(-z));
                Fs[tt * 64 + lane] = fmaxf(lbv + (1.0f - lbv) * sig, 1e-30f); Ks[tt * 64 + lane] = (1.0f - lbv) * (1.0f - sig); Qs[tt * 64 + lane] = qr / (1.0f + expf(-qr));
            }
            LDS_WAIT(); asm volatile("" ::: "memory");
            for (int tt = 0; tt < 16; ++tt) {
                const bf16* pr = proj + (row0 + qt * 16 + tt) * PROJ_LD + h * 64 + lane;
                const float iv = bf2f(pr[PC_HI]), gr = bf2f(pr[PC_HG]);
                float o = 0.f;
#pragma unroll
                for (int k = 0; k < 64; k += 4) {
                    const f32x4 f4 = *(const LAS f32x4*)(Fs + tt * 64 + k), k4 = *(const LAS f32x4*)(Ks + tt * 64 + k), q4 = *(const LAS f32x4*)(Qs + tt * 64 + k);
#pragma unroll
                    for (int e = 0; e < 4; ++e) { S[k + e] = f4[e] * S[k + e] + k4[e] * iv; o += q4[e] * S[k + e]; }
                }
                const float ms = wave_sum(o * o) * (1.0f / 64.0f);
                const float y = o * (1.0f / sqrtf(ms + 1e-5f)) * ng * (gr / (1.0f + expf(-gr)));
                mixed[(row0 + qt * 16 + tt) * DM + MC_HGRN + h * 64 + lane] = (bf16)f2bf(y);
            }
            LDS_WAIT(); asm volatile("" ::: "memory");
        }
    }
}

__device__ __forceinline__ void p_vt(Frame& F) {
    LAS unsigned short* T = (LAS unsigned short*)(F.lds + RING_OFF + F.wave * 16384);
    const bf16* proj = (const bf16*)(F.ws + WS_PROJ); bf16* vT = (bf16*)(F.ws + WS_VT);
    const int gw = F.bid * NWAVES + F.wave, NGW = F.G * NWAVES, lane = F.lane;
    for (int tile = gw; tile < BATCH * 2 * (SEQ / 64); tile += NGW) {
        const int bk = tile >> 5, tb = tile & 31, b = bk >> 1, kvh = bk & 1;
        const bf16* src = proj + (size_t)(b * SEQ + tb * 64) * PROJ_LD + PC_V + kvh * 64 + lane;
#pragma unroll 8
        for (int t = 0; t < 64; ++t) T[t * 66 + lane] = src[(size_t)t * PROJ_LD];
        LDS_WAIT(); asm volatile("" ::: "memory");
        bf16* dst = vT + (size_t)(bk * 64) * SEQ + tb * 64 + lane;
#pragma unroll 8
        for (int d = 0; d < 64; ++d) dst[(size_t)d * SEQ] = T[lane * 66 + d];
        LDS_WAIT(); asm volatile("" ::: "memory");
    }
}

typedef float f32x16 __attribute__((ext_vector_type(16)));
typedef short bf16x8v __attribute__((ext_vector_type(8)));
typedef float f32x2v __attribute__((ext_vector_type(2))); typedef __bf16 bf16x2v __attribute__((ext_vector_type(2)));
__device__ __forceinline__ unsigned cvtpk(float lo, float hi) { f32x2v v = {lo, hi}; bf16x2v b = __builtin_convertvector(v, bf16x2v); return __builtin_bit_cast(unsigned, b); }
constexpr int AT_KROW = 144, AT_VROW = 136, AT_KBYTES = 64 * AT_KROW, AT_VBYTES = 64 * AT_VROW, AT_BUF = AT_KBYTES + AT_VBYTES, AT_SCR = 2 * AT_BUF;
static_assert(AT_BUF % 16 == 0 && AT_SCR % 16 == 0, "attention LDS map alignment");
__device__ __forceinline__ void p_attn_flash(Frame& F) {
    const int tid = F.tid, lane = F.lane, wave = F.wave;
    const int r = lane & 31, hh = lane >> 5, g = wave & 3, qh = wave >> 2;
    LAS unsigned char* L = F.lds + RING_OFF;
    LAS float* scr = (LAS float*)(L + AT_SCR) + wave * 32;
    const bf16* proj = (const bf16*)(F.ws + WS_PROJ); const bf16* vT = (const bf16*)(F.ws + WS_VT); bf16* mixed = (bf16*)(F.ws + WS_MIXED);
    const unsigned* mask = (const unsigned*)(F.ws + WS_MASK);
    const int srow = tid >> 3, sch = tid & 7;
    const float C2 = 0.18033688011112042f, NEG = -1.0e30f;
    for (int pair = F.bid; pair < 256; pair += F.G) {
        const int bk = pair >> 4, b = bk >> 1, kvh = bk & 1, pp = pair & 15, h = kvh * 4 + g;
        for (int half = 0; half < 2; ++half) {
            const int qblk = half == 0 ? 31 - pp : pp;
            const int q0 = qblk * 64, nt = qblk + 1;
            const int tq = q0 + 32 * qh + r;
            bf16x8v qf[4];
            { const bf16* qp = proj + (size_t)(b * SEQ + tq) * PROJ_LD + PC_Q + h * 64 + 8 * hh;
#pragma unroll
              for (int d0 = 0; d0 < 4; ++d0) qf[d0] = *(const bf16x8v*)(qp + 16 * d0); }
            const unsigned* mrow = mask + (size_t)(b * SEQ + tq) * 64;
            const bf16* kg = proj + (size_t)(b * SEQ + srow) * PROJ_LD + PC_K + kvh * 64 + sch * 8;
            const bf16* vg = vT + (size_t)(bk * 64 + srow) * SEQ + sch * 8;
            { const v4u kreg = *(const v4u*)kg; const v4u vreg = *(const v4u*)vg;
              *(LAS v4u*)(L + srow * AT_KROW + sch * 16) = kreg;
              LAS unsigned char* vd = L + AT_KBYTES + srow * AT_VROW + sch * 16;
              *(LAS v2u*)vd = (v2u){vreg.x, vreg.y}; *(LAS v2u*)(vd + 8) = (v2u){vreg.z, vreg.w}; }
            v2u mw = *(const v2u*)mrow;
            __syncthreads();
            f32x16 o0, o1;
#pragma unroll
            for (int i = 0; i < 16; ++i) { o0[i] = 0.f; o1[i] = 0.f; }
            float m = -30000.0f, l = 0.f;
            for (int j = 0; j < nt; ++j) {
                LAS unsigned char* Kb = L + (j & 1) * AT_BUF; LAS unsigned char* Vb = Kb + AT_KBYTES;
                const bool more = (j + 1 < nt);
                v4u kn = (v4u){0u, 0u, 0u, 0u}, vn = (v4u){0u, 0u, 0u, 0u}; v2u mwn = (v2u){0u, 0u};
                if (more) { kn = *(const v4u*)(kg + (size_t)(j + 1) * 64 * PROJ_LD); vn = *(const v4u*)(vg + (j + 1) * 64); mwn = *(const v2u*)(mrow + 2 * (j + 1)); }
                f32x16 p0, p1;
#pragma unroll
                for (int i = 0; i < 16; ++i) { p0[i] = 0.f; p1[i] = 0.f; }
#pragma unroll
                for (int d0 = 0; d0 < 4; ++d0) {
                    const bf16x8v a0 = *(const LAS bf16x8v*)(Kb + r * AT_KROW + d0 * 32 + hh * 16);
                    const bf16x8v a1 = *(const LAS bf16x8v*)(Kb + (32 + r) * AT_KROW + d0 * 32 + hh * 16);
                    p0 = __builtin_amdgcn_mfma_f32_32x32x16_bf16(a0, qf[d0], p0, 0, 0, 0);
                    p1 = __builtin_amdgcn_mfma_f32_32x32x16_bf16(a1, qf[d0], p1, 0, 0, 0);
                }
                const unsigned w0 = mw.x >> (4 * hh), w1 = mw.y >> (4 * hh);
                float mx = NEG;
#pragma unroll
                for (int i = 0; i < 16; ++i) {
                    const int cr = (i & 3) + 8 * (i >> 2);
                    p0[i] = ((w0 >> cr) & 1u) ? p0[i] : NEG; p1[i] = ((w1 >> cr) & 1u) ? p1[i] : NEG;
                    mx = fmaxf(mx, fmaxf(p0[i], p1[i]));
                }
                mx = fmaxf(mx, __shfl_xor(mx, 32));
                const float mnew = fmaxf(m, mx * C2);
                const float alpha = __builtin_amdgcn_exp2f(m - mnew); m = mnew;
                float rs = 0.f;
#pragma unroll
                for (int i = 0; i < 16; ++i) {
                    p0[i] = __builtin_amdgcn_exp2f(__builtin_fmaf(p0[i], C2, -mnew)); p1[i] = __builtin_amdgcn_exp2f(__builtin_fmaf(p1[i], C2, -mnew));
                    rs += p0[i] + p1[i];
                }
                l = l * alpha + rs;
                if (hh == 0) scr[r] = alpha;
#pragma unroll
                for (int gq = 0; gq < 4; ++gq) {
                    const f32x4 a4 = *(const LAS f32x4*)(scr + 8 * gq + 4 * hh);
#pragma unroll
                    for (int e = 0; e < 4; ++e) { o0[4 * gq + e] *= a4[e]; o1[4 * gq + e] *= a4[e]; }
                }
                bf16x8v pf[4];
                { v4u t;
                  t.x = cvtpk(p0[0], p0[1]); t.y = cvtpk(p0[2], p0[3]); t.z = cvtpk(p0[4], p0[5]); t.w = cvtpk(p0[6], p0[7]); pf[0] = __builtin_bit_cast(bf16x8v, t);
                  t.x = cvtpk(p0[8], p0[9]); t.y = cvtpk(p0[10], p0[11]); t.z = cvtpk(p0[12], p0[13]); t.w = cvtpk(p0[14], p0[15]); pf[1] = __builtin_bit_cast(bf16x8v, t);
                  t.x = cvtpk(p1[0], p1[1]); t.y = cvtpk(p1[2], p1[3]); t.z = cvtpk(p1[4], p1[5]); t.w = cvtpk(p1[6], p1[7]); pf[2] = __builtin_bit_cast(bf16x8v, t);
                  t.x = cvtpk(p1[8], p1[9]); t.y = cvtpk(p1[10], p1[11]); t.z = cvtpk(p1[12], p1[13]); t.w = cvtpk(p1[14], p1[15]); pf[3] = __builtin_bit_cast(bf16x8v, t); }
#pragma unroll
                for (int ks = 0; ks < 4; ++ks) {
                    const LAS unsigned char* vp = Vb + r * AT_VROW + (16 * ks + 4 * hh) * 2;
                    const v2u l0 = *(const LAS v2u*)vp, h0 = *(const LAS v2u*)(vp + 16);
                    const v2u l1 = *(const LAS v2u*)(vp + 32 * AT_VROW), h1 = *(const LAS v2u*)(vp + 32 * AT_VROW + 16);
                    const bf16x8v vf0 = __builtin_bit_cast(bf16x8v, (v4u){l0.x, l0.y, h0.x, h0.y});
                    const bf16x8v vf1 = __builtin_bit_cast(bf16x8v, (v4u){l1.x, l1.y, h1.x, h1.y});
                    o0 = __builtin_amdgcn_mfma_f32_32x32x16_bf16(pf[ks], vf0, o0, 0, 0, 0);
                    o1 = __builtin_amdgcn_mfma_f32_32x32x16_bf16(pf[ks], vf1, o1, 0, 0, 0);
                }
                if (more) {
                    LAS unsigned char* Kn = L + ((j + 1) & 1) * AT_BUF;
                    *(LAS v4u*)(Kn + srow * AT_KROW + sch * 16) = kn;
                    LAS unsigned char* vd = Kn + AT_KBYTES + srow * AT_VROW + sch * 16;
                    *(LAS v2u*)vd = (v2u){vn.x, vn.y}; *(LAS v2u*)(vd + 8) = (v2u){vn.z, vn.w};
                    mw = mwn;
                }
                __syncthreads();
            }
            l += __shfl_xor(l, 32);
            if (hh == 0) scr[r] = 1.0f / l;
            bf16* op = mixed + (size_t)(b * SEQ + q0 + 32 * qh) * DM + MC_ATTN + h * 64 + r;
#pragma unroll
            for (int gq = 0; gq < 4; ++gq) {
                const f32x4 a4 = *(const LAS f32x4*)(scr + 8 * gq + 4 * hh);
#pragma unroll
                for (int e = 0; e < 4; ++e) {
                    const int q = 8 * gq + 4 * hh + e;
                    op[(size_t)q * DM] = (bf16)f2bf(o0[4 * gq + e] * a4[e]); op[(size_t)q * DM + 32] = (bf16)f2bf(o1[4 * gq + e] * a4[e]);
                }
            }
        }
    }
}

__device__ __forceinline__ void p_final(Frame& F) {
    const int gw = F.bid * NWAVES + F.wave, NGW = F.G * NWAVES;
    for (int row = gw; row < M; row += NGW) {
        f32x4* xr = (f32x4*)(F.xres + (size_t)row * DM) + F.lane;
        const f32x4* gr = (const f32x4*)F.fng + F.lane;
        f32x4 v[4]; float s = 0.f;
#pragma unroll
        for (int j = 0; j < 4; ++j) { v[j] = xr[64 * j]; s += (v[j][0] * v[j][0] + v[j][1] * v[j][1]) + (v[j][2] * v[j][2] + v[j][3] * v[j][3]); }
        s = wave_sum(s);
        const float rs = 1.0f / sqrtf(s * (1.0f / 1024.0f) + 1e-5f);
#pragma unroll
        for (int j = 0; j < 4; ++j) xr[64 * j] = v[j] * rs * gr[64 * j];
    }
}

#ifndef MK_SINGLE
#define MK_SINGLE 1
#endif
constexpr int NPL = 7;
constexpr int NPHASE = 1 + DEPTH * NPL + 1;
struct Args { const float* x; const int* pos; const float *n1g, *w_in, *pool_w, *pool_scale, *lb_logits, *hgrn_g, *w_out, *n2g, *w_ff_in, *w_ff_out, *fng; float* out; unsigned char* ws; int ph_lo, ph_hi; };
static_assert(sizeof(Args) == 15 * 8 + 8, "Args has no padding");


#define PHASE_BEGIN() do { int t_ = threadIdx.x; asm volatile("" : "+v"(t_)); F.tid = t_; F.lane = t_ & 63; F.wave = __builtin_amdgcn_readfirstlane(t_ >> 6); \
    unsigned char* w_ = args.ws; asm volatile("" : "+s"(w_)); F.ws = w_; } while (0)
__global__ void __launch_bounds__(NTHR, 2) fwd(Args args) {
    extern __shared__ __attribute__((aligned(16))) unsigned char lds[];
    Frame F;
    F.lds = (LAS unsigned char*)lds;
    F.MISC = (volatile LAS unsigned*)(F.lds + MISC_OFF);
    F.tid = threadIdx.x; F.lane = F.tid & 63; F.wave = __builtin_amdgcn_readfirstlane(F.tid >> 6);
    F.G = gridDim.x; F.bid = blockIdx.x;
    F.ws = args.ws; F.ctl = (gu32*)(args.ws + WS_CTL);
    F.x_in = args.x; F.pos = args.pos; F.n1g = args.n1g; F.w_in = args.w_in; F.pool_w = args.pool_w; F.pool_scale = args.pool_scale; F.lb_logits = args.lb_logits;
    F.hgrn_g = args.hgrn_g; F.w_out = args.w_out; F.n2g = args.n2g; F.w_ff_in = args.w_ff_in; F.w_ff_out = args.w_ff_out; F.fng = args.fng; F.xres = args.out;
    for (int u = F.tid; u < (LDS_BYTES - LDSCTL_OFF) / 4; u += NTHR) ((LAS unsigned*)(F.lds + LDSCTL_OFF))[u] = 0u;
    __syncthreads();
    XcdBarrier bar; bar.bar = (unsigned*)(F.ctl + CW_BAR); bar.x = 0; bar.st = nullptr;
    if (MK_SINGLE) bar = xcd_barrier_post((unsigned*)(F.ctl + CW_BAR), F.MISC + 8);
    const int lo = args.ph_lo, hi = args.ph_hi;
#define IN(k) (lo <= (k) && (k) < hi)
#define SEAM(k) do { if (MK_SINGLE && IN(k) && IN((k) + 1)) xcd_barrier(bar); } while (0)
    bf16* const xb = (bf16*)(F.ws + WS_XB); float* const ssq = (float*)(F.ws + WS_SSQ);
    bf16* const proj = (bf16*)(F.ws + WS_PROJ); bf16* const mixed = (bf16*)(F.ws + WS_MIXED); bf16* const hid = (bf16*)(F.ws + WS_HID);
    float* const idxf = (float*)(F.ws + WS_IDXF);

    if (IN(0)) { PHASE_BEGIN(); p_prologue(F); } SEAM(0);
    for (int layer = 0; layer < DEPTH; ++layer) {
        const int pb = 1 + layer * NPL;
        if (IN(pb + 0)) {
            pg8::Gemm g{xb, (const bf16*)(F.ws + WS_WIN), M, DINP, DM}; pg8::StaticOrder S; S.init(M, DINP, F.G, F.bid);
            pg8::EpiIn E{proj, idxf, ssq};
            pg8::gemm_phase<pg8::EpiIn, pg8::StaticOrder, true, true>(F.lds + RING_OFF, g, S, E);
        } SEAM(pb + 0);
        if (IN(pb + 1)) { PHASE_BEGIN(); p_rope(F); p_vt(F); cvt_layer_rest(F, layer); PHASE_BEGIN(); p_hgrn_local(F, layer); } SEAM(pb + 1);
        if (IN(pb + 2)) { PHASE_BEGIN(); p_pool(F, layer); PHASE_BEGIN(); p_mask(F); PHASE_BEGIN(); p_hgrn_scan(F); } SEAM(pb + 2);
        if (IN(pb + 3)) { PHASE_BEGIN(); p_hgrn_out(F, layer); PHASE_BEGIN(); p_attn_flash(F); } SEAM(pb + 3);
        if (IN(pb + 4)) {
            pg8::Gemm g{mixed, (const bf16*)(F.ws + WS_WOUT), M, DM, DM}; pg8::StaticOrder S; S.init(M, DM, F.G, F.bid);
            pg8::EpiRes E{layer == 0 ? F.x_in : (const float*)F.xres, F.xres, xb, ssq};
            pg8::gemm_phase<pg8::EpiRes, pg8::StaticOrder, true, true>(F.lds + RING_OFF, g, S, E);
        } SEAM(pb + 4);
        if (IN(pb + 5)) {
            pg8::Gemm g{xb, (const bf16*)(F.ws + WS_WFI), M, DFF, DM}; pg8::StaticOrder S; S.init(M, DFF, F.G, F.bid);
            pg8::EpiFfIn E{hid, ssq};
            pg8::gemm_phase<pg8::EpiFfIn, pg8::StaticOrder, true, true>(F.lds + RING_OFF, g, S, E);
        } SEAM(pb + 5);
        if (IN(pb + 6)) {
            pg8::Gemm g{hid, (const bf16*)(F.ws + WS_WFO), M, DM, DFF}; pg8::StaticOrder S; S.init(M, DM, F.G, F.bid);
            pg8::EpiRes E{(const float*)F.xres, F.xres, xb, ssq};
            pg8::gemm_phase<pg8::EpiRes, pg8::StaticOrder, true, true>(F.lds + RING_OFF, g, S, E);
        } SEAM(pb + 6);
    }
    if (IN(NPHASE - 1)) { PHASE_BEGIN(); p_final(F); }
#undef IN
#undef SEAM
}

extern "C" void kernel_launch(void* const* d_in, const int* in_sizes, int n_in, void* d_out, int out_size, void* d_ws, size_t ws_size, hipStream_t stream) {
    static int grid = 0;
    if (grid == 0) {
        if (n_in != 13 || out_size != M * DM || ws_size < WS_END) { fprintf(stderr, "kernel_launch: unexpected shapes (n_in %d, out %d, ws %zu)\n", n_in, out_size, ws_size); grid = -1; return; }
        int dev = 0, cus = 0, per_cu = 0;
        if (hipGetDevice(&dev) != hipSuccess || hipDeviceGetAttribute(&cus, hipDeviceAttributeMultiprocessorCount, dev) != hipSuccess) { grid = -1; return; }
        if (hipFuncSetAttribute((const void*)fwd, hipFuncAttributeMaxDynamicSharedMemorySize, LDS_BYTES) != hipSuccess) { fprintf(stderr, "kernel_launch: hipFuncSetAttribute failed\n"); grid = -1; return; }
        if (hipOccupancyMaxActiveBlocksPerMultiprocessor(&per_cu, (const void*)fwd, NTHR, LDS_BYTES) != hipSuccess || per_cu < 1) { fprintf(stderr, "kernel_launch: occupancy query says %d\n", per_cu); }
        (void)hipGetLastError();
        grid = cus;
        if (grid > 256) grid = 256;
        grid -= grid % 8;
    }
    if (grid <= 0) return;
    (void)hipMemsetAsync((char*)d_ws + WS_CTL, 0, CTL_ZERO_BYTES, stream);
    Args a{};
    a.x = (const float*)d_in[0]; a.pos = (const int*)d_in[1]; a.n1g = (const float*)d_in[2]; a.w_in = (const float*)d_in[3]; a.pool_w = (const float*)d_in[4];
    a.pool_scale = (const float*)d_in[5]; a.lb_logits = (const float*)d_in[6]; a.hgrn_g = (const float*)d_in[7]; a.w_out = (const float*)d_in[8]; a.n2g = (const float*)d_in[9];
    a.w_ff_in = (const float*)d_in[10]; a.w_ff_out = (const float*)d_in[11]; a.fng = (const float*)d_in[12];
    a.out = (float*)d_out; a.ws = (unsigned char*)d_ws;
    if (MK_SINGLE) {
        a.ph_lo = 0; a.ph_hi = NPHASE;
        hipLaunchKernelGGL(fwd, dim3(grid), dim3(NTHR), LDS_BYTES, stream, a);
    } else {
        for (int p = 0; p < NPHASE; ++p) { a.ph_lo = p; a.ph_hi = p + 1; hipLaunchKernelGGL(fwd, dim3(grid), dim3(NTHR), LDS_BYTES, stream, a); }
    }
}
```

```cpp
#include <hip/hip_runtime.h>
#include <cstdio>
#include <cstdint>
namespace pg8 {
#define PG8_LAS __attribute__((address_space(3)))
typedef unsigned short bf16_t;
typedef short bf16x8 __attribute__((ext_vector_type(8)));
typedef float f32x4 __attribute__((ext_vector_type(4)));
typedef unsigned u32x4 __attribute__((ext_vector_type(4)));
constexpr int BM = 256, BK = 64, HALF = 128, HTB = HALF * BK * 2  , STAGE_BYTES = 8 * HTB, NXCD = 8, WGM = 8;

__host__ __device__ __forceinline__ int lds_byte(int r, int c) { const int st = (r >> 4) * 2 + (c >> 5), rr = r & 15, cc = c & 31, ob = rr * 64 + cc * 2; return st * 1024 + (ob ^ (((ob >> 9) & 1) << 5)); }
__host__ __device__ __forceinline__ void stage_rc(int b, int& R, int& C) { const int st = b / 1024, sb = b % 1024, swz = sb ^ (((sb >> 9) & 1) << 5); R = (st >> 1) * 16 + swz / 64; C = (st & 1) * 32 + (swz % 64) / 2; }
__host__ __device__ __forceinline__ int perm32(int rho) { const int n = rho >> 4, i = rho & 15; return 8 * (i >> 2) + 4 * n + (i & 3); }

struct Unit { int pm, pn; };
struct Gemm { const bf16_t* A; const bf16_t* Bt; int M, N, K; };

struct StaticOrder {
    int nM, nN, nwg, G, c;
    __host__ __device__ void init(int M, int N, int G_, int c_) { nM = M / BM; nN = N / BM; nwg = nM * nN; G = G_; c = c_; }
    __host__ __device__ bool next(int i, Unit& u) const {
        const long L = (long)i * G + c; if (L >= nwg) return false;
        int wgid = (int)L; { const int q = nwg / NXCD, r = nwg % NXCD, xcd = wgid % NXCD, off = wgid / NXCD; wgid = (xcd < r ? xcd * (q + 1) : r * (q + 1) + (xcd - r) * q) + off; }
        const int nig = WGM * nN, gid = wgid / nig, fm = gid * WGM, gsz = (nM - fm) < WGM ? (nM - fm) : WGM;
        u.pm = fm + ((wgid % nig) % gsz); u.pn = (wgid % nig) / gsz; return true;
    }
    __device__ __forceinline__ void a_ready(const Unit&) const {}
    __device__ __forceinline__ void done(const Unit&) const {}
};

__device__ __forceinline__ unsigned cvt_pk_bf16(float lo, float hi) { unsigned r; asm volatile("v_cvt_pk_bf16_f32 %0, %1, %2" : "=v"(r) : "v"(lo), "v"(hi)); return r; }
typedef float f32x2 __attribute__((ext_vector_type(2)));

constexpr float RMS_EPS_F = 1e-5f;
__device__ __forceinline__ float row_rstd(const float* ssq, int row) {
    const f32x4* p = (const f32x4*)(ssq + (size_t)row * 16);
    const f32x4 a = p[0], b = p[1], c = p[2], d = p[3];
    const float s = ((a[0] + a[1]) + (a[2] + a[3])) + ((b[0] + b[1]) + (b[2] + b[3])) + ((c[0] + c[1]) + (c[2] + c[3])) + ((d[0] + d[1]) + (d[2] + d[3]));
    return 1.0f / sqrtf(s * (1.0f / 1024.0f) + RMS_EPS_F);
}
struct EpiIn {
    static constexpr bool PERM = true, AFTER_DRAIN = false;
    bf16_t* proj; float* idxf; const float* ssq;
    __device__ __forceinline__ void operator()(const f32x4 (&acc)[2][2][4][2], const Unit& u, int wr, int wc, int fr, int fq) const {
        const int row0 = u.pm * BM + wr * 64 + fr;
        const int colt = u.pn * BM + wc * 32 + 8 * fq;
#pragma unroll
        for (int ai = 0; ai < 2; ++ai)
#pragma unroll
            for (int m = 0; m < 4; ++m) {
                const int row = row0 + ai * HALF + m * 16;
                const float rs = row_rstd(ssq, row);
#pragma unroll
                for (int bj = 0; bj < 2; ++bj) {
                    const f32x4 v0 = acc[ai][bj][m][0] * rs, v1 = acc[ai][bj][m][1] * rs;
                    const int col = colt + bj * HALF;
                    if (u.pn < 8) {
                        u32x4 w; w.x = cvt_pk_bf16(v0[0], v0[1]); w.y = cvt_pk_bf16(v0[2], v0[3]); w.z = cvt_pk_bf16(v1[0], v1[1]); w.w = cvt_pk_bf16(v1[2], v1[3]);
                        *(u32x4*)(proj + (size_t)row * 2048 + col) = w;
                    } else {
                        float* o = idxf + (size_t)row * 512 + (col - 2048);
                        *(f32x4*)o = v0; *(f32x4*)(o + 4) = v1;
                    }
                }
            }
    }
};
struct EpiRes {
    static constexpr bool PERM = true, AFTER_DRAIN = false;
    const float* xin; float* xout; bf16_t* xb; float* ssq;
    __device__ __forceinline__ void operator()(const f32x4 (&acc)[2][2][4][2], const Unit& u, int wr, int wc, int fr, int fq) const {
        const int row0 = u.pm * BM + wr * 64 + fr;
        const int colt = u.pn * BM + wc * 32 + 8 * fq;
#pragma unroll
        for (int ai = 0; ai < 2; ++ai)
#pragma unroll
            for (int m = 0; m < 4; ++m) {
                const int row = row0 + ai * HALF + m * 16;
                float sq = 0.f;
#pragma unroll
                for (int bj = 0; bj < 2; ++bj) {
                    const size_t off = (size_t)row * 1024 + colt + bj * HALF;
                    const f32x4 a0 = *(const f32x4*)(xin + off), a1 = *(const f32x4*)(xin + off + 4);
                    const f32x4 v0 = a0 + acc[ai][bj][m][0], v1 = a1 + acc[ai][bj][m][1];
                    *(f32x4*)(xout + off) = v0; *(f32x4*)(xout + off + 4) = v1;
                    u32x4 w; w.x = cvt_pk_bf16(v0[0], v0[1]); w.y = cvt_pk_bf16(v0[2], v0[3]); w.z = cvt_pk_bf16(v1[0], v1[1]); w.w = cvt_pk_bf16(v1[2], v1[3]);
                    *(u32x4*)(xb + off) = w;
                    sq += (v0[0] * v0[0] + v0[1] * v0[1]) + (v0[2] * v0[2] + v0[3] * v0[3]) + (v1[0] * v1[0] + v1[1] * v1[1]) + (v1[2] * v1[2] + v1[3] * v1[3]);
                }
                sq += __shfl_xor(sq, 16); sq += __shfl_xor(sq, 32);
                if (fq == 0) ssq[(size_t)row * 16 + u.pn * 4 + wc] = sq;
            }
    }
};
struct EpiFfIn {
    static constexpr bool PERM = true, AFTER_DRAIN = false;
    bf16_t* hid; const float* ssq;
    __device__ __forceinline__ void operator()(const f32x4 (&acc)[2][2][4][2], const Unit& u, int wr, int wc, int fr, int fq) const {
        const int row0 = u.pm * BM + wr * 64 + fr;
        const int colt = u.pn * BM + wc * 32 + 8 * fq;
#pragma unroll
        for (int ai = 0; ai < 2; ++ai)
#pragma unroll
            for (int m = 0; m < 4; ++m) {
                const int row = row0 + ai * HALF + m * 16;
                const float rs = row_rstd(ssq, row);
#pragma unroll
                for (int bj = 0; bj < 2; ++bj) {
                    f32x4 v0 = acc[ai][bj][m][0] * rs, v1 = acc[ai][bj][m][1] * rs;
#pragma unroll
                    for (int e = 0; e < 4; ++e) { const float a = fmaxf(v0[e], 0.f), b = fmaxf(v1[e], 0.f); v0[e] = a * a; v1[e] = b * b; }
                    u32x4 w; w.x = cvt_pk_bf16(v0[0], v0[1]); w.y = cvt_pk_bf16(v0[2], v0[3]); w.z = cvt_pk_bf16(v1[0], v1[1]); w.w = cvt_pk_bf16(v1[2], v1[3]);
                    *(u32x4*)(hid + (size_t)row * 4096 + colt + bj * HALF) = w;
                }
            }
    }
};
template <class Epi, class Sched, bool ALIGN_EPI = false, bool SP2 = false>
__device__ __forceinline__ void gemm_phase(PG8_LAS unsigned char* lds, const Gemm g, const Sched& S, const Epi& E) {
    int tid_ = threadIdx.x; asm volatile("" : "+v"(tid_));
    const int tid = tid_, wid = __builtin_amdgcn_readfirstlane(tid >> 6), lane = tid & 63, wr = wid >> 2, wc = wid & 3, fr = lane & 15, fq = lane >> 4;
    const int K = g.K, nt = K / BK;
    unsigned voffA[2], voffB[2];
#pragma unroll
    for (int i = 0; i < 2; ++i) { int R, C; stage_rc(tid * 16 + i * 8192, R, C); const int Rb = Epi::PERM ? ((R & ~31) + perm32(R & 31)) : R;
        voffA[i] = (unsigned)(R * K + C) * 2u; voffB[i] = (unsigned)(Rb * K + C) * 2u; }
    const size_t kstep = (size_t)(BK * 2);
    const size_t hstep = (size_t)HALF * K * 2;
    const size_t tstep = 2 * hstep;
    const unsigned ldsw = (unsigned)wid * 1024u;
    const int aoff = lds_byte(wr * 64 + fr, fq * 8), boff = lds_byte(wc * 32 + fr, fq * 8);
#define PG8_SA(b, h) (((b) * 2 + (h)) * HTB)
#define PG8_SB(b, h) ((4 + (b) * 2 + (h)) * HTB)
#define PG8_STAGE(bufoff, gbase, voff) do { _Pragma("unroll") for (int _i = 0; _i < 2; ++_i) \
        __builtin_amdgcn_global_load_lds((const unsigned*)((const char*)(gbase) + (voff)[_i]), (PG8_LAS unsigned*)(lds + (bufoff) + ldsw + _i * 8192), 16, 0, 0); } while (0)
#define PG8_LDA(dst, b, h) do { _Pragma("unroll") for (int m = 0; m < 4; ++m) _Pragma("unroll") for (int k = 0; k < 2; ++k) dst[m][k] = *(const PG8_LAS bf16x8*)(lds + PG8_SA(b, h) + aoff + m * 2048 + k * 1024); } while (0)
#define PG8_LDB(dst, b, h) do { _Pragma("unroll") for (int n = 0; n < 2; ++n) _Pragma("unroll") for (int k = 0; k < 2; ++k) dst[n][k] = *(const PG8_LAS bf16x8*)(lds + PG8_SB(b, h) + boff + n * 2048 + k * 1024); } while (0)
#define PG8_MMA(ai, bj, At, Bt) do { __builtin_amdgcn_s_setprio(1); _Pragma("unroll") for (int m = 0; m < 4; ++m) _Pragma("unroll") for (int n = 0; n < 2; ++n) _Pragma("unroll") for (int k = 0; k < 2; ++k) \
        acc[ai][bj][m][n] = __builtin_amdgcn_mfma_f32_16x16x32_bf16(Bt[n][k], At[m][k], acc[ai][bj][m][n], 0, 0, 0); __builtin_amdgcn_s_setprio(0); } while (0)
#define PG8_WAIT_V(n) asm volatile("s_waitcnt vmcnt(" #n ")" ::: "memory")
#define PG8_WAIT_L(n) asm volatile("s_waitcnt lgkmcnt(" #n ")" ::: "memory")
#define PG8_BAR __builtin_amdgcn_s_barrier()
#define PG8_SCHED __builtin_amdgcn_sched_barrier(0)
    Unit cur, nxt; int ui = 0;
    if (!S.next(0, cur)) return;
    f32x4 acc[2][2][4][2];
#pragma unroll
    for (int a = 0; a < 2; ++a)
#pragma unroll
        for (int b = 0; b < 2; ++b)
#pragma unroll
            for (int m = 0; m < 4; ++m)
#pragma unroll
                for (int n = 0; n < 2; ++n) acc[a][b][m][n] = (f32x4){0.f, 0.f, 0.f, 0.f};
    bf16x8 At[4][2], B0[2][2], B1[2][2];
    const char* cA = (const char*)g.A + (size_t)cur.pm * tstep; const char* cB = (const char*)g.Bt + (size_t)cur.pn * tstep;
    S.a_ready(cur);
    if constexpr (SP2) {
        PG8_STAGE(PG8_SB(0, 0), cB, voffB); PG8_STAGE(PG8_SB(0, 1), cB + hstep, voffB); PG8_STAGE(PG8_SA(0, 0), cA, voffA); PG8_STAGE(PG8_SA(0, 1), cA + hstep, voffA);
        if (wr == 1) PG8_BAR;
        PG8_WAIT_V(2); PG8_BAR;
        PG8_STAGE(PG8_SB(1, 0), cB + kstep, voffB); PG8_STAGE(PG8_SA(1, 0), cA + kstep, voffA); PG8_STAGE(PG8_SB(1, 1), cB + hstep + kstep, voffB);
        PG8_WAIT_V(6); PG8_BAR;
    } else {
        PG8_STAGE(PG8_SB(0, 0), cB, voffB); PG8_STAGE(PG8_SA(0, 0), cA, voffA); PG8_STAGE(PG8_SB(0, 1), cB + hstep, voffB); PG8_STAGE(PG8_SA(0, 1), cA + hstep, voffA);
        if (wr == 1) PG8_BAR;
        PG8_WAIT_V(4); PG8_BAR;
        PG8_STAGE(PG8_SB(1, 0), cB + kstep, voffB); PG8_STAGE(PG8_SA(1, 0), cA + kstep, voffA); PG8_STAGE(PG8_SB(1, 1), cB + hstep + kstep, voffB);
        PG8_WAIT_V(6); PG8_BAR;
    }
    for (;;) {
        const bool has_next = S.next(ui + 1, nxt);
        const char* nA = has_next ? (const char*)g.A + (size_t)nxt.pm * tstep : cA; const char* nB = has_next ? (const char*)g.Bt + (size_t)nxt.pn * tstep : cB;
        for (int t = 0; t < nt; t += 2) {
            const bool last = (t == nt - 2);
            const char* a1 = cA + (size_t)(t + 1) * kstep;
            const char* a2 = last ? nA : cA + (size_t)(t + 2) * kstep; const char* b2 = last ? nB : cB + (size_t)(t + 2) * kstep;
            const char* a3 = a2 + kstep; const char* b3 = b2 + kstep;
            if (last && has_next) S.a_ready(nxt);
            if constexpr (SP2) {
            PG8_LDB(B0, 0, 0); PG8_LDB(B1, 0, 1); PG8_SCHED; PG8_LDA(At, 0, 0); PG8_STAGE(PG8_SA(1, 1), a1 + hstep, voffA);
            PG8_WAIT_V(8); PG8_WAIT_L(0); PG8_BAR; PG8_MMA(0, 0, At, B0); PG8_MMA(0, 1, At, B1); PG8_BAR; PG8_SCHED;
            PG8_LDA(At, 0, 1); PG8_STAGE(PG8_SB(0, 0), b2, voffB); PG8_STAGE(PG8_SB(0, 1), b2 + hstep, voffB); PG8_STAGE(PG8_SA(0, 0), a2, voffA);
            PG8_WAIT_V(8); PG8_WAIT_L(0); PG8_BAR; PG8_MMA(1, 0, At, B0); PG8_MMA(1, 1, At, B1); PG8_BAR; PG8_SCHED;
            PG8_LDB(B0, 1, 0); PG8_LDB(B1, 1, 1); PG8_SCHED; PG8_LDA(At, 1, 0); PG8_STAGE(PG8_SA(0, 1), a2 + hstep, voffA);
            PG8_WAIT_V(8); PG8_WAIT_L(0); PG8_BAR; PG8_MMA(0, 0, At, B0); PG8_MMA(0, 1, At, B1); PG8_BAR; PG8_SCHED;
            PG8_LDA(At, 1, 1); PG8_STAGE(PG8_SB(1, 0), b3, voffB); PG8_STAGE(PG8_SB(1, 1), b3 + hstep, voffB); PG8_STAGE(PG8_SA(1, 0), a3, voffA);
            PG8_WAIT_V(8); PG8_WAIT_L(0); PG8_BAR; PG8_MMA(1, 0, At, B0); PG8_MMA(1, 1, At, B1); PG8_BAR; PG8_SCHED;
            } else {
            PG8_LDB(B0, 0, 0); PG8_SCHED; PG8_LDA(At, 0, 0); PG8_STAGE(PG8_SA(1, 1), a1 + hstep, voffA);
            PG8_WAIT_L(8); PG8_BAR; PG8_WAIT_L(0); PG8_MMA(0, 0, At, B0); PG8_BAR; PG8_SCHED;
            PG8_LDB(B1, 0, 1); PG8_STAGE(PG8_SB(0, 0), b2, voffB);
            PG8_BAR; PG8_WAIT_L(0); PG8_MMA(0, 1, At, B1); PG8_BAR;
            PG8_LDA(At, 0, 1); PG8_STAGE(PG8_SA(0, 0), a2, voffA);
            PG8_BAR; PG8_WAIT_L(0); PG8_MMA(1, 0, At, B0); PG8_BAR; PG8_SCHED;
            PG8_STAGE(PG8_SB(0, 1), b2 + hstep, voffB);
            PG8_WAIT_V(6); PG8_BAR; PG8_MMA(1, 1, At, B1); PG8_BAR;
            PG8_LDB(B0, 1, 0); PG8_SCHED; PG8_LDA(At, 1, 0); PG8_STAGE(PG8_SA(0, 1), a2 + hstep, voffA);
            PG8_WAIT_L(8); PG8_BAR; PG8_WAIT_L(0); PG8_MMA(0, 0, At, B0); PG8_BAR; PG8_SCHED;
            PG8_LDB(B1, 1, 1); PG8_STAGE(PG8_SB(1, 0), b3, voffB);
            PG8_BAR; PG8_WAIT_L(0); PG8_MMA(0, 1, At, B1); PG8_BAR;
            PG8_LDA(At, 1, 1); PG8_STAGE(PG8_SA(1, 0), a3, voffA);
            PG8_BAR; PG8_WAIT_L(0); PG8_MMA(1, 0, At, B0); PG8_BAR; PG8_SCHED;
            PG8_STAGE(PG8_SB(1, 1), b3 + hstep, voffB);
            PG8_WAIT_V(6); PG8_BAR; PG8_MMA(1, 1, At, B1); PG8_BAR;
            }
        }
        if constexpr (ALIGN_EPI) { if (wr == 0) PG8_BAR; }
        if constexpr (!Epi::AFTER_DRAIN) { E(acc, cur, wr, wc, fr, fq); S.done(cur); }
        if (!has_next) break;
#pragma unroll
        for (int a = 0; a < 2; ++a)
#pragma unroll
            for (int b = 0; b < 2; ++b)
#pragma unroll
                for (int m = 0; m < 4; ++m)
#pragma unroll
                    for (int n = 0; n < 2; ++n) acc[a][b][m][n] = (f32x4){0.f, 0.f, 0.f, 0.f};
        cur = nxt; cA = nA; cB = nB; ++ui;
        if constexpr (ALIGN_EPI) { if (wr == 1) PG8_BAR; }
    }
    PG8_WAIT_V(0);
    if constexpr (!ALIGN_EPI) { if (wr == 0) PG8_BAR; }
    PG8_BAR;
    if constexpr (Epi::AFTER_DRAIN) { E.fused(acc, cur, wr, wc, fr, fq, lds, wid, lane); S.done(cur); }
#undef PG8_SA
#undef PG8_SB
#undef PG8_STAGE
#undef PG8_LDA
#undef PG8_LDB
#undef PG8_MMA
#undef PG8_WAIT_V
#undef PG8_WAIT_L
#undef PG8_BAR
#undef PG8_SCHED
}
}

constexpr int BATCH = 8, SEQ = 2048, DM = 1024, DEPTH = 4, M = BATCH * SEQ, DIN = 2372, DINP = 2560, DFF = 4096;
constexpr int NWAVES = 8, NTHR = NWAVES * 64;
constexpr int TOPK = 256;
constexpr int PC_POOL = 0, PC_HQ = 256, PC_HF = 512, PC_HI = 768, PC_HG = 1024, PC_Q = 1280, PC_K = 1792, PC_V = 1920, PROJ_LD = 2048;
constexpr int IC_QI = 0, IC_KI = 256, IC_WI = 320, IDX_LD = 512;
constexpr int MC_POOL = 0, MC_HGRN = 256, MC_ATTN = 512;

constexpr size_t MiB = 1u << 20;
constexpr size_t WS_CTL = 0, CTL_ZERO_BYTES = 1 * MiB;
constexpr size_t WS_ROPE = 1 * MiB;
constexpr size_t WS_SSQ = 2 * MiB;
constexpr size_t WS_LB = 3 * MiB;
constexpr size_t WS_MASK = 4 * MiB;
constexpr size_t WS_WIN = 8 * MiB;
constexpr size_t WS_WOUT = 13 * MiB;
constexpr size_t WS_WFI = 15 * MiB;
constexpr size_t WS_WFO = 23 * MiB;
constexpr size_t WS_XB = 32 * MiB;
constexpr size_t WS_HID = 64 * MiB;
constexpr size_t WS_PROJ = 64 * MiB;
constexpr size_t WS_MIXED = 128 * MiB;
constexpr size_t WS_HST = 160 * MiB;
constexpr size_t WS_HDN = 176 * MiB;
constexpr size_t WS_IDXF = 192 * MiB;
constexpr size_t WS_VT = 224 * MiB;
constexpr size_t WS_END = 256 * MiB;
constexpr int CW_TMO = 0, CW_BAR = 4096;

constexpr int RING_OFF = 0, RING_BYTES = 131072;
constexpr int LDS_BYTES = 147456;
constexpr int LDSCTL_OFF = LDS_BYTES - 1024, MISC_OFF = LDSCTL_OFF + 320;

#define GAS __attribute__((address_space(1)))
#define LAS __attribute__((address_space(3)))
typedef unsigned short bf16;
typedef unsigned v4u __attribute__((ext_vector_type(4)));
typedef unsigned v2u __attribute__((ext_vector_type(2)));
typedef float f32x4 __attribute__((ext_vector_type(4)));
typedef GAS unsigned gu32;
#define RLX_AGENT __ATOMIC_RELAXED, __HIP_MEMORY_SCOPE_AGENT
#define LDS_WAIT() asm volatile("s_waitcnt lgkmcnt(0)" ::: "memory")
__device__ __forceinline__ unsigned f2bf(float f) { unsigned u = __builtin_bit_cast(unsigned, f); return (u + 0x7fffu + ((u >> 16) & 1u)) >> 16; }
__device__ __forceinline__ unsigned pk2(float lo, float hi) { return f2bf(lo) | (f2bf(hi) << 16); }
__device__ __forceinline__ float bf2f(unsigned short h) { return __builtin_bit_cast(float, (unsigned)h << 16); }
__device__ __forceinline__ float wave_sum(float v) {
#pragma unroll
    for (int o = 1; o < 64; o <<= 1) v += __shfl_xor(v, o);
    return v;
}
__device__ __forceinline__ float wave_max(float v) {
#pragma unroll
    for (int o = 1; o < 64; o <<= 1) v = fmaxf(v, __shfl_xor(v, o));
    return v;
}
#define XB_TMO      128
#define XB_XCNT(j)  (256  + 64 * (j))
#define XB_XSUB(j)  (1280 + 64 * (j))
#define XB_XGEN(j)  (2304 + 64 * (j))
#define XB_TOP      3328
#define XB_TOPGEN   3392
#define XCD_BAR_WORDS 3456
#define XB_SPIN_CAP (1u << 18)

__device__ __forceinline__ unsigned xb_ld(unsigned* p)              { return __hip_atomic_load(p, __ATOMIC_RELAXED, __HIP_MEMORY_SCOPE_AGENT); }
__device__ __forceinline__ unsigned xb_add(unsigned* p, unsigned v) { return __hip_atomic_fetch_add(p, v, __ATOMIC_RELAXED, __HIP_MEMORY_SCOPE_AGENT); }
__device__ __forceinline__ unsigned xb_xcc_id() { return (unsigned)__builtin_amdgcn_s_getreg((3 << 11) | 20) & 0xFu; }
#define XB_SPIN(cond, bar) do { unsigned _sp = 0; while (cond) { __builtin_amdgcn_s_sleep(1); \
    if ((++_sp & 255u) == 0u) { if (xb_ld(&(bar)[XB_TMO])) break; if (_sp > XB_SPIN_CAP) { atomicAdd(&(bar)[XB_TMO], 1u); break; } } } } while (0)

struct XcdBarrier {
    unsigned* bar; unsigned x;
    volatile LAS unsigned* st;
};

__device__ __forceinline__ XcdBarrier xcd_barrier_post(unsigned* bar, volatile LAS unsigned* st) {
    XcdBarrier b; b.bar = bar; b.x = xb_xcc_id(); b.st = st;
    if (threadIdx.x == 0) (void)xb_add(&bar[XB_XCNT(b.x)], 1u);
    return b;
}
__device__ __forceinline__ void xcd_barrier_complete(unsigned* bar, unsigned x, unsigned& nloc, unsigned& nx) {
    const unsigned G = gridDim.x * gridDim.y * gridDim.z;
    unsigned sum, cnt, mine, sp = 0u;
    for (;;) {
        sum = 0u; cnt = 0u; mine = 0u;
#pragma unroll
        for (unsigned j = 0; j < 16; ++j) { const unsigned c = xb_ld(&bar[XB_XCNT(j)]); sum += c; cnt += (c > 0u) ? 1u : 0u; mine = (j == x) ? c : mine; }
        if (sum == G) break;
        __builtin_amdgcn_s_sleep(1);
        if ((++sp & 255u) == 0u) { if (xb_ld(&bar[XB_TMO])) break; if (sp > XB_SPIN_CAP) { atomicAdd(&bar[XB_TMO], 1u); break; } }
    }
    nloc = mine > 0u ? mine : 1u; nx = cnt > 0u ? cnt : 1u;
}

__device__ __forceinline__ void xcd_barrier(const XcdBarrier& b) {
    asm volatile("s_waitcnt vmcnt(0)" ::: "memory");
    __syncthreads();
    if (threadIdx.x == 0) {
        unsigned* bar = b.bar;
        __builtin_amdgcn_s_waitcnt(0);
        unsigned nloc = b.st[0], nx = b.st[1];
        if (nloc == 0u) { xcd_barrier_complete(bar, b.x, nloc, nx); b.st[0] = nloc; b.st[1] = nx; }
        const unsigned old = xb_add(&bar[XB_XSUB(b.x)], 1u);
        const unsigned gen = old / nloc;
        if (old + 1u == (gen + 1u) * nloc) {
            __builtin_amdgcn_fence(__ATOMIC_RELEASE, "agent");
            asm volatile("s_waitcnt vmcnt(0)" ::: "memory");
            const unsigned og = xb_add(&bar[XB_TOP], 1u);
            const unsigned tg = og / nx;
            if (og + 1u == (tg + 1u) * nx) xb_add(&bar[XB_TOPGEN], 1u);
            else XB_SPIN(xb_ld(&bar[XB_TOPGEN]) == tg, bar);
            __builtin_amdgcn_fence(__ATOMIC_ACQUIRE, "agent");
            xb_add(&bar[XB_XGEN(b.x)], 1u);
            asm volatile("s_waitcnt vmcnt(0)" ::: "memory");
        } else {
            XB_SPIN(xb_ld(&bar[XB_XGEN(b.x)]) == gen, bar);
            __builtin_amdgcn_fence(__ATOMIC_ACQUIRE, "agent");
            asm volatile("s_waitcnt vmcnt(0)" ::: "memory");
        }
    }
    __syncthreads();
}


struct Frame {
    LAS unsigned char* lds;
    volatile LAS unsigned* MISC;
    gu32* ctl;
    int tid, lane, wave, G, bid;
    const float* x_in; const int* pos;
    const float *n1g, *w_in, *pool_w, *pool_scale, *lb_logits, *hgrn_g, *w_out, *n2g, *w_ff_in, *w_ff_out, *fng;
    float* xres;
    unsigned char* ws;
};
__constant__ float c_invf[8] = {1.0f, 0.19392274474868576f, 0.03760603093086393f, 0.007292664737217109f, 0.001414213562373095f, 0.0002742481756762073f, 5.318295896944988e-05f, 1.031338537721246e-05f};

__device__ __forceinline__ void cvt_item(const float* W, const float* g, int K, int N, bf16* WT, LAS float* scr, int kb, int nb, int lane) {
    const int k0 = 64 * kb, n0 = 32 * nb;
    const int n = n0 + (lane & 31);
#pragma unroll 8
    for (int i = 0; i < 32; ++i) { const int kk = 2 * i + (lane >> 5); float v = (n < N) ? W[(size_t)(k0 + kk) * N + n] : 0.f; if (g) v *= g[k0 + kk]; scr[kk * 33 + (lane & 31)] = v; }
    LDS_WAIT(); asm volatile("" ::: "memory");
    const int c = lane & 7;
#pragma unroll
    for (int j = 0; j < 4; ++j) { const int nl = (lane >> 3) + 8 * j; const LAS float* s = scr + (8 * c) * 33 + nl;
        v4u o; o.x = pk2(s[0 * 33], s[1 * 33]); o.y = pk2(s[2 * 33], s[3 * 33]); o.z = pk2(s[4 * 33], s[5 * 33]); o.w = pk2(s[6 * 33], s[7 * 33]);
        *(GAS v4u*)(WT + (size_t)(n0 + nl) * K + k0 + 8 * c) = o; }
    LDS_WAIT(); asm volatile("" ::: "memory");
}
__device__ __forceinline__ void cvt_matrix(Frame& F, const float* W, const float* g, int K, int N, int Npad, bf16* WT) {
    LAS float* scr = (LAS float*)(F.lds + RING_OFF + F.wave * 16384);
    const int gw = F.bid * NWAVES + F.wave, NGW = F.G * NWAVES;
    const int nblk = Npad / 32, nitems = (K / 64) * nblk;
    for (int it = gw; it < nitems; it += NGW) cvt_item(W, g, K, N, WT, scr, it / nblk, it % nblk, F.lane);
}
__device__ __forceinline__ void cvt_layer_rest(Frame& F, int layer) {
    cvt_matrix(F, F.w_out + (size_t)layer * DM * DM, nullptr, DM, DM, DM, (bf16*)(F.ws + WS_WOUT));
    cvt_matrix(F, F.w_ff_in + (size_t)layer * DM * DFF, F.n2g + layer * DM, DM, DFF, DFF, (bf16*)(F.ws + WS_WFI));
    cvt_matrix(F, F.w_ff_out + (size_t)layer * DFF * DM, nullptr, DFF, DM, DM, (bf16*)(F.ws + WS_WFO));
    if (layer + 1 < DEPTH) cvt_matrix(F, F.w_in + (size_t)(layer + 1) * DM * DIN, F.n1g + (layer + 1) * DM, DM, DIN, DINP, (bf16*)(F.ws + WS_WIN));
}

__device__ __forceinline__ void p_prologue(Frame& F) {
    const int gtid = F.bid * NTHR + F.tid, NT = F.G * NTHR;
    float* tab = (float*)(F.ws + WS_ROPE);
    for (int idx = gtid; idx < M * 8; idx += NT) {
        const int row = idx >> 3, i = idx & 7;
        const float angf = (float)F.pos[row] * c_invf[i];
        double r = (double)angf * 0.15915494309189535; r -= floor(r);
        const float a = (float)(r * 6.283185307179586);
        tab[row * 16 + i] = cosf(a); tab[row * 16 + 8 + i] = sinf(a);
    }
    if (gtid < 256) {
        const int c = gtid; float* lb = (float*)(F.ws + WS_LB);
        const float l0 = F.lb_logits[c], l1 = F.lb_logits[256 + c], l2 = F.lb_logits[512 + c], l3 = F.lb_logits[768 + c];
        const float mx = fmaxf(fmaxf(l0, l1), fmaxf(l2, l3));
        const float e0 = expf(l0 - mx), e1 = expf(l1 - mx), e2 = expf(l2 - mx), e3 = expf(l3 - mx);
        const float inv = 1.0f / (e0 + e1 + e2 + e3);
        lb[c] = 0.f; lb[256 + c] = e1 * inv; lb[512 + c] = (e1 + e2) * inv; lb[768 + c] = (e1 + e2 + e3) * inv;
    }
    const int gw = F.bid * NWAVES + F.wave, NGW = F.G * NWAVES;
    bf16* xb = (bf16*)(F.ws + WS_XB); float* ssq = (float*)(F.ws + WS_SSQ);
    for (int row = gw; row < M; row += NGW) {
        const f32x4* xr = (const f32x4*)(F.x_in + (size_t)row * DM) + F.lane;
        f32x4 v[4]; float s = 0.f;
#pragma unroll
        for (int j = 0; j < 4; ++j) { v[j] = xr[64 * j]; s += (v[j][0] * v[j][0] + v[j][1] * v[j][1]) + (v[j][2] * v[j][2] + v[j][3] * v[j][3]); }
        s = wave_sum(s);
        unsigned long long* o8 = (unsigned long long*)(xb + (size_t)row * DM) + F.lane;
#pragma unroll
        for (int j = 0; j < 4; ++j) o8[64 * j] = (unsigned long long)pk2(v[j][0], v[j][1]) | ((unsigned long long)pk2(v[j][2], v[j][3]) << 32);
        if (F.lane < 16) ssq[(size_t)row * 16 + F.lane] = (F.lane == 0) ? s : 0.f;
    }
    cvt_matrix(F, F.w_in, F.n1g, DM, DIN, DINP, (bf16*)(F.ws + WS_WIN));
}

__device__ __forceinline__ void p_rope(Frame& F) {
    const int gtid = F.bid * NTHR + F.tid, NT = F.G * NTHR;
    const float* tab = (const float*)(F.ws + WS_ROPE);
    bf16* proj = (bf16*)(F.ws + WS_PROJ); float* idxf = (float*)(F.ws + WS_IDXF);
    for (int idx = gtid; idx < M * 15 * 8; idx += NT) {
        const int i = idx & 7, rh = idx >> 3, hh = rh % 15, row = rh / 15;
        const float c = tab[row * 16 + i], s = tab[row * 16 + 8 + i];
        if (hh < 10) {
            const int col = hh < 8 ? PC_Q + hh * 64 : PC_K + (hh - 8) * 64;
            bf16* p = proj + (size_t)row * PROJ_LD + col;
            const float x1 = bf2f(p[i]), x2 = bf2f(p[8 + i]);
            p[i] = (bf16)f2bf(x1 * c - x2 * s); p[8 + i] = (bf16)f2bf(x2 * c + x1 * s);
        } else {
            const int col = hh < 14 ? IC_QI + (hh - 10) * 64 : IC_KI;
            float* p = idxf + (size_t)row * IDX_LD + col;
            const float x1 = p[i], x2 = p[8 + i];
            p[i] = x1 * c - x2 * s; p[8 + i] = x2 * c + x1 * s;
        }
    }
}

__device__ __forceinline__ void p_pool(Frame& F, int layer) {
    LAS float* P = (LAS float*)(F.lds + RING_OFF);
    const bf16* proj = (const bf16*)(F.ws + WS_PROJ); bf16* mixed = (bf16*)(F.ws + WS_MIXED);
    const float* pw = F.pool_w + (size_t)layer * 4 * 64 * 64; const float* ps = F.pool_scale + layer * 256;
    const int c = F.tid & 255, half = F.tid >> 8, g = c >> 6, win = 2 << g, dd = c & 63;
    for (int unit = F.bid; unit < M / 16; unit += F.G) {
        const int t0 = unit * 16;
        for (int tt = half * 8; tt < half * 8 + 8; ++tt) {
            const int row = t0 + tt, tloc = row & (SEQ - 1); const int cnt = (tloc + 1 < win) ? tloc + 1 : win;
            float s = 0.f;
            for (int j = 0; j < cnt; ++j) s += bf2f(proj[(size_t)(row - j) * PROJ_LD + PC_POOL + c]);
            P[tt * 256 + c] = s / (float)cnt - bf2f(proj[(size_t)row * PROJ_LD + PC_POOL + c]);
        }
        __syncthreads();
        for (int tt = half * 8; tt < half * 8 + 8; ++tt) {
            float y = 0.f;
#pragma unroll 8
            for (int cc = 0; cc < 64; ++cc) y += P[tt * 256 + g * 64 + cc] * pw[(g * 64 + cc) * 64 + dd];
            mixed[(size_t)(t0 + tt) * DM + MC_POOL + c] = (bf16)f2bf(y * ps[c]);
        }
        __syncthreads();
    }
}

typedef float f32x16 __attribute__((ext_vector_type(16)));
typedef short bf16x8v __attribute__((ext_vector_type(8)));
typedef float f32x2v __attribute__((ext_vector_type(2))); typedef __bf16 bf16x2v __attribute__((ext_vector_type(2)));
__device__ __forceinline__ unsigned cvtpk(float lo, float hi) { f32x2v v = {lo, hi}; bf16x2v b = __builtin_convertvector(v, bf16x2v); return __builtin_bit_cast(unsigned, b); }
__device__ __forceinline__ unsigned sort_key(float v) { if (v == 0.f) v = 0.f; const unsigned u = __builtin_bit_cast(unsigned, v); return (u & 0x80000000u) ? ~u : (u | 0x80000000u); }
__device__ __forceinline__ void split8(const f32x4 a, const f32x4 b, bf16x8v& hi, bf16x8v& lo) {
    v4u h, l;
    h.x = cvtpk(a[0], a[1]); h.y = cvtpk(a[2], a[3]); h.z = cvtpk(b[0], b[1]); h.w = cvtpk(b[2], b[3]);
    l.x = cvtpk(a[0] - __builtin_bit_cast(float, h.x << 16), a[1] - __builtin_bit_cast(float, h.x & 0xffff0000u));
    l.y = cvtpk(a[2] - __builtin_bit_cast(float, h.y << 16), a[3] - __builtin_bit_cast(float, h.y & 0xffff0000u));
    l.z = cvtpk(b[0] - __builtin_bit_cast(float, h.z << 16), b[1] - __builtin_bit_cast(float, h.z & 0xffff0000u));
    l.w = cvtpk(b[2] - __builtin_bit_cast(float, h.w << 16), b[3] - __builtin_bit_cast(float, h.w & 0xffff0000u));
    hi = __builtin_bit_cast(bf16x8v, h); lo = __builtin_bit_cast(bf16x8v, l);
}
constexpr int MK_STRIDE = 2049;
__device__ __forceinline__ void p_mask(Frame& F) {
    LAS unsigned* keys = (LAS unsigned*)(F.lds + RING_OFF);
    const float* idxf = (const float*)(F.ws + WS_IDXF); unsigned* mask = (unsigned*)(F.ws + WS_MASK);
    const int tid = F.tid, lane = F.lane, wave = F.wave, q = lane & 15, kg = lane >> 4;
    for (int c = F.bid; c < 256; c += F.G) {
        for (int ui = 0; ui < 4; ++ui) {
            const int b = (c >> 6) * 2 + (ui >> 1), bq = c & 63, qb = (ui & 1) ? 127 - bq : bq;
            const int t0 = qb * 16; const size_t rowq0 = (size_t)b * SEQ + t0;
            if (qb < 16) {
                for (int w = tid; w < 1024; w += NTHR) { const int qq = w >> 6, j = w & 63, n = t0 + qq + 1, lo = j * 32;
                    mask[(rowq0 + qq) * 64 + j] = (n >= lo + 32) ? 0xffffffffu : (n > lo ? ((1u << (n - lo)) - 1u) : 0u); }
                continue;
            }
            bf16x8v bh[4][2], bl[4][2];
#pragma unroll
            for (int h = 0; h < 4; ++h)
#pragma unroll
                for (int dh = 0; dh < 2; ++dh) { const float* pq = idxf + (rowq0 + q) * IDX_LD + IC_QI + h * 64 + dh * 32 + kg * 8;
                    split8(*(const f32x4*)pq, *(const f32x4*)(pq + 4), bh[h][dh], bl[h][dh]); }
            const f32x4 wv = *(const f32x4*)(idxf + (rowq0 + q) * IDX_LD + IC_WI);
            const int ntile = qb + 1;
            for (int kt = wave; kt < ntile; kt += NWAVES) {
                const int s0 = kt * 16;
                bf16x8v ah[2], al[2];
#pragma unroll
                for (int dh = 0; dh < 2; ++dh) { const float* pk = idxf + ((size_t)b * SEQ + s0 + q) * IDX_LD + IC_KI + dh * 32 + kg * 8;
                    split8(*(const f32x4*)pk, *(const f32x4*)(pk + 4), ah[dh], al[dh]); }
                f32x4 acc[4];
#pragma unroll
                for (int h = 0; h < 4; ++h) { acc[h] = (f32x4){0.f, 0.f, 0.f, 0.f};
#pragma unroll
                    for (int dh = 0; dh < 2; ++dh) {
                        acc[h] = __builtin_amdgcn_mfma_f32_16x16x32_bf16(ah[dh], bh[h][dh], acc[h], 0, 0, 0);
                        acc[h] = __builtin_amdgcn_mfma_f32_16x16x32_bf16(ah[dh], bl[h][dh], acc[h], 0, 0, 0);
                        acc[h] = __builtin_amdgcn_mfma_f32_16x16x32_bf16(al[dh], bh[h][dh], acc[h], 0, 0, 0);
                    } }
#pragma unroll
                for (int r = 0; r < 4; ++r) {
                    const float I = wv[0] * fmaxf(acc[0][r], 0.f) + wv[1] * fmaxf(acc[1][r], 0.f) + wv[2] * fmaxf(acc[2][r], 0.f) + wv[3] * fmaxf(acc[3][r], 0.f);
                    const int s = s0 + 4 * kg + r;
                    keys[q * MK_STRIDE + s] = (s <= t0 + q) ? sort_key(I) : 0u;
                }
            }
            __syncthreads();
            const int nk = t0 + 16;
            for (int qq = 2 * wave; qq < 2 * wave + 2; ++qq) {
                unsigned k[32];
#pragma unroll
                for (int i = 0; i < 32; ++i) { const int s = lane + 64 * i; k[i] = (s < nk) ? keys[qq * MK_STRIDE + s] : 0u; }
                unsigned prefix = 0u; bool exact = false;
                for (int bit = 31; bit >= 0; --bit) {
                    const unsigned cand = prefix | (1u << bit);
                    unsigned cnt = 0u;
#pragma unroll
                    for (int i = 0; i < 32; ++i) cnt += (unsigned)__popcll(__ballot(k[i] >= cand));
                    if (cnt >= (unsigned)TOPK) { prefix = cand; if (cnt == (unsigned)TOPK) { exact = true; break; } }
                }
                unsigned* mrow = mask + (rowq0 + qq) * 64;
                if (exact) {
#pragma unroll
                    for (int i = 0; i < 32; ++i) { const unsigned long long sb = __ballot(k[i] >= prefix); if (lane == 0) *(v2u*)(mrow + 2 * i) = (v2u){(unsigned)sb, (unsigned)(sb >> 32)}; }
                } else {
                    const unsigned tau = prefix; unsigned cgt = 0u;
#pragma unroll
                    for (int i = 0; i < 32; ++i) cgt += (unsigned)__popcll(__ballot(k[i] > tau));
                    const unsigned need = (unsigned)TOPK - cgt; unsigned base = 0u;
#pragma unroll
                    for (int i = 0; i < 32; ++i) {
                        const unsigned long long eqb = __ballot(k[i] == tau);
                        const unsigned rank = base + (unsigned)__popcll(eqb & ((1ull << lane) - 1ull));
                        const unsigned long long sb = __ballot((k[i] > tau) || ((k[i] == tau) && (rank < need)));
                        if (lane == 0) *(v2u*)(mrow + 2 * i) = (v2u){(unsigned)sb, (unsigned)(sb >> 32)};
                        base += (unsigned)__popcll(eqb);
                    }
                }
            }
            __syncthreads();
        }
    }
}

__device__ __forceinline__ void p_hgrn_local(Frame& F, int layer) {
    const int lane = F.lane;
    LAS float* Fs = (LAS float*)(F.lds + RING_OFF + F.wave * 16384); LAS float* Ks = Fs + 1024;
    const bf16* proj = (const bf16*)(F.ws + WS_PROJ); float* hst = (float*)(F.ws + WS_HST); float* hdn = (float*)(F.ws + WS_HDN);
    for (int unit = F.wave * F.G + F.bid; unit < BATCH * 4 * (SEQ / 64); unit += NWAVES * F.G) {
        const int bh = unit >> 5, chunk = unit & 31, b = bh >> 2, h = bh & 3;
        const float lbv = ((const float*)(F.ws + WS_LB))[layer * 256 + h * 64 + lane];
        const size_t row0 = (size_t)b * SEQ + chunk * 64;
        float S[64]; float dprod = 1.0f;
#pragma unroll
        for (int k = 0; k < 64; ++k) S[k] = 0.f;
        for (int qt = 0; qt < 4; ++qt) {
#pragma unroll 4
            for (int tt = 0; tt < 16; ++tt) {
                const float z = bf2f(proj[(row0 + qt * 16 + tt) * PROJ_LD + PC_HF + h * 64 + lane]);
                const float sig = 1.0f / (1.0f + expf(-z));
                const float f = fmaxf(lbv + (1.0f - lbv) * sig, 1e-30f);
                Fs[tt * 64 + lane] = f; Ks[tt * 64 + lane] = (1.0f - lbv) * (1.0f - sig); dprod *= f;
            }
            LDS_WAIT(); asm volatile("" ::: "memory");
            for (int tt = 0; tt < 16; ++tt) {
                const float iv = bf2f(proj[(row0 + qt * 16 + tt) * PROJ_LD + PC_HI + h * 64 + lane]);
#pragma unroll
                for (int k = 0; k < 64; k += 4) {
                    const f32x4 f4 = *(const LAS f32x4*)(Fs + tt * 64 + k), k4 = *(const LAS f32x4*)(Ks + tt * 64 + k);
#pragma unroll
                    for (int e = 0; e < 4; ++e) S[k + e] = f4[e] * S[k + e] + k4[e] * iv;
                }
            }
            LDS_WAIT(); asm volatile("" ::: "memory");
        }
        float* U = hst + (size_t)unit * 4096 + lane;
#pragma unroll
        for (int k = 0; k < 64; ++k) U[k * 64] = S[k];
        hdn[unit * 64 + lane] = dprod;
    }
}
__device__ __forceinline__ void p_hgrn_scan(Frame& F) {
    float* hst = (float*)(F.ws + WS_HST); const float* hdn = (const float*)(F.ws + WS_HDN);
    for (int e = F.bid * NTHR + F.tid; e < BATCH * 4 * 4096; e += F.G * NTHR) {
        const int bh = e >> 12, kv = e & 4095, k = kv >> 6;
        float S = 0.f;
        for (int n = 0; n < SEQ / 64; ++n) {
            const size_t idx = ((size_t)(bh * 32 + n) << 12) + kv;
            const float u = hst[idx]; hst[idx] = S;
            S = hdn[(bh * 32 + n) * 64 + k] * S + u;
        }
    }
}
constexpr int HG_LDS_OFF = 40960;
__device__ __forceinline__ void p_hgrn_out(Frame& F, int layer) {
    const int lane = F.lane;
    LAS float* Fs = (LAS float*)(F.lds + RING_OFF + HG_LDS_OFF + F.wave * 12288); LAS float* Ks = Fs + 1024; LAS float* Qs = Ks + 1024;
    const bf16* proj = (const bf16*)(F.ws + WS_PROJ); bf16* mixed = (bf16*)(F.ws + WS_MIXED); const float* hst = (const float*)(F.ws + WS_HST);
    for (int unit = F.wave * F.G + F.bid; unit < BATCH * 4 * (SEQ / 64); unit += NWAVES * F.G) {
        const int bh = unit >> 5, chunk = unit & 31, b = bh >> 2, h = bh & 3;
        const float lbv = ((const float*)(F.ws + WS_LB))[layer * 256 + h * 64 + lane];
        const float ng = F.hgrn_g[layer * 256 + h * 64 + lane];
        const size_t row0 = (size_t)b * SEQ + chunk * 64;
        float S[64];
        { const float* U = hst + (size_t)unit * 4096 + lane;
#pragma unroll
          for (int k = 0; k < 64; ++k) S[k] = U[k * 64]; }
        for (int qt = 0; qt < 4; ++qt) {
#pragma unroll 4
            for (int tt = 0; tt < 16; ++tt) {
                const bf16* pr = proj + (row0 + qt * 16 + tt) * PROJ_LD + h * 64 + lane;
                const float z = bf2f(pr[PC_HF]), qr = bf2f(pr[PC_HQ]);
                const float sig = 1.0f / (1.0f + expf(-z));
                Fs[tt * 64 + lane] = fmaxf(lbv + (1.0f - lbv) * sig, 1e-30f); Ks[tt * 64 + lane] = (1.0f - lbv) * (1.0f - sig); Qs[tt * 64 + lane] = qr / (1.0f + expf(-qr));
            }
            LDS_WAIT(); asm volatile("" ::: "memory");
            for (int tt = 0; tt < 16; ++tt) {
                const bf16* pr = proj + (row0 + qt * 16 + tt) * PROJ_LD + h * 64 + lane;
                const float iv = bf2f(pr[PC_HI]), gr = bf2f(pr[PC_HG]);
                float o = 0.f;
#pragma unroll
                for (int k = 0; k < 64; k += 4) {
                    const f32x4 f4 = *(const LAS f32x4*)(Fs + tt * 64 + k), k4 = *(const LAS f32x4*)(Ks + tt * 64 + k), q4 = *(const LAS f32x4*)(Qs + tt * 64 + k);
#pragma unroll
                    for (int e = 0; e < 4; ++e) { S[k + e] = f4[e] * S[k + e] + k4[e] * iv; o += q4[e] * S[k + e]; }
                }
                const float ms = wave_sum(o * o) * (1.0f / 64.0f);
                const float y = o * (1.0f / sqrtf(ms + 1e-5f)) * ng * (gr / (1.0f + expf(-gr)));
                mixed[(row0 + qt * 16 + tt) * DM + MC_HGRN + h * 64 + lane] = (bf16)f2bf(y);
            }
            LDS_WAIT(); asm volatile("" ::: "memory");
        }
    }
}

__device__ __forceinline__ void p_vt(Frame& F) {
    LAS unsigned short* T = (LAS unsigned short*)(F.lds + RING_OFF + F.wave * 16384);
    const bf16* proj = (const bf16*)(F.ws + WS_PROJ); bf16* vT = (bf16*)(F.ws + WS_VT);
    const int gw = F.bid * NWAVES + F.wave, NGW = F.G * NWAVES, lane = F.lane;
    for (int tile = gw; tile < BATCH * 2 * (SEQ / 64); tile += NGW) {
        const int bk = tile >> 5, tb = tile & 31, b = bk >> 1, kvh = bk & 1;
        const bf16* src = proj + (size_t)(b * SEQ + tb * 64) * PROJ_LD + PC_V + kvh * 64 + lane;
#pragma unroll 8
        for (int t = 0; t < 64; ++t) T[t * 66 + lane] = src[(size_t)t * PROJ_LD];
        LDS_WAIT(); asm volatile("" ::: "memory");
        bf16* dst = vT + (size_t)(bk * 64) * SEQ + tb * 64 + lane;
#pragma unroll 8
        for (int d = 0; d < 64; ++d) dst[(size_t)d * SEQ] = T[lane * 66 + d];
        LDS_WAIT(); asm volatile("" ::: "memory");
    }
}

constexpr int AT_KROW = 144, AT_VROW = 136, AT_KBYTES = 64 * AT_KROW, AT_VBYTES = 64 * AT_VROW, AT_BUF = AT_KBYTES + AT_VBYTES, AT_SCR = 2 * AT_BUF;
static_assert(AT_BUF % 16 == 0 && AT_SCR % 16 == 0, "attention LDS map alignment");
__device__ __forceinline__ void p_attn_flash(Frame& F) {
    const int tid = F.tid, lane = F.lane, wave = F.wave;
    const int r = lane & 31, hh = lane >> 5, g = wave & 3, qh = wave >> 2;
    LAS unsigned char* L = F.lds + RING_OFF;
    LAS float* scr = (LAS float*)(L + AT_SCR) + wave * 32;
    const bf16* proj = (const bf16*)(F.ws + WS_PROJ); const bf16* vT = (const bf16*)(F.ws + WS_VT); bf16* mixed = (bf16*)(F.ws + WS_MIXED);
    const unsigned* mask = (const unsigned*)(F.ws + WS_MASK);
    const int srow = tid >> 3, sch = tid & 7;
    const float C2 = 0.18033688011112042f, NEG = -1.0e30f;
    for (int pair = F.bid; pair < 256; pair += F.G) {
        const int bk = pair >> 4, b = bk >> 1, kvh = bk & 1, pp = pair & 15, h = kvh * 4 + g;
        for (int half = 0; half < 2; ++half) {
            const int qblk = half == 0 ? 31 - pp : pp;
            const int q0 = qblk * 64, nt = qblk + 1;
            const int tq = q0 + 32 * qh + r;
            bf16x8v qf[4];
            { const bf16* qp = proj + (size_t)(b * SEQ + tq) * PROJ_LD + PC_Q + h * 64 + 8 * hh;
#pragma unroll
              for (int d0 = 0; d0 < 4; ++d0) qf[d0] = *(const bf16x8v*)(qp + 16 * d0); }
            const unsigned* mrow = mask + (size_t)(b * SEQ + tq) * 64;
            const bf16* kg = proj + (size_t)(b * SEQ + srow) * PROJ_LD + PC_K + kvh * 64 + sch * 8;
            const bf16* vg = vT + (size_t)(bk * 64 + srow) * SEQ + sch * 8;
            { const v4u kreg = *(const v4u*)kg; const v4u vreg = *(const v4u*)vg;
              *(LAS v4u*)(L + srow * AT_KROW + sch * 16) = kreg;
              LAS unsigned char* vd = L + AT_KBYTES + srow * AT_VROW + sch * 16;
              *(LAS v2u*)vd = (v2u){vreg.x, vreg.y}; *(LAS v2u*)(vd + 8) = (v2u){vreg.z, vreg.w}; }
            v2u mw = *(const v2u*)mrow;
            __syncthreads();
            f32x16 o0, o1;
#pragma unroll
            for (int i = 0; i < 16; ++i) { o0[i] = 0.f; o1[i] = 0.f; }
            float m = -30000.0f, l = 0.f;
            for (int j = 0; j < nt; ++j) {
                LAS unsigned char* Kb = L + (j & 1) * AT_BUF; LAS unsigned char* Vb = Kb + AT_KBYTES;
                const bool more = (j + 1 < nt);
                v4u kn = (v4u){0u, 0u, 0u, 0u}, vn = (v4u){0u, 0u, 0u, 0u}; v2u mwn = (v2u){0u, 0u};
                if (more) { kn = *(const v4u*)(kg + (size_t)(j + 1) * 64 * PROJ_LD); vn = *(const v4u*)(vg + (j + 1) * 64); mwn = *(const v2u*)(mrow + 2 * (j + 1)); }
                f32x16 p0, p1;
#pragma unroll
                for (int i = 0; i < 16; ++i) { p0[i] = 0.f; p1[i] = 0.f; }
#pragma unroll
                for (int d0 = 0; d0 < 4; ++d0) {
                    const bf16x8v a0 = *(const LAS bf16x8v*)(Kb + r * AT_KROW + d0 * 32 + hh * 16);
                    const bf16x8v a1 = *(const LAS bf16x8v*)(Kb + (32 + r) * AT_KROW + d0 * 32 + hh * 16);
                    p0 = __builtin_amdgcn_mfma_f32_32x32x16_bf16(a0, qf[d0], p0, 0, 0, 0);
                    p1 = __builtin_amdgcn_mfma_f32_32x32x16_bf16(a1, qf[d0], p1, 0, 0, 0);
                }
                const unsigned w0 = mw.x >> (4 * hh), w1 = mw.y >> (4 * hh);
                float mx = NEG;
#pragma unroll
                for (int i = 0; i < 16; ++i) {
                    const int cr = (i & 3) + 8 * (i >> 2);
                    p0[i] = ((w0 >> cr) & 1u) ? p0[i] : NEG; p1[i] = ((w1 >> cr) & 1u) ? p1[i] : NEG;
                    mx = fmaxf(mx, fmaxf(p0[i], p1[i]));
                }
                mx = fmaxf(mx, __shfl_xor(mx, 32));
                const float mnew = fmaxf(m, mx * C2);
                const float alpha = __builtin_amdgcn_exp2f(m - mnew); m = mnew;
                float rs = 0.f;
#pragma unroll
                for (int i = 0; i < 16; ++i) {
                    p0[i] = __builtin_amdgcn_exp2f(__builtin_fmaf(p0[i], C2, -mnew)); p1[i] = __builtin_amdgcn_exp2f(__builtin_fmaf(p1[i], C2, -mnew));
                    rs += p0[i] + p1[i];
                }
                l = l * alpha + rs;
                if (hh == 0) scr[r] = alpha;
#pragma unroll
                for (int gq = 0; gq < 4; ++gq) {
                    const f32x4 a4 = *(const LAS f32x4*)(scr + 8 * gq + 4 * hh);
#pragma unroll
                    for (int e = 0; e < 4; ++e) { o0[4 * gq + e] *= a4[e]; o1[4 * gq + e] *= a4[e]; }
                }
                bf16x8v pf[4];
                { v4u t;
                  t.x = cvtpk(p0[0], p0[1]); t.y = cvtpk(p0[2], p0[3]); t.z = cvtpk(p0[4], p0[5]); t.w = cvtpk(p0[6], p0[7]); pf[0] = __builtin_bit_cast(bf16x8v, t);
                  t.x = cvtpk(p0[8], p0[9]); t.y = cvtpk(p0[10], p0[11]); t.z = cvtpk(p0[12], p0[13]); t.w = cvtpk(p0[14], p0[15]); pf[1] = __builtin_bit_cast(bf16x8v, t);
                  t.x = cvtpk(p1[0], p1[1]); t.y = cvtpk(p1[2], p1[3]); t.z = cvtpk(p1[4], p1[5]); t.w = cvtpk(p1[6], p1[7]); pf[2] = __builtin_bit_cast(bf16x8v, t);
                  t.x = cvtpk(p1[8], p1[9]); t.y = cvtpk(p1[10], p1[11]); t.z = cvtpk(p1[12], p1[13]); t.w = cvtpk(p1[14], p1[15]); pf[3] = __builtin_bit_cast(bf16x8v, t); }
#pragma unroll
                for (int ks = 0; ks < 4; ++ks) {
                    const LAS unsigned char* vp = Vb + r * AT_VROW + (16 * ks + 4 * hh) * 2;
                    const v2u l0 = *(const LAS v2u*)vp, h0 = *(const LAS v2u*)(vp + 16);
                    const v2u l1 = *(const LAS v2u*)(vp + 32 * AT_VROW), h1 = *(const LAS v2u*)(vp + 32 * AT_VROW + 16);
                    const bf16x8v vf0 = __builtin_bit_cast(bf16x8v, (v4u){l0.x, l0.y, h0.x, h0.y});
                    const bf16x8v vf1 = __builtin_bit_cast(bf16x8v, (v4u){l1.x, l1.y, h1.x, h1.y});
                    o0 = __builtin_amdgcn_mfma_f32_32x32x16_bf16(pf[ks], vf0, o0, 0, 0, 0);
                    o1 = __builtin_amdgcn_mfma_f32_32x32x16_bf16(pf[ks], vf1, o1, 0, 0, 0);
                }
                if (more) {
                    LAS unsigned char* Kn = L + ((j + 1) & 1) * AT_BUF;
                    *(LAS v4u*)(Kn + srow * AT_KROW + sch * 16) = kn;
                    LAS unsigned char* vd = Kn + AT_KBYTES + srow * AT_VROW + sch * 16;
                    *(LAS v2u*)vd = (v2u){vn.x, vn.y}; *(LAS v2u*)(vd + 8) = (v2u){vn.z, vn.w};
                    mw = mwn;
                }
                __syncthreads();
            }
            l += __shfl_xor(l, 32);
            if (hh == 0) scr[r] = 1.0f / l;
            bf16* op = mixed + (size_t)(b * SEQ + q0 + 32 * qh) * DM + MC_ATTN + h * 64 + r;
#pragma unroll
            for (int gq = 0; gq < 4; ++gq) {
                const f32x4 a4 = *(const LAS f32x4*)(scr + 8 * gq + 4 * hh);
#pragma unroll
                for (int e = 0; e < 4; ++e) {
                    const int q = 8 * gq + 4 * hh + e;
                    op[(size_t)q * DM] = (bf16)f2bf(o0[4 * gq + e] * a4[e]); op[(size_t)q * DM + 32] = (bf16)f2bf(o1[4 * gq + e] * a4[e]);
                }
            }
        }
    }
}

__device__ __forceinline__ void p_final(Frame& F) {
    const int gw = F.bid * NWAVES + F.wave, NGW = F.G * NWAVES;
    for (int row = gw; row < M; row += NGW) {
        f32x4* xr = (f32x4*)(F.xres + (size_t)row * DM) + F.lane;
        const f32x4* gr = (const f32x4*)F.fng + F.lane;
        f32x4 v[4]; float s = 0.f;
#pragma unroll
        for (int j = 0; j < 4; ++j) { v[j] = xr[64 * j]; s += (v[j][0] * v[j][0] + v[j][1] * v[j][1]) + (v[j][2] * v[j][2] + v[j][3] * v[j][3]); }
        s = wave_sum(s);
        const float rs = 1.0f / sqrtf(s * (1.0f / 1024.0f) + 1e-5f);
#pragma unroll
        for (int j = 0; j < 4; ++j) xr[64 * j] = v[j] * rs * gr[64 * j];
    }
}

#ifndef MK_SINGLE
#define MK_SINGLE 1
#endif
constexpr int NPL = 7;
constexpr int NPHASE = 1 + DEPTH * NPL + 1;
struct Args { const float* x; const int* pos; const float *n1g, *w_in, *pool_w, *pool_scale, *lb_logits, *hgrn_g, *w_out, *n2g, *w_ff_in, *w_ff_out, *fng; float* out; unsigned char* ws; int ph_lo, ph_hi; };
static_assert(sizeof(Args) == 15 * 8 + 8, "Args has no padding");


#define PHASE_BEGIN() do { int t_ = threadIdx.x; asm volatile("" : "+v"(t_)); F.tid = t_; F.lane = t_ & 63; F.wave = __builtin_amdgcn_readfirstlane(t_ >> 6); \
    unsigned char* w_ = args.ws; asm volatile("" : "+s"(w_)); F.ws = w_; } while (0)
__global__ void __launch_bounds__(NTHR, 2) fwd(Args args) {
    extern __shared__ __attribute__((aligned(16))) unsigned char lds[];
    Frame F;
    F.lds = (LAS unsigned char*)lds;
    F.MISC = (volatile LAS unsigned*)(F.lds + MISC_OFF);
    F.tid = threadIdx.x; F.lane = F.tid & 63; F.wave = __builtin_amdgcn_readfirstlane(F.tid >> 6);
    F.G = gridDim.x; F.bid = blockIdx.x;
    F.ws = args.ws; F.ctl = (gu32*)(args.ws + WS_CTL);
    F.x_in = args.x; F.pos = args.pos; F.n1g = args.n1g; F.w_in = args.w_in; F.pool_w = args.pool_w; F.pool_scale = args.pool_scale; F.lb_logits = args.lb_logits;
    F.hgrn_g = args.hgrn_g; F.w_out = args.w_out; F.n2g = args.n2g; F.w_ff_in = args.w_ff_in; F.w_ff_out = args.w_ff_out; F.fng = args.fng; F.xres = args.out;
    for (int u = F.tid; u < (LDS_BYTES - LDSCTL_OFF) / 4; u += NTHR) ((LAS unsigned*)(F.lds + LDSCTL_OFF))[u] = 0u;
    __syncthreads();
    XcdBarrier bar; bar.bar = (unsigned*)(F.ctl + CW_BAR); bar.x = 0; bar.st = nullptr;
    if (MK_SINGLE) bar = xcd_barrier_post((unsigned*)(F.ctl + CW_BAR), F.MISC + 8);
    const int lo = args.ph_lo, hi = args.ph_hi;
#define IN(k) (lo <= (k) && (k) < hi)
#define SEAM(k) do { if (MK_SINGLE && IN(k) && IN((k) + 1)) xcd_barrier(bar); } while (0)
    bf16* const xb = (bf16*)(F.ws + WS_XB); float* const ssq = (float*)(F.ws + WS_SSQ);
    bf16* const proj = (bf16*)(F.ws + WS_PROJ); bf16* const mixed = (bf16*)(F.ws + WS_MIXED); bf16* const hid = (bf16*)(F.ws + WS_HID);
    float* const idxf = (float*)(F.ws + WS_IDXF);

    if (IN(0)) { PHASE_BEGIN(); p_prologue(F); } SEAM(0);
    for (int layer = 0; layer < DEPTH; ++layer) {
        const int pb = 1 + layer * NPL;
        if (IN(pb + 0)) {
            pg8::Gemm g{xb, (const bf16*)(F.ws + WS_WIN), M, DINP, DM}; pg8::StaticOrder S; S.init(M, DINP, F.G, F.bid);
            pg8::EpiIn E{proj, idxf, ssq};
            pg8::gemm_phase<pg8::EpiIn, pg8::StaticOrder, true, true>(F.lds + RING_OFF, g, S, E);
        } SEAM(pb + 0);
        if (IN(pb + 1)) { PHASE_BEGIN(); p_rope(F); p_vt(F); cvt_layer_rest(F, layer); PHASE_BEGIN(); p_hgrn_local(F, layer); } SEAM(pb + 1);
        if (IN(pb + 2)) { PHASE_BEGIN(); p_pool(F, layer); PHASE_BEGIN(); p_mask(F); PHASE_BEGIN(); p_hgrn_scan(F); } SEAM(pb + 2);
        if (IN(pb + 3)) { PHASE_BEGIN(); p_hgrn_out(F, layer); PHASE_BEGIN(); p_attn_flash(F); } SEAM(pb + 3);
        if (IN(pb + 4)) {
            pg8::Gemm g{mixed, (const bf16*)(F.ws + WS_WOUT), M, DM, DM}; pg8::StaticOrder S; S.init(M, DM, F.G, F.bid);
            pg8::EpiRes E{layer == 0 ? F.x_in : (const float*)F.xres, F.xres, xb, ssq};
            pg8::gemm_phase<pg8::EpiRes, pg8::StaticOrder, true, true>(F.lds + RING_OFF, g, S, E);
        } SEAM(pb + 4);
        if (IN(pb + 5)) {
            pg8::Gemm g{xb, (const bf16*)(F.ws + WS_WFI), M, DFF, DM}; pg8::StaticOrder S; S.init(M, DFF, F.G, F.bid);
            pg8::EpiFfIn E{hid, ssq};
            pg8::gemm_phase<pg8::EpiFfIn, pg8::StaticOrder, true, true>(F.lds + RING_OFF, g, S, E);
        } SEAM(pb + 5);
        if (IN(pb + 6)) {
            pg8::Gemm g{hid, (const bf16*)(F.ws + WS_WFO), M, DM, DFF}; pg8::StaticOrder S; S.init(M, DM, F.G, F.bid);
            pg8::EpiRes E{(const float*)F.xres, F.xres, xb, ssq};
            pg8::gemm_phase<pg8::EpiRes, pg8::StaticOrder, true, true>(F.lds + RING_OFF, g, S, E);
        } SEAM(pb + 6);
    }
    if (IN(NPHASE - 1)) { PHASE_BEGIN(); p_final(F); }
#undef IN
#undef SEAM
}

extern "C" void kernel_launch(void* const* d_in, const int* in_sizes, int n_in, void* d_out, int out_size, void* d_ws, size_t ws_size, hipStream_t stream) {
    static int grid = 0;
    if (grid == 0) {
        if (n_in != 13 || out_size != M * DM || ws_size < WS_END) { fprintf(stderr, "kernel_launch: unexpected shapes (n_in %d, out %d, ws %zu)\n", n_in, out_size, ws_size); grid = -1; return; }
        int dev = 0, cus = 0, per_cu = 0;
        if (hipGetDevice(&dev) != hipSuccess || hipDeviceGetAttribute(&cus, hipDeviceAttributeMultiprocessorCount, dev) != hipSuccess) { grid = -1; return; }
        if (hipFuncSetAttribute((const void*)fwd, hipFuncAttributeMaxDynamicSharedMemorySize, LDS_BYTES) != hipSuccess) { fprintf(stderr, "kernel_launch: hipFuncSetAttribute failed\n"); grid = -1; return; }
        if (hipOccupancyMaxActiveBlocksPerMultiprocessor(&per_cu, (const void*)fwd, NTHR, LDS_BYTES) != hipSuccess || per_cu < 1) { fprintf(stderr, "kernel_launch: occupancy query says %d\n", per_cu); }
        (void)hipGetLastError();
        grid = cus;
        if (grid > 256) grid = 256;
        grid -= grid % 8;
    }
    if (grid <= 0) return;
    (void)hipMemsetAsync((char*)d_ws + WS_CTL, 0, CTL_ZERO_BYTES, stream);
    Args a{};
    a.x = (const float*)d_in[0]; a.pos = (const int*)d_in[1]; a.n1g = (const float*)d_in[2]; a.w_in = (const float*)d_in[3]; a.pool_w = (const float*)d_in[4];
    a.pool_scale = (const float*)d_in[5]; a.lb_logits = (const float*)d_in[6]; a.hgrn_g = (const float*)d_in[7]; a.w_out = (const float*)d_in[8]; a.n2g = (const float*)d_in[9];
    a.w_ff_in = (const float*)d_in[10]; a.w_ff_out = (const float*)d_in[11]; a.fng = (const float*)d_in[12];
    a.out = (float*)d_out; a.ws = (unsigned char*)d_ws;
    if (MK_SINGLE) {
        a.ph_lo = 0; a.ph_hi = NPHASE;
        hipLaunchKernelGGL(fwd, dim3(grid), dim3(NTHR), LDS_BYTES, stream, a);
    } else {
        for (int p = 0; p < NPHASE; ++p) { a.ph_lo = p; a.ph_hi = p + 1; hipLaunchKernelGGL(fwd, dim3(grid), dim3(NTHR), LDS_BYTES, stream, a); }
    }
}
```

```cpp
#include <hip/hip_runtime.h>
#include <cstdio>
#include <cstdint>
namespace pg8 {
#define PG8_LAS __attribute__((address_space(3)))
typedef unsigned short bf16_t;
typedef short bf16x8 __attribute__((ext_vector_type(8)));
typedef float f32x4 __attribute__((ext_vector_type(4)));
typedef unsigned u32x4 __attribute__((ext_vector_type(4)));
constexpr int BM = 256, BK = 64, HALF = 128, HTB = HALF * BK * 2  , STAGE_BYTES = 8 * HTB, NXCD = 8, WGM = 8;

__host__ __device__ __forceinline__ int lds_byte(int r, int c) { const int st = (r >> 4) * 2 + (c >> 5), rr = r & 15, cc = c & 31, ob = rr * 64 + cc * 2; return st * 1024 + (ob ^ (((ob >> 9) & 1) << 5)); }
__host__ __device__ __forceinline__ void stage_rc(int b, int& R, int& C) { const int st = b / 1024, sb = b % 1024, swz = sb ^ (((sb >> 9) & 1) << 5); R = (st >> 1) * 16 + swz / 64; C = (st & 1) * 32 + (swz % 64) / 2; }
__host__ __device__ __forceinline__ int perm32(int rho) { const int n = rho >> 4, i = rho & 15; return 8 * (i >> 2) + 4 * n + (i & 3); }

struct Unit { int pm, pn; };
struct Gemm { const bf16_t* A; const bf16_t* Bt; int M, N, K; };

struct StaticOrder {
    int nM, nN, nwg, G, c;
    __host__ __device__ void init(int M, int N, int G_, int c_) { nM = M / BM; nN = N / BM; nwg = nM * nN; G = G_; c = c_; }
    __host__ __device__ bool next(int i, Unit& u) const {
        const long L = (long)i * G + c; if (L >= nwg) return false;
        int wgid = (int)L; { const int q = nwg / NXCD, r = nwg % NXCD, xcd = wgid % NXCD, off = wgid / NXCD; wgid = (xcd < r ? xcd * (q + 1) : r * (q + 1) + (xcd - r) * q) + off; }
        const int nig = WGM * nN, gid = wgid / nig, fm = gid * WGM, gsz = (nM - fm) < WGM ? (nM - fm) : WGM;
        u.pm = fm + ((wgid % nig) % gsz); u.pn = (wgid % nig) / gsz; return true;
    }
    __device__ __forceinline__ void a_ready(const Unit&) const {}
    __device__ __forceinline__ void done(const Unit&) const {}
};

__device__ __forceinline__ unsigned cvt_pk_bf16(float lo, float hi) { unsigned r; asm volatile("v_cvt_pk_bf16_f32 %0, %1, %2" : "=v"(r) : "v"(lo), "v"(hi)); return r; }
typedef float f32x2 __attribute__((ext_vector_type(2)));

constexpr float RMS_EPS_F = 1e-5f;
#define PG8_GAS __attribute__((address_space(1)))
__device__ __forceinline__ float row_rstd(const float* ssq, int row) {
    const PG8_GAS f32x4* p = (const PG8_GAS f32x4*)(ssq + (size_t)row * 16);
    const f32x4 a = p[0], b = p[1], c = p[2], d = p[3];
    const float s = ((a[0] + a[1]) + (a[2] + a[3])) + ((b[0] + b[1]) + (b[2] + b[3])) + ((c[0] + c[1]) + (c[2] + c[3])) + ((d[0] + d[1]) + (d[2] + d[3]));
    return 1.0f / sqrtf(s * (1.0f / 1024.0f) + RMS_EPS_F);
}
__device__ __forceinline__ unsigned cvt_pk_rne(float lo, float hi) { typedef float f2 __attribute__((ext_vector_type(2))); typedef __bf16 b2 __attribute__((ext_vector_type(2))); f2 v = {lo, hi}; b2 b = __builtin_convertvector(v, b2); return __builtin_bit_cast(unsigned, b); }
__device__ __forceinline__ void split_hl(const f32x4 a, const f32x4 b, u32x4& h, u32x4& l) {
    h.x = cvt_pk_rne(a[0], a[1]); h.y = cvt_pk_rne(a[2], a[3]); h.z = cvt_pk_rne(b[0], b[1]); h.w = cvt_pk_rne(b[2], b[3]);
    l.x = cvt_pk_rne(a[0] - __builtin_bit_cast(float, h.x << 16), a[1] - __builtin_bit_cast(float, h.x & 0xffff0000u));
    l.y = cvt_pk_rne(a[2] - __builtin_bit_cast(float, h.y << 16), a[3] - __builtin_bit_cast(float, h.y & 0xffff0000u));
    l.z = cvt_pk_rne(b[0] - __builtin_bit_cast(float, h.z << 16), b[1] - __builtin_bit_cast(float, h.z & 0xffff0000u));
    l.w = cvt_pk_rne(b[2] - __builtin_bit_cast(float, h.w << 16), b[3] - __builtin_bit_cast(float, h.w & 0xffff0000u));
}
struct EpiIn {
    static constexpr bool PERM = true, AFTER_DRAIN = false;
    bf16_t* proj; bf16_t* qi_hl; bf16_t* ki_hl; float* wi; bf16_t* vT; const float* ssq; const float* rope;
    __device__ __forceinline__ void operator()(const f32x4 (&acc)[2][2][4][2], const Unit& u, int wr, int wc, int fr, int fq) const {
        const int row0 = u.pm * BM + wr * 64 + fr, pn = u.pn;
        const bool rot_lane = ((wc & 1) == 0) && (fq < 2);
        const float sgn = (fq == 0) ? -1.f : 1.f;
#pragma unroll
        for (int ai = 0; ai < 2; ++ai)
#pragma unroll
            for (int m = 0; m < 4; ++m) {
                const int row = row0 + ai * HALF + m * 16;
                const float rs = row_rstd(ssq, row);
                f32x4 c0 = {1.f, 1.f, 1.f, 1.f}, c1 = c0, s0 = {0.f, 0.f, 0.f, 0.f}, s1 = s0;
                if (pn >= 5) { const PG8_GAS f32x4* tp = (const PG8_GAS f32x4*)(rope + (size_t)row * 16); c0 = tp[0]; c1 = tp[1]; s0 = tp[2]; s1 = tp[3]; }
#pragma unroll
                for (int bj = 0; bj < 2; ++bj) {
                    f32x4 v0 = acc[ai][bj][m][0] * rs, v1 = acc[ai][bj][m][1] * rs;
                    const bool rope_tile = (pn == 5) || (pn == 6) || (pn == 8) || (pn == 7 && bj == 0) || (pn == 9 && bj == 0 && wc < 2);
                    if (rope_tile) {
                        f32x4 p0, p1;
#pragma unroll
                        for (int e = 0; e < 4; ++e) { p0[e] = __shfl_xor(v0[e], 16); p1[e] = __shfl_xor(v1[e], 16); }
                        if (rot_lane) { v0 = v0 * c0 + (p0 * s0) * sgn; v1 = v1 * c1 + (p1 * s1) * sgn; }
                    }
                    const int cl = bj * HALF + wc * 32 + 8 * fq;
                    if (pn < 7 || (pn == 7 && bj == 0)) {
                        u32x4 w; w.x = cvt_pk_bf16(v0[0], v0[1]); w.y = cvt_pk_bf16(v0[2], v0[3]); w.z = cvt_pk_bf16(v1[0], v1[1]); w.w = cvt_pk_bf16(v1[2], v1[3]);
                        *(PG8_GAS u32x4*)(proj + (size_t)row * 2048 + pn * BM + cl) = w;
                    } else if (pn == 7) {
                        const int vc = cl - HALF, kvh = vc >> 6, d = vc & 63, b = row >> 11, t = row & 2047;
                        PG8_GAS bf16_t* o = (PG8_GAS bf16_t*)vT + ((size_t)((b * 2 + kvh) * 64 + d)) * 2048 + t;
                        const u32x4 w = (u32x4){cvt_pk_bf16(v0[0], v0[1]), cvt_pk_bf16(v0[2], v0[3]), cvt_pk_bf16(v1[0], v1[1]), cvt_pk_bf16(v1[2], v1[3])};
                        o[0 * 2048] = (bf16_t)(w.x & 0xffffu); o[1 * 2048] = (bf16_t)(w.x >> 16); o[2 * 2048] = (bf16_t)(w.y & 0xffffu); o[3 * 2048] = (bf16_t)(w.y >> 16);
                        o[4 * 2048] = (bf16_t)(w.z & 0xffffu); o[5 * 2048] = (bf16_t)(w.z >> 16); o[6 * 2048] = (bf16_t)(w.w & 0xffffu); o[7 * 2048] = (bf16_t)(w.w >> 16);
                    } else if (pn == 8) {
                        u32x4 h, l; split_hl(v0, v1, h, l);
                        *(PG8_GAS u32x4*)(qi_hl + (size_t)row * 512 + cl) = h; *(PG8_GAS u32x4*)(qi_hl + (size_t)row * 512 + 256 + cl) = l;
                    } else if (bj == 0) {
                        if (wc < 2) { u32x4 h, l; split_hl(v0, v1, h, l); *(PG8_GAS u32x4*)(ki_hl + (size_t)row * 128 + cl) = h; *(PG8_GAS u32x4*)(ki_hl + (size_t)row * 128 + 64 + cl) = l; }
                        else if (wc == 2 && fq == 0) { *(PG8_GAS f32x4*)(wi + (size_t)row * 4) = v0; }
                    }
                }
            }
    }
};
struct EpiRes {
    static constexpr bool PERM = true, AFTER_DRAIN = false;
    const float* xin; float* xout; bf16_t* xb; float* ssq;
    __device__ __forceinline__ void operator()(const f32x4 (&acc)[2][2][4][2], const Unit& u, int wr, int wc, int fr, int fq) const {
        const int row0 = u.pm * BM + wr * 64 + fr;
        const int colt = u.pn * BM + wc * 32 + 8 * fq;
#pragma unroll
        for (int ai = 0; ai < 2; ++ai)
#pragma unroll
            for (int m = 0; m < 4; ++m) {
                const int row = row0 + ai * HALF + m * 16;
                float sq = 0.f;
#pragma unroll
                for (int bj = 0; bj < 2; ++bj) {
                    const size_t off = (size_t)row * 1024 + colt + bj * HALF;
                    const f32x4 a0 = *(const PG8_GAS f32x4*)(xin + off), a1 = *(const PG8_GAS f32x4*)(xin + off + 4);
                    const f32x4 v0 = a0 + acc[ai][bj][m][0], v1 = a1 + acc[ai][bj][m][1];
                    *(PG8_GAS f32x4*)(xout + off) = v0; *(PG8_GAS f32x4*)(xout + off + 4) = v1;
                    u32x4 w; w.x = cvt_pk_bf16(v0[0], v0[1]); w.y = cvt_pk_bf16(v0[2], v0[3]); w.z = cvt_pk_bf16(v1[0], v1[1]); w.w = cvt_pk_bf16(v1[2], v1[3]);
                    *(PG8_GAS u32x4*)(xb + off) = w;
                    sq += (v0[0] * v0[0] + v0[1] * v0[1]) + (v0[2] * v0[2] + v0[3] * v0[3]) + (v1[0] * v1[0] + v1[1] * v1[1]) + (v1[2] * v1[2] + v1[3] * v1[3]);
                }
                sq += __shfl_xor(sq, 16); sq += __shfl_xor(sq, 32);
                if (fq == 0) ((PG8_GAS float*)ssq)[(size_t)row * 16 + u.pn * 4 + wc] = sq;
            }
    }
};
struct EpiFfIn {
    static constexpr bool PERM = true, AFTER_DRAIN = false;
    bf16_t* hid; const float* ssq;
    __device__ __forceinline__ void operator()(const f32x4 (&acc)[2][2][4][2], const Unit& u, int wr, int wc, int fr, int fq) const {
        const int row0 = u.pm * BM + wr * 64 + fr;
        const int colt = u.pn * BM + wc * 32 + 8 * fq;
#pragma unroll
        for (int ai = 0; ai < 2; ++ai)
#pragma unroll
            for (int m = 0; m < 4; ++m) {
                const int row = row0 + ai * HALF + m * 16;
                const float rs = row_rstd(ssq, row);
#pragma unroll
                for (int bj = 0; bj < 2; ++bj) {
                    f32x4 v0 = acc[ai][bj][m][0] * rs, v1 = acc[ai][bj][m][1] * rs;
#pragma unroll
                    for (int e = 0; e < 4; ++e) { const float a = fmaxf(v0[e], 0.f), b = fmaxf(v1[e], 0.f); v0[e] = a * a; v1[e] = b * b; }
                    u32x4 w; w.x = cvt_pk_bf16(v0[0], v0[1]); w.y = cvt_pk_bf16(v0[2], v0[3]); w.z = cvt_pk_bf16(v1[0], v1[1]); w.w = cvt_pk_bf16(v1[2], v1[3]);
                    *(PG8_GAS u32x4*)(hid + (size_t)row * 4096 + colt + bj * HALF) = w;
                }
            }
    }
};
template <class Epi, class Sched, bool ALIGN_EPI = false, bool SP2 = false>
__device__ __forceinline__ void gemm_phase(PG8_LAS unsigned char* lds, const Gemm g, const Sched& S, const Epi& E) {
    int tid_ = threadIdx.x; asm volatile("" : "+v"(tid_));
    const int tid = tid_, wid = __builtin_amdgcn_readfirstlane(tid >> 6), lane = tid & 63, wr = wid >> 2, wc = wid & 3, fr = lane & 15, fq = lane >> 4;
    const int K = g.K, nt = K / BK;
    unsigned voffA[2], voffB[2];
#pragma unroll
    for (int i = 0; i < 2; ++i) { int R, C; stage_rc(tid * 16 + i * 8192, R, C); const int Rb = Epi::PERM ? ((R & ~31) + perm32(R & 31)) : R;
        voffA[i] = (unsigned)(R * K + C) * 2u; voffB[i] = (unsigned)(Rb * K + C) * 2u; }
    const size_t kstep = (size_t)(BK * 2);
    const size_t hstep = (size_t)HALF * K * 2;
    const size_t tstep = 2 * hstep;
    const unsigned ldsw = (unsigned)wid * 1024u;
    const int aoff = lds_byte(wr * 64 + fr, fq * 8), boff = lds_byte(wc * 32 + fr, fq * 8);
#define PG8_SA(b, h) (((b) * 2 + (h)) * HTB)
#define PG8_SB(b, h) ((4 + (b) * 2 + (h)) * HTB)
#define PG8_STAGE(bufoff, gbase, voff) do { _Pragma("unroll") for (int _i = 0; _i < 2; ++_i) \
        __builtin_amdgcn_global_load_lds((const unsigned*)((const char*)(gbase) + (voff)[_i]), (PG8_LAS unsigned*)(lds + (bufoff) + ldsw + _i * 8192), 16, 0, 0); } while (0)
#define PG8_LDA(dst, b, h) do { _Pragma("unroll") for (int m = 0; m < 4; ++m) _Pragma("unroll") for (int k = 0; k < 2; ++k) dst[m][k] = *(const PG8_LAS bf16x8*)(lds + PG8_SA(b, h) + aoff + m * 2048 + k * 1024); } while (0)
#define PG8_LDB(dst, b, h) do { _Pragma("unroll") for (int n = 0; n < 2; ++n) _Pragma("unroll") for (int k = 0; k < 2; ++k) dst[n][k] = *(const PG8_LAS bf16x8*)(lds + PG8_SB(b, h) + boff + n * 2048 + k * 1024); } while (0)
#define PG8_MMA(ai, bj, At, Bt) do { __builtin_amdgcn_s_setprio(1); _Pragma("unroll") for (int m = 0; m < 4; ++m) _Pragma("unroll") for (int n = 0; n < 2; ++n) _Pragma("unroll") for (int k = 0; k < 2; ++k) \
        acc[ai][bj][m][n] = __builtin_amdgcn_mfma_f32_16x16x32_bf16(Bt[n][k], At[m][k], acc[ai][bj][m][n], 0, 0, 0); __builtin_amdgcn_s_setprio(0); } while (0)
#define PG8_WAIT_V(n) asm volatile("s_waitcnt vmcnt(" #n ")" ::: "memory")
#define PG8_WAIT_L(n) asm volatile("s_waitcnt lgkmcnt(" #n ")" ::: "memory")
#define PG8_BAR __builtin_amdgcn_s_barrier()
#define PG8_SCHED __builtin_amdgcn_sched_barrier(0)
    Unit cur, nxt; int ui = 0;
    if (!S.next(0, cur)) return;
    f32x4 acc[2][2][4][2];
#pragma unroll
    for (int a = 0; a < 2; ++a)
#pragma unroll
        for (int b = 0; b < 2; ++b)
#pragma unroll
            for (int m = 0; m < 4; ++m)
#pragma unroll
                for (int n = 0; n < 2; ++n) acc[a][b][m][n] = (f32x4){0.f, 0.f, 0.f, 0.f};
    bf16x8 At[4][2], B0[2][2], B1[2][2];
    const char* cA = (const char*)g.A + (size_t)cur.pm * tstep; const char* cB = (const char*)g.Bt + (size_t)cur.pn * tstep;
    S.a_ready(cur);
    if constexpr (SP2) {
        PG8_STAGE(PG8_SB(0, 0), cB, voffB); PG8_STAGE(PG8_SB(0, 1), cB + hstep, voffB); PG8_STAGE(PG8_SA(0, 0), cA, voffA); PG8_STAGE(PG8_SA(0, 1), cA + hstep, voffA);
        if (wr == 1) PG8_BAR;
        PG8_WAIT_V(2); PG8_BAR;
        PG8_STAGE(PG8_SB(1, 0), cB + kstep, voffB); PG8_STAGE(PG8_SA(1, 0), cA + kstep, voffA); PG8_STAGE(PG8_SB(1, 1), cB + hstep + kstep, voffB);
        PG8_WAIT_V(6); PG8_BAR;
    } else {
        PG8_STAGE(PG8_SB(0, 0), cB, voffB); PG8_STAGE(PG8_SA(0, 0), cA, voffA); PG8_STAGE(PG8_SB(0, 1), cB + hstep, voffB); PG8_STAGE(PG8_SA(0, 1), cA + hstep, voffA);
        if (wr == 1) PG8_BAR;
        PG8_WAIT_V(4); PG8_BAR;
        PG8_STAGE(PG8_SB(1, 0), cB + kstep, voffB); PG8_STAGE(PG8_SA(1, 0), cA + kstep, voffA); PG8_STAGE(PG8_SB(1, 1), cB + hstep + kstep, voffB);
        PG8_WAIT_V(6); PG8_BAR;
    }
    for (;;) {
        const bool has_next = S.next(ui + 1, nxt);
        const char* nA = has_next ? (const char*)g.A + (size_t)nxt.pm * tstep : cA; const char* nB = has_next ? (const char*)g.Bt + (size_t)nxt.pn * tstep : cB;
        for (int t = 0; t < nt; t += 2) {
            const bool last = (t == nt - 2);
            const char* a1 = cA + (size_t)(t + 1) * kstep;
            const char* a2 = last ? nA : cA + (size_t)(t + 2) * kstep; const char* b2 = last ? nB : cB + (size_t)(t + 2) * kstep;
            const char* a3 = a2 + kstep; const char* b3 = b2 + kstep;
            if (last && has_next) S.a_ready(nxt);
            if constexpr (SP2) {
            PG8_LDB(B0, 0, 0); PG8_LDB(B1, 0, 1); PG8_SCHED; PG8_LDA(At, 0, 0); PG8_STAGE(PG8_SA(1, 1), a1 + hstep, voffA);
            PG8_WAIT_V(8); PG8_WAIT_L(0); PG8_BAR; PG8_MMA(0, 0, At, B0); PG8_MMA(0, 1, At, B1); PG8_BAR; PG8_SCHED;
            PG8_LDA(At, 0, 1); PG8_STAGE(PG8_SB(0, 0), b2, voffB); PG8_STAGE(PG8_SB(0, 1), b2 + hstep, voffB); PG8_STAGE(PG8_SA(0, 0), a2, voffA);
            PG8_WAIT_V(8); PG8_WAIT_L(0); PG8_BAR; PG8_MMA(1, 0, At, B0); PG8_MMA(1, 1, At, B1); PG8_BAR; PG8_SCHED;
            PG8_LDB(B0, 1, 0); PG8_LDB(B1, 1, 1); PG8_SCHED; PG8_LDA(At, 1, 0); PG8_STAGE(PG8_SA(0, 1), a2 + hstep, voffA);
            PG8_WAIT_V(8); PG8_WAIT_L(0); PG8_BAR; PG8_MMA(0, 0, At, B0); PG8_MMA(0, 1, At, B1); PG8_BAR; PG8_SCHED;
            PG8_LDA(At, 1, 1); PG8_STAGE(PG8_SB(1, 0), b3, voffB); PG8_STAGE(PG8_SB(1, 1), b3 + hstep, voffB); PG8_STAGE(PG8_SA(1, 0), a3, voffA);
            PG8_WAIT_V(8); PG8_WAIT_L(0); PG8_BAR; PG8_MMA(1, 0, At, B0); PG8_MMA(1, 1, At, B1); PG8_BAR; PG8_SCHED;
            } else {
            PG8_LDB(B0, 0, 0); PG8_SCHED; PG8_LDA(At, 0, 0); PG8_STAGE(PG8_SA(1, 1), a1 + hstep, voffA);
            PG8_WAIT_L(8); PG8_BAR; PG8_WAIT_L(0); PG8_MMA(0, 0, At, B0); PG8_BAR; PG8_SCHED;
            PG8_LDB(B1, 0, 1); PG8_STAGE(PG8_SB(0, 0), b2, voffB);
            PG8_BAR; PG8_WAIT_L(0); PG8_MMA(0, 1, At, B1); PG8_BAR;
            PG8_LDA(At, 0, 1); PG8_STAGE(PG8_SA(0, 0), a2, voffA);
            PG8_BAR; PG8_WAIT_L(0); PG8_MMA(1, 0, At, B0); PG8_BAR; PG8_SCHED;
            PG8_STAGE(PG8_SB(0, 1), b2 + hstep, voffB);
            PG8_WAIT_V(6); PG8_BAR; PG8_MMA(1, 1, At, B1); PG8_BAR;
            PG8_LDB(B0, 1, 0); PG8_SCHED; PG8_LDA(At, 1, 0); PG8_STAGE(PG8_SA(0, 1), a2 + hstep, voffA);
            PG8_WAIT_L(8); PG8_BAR; PG8_WAIT_L(0); PG8_MMA(0, 0, At, B0); PG8_BAR; PG8_SCHED;
            PG8_LDB(B1, 1, 1); PG8_STAGE(PG8_SB(1, 0), b3, voffB);
            PG8_BAR; PG8_WAIT_L(0); PG8_MMA(0, 1, At, B1); PG8_BAR;
            PG8_LDA(At, 1, 1); PG8_STAGE(PG8_SA(1, 0), a3, voffA);
            PG8_BAR; PG8_WAIT_L(0); PG8_MMA(1, 0, At, B0); PG8_BAR; PG8_SCHED;
            PG8_STAGE(PG8_SB(1, 1), b3 + hstep, voffB);
            PG8_WAIT_V(6); PG8_BAR; PG8_MMA(1, 1, At, B1); PG8_BAR;
            }
        }
        if constexpr (ALIGN_EPI) { if (wr == 0) PG8_BAR; }
        if constexpr (!Epi::AFTER_DRAIN) { E(acc, cur, wr, wc, fr, fq); S.done(cur); }
        if (!has_next) break;
#pragma unroll
        for (int a = 0; a < 2; ++a)
#pragma unroll
            for (int b = 0; b < 2; ++b)
#pragma unroll
                for (int m = 0; m < 4; ++m)
#pragma unroll
                    for (int n = 0; n < 2; ++n) acc[a][b][m][n] = (f32x4){0.f, 0.f, 0.f, 0.f};
        cur = nxt; cA = nA; cB = nB; ++ui;
        if constexpr (ALIGN_EPI) { if (wr == 1) PG8_BAR; }
    }
    PG8_WAIT_V(0);
    if constexpr (!ALIGN_EPI) { if (wr == 0) PG8_BAR; }
    PG8_BAR;
    if constexpr (Epi::AFTER_DRAIN) { E.fused(acc, cur, wr, wc, fr, fq, lds, wid, lane); S.done(cur); }
#undef PG8_SA
#undef PG8_SB
#undef PG8_STAGE
#undef PG8_LDA
#undef PG8_LDB
#undef PG8_MMA
#undef PG8_WAIT_V
#undef PG8_WAIT_L
#undef PG8_BAR
#undef PG8_SCHED
}
}

constexpr int BATCH = 8, SEQ = 2048, DM = 1024, DEPTH = 4, M = BATCH * SEQ, DIN = 2372, DINP = 2560, DFF = 4096;
constexpr int NWAVES = 8, NTHR = NWAVES * 64;
constexpr int TOPK = 256;
constexpr int PC_POOL = 0, PC_HQ = 256, PC_HF = 512, PC_HI = 768, PC_HG = 1024, PC_Q = 1280, PC_K = 1792, PC_V = 1920, PROJ_LD = 2048;
constexpr int MC_POOL = 0, MC_HGRN = 256, MC_ATTN = 512;

constexpr size_t MiB = 1u << 20;
constexpr size_t WS_CTL = 0, CTL_ZERO_BYTES = 1 * MiB;
constexpr size_t WS_ROPE = 1 * MiB;
constexpr size_t WS_SSQ = 2 * MiB;
constexpr size_t WS_LB = 3 * MiB;
constexpr size_t WS_MASK = 4 * MiB;
constexpr size_t WS_WIN = 8 * MiB;
constexpr size_t WS_WOUT = 13 * MiB;
constexpr size_t WS_WFI = 15 * MiB;
constexpr size_t WS_WFO = 23 * MiB;
constexpr size_t WS_XB = 32 * MiB;
constexpr size_t WS_HID = 64 * MiB;
constexpr size_t WS_PROJ = 64 * MiB;
constexpr size_t WS_MIXED = 128 * MiB;
constexpr size_t WS_HST = 160 * MiB;
constexpr size_t WS_HDN = 176 * MiB;
constexpr size_t WS_QIHL = 192 * MiB;
constexpr size_t WS_KIHL = 208 * MiB;
constexpr size_t WS_WI = 212 * MiB;
constexpr size_t WS_VT = 224 * MiB;
constexpr size_t WS_END = 256 * MiB;
constexpr int CW_TMO = 0, CW_BAR = 4096;

constexpr int RING_OFF = 0, RING_BYTES = 131072;
constexpr int LDS_BYTES = 147456;
constexpr int LDSCTL_OFF = LDS_BYTES - 1024, MISC_OFF = LDSCTL_OFF + 320;

#define GAS __attribute__((address_space(1)))
#define LAS __attribute__((address_space(3)))
typedef unsigned short bf16;
typedef unsigned v4u __attribute__((ext_vector_type(4)));
typedef unsigned v2u __attribute__((ext_vector_type(2)));
typedef float f32x4 __attribute__((ext_vector_type(4)));
typedef GAS unsigned gu32;
#define RLX_AGENT __ATOMIC_RELAXED, __HIP_MEMORY_SCOPE_AGENT
#define LDS_WAIT() asm volatile("s_waitcnt lgkmcnt(0)" ::: "memory")
__device__ __forceinline__ unsigned f2bf(float f) { unsigned u = __builtin_bit_cast(unsigned, f); return (u + 0x7fffu + ((u >> 16) & 1u)) >> 16; }
__device__ __forceinline__ unsigned pk2(float lo, float hi) { return f2bf(lo) | (f2bf(hi) << 16); }
__device__ __forceinline__ float bf2f(unsigned short h) { return __builtin_bit_cast(float, (unsigned)h << 16); }
__device__ __forceinline__ float wave_sum(float v) {
#pragma unroll
    for (int o = 1; o < 64; o <<= 1) v += __shfl_xor(v, o);
    return v;
}
__device__ __forceinline__ float wave_max(float v) {
#pragma unroll
    for (int o = 1; o < 64; o <<= 1) v = fmaxf(v, __shfl_xor(v, o));
    return v;
}
#define XB_TMO      128
#define XB_XCNT(j)  (256  + 64 * (j))
#define XB_XSUB(j)  (1280 + 64 * (j))
#define XB_XGEN(j)  (2304 + 64 * (j))
#define XB_TOP      3328
#define XB_TOPGEN   3392
#define XCD_BAR_WORDS 3456
#define XB_SPIN_CAP (1u << 18)

__device__ __forceinline__ unsigned xb_ld(unsigned* p)              { return __hip_atomic_load(p, __ATOMIC_RELAXED, __HIP_MEMORY_SCOPE_AGENT); }
__device__ __forceinline__ unsigned xb_add(unsigned* p, unsigned v) { return __hip_atomic_fetch_add(p, v, __ATOMIC_RELAXED, __HIP_MEMORY_SCOPE_AGENT); }
__device__ __forceinline__ unsigned xb_xcc_id() { return (unsigned)__builtin_amdgcn_s_getreg((3 << 11) | 20) & 0xFu; }
#define XB_SPIN(cond, bar) do { unsigned _sp = 0; while (cond) { __builtin_amdgcn_s_sleep(1); \
    if ((++_sp & 255u) == 0u) { if (xb_ld(&(bar)[XB_TMO])) break; if (_sp > XB_SPIN_CAP) { atomicAdd(&(bar)[XB_TMO], 1u); break; } } } } while (0)

struct XcdBarrier {
    unsigned* bar; unsigned x;
    volatile LAS unsigned* st;
};

__device__ __forceinline__ XcdBarrier xcd_barrier_post(unsigned* bar, volatile LAS unsigned* st) {
    XcdBarrier b; b.bar = bar; b.x = xb_xcc_id(); b.st = st;
    if (threadIdx.x == 0) (void)xb_add(&bar[XB_XCNT(b.x)], 1u);
    return b;
}
__device__ __forceinline__ void xcd_barrier_complete(unsigned* bar, unsigned x, unsigned& nloc, unsigned& nx) {
    const unsigned G = gridDim.x * gridDim.y * gridDim.z;
    unsigned sum, cnt, mine, sp = 0u;
    for (;;) {
        sum = 0u; cnt = 0u; mine = 0u;
#pragma unroll
        for (unsigned j = 0; j < 16; ++j) { const unsigned c = xb_ld(&bar[XB_XCNT(j)]); sum += c; cnt += (c > 0u) ? 1u : 0u; mine = (j == x) ? c : mine; }
        if (sum == G) break;
        __builtin_amdgcn_s_sleep(1);
        if ((++sp & 255u) == 0u) { if (xb_ld(&bar[XB_TMO])) break; if (sp > XB_SPIN_CAP) { atomicAdd(&bar[XB_TMO], 1u); break; } }
    }
    nloc = mine > 0u ? mine : 1u; nx = cnt > 0u ? cnt : 1u;
}

__device__ __forceinline__ void xcd_barrier(const XcdBarrier& b) {
    asm volatile("s_waitcnt vmcnt(0)" ::: "memory");
    __syncthreads();
    if (threadIdx.x == 0) {
        unsigned* bar = b.bar;
        __builtin_amdgcn_s_waitcnt(0);
        unsigned nloc = b.st[0], nx = b.st[1];
        if (nloc == 0u) { xcd_barrier_complete(bar, b.x, nloc, nx); b.st[0] = nloc; b.st[1] = nx; }
        const unsigned old = xb_add(&bar[XB_XSUB(b.x)], 1u);
        const unsigned gen = old / nloc;
        if (old + 1u == (gen + 1u) * nloc) {
            __builtin_amdgcn_fence(__ATOMIC_RELEASE, "agent");
            asm volatile("s_waitcnt vmcnt(0)" ::: "memory");
            const unsigned og = xb_add(&bar[XB_TOP], 1u);
            const unsigned tg = og / nx;
            if (og + 1u == (tg + 1u) * nx) xb_add(&bar[XB_TOPGEN], 1u);
            else XB_SPIN(xb_ld(&bar[XB_TOPGEN]) == tg, bar);
            __builtin_amdgcn_fence(__ATOMIC_ACQUIRE, "agent");
            xb_add(&bar[XB_XGEN(b.x)], 1u);
            asm volatile("s_waitcnt vmcnt(0)" ::: "memory");
        } else {
            XB_SPIN(xb_ld(&bar[XB_XGEN(b.x)]) == gen, bar);
            __builtin_amdgcn_fence(__ATOMIC_ACQUIRE, "agent");
            asm volatile("s_waitcnt vmcnt(0)" ::: "memory");
        }
    }
    __syncthreads();
}


struct Frame {
    LAS unsigned char* lds;
    volatile LAS unsigned* MISC;
    gu32* ctl;
    int tid, lane, wave, G, bid;
    const float* x_in; const int* pos;
    const float *n1g, *w_in, *pool_w, *pool_scale, *lb_logits, *hgrn_g, *w_out, *n2g, *w_ff_in, *w_ff_out, *fng;
    float* xres;
    unsigned char* ws;
};
__constant__ float c_invf[8] = {1.0f, 0.19392274474868576f, 0.03760603093086393f, 0.007292664737217109f, 0.001414213562373095f, 0.0002742481756762073f, 5.318295896944988e-05f, 1.031338537721246e-05f};

typedef float f32x16 __attribute__((ext_vector_type(16)));
typedef short bf16x8v __attribute__((ext_vector_type(8)));
typedef float f32x2v __attribute__((ext_vector_type(2))); typedef __bf16 bf16x2v __attribute__((ext_vector_type(2)));
__device__ __forceinline__ unsigned cvtpk(float lo, float hi) { f32x2v v = {lo, hi}; bf16x2v b = __builtin_convertvector(v, bf16x2v); return __builtin_bit_cast(unsigned, b); }

__device__ __forceinline__ void cvt_item(const GAS float* W, const GAS float* g, int K, int N, bf16* WT, LAS float* scr, int kb, int nb, int lane) {
    const int k0 = 64 * kb, n0 = 32 * nb;
    const int n = n0 + (lane & 31);
    float v[32];
#pragma unroll
    for (int i = 0; i < 32; ++i) { const int kk = 2 * i + (lane >> 5); v[i] = (n < N) ? W[(size_t)(k0 + kk) * N + n] : 0.f; }
    const int c = lane & 7;
    f32x4 g0 = {1.f, 1.f, 1.f, 1.f}, g1 = g0;
    if (g) { g0 = *(const GAS f32x4*)(g + k0 + 8 * c); g1 = *(const GAS f32x4*)(g + k0 + 8 * c + 4); }
    __builtin_amdgcn_sched_barrier(0);
#pragma unroll
    for (int i = 0; i < 32; ++i) { const int kk = 2 * i + (lane >> 5); scr[kk * 33 + (lane & 31)] = v[i]; }
    LDS_WAIT(); asm volatile("" ::: "memory");
#pragma unroll
    for (int j = 0; j < 4; ++j) { const int nl = (lane >> 3) + 8 * j; const LAS float* sp = scr + (8 * c) * 33 + nl;
        v4u o; o.x = pk2(sp[0 * 33] * g0[0], sp[1 * 33] * g0[1]); o.y = pk2(sp[2 * 33] * g0[2], sp[3 * 33] * g0[3]); o.z = pk2(sp[4 * 33] * g1[0], sp[5 * 33] * g1[1]); o.w = pk2(sp[6 * 33] * g1[2], sp[7 * 33] * g1[3]);
        *(GAS v4u*)(WT + (size_t)(n0 + nl) * K + k0 + 8 * c) = o; }
    LDS_WAIT(); asm volatile("" ::: "memory");
}
__device__ __forceinline__ void cvt_matrix(Frame& F, const float* W_, const float* g_, int K, int N, int Npad, bf16* WT) {
    const GAS float* W = (const GAS float*)W_; const GAS float* g = (const GAS float*)g_;
    LAS float* scr = (LAS float*)(F.lds + RING_OFF + F.wave * 16384);
    const int gw = F.bid * NWAVES + F.wave, NGW = F.G * NWAVES;
    const int nblk = Npad / 32, nitems = (K / 64) * nblk;
    for (int it = gw; it < nitems; it += NGW) cvt_item(W, g, K, N, WT, scr, it / nblk, it % nblk, F.lane);
}
__device__ __forceinline__ void cvt_layer_rest(Frame& F, int layer) {
    cvt_matrix(F, F.w_out + (size_t)layer * DM * DM, nullptr, DM, DM, DM, (bf16*)(F.ws + WS_WOUT));
    cvt_matrix(F, F.w_ff_in + (size_t)layer * DM * DFF, F.n2g + layer * DM, DM, DFF, DFF, (bf16*)(F.ws + WS_WFI));
    cvt_matrix(F, F.w_ff_out + (size_t)layer * DFF * DM, nullptr, DFF, DM, DM, (bf16*)(F.ws + WS_WFO));
    if (layer + 1 < DEPTH) cvt_matrix(F, F.w_in + (size_t)(layer + 1) * DM * DIN, F.n1g + (layer + 1) * DM, DM, DIN, DINP, (bf16*)(F.ws + WS_WIN));
}

__device__ __forceinline__ void p_prologue(Frame& F) {
    const int gtid = F.bid * NTHR + F.tid, NT = F.G * NTHR;
    GAS float* tab = (GAS float*)(F.ws + WS_ROPE);
    for (int idx = gtid; idx < M * 8; idx += NT) {
        const int row = idx >> 3, i = idx & 7;
        const float angf = (float)((const GAS int*)F.pos)[row] * c_invf[i];
        double r = (double)angf * 0.15915494309189535; r -= floor(r);
        const float a = (float)(r * 6.283185307179586);
        tab[row * 16 + i] = cosf(a); tab[row * 16 + 8 + i] = sinf(a);
    }
    if (gtid < 256) {
        const int c = gtid; GAS float* lb = (GAS float*)(F.ws + WS_LB); const GAS float* lbl = (const GAS float*)F.lb_logits;
        const float l0 = lbl[c], l1 = lbl[256 + c], l2 = lbl[512 + c], l3 = lbl[768 + c];
        const float mx = fmaxf(fmaxf(l0, l1), fmaxf(l2, l3));
        const float e0 = expf(l0 - mx), e1 = expf(l1 - mx), e2 = expf(l2 - mx), e3 = expf(l3 - mx);
        const float inv = 1.0f / (e0 + e1 + e2 + e3);
        lb[c] = 0.f; lb[256 + c] = e1 * inv; lb[512 + c] = (e1 + e2) * inv; lb[768 + c] = (e1 + e2 + e3) * inv;
    }
    const int gw = F.bid * NWAVES + F.wave, NGW = F.G * NWAVES;
    GAS bf16* xb = (GAS bf16*)(F.ws + WS_XB); GAS float* ssq = (GAS float*)(F.ws + WS_SSQ);
    for (int row = gw; row < M; row += NGW) {
        const GAS f32x4* xr = (const GAS f32x4*)(F.x_in + (size_t)row * DM) + F.lane;
        f32x4 v[4]; float s = 0.f;
#pragma unroll
        for (int j = 0; j < 4; ++j) { v[j] = xr[64 * j]; s += (v[j][0] * v[j][0] + v[j][1] * v[j][1]) + (v[j][2] * v[j][2] + v[j][3] * v[j][3]); }
        s = wave_sum(s);
        GAS unsigned long long* o8 = (GAS unsigned long long*)(xb + (size_t)row * DM) + F.lane;
#pragma unroll
        for (int j = 0; j < 4; ++j) o8[64 * j] = (unsigned long long)pk2(v[j][0], v[j][1]) | ((unsigned long long)pk2(v[j][2], v[j][3]) << 32);
        if (F.lane < 16) ssq[(size_t)row * 16 + F.lane] = (F.lane == 0) ? s : 0.f;
    }
    cvt_matrix(F, F.w_in, F.n1g, DM, DIN, DINP, (bf16*)(F.ws + WS_WIN));
}

constexpr int PL_WROW = 72, PL_PROW = 264, PL_WT_BYTES = 4 * 64 * PL_WROW * 2, PL_P_OFF = PL_WT_BYTES;
template <int WIN> __device__ __forceinline__ void pool_core(const GAS bf16* up, int tl0, LAS unsigned short* Pc) {
    float ps[49]; ps[0] = 0.f;
    float uv[48];
#pragma unroll
    for (int i = 0; i < 48; ++i) { const int tl = tl0 - 16 + i; uv[i] = (tl >= 0) ? bf2f(up[(long)(i - 16) * PROJ_LD]) : 0.f; }
    __builtin_amdgcn_sched_barrier(0);
#pragma unroll
    for (int i = 0; i < 48; ++i) ps[i + 1] = ps[i] + uv[i];
#pragma unroll
    for (int i = 16; i < 48; ++i) {
        const int tl = tl0 - 16 + i; const int cnt = (tl + 1 < WIN) ? tl + 1 : WIN;
        const float mean = (ps[i + 1] - ps[i + 1 - WIN]) / (float)cnt;
        Pc[(i - 16) * PL_PROW] = (unsigned short)f2bf(mean - uv[i]);
    }
}
__device__ __forceinline__ void p_pool(Frame& F, int layer) {
    LAS unsigned short* WT = (LAS unsigned short*)(F.lds + RING_OFF);
    LAS unsigned short* P = (LAS unsigned short*)(F.lds + RING_OFF + PL_P_OFF);
    const GAS bf16* proj = (const GAS bf16*)(F.ws + WS_PROJ); GAS bf16* mixed = (GAS bf16*)(F.ws + WS_MIXED);
    const GAS float* pw = (const GAS float*)F.pool_w + (size_t)layer * 4 * 64 * 64; const GAS float* ps_ = (const GAS float*)F.pool_scale + layer * 256;
    const int tid = F.tid, lane = F.lane, wave = F.wave;
#pragma unroll 8
    for (int i = 0; i < 32; ++i) { const int e = i * NTHR + tid; const int g = e >> 12, c = (e >> 6) & 63, d = e & 63; WT[(g * 64 + d) * PL_WROW + c] = (unsigned short)f2bf(pw[e]); }
    const int c = tid & 255, hf = tid >> 8, g = wave & 3;
    for (int unit = F.bid; unit < M / 64; unit += F.G) {
        const int t0 = unit * 64 + 32 * hf;
        { const GAS bf16* up = proj + (size_t)t0 * PROJ_LD + PC_POOL + c; LAS unsigned short* Pc = P + (32 * hf) * PL_PROW + c; const int tl0 = t0 & (SEQ - 1);
          if (g == 0) pool_core<2>(up, tl0, Pc); else if (g == 1) pool_core<4>(up, tl0, Pc); else if (g == 2) pool_core<8>(up, tl0, Pc); else pool_core<16>(up, tl0, Pc); }
        __syncthreads();
        { const int th = wave >> 2, fr = lane & 15, kg = lane >> 4;
#pragma unroll
          for (int tb = 0; tb < 2; ++tb) {
              bf16x8v af[2];
#pragma unroll
              for (int ks = 0; ks < 2; ++ks) af[ks] = *(const LAS bf16x8v*)(P + (32 * th + 16 * tb + fr) * PL_PROW + g * 64 + 32 * ks + 8 * kg);
#pragma unroll
              for (int db = 0; db < 4; ++db) {
                  f32x4 acc = {0.f, 0.f, 0.f, 0.f};
#pragma unroll
                  for (int ks = 0; ks < 2; ++ks) { const bf16x8v bfr = *(const LAS bf16x8v*)(WT + (g * 64 + 16 * db + fr) * PL_WROW + 32 * ks + 8 * kg);
                      acc = __builtin_amdgcn_mfma_f32_16x16x32_bf16(af[ks], bfr, acc, 0, 0, 0); }
                  const int dcol = g * 64 + 16 * db + fr; const float sc = ps_[dcol];
                  GAS bf16* op = mixed + (size_t)(unit * 64 + 32 * th + 16 * tb + 4 * kg) * DM + MC_POOL + dcol;
#pragma unroll
                  for (int r = 0; r < 4; ++r) op[(size_t)r * DM] = (bf16)f2bf(acc[r] * sc);
              }
          } }
        __syncthreads();
    }
}

__device__ __forceinline__ unsigned sort_key(float v) { if (v == 0.f) v = 0.f; const unsigned u = __builtin_bit_cast(unsigned, v); return (u & 0x80000000u) ? ~u : (u | 0x80000000u); }
constexpr int MK_STRIDE = 2049;
__device__ __forceinline__ void p_mask(Frame& F) {
    LAS unsigned* keys = (LAS unsigned*)(F.lds + RING_OFF);
    const GAS bf16* qi_hl = (const GAS bf16*)(F.ws + WS_QIHL); const GAS bf16* ki_hl = (const GAS bf16*)(F.ws + WS_KIHL); const GAS float* wi = (const GAS float*)(F.ws + WS_WI); GAS unsigned* mask = (GAS unsigned*)(F.ws + WS_MASK);
    const int tid = F.tid, lane = F.lane, wave = F.wave, q = lane & 15, kg = lane >> 4;
    for (int c = F.bid; c < 256; c += F.G) {
        for (int ui = 0; ui < 4; ++ui) {
            const int b = (c >> 6) * 2 + (ui >> 1), bq = c & 63, qb = (ui & 1) ? 127 - bq : bq;
            const int t0 = qb * 16; const size_t rowq0 = (size_t)b * SEQ + t0;
            if (qb < 16) {
                for (int w = tid; w < 1024; w += NTHR) { const int qq = w >> 6, j = w & 63, n = t0 + qq + 1, lo = j * 32;
                    mask[(rowq0 + qq) * 64 + j] = (n >= lo + 32) ? 0xffffffffu : (n > lo ? ((1u << (n - lo)) - 1u) : 0u); }
                continue;
            }
            bf16x8v bh[4][2], bl[4][2];
#pragma unroll
            for (int h = 0; h < 4; ++h)
#pragma unroll
                for (int dh = 0; dh < 2; ++dh) { const GAS bf16* pq = qi_hl + (rowq0 + q) * 512 + h * 64 + dh * 32 + kg * 8;
                    bh[h][dh] = *(const GAS bf16x8v*)pq; bl[h][dh] = *(const GAS bf16x8v*)(pq + 256); }
            const f32x4 wv = *(const GAS f32x4*)(wi + (rowq0 + q) * 4);
            const int ntile = qb + 1;
            bf16x8v ah[2], al[2];
            { const int kt0 = wave < ntile ? wave : 0;
#pragma unroll
              for (int dh = 0; dh < 2; ++dh) { const GAS bf16* pk = ki_hl + ((size_t)b * SEQ + kt0 * 16 + q) * 128 + dh * 32 + kg * 8;
                  ah[dh] = *(const GAS bf16x8v*)pk; al[dh] = *(const GAS bf16x8v*)(pk + 64); } }
            for (int kt = wave; kt < ntile; kt += NWAVES) {
                const int s0 = kt * 16;
                bf16x8v ahn[2], aln[2];
                { const int ktn = (kt + NWAVES < ntile) ? kt + NWAVES : kt;
#pragma unroll
                  for (int dh = 0; dh < 2; ++dh) { const GAS bf16* pk = ki_hl + ((size_t)b * SEQ + ktn * 16 + q) * 128 + dh * 32 + kg * 8;
                      ahn[dh] = *(const GAS bf16x8v*)pk; aln[dh] = *(const GAS bf16x8v*)(pk + 64); } }
                __builtin_amdgcn_sched_barrier(0);
                f32x4 acc[4];
#pragma unroll
                for (int h = 0; h < 4; ++h) { acc[h] = (f32x4){0.f, 0.f, 0.f, 0.f};
#pragma unroll
                    for (int dh = 0; dh < 2; ++dh) {
                        acc[h] = __builtin_amdgcn_mfma_f32_16x16x32_bf16(ah[dh], bh[h][dh], acc[h], 0, 0, 0);
                        acc[h] = __builtin_amdgcn_mfma_f32_16x16x32_bf16(ah[dh], bl[h][dh], acc[h], 0, 0, 0);
                        acc[h] = __builtin_amdgcn_mfma_f32_16x16x32_bf16(al[dh], bh[h][dh], acc[h], 0, 0, 0);
                    } }
#pragma unroll
                for (int r = 0; r < 4; ++r) {
                    const float I = wv[0] * fmaxf(acc[0][r], 0.f) + wv[1] * fmaxf(acc[1][r], 0.f) + wv[2] * fmaxf(acc[2][r], 0.f) + wv[3] * fmaxf(acc[3][r], 0.f);
                    const int s = s0 + 4 * kg + r;
                    keys[q * MK_STRIDE + s] = (s <= t0 + q) ? sort_key(I) : 0u;
                }
                __builtin_amdgcn_sched_barrier(0);
#pragma unroll
                for (int dh = 0; dh < 2; ++dh) { ah[dh] = ahn[dh]; al[dh] = aln[dh]; }
            }
            __syncthreads();
            const int nk = t0 + 16;
            for (int qq = 2 * wave; qq < 2 * wave + 2; ++qq) {
                unsigned k[32];
#pragma unroll
                for (int i = 0; i < 32; ++i) { const int s = lane + 64 * i; k[i] = (s < nk) ? keys[qq * MK_STRIDE + s] : 0u; }
                unsigned prefix = 0u; bool exact = false;
                for (int bit = 31; bit >= 0; --bit) {
                    const unsigned cand = prefix | (1u << bit);
                    unsigned cnt = 0u;
#pragma unroll
                    for (int i = 0; i < 32; ++i) cnt += (unsigned)__popcll(__ballot(k[i] >= cand));
                    if (cnt >= (unsigned)TOPK) { prefix = cand; if (cnt == (unsigned)TOPK) { exact = true; break; } }
                }
                GAS unsigned* mrow = mask + (rowq0 + qq) * 64;
                if (exact) {
#pragma unroll
                    for (int i = 0; i < 32; ++i) { const unsigned long long sb = __ballot(k[i] >= prefix); if (lane == 0) *(GAS v2u*)(mrow + 2 * i) = (v2u){(unsigned)sb, (unsigned)(sb >> 32)}; }
                } else {
                    const unsigned tau = prefix; unsigned cgt = 0u;
#pragma unroll
                    for (int i = 0; i < 32; ++i) cgt += (unsigned)__popcll(__ballot(k[i] > tau));
                    const unsigned need = (unsigned)TOPK - cgt; unsigned base = 0u;
#pragma unroll
                    for (int i = 0; i < 32; ++i) {
                        const unsigned long long eqb = __ballot(k[i] == tau);
                        const unsigned rank = base + (unsigned)__popcll(eqb & ((1ull << lane) - 1ull));
                        const unsigned long long sb = __ballot((k[i] > tau) || ((k[i] == tau) && (rank < need)));
                        if (lane == 0) *(GAS v2u*)(mrow + 2 * i) = (v2u){(unsigned)sb, (unsigned)(sb >> 32)};
                        base += (unsigned)__popcll(eqb);
                    }
                }
            }
            __syncthreads();
        }
    }
}

__device__ __forceinline__ void p_hgrn_local(Frame& F, int layer) {
    const int lane = F.lane;
    LAS float* Fs = (LAS float*)(F.lds + RING_OFF + F.wave * 16384); LAS float* Ks = Fs + 1024; LAS float* Is = Ks + 1024;
    const GAS bf16* proj = (const GAS bf16*)(F.ws + WS_PROJ); GAS float* hst = (GAS float*)(F.ws + WS_HST); GAS float* hdn = (GAS float*)(F.ws + WS_HDN);
    for (int unit = F.wave * F.G + F.bid; unit < BATCH * 4 * (SEQ / 64); unit += NWAVES * F.G) {
        const int bh = unit >> 5, chunk = unit & 31, b = bh >> 2, h = bh & 3;
        const float lbv = ((const GAS float*)(F.ws + WS_LB))[layer * 256 + h * 64 + lane];
        const size_t row0 = (size_t)b * SEQ + chunk * 64;
        float S[64]; float dprod = 1.0f;
#pragma unroll
        for (int k = 0; k < 64; ++k) S[k] = 0.f;
        for (int qt = 0; qt < 4; ++qt) {
#pragma unroll
            for (int tt = 0; tt < 16; ++tt) {
                const GAS bf16* pr = proj + (row0 + qt * 16 + tt) * PROJ_LD + h * 64 + lane;
                const float z = bf2f(pr[PC_HF]);
                const float sig = 1.0f / (1.0f + __expf(-z));
                const float f = fmaxf(lbv + (1.0f - lbv) * sig, 1e-30f);
                Fs[tt * 64 + lane] = f; Ks[tt * 64 + lane] = (1.0f - lbv) * (1.0f - sig); Is[tt * 64 + lane] = bf2f(pr[PC_HI]); dprod *= f;
            }
            LDS_WAIT(); asm volatile("" ::: "memory");
            f32x4 fa[8], ka[8], fb[8], kb[8];
#pragma unroll
            for (int i = 0; i < 8; ++i) { fa[i] = *(const LAS f32x4*)(Fs + 4 * i); ka[i] = *(const LAS f32x4*)(Ks + 4 * i); }
#pragma unroll 1
            for (int tt = 0; tt < 16; ++tt) {
                const float iv = Is[tt * 64 + lane];
#pragma unroll
                for (int i = 0; i < 8; ++i) { fb[i] = *(const LAS f32x4*)(Fs + tt * 64 + 32 + 4 * i); kb[i] = *(const LAS f32x4*)(Ks + tt * 64 + 32 + 4 * i); }
                __builtin_amdgcn_sched_barrier(0);
#pragma unroll
                for (int i = 0; i < 8; ++i)
#pragma unroll
                    for (int e = 0; e < 4; ++e) S[4 * i + e] = fa[i][e] * S[4 * i + e] + ka[i][e] * iv;
                __builtin_amdgcn_sched_barrier(0);
                const int tn = (tt + 1) & 15;
#pragma unroll
                for (int i = 0; i < 8; ++i) { fa[i] = *(const LAS f32x4*)(Fs + tn * 64 + 4 * i); ka[i] = *(const LAS f32x4*)(Ks + tn * 64 + 4 * i); }
                __builtin_amdgcn_sched_barrier(0);
#pragma unroll
                for (int i = 0; i < 8; ++i)
#pragma unroll
                    for (int e = 0; e < 4; ++e) S[32 + 4 * i + e] = fb[i][e] * S[32 + 4 * i + e] + kb[i][e] * iv;
                __builtin_amdgcn_sched_barrier(0);
            }
            LDS_WAIT(); asm volatile("" ::: "memory");
        }
        GAS float* U = hst + (size_t)unit * 4096 + lane;
#pragma unroll
        for (int k = 0; k < 64; ++k) U[k * 64] = S[k];
        hdn[unit * 64 + lane] = dprod;
    }
}
__device__ __forceinline__ void p_hgrn_scan(Frame& F) {
    GAS float* hst = (GAS float*)(F.ws + WS_HST); const GAS float* hdn = (const GAS float*)(F.ws + WS_HDN);
    for (int e = F.bid * NTHR + F.tid; e < BATCH * 4 * 4096; e += F.G * NTHR) {
        const int bh = e >> 12, kv = e & 4095, k = kv >> 6;
        float S = 0.f;
        for (int n = 0; n < SEQ / 64; ++n) {
            const size_t idx = ((size_t)(bh * 32 + n) << 12) + kv;
            const float u = hst[idx]; hst[idx] = S;
            S = hdn[(bh * 32 + n) * 64 + k] * S + u;
        }
    }
}
constexpr int HG_LDS_OFF = 40960;
__device__ __forceinline__ void p_hgrn_out(Frame& F, int layer) {
    const int lane = F.lane;
    LAS float* Fs = (LAS float*)(F.lds + RING_OFF + HG_LDS_OFF + F.wave * 20480); LAS float* Ks = Fs + 1024; LAS float* Qs = Ks + 1024; LAS float* Is = Qs + 1024; LAS float* Os = Is + 1024;
    const GAS bf16* proj = (const GAS bf16*)(F.ws + WS_PROJ); GAS bf16* mixed = (GAS bf16*)(F.ws + WS_MIXED); const GAS float* hst = (const GAS float*)(F.ws + WS_HST);
    for (int unit = F.wave * F.G + F.bid; unit < BATCH * 4 * (SEQ / 64); unit += NWAVES * F.G) {
        const int bh = unit >> 5, chunk = unit & 31, b = bh >> 2, h = bh & 3;
        const float lbv = ((const GAS float*)(F.ws + WS_LB))[layer * 256 + h * 64 + lane];
        const float ng = ((const GAS float*)F.hgrn_g)[layer * 256 + h * 64 + lane];
        const size_t row0 = (size_t)b * SEQ + chunk * 64;
        float S[64];
        { const GAS float* U = hst + (size_t)unit * 4096 + lane;
#pragma unroll
          for (int k = 0; k < 64; ++k) S[k] = U[k * 64]; }
        for (int qt = 0; qt < 4; ++qt) {
            float gv[16];
#pragma unroll
            for (int tt = 0; tt < 16; ++tt) {
                const GAS bf16* pr = proj + (row0 + qt * 16 + tt) * PROJ_LD + h * 64 + lane;
                const float z = bf2f(pr[PC_HF]), qr = bf2f(pr[PC_HQ]); gv[tt] = bf2f(pr[PC_HG]);
                const float sig = 1.0f / (1.0f + __expf(-z));
                Fs[tt * 64 + lane] = fmaxf(lbv + (1.0f - lbv) * sig, 1e-30f); Ks[tt * 64 + lane] = (1.0f - lbv) * (1.0f - sig); Qs[tt * 64 + lane] = qr / (1.0f + __expf(-qr));
                Is[tt * 64 + lane] = bf2f(pr[PC_HI]);
            }
            LDS_WAIT(); asm volatile("" ::: "memory");
            f32x4 fa[4], ka[4], qa[4], fb[4], kb[4], qb[4];
#pragma unroll
            for (int i = 0; i < 4; ++i) { fa[i] = *(const LAS f32x4*)(Fs + 4 * i); ka[i] = *(const LAS f32x4*)(Ks + 4 * i); qa[i] = *(const LAS f32x4*)(Qs + 4 * i); }
#pragma unroll 1
            for (int tt = 0; tt < 16; ++tt) {
                const float iv = Is[tt * 64 + lane];
                float o0 = 0.f, o1 = 0.f, o2 = 0.f, o3 = 0.f;
#pragma unroll
                for (int qk = 0; qk < 4; ++qk) {
                    const int nq = (qk + 1) & 3, nt = (qk == 3) ? ((tt + 1) & 15) : tt;
                    if ((qk & 1) == 0) {
#pragma unroll
                        for (int i = 0; i < 4; ++i) { fb[i] = *(const LAS f32x4*)(Fs + nt * 64 + nq * 16 + 4 * i); kb[i] = *(const LAS f32x4*)(Ks + nt * 64 + nq * 16 + 4 * i); qb[i] = *(const LAS f32x4*)(Qs + nt * 64 + nq * 16 + 4 * i); }
                        __builtin_amdgcn_sched_barrier(0);
#pragma unroll
                        for (int i = 0; i < 4; ++i) { const int k = qk * 16 + 4 * i;
                            S[k] = fa[i][0] * S[k] + ka[i][0] * iv; o0 += qa[i][0] * S[k];
                            S[k + 1] = fa[i][1] * S[k + 1] + ka[i][1] * iv; o1 += qa[i][1] * S[k + 1];
                            S[k + 2] = fa[i][2] * S[k + 2] + ka[i][2] * iv; o2 += qa[i][2] * S[k + 2];
                            S[k + 3] = fa[i][3] * S[k + 3] + ka[i][3] * iv; o3 += qa[i][3] * S[k + 3]; }
                        __builtin_amdgcn_sched_barrier(0);
                    } else {
#pragma unroll
                        for (int i = 0; i < 4; ++i) { fa[i] = *(const LAS f32x4*)(Fs + nt * 64 + nq * 16 + 4 * i); ka[i] = *(const LAS f32x4*)(Ks + nt * 64 + nq * 16 + 4 * i); qa[i] = *(const LAS f32x4*)(Qs + nt * 64 + nq * 16 + 4 * i); }
                        __builtin_amdgcn_sched_barrier(0);
#pragma unroll
                        for (int i = 0; i < 4; ++i) { const int k = qk * 16 + 4 * i;
                            S[k] = fb[i][0] * S[k] + kb[i][0] * iv; o0 += qb[i][0] * S[k];
                            S[k + 1] = fb[i][1] * S[k + 1] + kb[i][1] * iv; o1 += qb[i][1] * S[k + 1];
                            S[k + 2] = fb[i][2] * S[k + 2] + kb[i][2] * iv; o2 += qb[i][2] * S[k + 2];
                            S[k + 3] = fb[i][3] * S[k + 3] + kb[i][3] * iv; o3 += qb[i][3] * S[k + 3]; }
                        __builtin_amdgcn_sched_barrier(0);
                    }
                }
                Os[tt * 64 + lane] = (o0 + o1) + (o2 + o3);
            }
            LDS_WAIT(); asm volatile("" ::: "memory");
            float ov[16], ms[16];
#pragma unroll
            for (int tt = 0; tt < 16; ++tt) { ov[tt] = Os[tt * 64 + lane]; ms[tt] = ov[tt] * ov[tt]; }
#pragma unroll
            for (int o = 1; o < 64; o <<= 1)
#pragma unroll
                for (int tt = 0; tt < 16; ++tt) ms[tt] += __shfl_xor(ms[tt], o);
#pragma unroll
            for (int tt = 0; tt < 16; ++tt) {
                const float y = ov[tt] * (1.0f / sqrtf(ms[tt] * (1.0f / 64.0f) + 1e-5f)) * ng * (gv[tt] / (1.0f + __expf(-gv[tt])));
                mixed[(row0 + qt * 16 + tt) * DM + MC_HGRN + h * 64 + lane] = (bf16)f2bf(y);
            }
            LDS_WAIT(); asm volatile("" ::: "memory");
        }
    }
}

constexpr int AT_KROW = 144, AT_VROW = 136, AT_KBYTES = 64 * AT_KROW, AT_VBYTES = 64 * AT_VROW, AT_BUF = AT_KBYTES + AT_VBYTES, AT_SCR = 2 * AT_BUF;
static_assert(AT_BUF % 16 == 0 && AT_SCR % 16 == 0, "attention LDS map alignment");
__device__ __forceinline__ void p_attn_flash(Frame& F) {
    const int tid = F.tid, lane = F.lane, wave = F.wave;
    const int r = lane & 31, hh = lane >> 5, g = wave & 3, qh = wave >> 2;
    LAS unsigned char* L = F.lds + RING_OFF;
    LAS float* scr = (LAS float*)(L + AT_SCR) + wave * 32;
    const GAS bf16* proj = (const GAS bf16*)(F.ws + WS_PROJ); const GAS bf16* vT = (const GAS bf16*)(F.ws + WS_VT); GAS bf16* mixed = (GAS bf16*)(F.ws + WS_MIXED);
    const GAS unsigned* mask = (const GAS unsigned*)(F.ws + WS_MASK);
    const int srow = tid >> 3, sch = tid & 7;
    const float C2 = 0.18033688011112042f, NEG = -1.0e30f;
    for (int pair = F.bid; pair < 256; pair += F.G) {
        const int bk = pair >> 4, b = bk >> 1, kvh = bk & 1, pp = pair & 15, h = kvh * 4 + g;
        for (int half = 0; half < 2; ++half) {
            const int qblk = half == 0 ? 31 - pp : pp;
            const int q0 = qblk * 64, nt = qblk + 1;
            const int tq = q0 + 32 * qh + r;
            bf16x8v qf[4];
            { const GAS bf16* qp = proj + (size_t)(b * SEQ + tq) * PROJ_LD + PC_Q + h * 64 + 8 * hh;
#pragma unroll
              for (int d0 = 0; d0 < 4; ++d0) qf[d0] = *(const GAS bf16x8v*)(qp + 16 * d0); }
            const GAS unsigned* mrow = mask + (size_t)(b * SEQ + tq) * 64;
            const GAS bf16* kg = proj + (size_t)(b * SEQ + srow) * PROJ_LD + PC_K + kvh * 64 + sch * 8;
            const GAS bf16* vg = vT + (size_t)(bk * 64 + srow) * SEQ + sch * 8;
            { const v4u kreg = *(const GAS v4u*)kg; const v4u vreg = *(const GAS v4u*)vg;
              *(LAS v4u*)(L + srow * AT_KROW + sch * 16) = kreg;
              LAS unsigned char* vd = L + AT_KBYTES + srow * AT_VROW + sch * 16;
              *(LAS v2u*)vd = (v2u){vreg.x, vreg.y}; *(LAS v2u*)(vd + 8) = (v2u){vreg.z, vreg.w}; }
            v2u mw = *(const GAS v2u*)mrow;
            __syncthreads();
            f32x16 o0, o1;
#pragma unroll
            for (int i = 0; i < 16; ++i) { o0[i] = 0.f; o1[i] = 0.f; }
            float m = -30000.0f, l = 0.f;
            for (int j = 0; j < nt; ++j) {
                LAS unsigned char* Kb = L + (j & 1) * AT_BUF; LAS unsigned char* Vb = Kb + AT_KBYTES;
                const bool more = (j + 1 < nt);
                const int jn = more ? j + 1 : j;
                const v4u kn = *(const GAS v4u*)(kg + (size_t)jn * 64 * PROJ_LD); const v4u vn = *(const GAS v4u*)(vg + jn * 64); const v2u mwn = *(const GAS v2u*)(mrow + 2 * jn);
                bf16x8v kf[8];
#pragma unroll
                for (int d0 = 0; d0 < 4; ++d0) { kf[2 * d0] = *(const LAS bf16x8v*)(Kb + r * AT_KROW + d0 * 32 + hh * 16); kf[2 * d0 + 1] = *(const LAS bf16x8v*)(Kb + (32 + r) * AT_KROW + d0 * 32 + hh * 16); }
                __builtin_amdgcn_sched_barrier(0);
                f32x16 p0, p1;
#pragma unroll
                for (int i = 0; i < 16; ++i) { p0[i] = 0.f; p1[i] = 0.f; }
#pragma unroll
                for (int d0 = 0; d0 < 4; ++d0) {
                    p0 = __builtin_amdgcn_mfma_f32_32x32x16_bf16(kf[2 * d0], qf[d0], p0, 0, 0, 0);
                    p1 = __builtin_amdgcn_mfma_f32_32x32x16_bf16(kf[2 * d0 + 1], qf[d0], p1, 0, 0, 0);
                }
                v2u vl[8], vh[8];
#pragma unroll
                for (int ks = 0; ks < 4; ++ks) {
                    const LAS unsigned char* vp = Vb + r * AT_VROW + (16 * ks + 4 * hh) * 2;
                    vl[2 * ks] = *(const LAS v2u*)vp; vh[2 * ks] = *(const LAS v2u*)(vp + 16);
                    vl[2 * ks + 1] = *(const LAS v2u*)(vp + 32 * AT_VROW); vh[2 * ks + 1] = *(const LAS v2u*)(vp + 32 * AT_VROW + 16);
                }
                __builtin_amdgcn_sched_barrier(0);
                const unsigned w0 = mw.x >> (4 * hh), w1 = mw.y >> (4 * hh);
                float mx = NEG;
#pragma unroll
                for (int i = 0; i < 16; ++i) {
                    const int cr = (i & 3) + 8 * (i >> 2);
                    p0[i] = ((w0 >> cr) & 1u) ? p0[i] : NEG; p1[i] = ((w1 >> cr) & 1u) ? p1[i] : NEG;
                    mx = fmaxf(mx, fmaxf(p0[i], p1[i]));
                }
                mx = fmaxf(mx, __shfl_xor(mx, 32));
                const float mxs = mx * C2;
                const bool need = mxs > m + 8.0f;
                if (__any(need)) {
                    const float mnew = need ? mxs : m;
                    const float alpha = __builtin_amdgcn_exp2f(m - mnew); m = mnew; l *= alpha;
                    if (hh == 0) scr[r] = alpha;
#pragma unroll
                    for (int gq = 0; gq < 4; ++gq) {
                        const f32x4 a4 = *(const LAS f32x4*)(scr + 8 * gq + 4 * hh);
#pragma unroll
                        for (int e = 0; e < 4; ++e) { o0[4 * gq + e] *= a4[e]; o1[4 * gq + e] *= a4[e]; }
                    }
                }
                float rs = 0.f;
#pragma unroll
                for (int i = 0; i < 16; ++i) {
                    p0[i] = __builtin_amdgcn_exp2f(__builtin_fmaf(p0[i], C2, -m)); p1[i] = __builtin_amdgcn_exp2f(__builtin_fmaf(p1[i], C2, -m));
                    rs += p0[i] + p1[i];
                }
                l += rs;
                bf16x8v pf[4];
                { v4u t;
                  t.x = cvtpk(p0[0], p0[1]); t.y = cvtpk(p0[2], p0[3]); t.z = cvtpk(p0[4], p0[5]); t.w = cvtpk(p0[6], p0[7]); pf[0] = __builtin_bit_cast(bf16x8v, t);
                  t.x = cvtpk(p0[8], p0[9]); t.y = cvtpk(p0[10], p0[11]); t.z = cvtpk(p0[12], p0[13]); t.w = cvtpk(p0[14], p0[15]); pf[1] = __builtin_bit_cast(bf16x8v, t);
                  t.x = cvtpk(p1[0], p1[1]); t.y = cvtpk(p1[2], p1[3]); t.z = cvtpk(p1[4], p1[5]); t.w = cvtpk(p1[6], p1[7]); pf[2] = __builtin_bit_cast(bf16x8v, t);
                  t.x = cvtpk(p1[8], p1[9]); t.y = cvtpk(p1[10], p1[11]); t.z = cvtpk(p1[12], p1[13]); t.w = cvtpk(p1[14], p1[15]); pf[3] = __builtin_bit_cast(bf16x8v, t); }
                __builtin_amdgcn_sched_barrier(0);
#pragma unroll
                for (int ks = 0; ks < 4; ++ks) {
                    const bf16x8v vf0 = __builtin_bit_cast(bf16x8v, (v4u){vl[2 * ks].x, vl[2 * ks].y, vh[2 * ks].x, vh[2 * ks].y});
                    const bf16x8v vf1 = __builtin_bit_cast(bf16x8v, (v4u){vl[2 * ks + 1].x, vl[2 * ks + 1].y, vh[2 * ks + 1].x, vh[2 * ks + 1].y});
                    o0 = __builtin_amdgcn_mfma_f32_32x32x16_bf16(pf[ks], vf0, o0, 0, 0, 0);
                    o1 = __builtin_amdgcn_mfma_f32_32x32x16_bf16(pf[ks], vf1, o1, 0, 0, 0);
                }
                __builtin_amdgcn_sched_barrier(0);
                if (more) {
                    LAS unsigned char* Kn = L + ((j + 1) & 1) * AT_BUF;
                    *(LAS v4u*)(Kn + srow * AT_KROW + sch * 16) = kn;
                    LAS unsigned char* vd = Kn + AT_KBYTES + srow * AT_VROW + sch * 16;
                    *(LAS v2u*)vd = (v2u){vn.x, vn.y}; *(LAS v2u*)(vd + 8) = (v2u){vn.z, vn.w};
                }
                mw = mwn;
                __syncthreads();
            }
            l += __shfl_xor(l, 32);
            if (hh == 0) scr[r] = 1.0f / l;
            GAS bf16* op = mixed + (size_t)(b * SEQ + q0 + 32 * qh) * DM + MC_ATTN + h * 64 + r;
#pragma unroll
            for (int gq = 0; gq < 4; ++gq) {
                const f32x4 a4 = *(const LAS f32x4*)(scr + 8 * gq + 4 * hh);
#pragma unroll
                for (int e = 0; e < 4; ++e) {
                    const int q = 8 * gq + 4 * hh + e;
                    op[(size_t)q * DM] = (bf16)f2bf(o0[4 * gq + e] * a4[e]); op[(size_t)q * DM + 32] = (bf16)f2bf(o1[4 * gq + e] * a4[e]);
                }
            }
        }
    }
}

__device__ __forceinline__ void p_final(Frame& F) {
    const int gw = F.bid * NWAVES + F.wave, NGW = F.G * NWAVES;
    for (int row = gw; row < M; row += NGW) {
        GAS f32x4* xr = (GAS f32x4*)(F.xres + (size_t)row * DM) + F.lane;
        const GAS f32x4* gr = (const GAS f32x4*)F.fng + F.lane;
        f32x4 v[4]; float s = 0.f;
#pragma unroll
        for (int j = 0; j < 4; ++j) { v[j] = xr[64 * j]; s += (v[j][0] * v[j][0] + v[j][1] * v[j][1]) + (v[j][2] * v[j][2] + v[j][3] * v[j][3]); }
        s = wave_sum(s);
        const float rs = 1.0f / sqrtf(s * (1.0f / 1024.0f) + 1e-5f);
#pragma unroll
        for (int j = 0; j < 4; ++j) xr[64 * j] = v[j] * rs * gr[64 * j];
    }
}

#ifndef MK_SINGLE
#define MK_SINGLE 1
#endif
constexpr int NPL = 7;
constexpr int NPHASE = 1 + DEPTH * NPL + 1;
struct Args { const float* x; const int* pos; const float *n1g, *w_in, *pool_w, *pool_scale, *lb_logits, *hgrn_g, *w_out, *n2g, *w_ff_in, *w_ff_out, *fng; float* out; unsigned char* ws; int ph_lo, ph_hi; };
static_assert(sizeof(Args) == 15 * 8 + 8, "Args has no padding");


#define PHASE_BEGIN() do { int t_ = threadIdx.x; asm volatile("" : "+v"(t_)); F.tid = t_; F.lane = t_ & 63; F.wave = __builtin_amdgcn_readfirstlane(t_ >> 6); \
    unsigned char* w_ = args.ws; asm volatile("" : "+s"(w_)); F.ws = w_; } while (0)
__global__ void __launch_bounds__(NTHR, 2) fwd(Args args) {
    extern __shared__ __attribute__((aligned(16))) unsigned char lds[];
    Frame F;
    F.lds = (LAS unsigned char*)lds;
    F.MISC = (volatile LAS unsigned*)(F.lds + MISC_OFF);
    F.tid = threadIdx.x; F.lane = F.tid & 63; F.wave = __builtin_amdgcn_readfirstlane(F.tid >> 6);
    F.G = gridDim.x; F.bid = blockIdx.x;
    F.ws = args.ws; F.ctl = (gu32*)(args.ws + WS_CTL);
    F.x_in = args.x; F.pos = args.pos; F.n1g = args.n1g; F.w_in = args.w_in; F.pool_w = args.pool_w; F.pool_scale = args.pool_scale; F.lb_logits = args.lb_logits;
    F.hgrn_g = args.hgrn_g; F.w_out = args.w_out; F.n2g = args.n2g; F.w_ff_in = args.w_ff_in; F.w_ff_out = args.w_ff_out; F.fng = args.fng; F.xres = args.out;
    for (int u = F.tid; u < (LDS_BYTES - LDSCTL_OFF) / 4; u += NTHR) ((LAS unsigned*)(F.lds + LDSCTL_OFF))[u] = 0u;
    __syncthreads();
    XcdBarrier bar; bar.bar = (unsigned*)(F.ctl + CW_BAR); bar.x = 0; bar.st = nullptr;
    if (MK_SINGLE) bar = xcd_barrier_post((unsigned*)(F.ctl + CW_BAR), F.MISC + 8);
    const int lo = args.ph_lo, hi = args.ph_hi;
#define IN(k) (lo <= (k) && (k) < hi)
#define SEAM(k) do { if (MK_SINGLE && IN(k) && IN((k) + 1)) xcd_barrier(bar); } while (0)
    bf16* const xb = (bf16*)(F.ws + WS_XB); float* const ssq = (float*)(F.ws + WS_SSQ);
    bf16* const proj = (bf16*)(F.ws + WS_PROJ); bf16* const mixed = (bf16*)(F.ws + WS_MIXED); bf16* const hid = (bf16*)(F.ws + WS_HID);

    if (IN(0)) { PHASE_BEGIN(); p_prologue(F); } SEAM(0);
    for (int layer = 0; layer < DEPTH; ++layer) {
        const int pb = 1 + layer * NPL;
        if (IN(pb + 0)) {
            pg8::Gemm g{xb, (const bf16*)(F.ws + WS_WIN), M, DINP, DM}; pg8::StaticOrder S; S.init(M, DINP, F.G, F.bid);
            pg8::EpiIn E{proj, (bf16*)(F.ws + WS_QIHL), (bf16*)(F.ws + WS_KIHL), (float*)(F.ws + WS_WI), (bf16*)(F.ws + WS_VT), ssq, (const float*)(F.ws + WS_ROPE)};
            pg8::gemm_phase<pg8::EpiIn, pg8::StaticOrder, true, true>(F.lds + RING_OFF, g, S, E);
        } SEAM(pb + 0);
        if (IN(pb + 1)) { PHASE_BEGIN(); cvt_layer_rest(F, layer); PHASE_BEGIN(); p_hgrn_local(F, layer); } SEAM(pb + 1);
        if (IN(pb + 2)) { PHASE_BEGIN(); p_pool(F, layer); PHASE_BEGIN(); p_mask(F); PHASE_BEGIN(); p_hgrn_scan(F); } SEAM(pb + 2);
        if (IN(pb + 3)) { PHASE_BEGIN(); p_hgrn_out(F, layer); PHASE_BEGIN(); p_attn_flash(F); } SEAM(pb + 3);
        if (IN(pb + 4)) {
            pg8::Gemm g{mixed, (const bf16*)(F.ws + WS_WOUT), M, DM, DM}; pg8::StaticOrder S; S.init(M, DM, F.G, F.bid);
            pg8::EpiRes E{layer == 0 ? F.x_in : (const float*)F.xres, F.xres, xb, ssq};
            pg8::gemm_phase<pg8::EpiRes, pg8::StaticOrder, true, true>(F.lds + RING_OFF, g, S, E);
        } SEAM(pb + 4);
        if (IN(pb + 5)) {
            pg8::Gemm g{xb, (const bf16*)(F.ws + WS_WFI), M, DFF, DM}; pg8::StaticOrder S; S.init(M, DFF, F.G, F.bid);
            pg8::EpiFfIn E{hid, ssq};
            pg8::gemm_phase<pg8::EpiFfIn, pg8::StaticOrder, true, true>(F.lds + RING_OFF, g, S, E);
        } SEAM(pb + 5);
        if (IN(pb + 6)) {
            pg8::Gemm g{hid, (const bf16*)(F.ws + WS_WFO), M, DM, DFF}; pg8::StaticOrder S; S.init(M, DM, F.G, F.bid);
            pg8::EpiRes E{(const float*)F.xres, F.xres, xb, ssq};
            pg8::gemm_phase<pg8::EpiRes, pg8::StaticOrder, true, true>(F.lds + RING_OFF, g, S, E);
        } SEAM(pb + 6);
    }
    if (IN(NPHASE - 1)) { PHASE_BEGIN(); p_final(F); }
#undef IN
#undef SEAM
}

extern "C" void kernel_launch(void* const* d_in, const int* in_sizes, int n_in, void* d_out, int out_size, void* d_ws, size_t ws_size, hipStream_t stream) {
    static int grid = 0;
    if (grid == 0) {
        if (n_in != 13 || out_size != M * DM || ws_size < WS_END) { fprintf(stderr, "kernel_launch: unexpected shapes (n_in %d, out %d, ws %zu)\n", n_in, out_size, ws_size); grid = -1; return; }
        int dev = 0, cus = 0, per_cu = 0;
        if (hipGetDevice(&dev) != hipSuccess || hipDeviceGetAttribute(&cus, hipDeviceAttributeMultiprocessorCount, dev) != hipSuccess) { grid = -1; return; }
        if (hipFuncSetAttribute((const void*)fwd, hipFuncAttributeMaxDynamicSharedMemorySize, LDS_BYTES) != hipSuccess) { fprintf(stderr, "kernel_launch: hipFuncSetAttribute failed\n"); grid = -1; return; }
        if (hipOccupancyMaxActiveBlocksPerMultiprocessor(&per_cu, (const void*)fwd, NTHR, LDS_BYTES) != hipSuccess || per_cu < 1) { fprintf(stderr, "kernel_launch: occupancy query says %d\n", per_cu); }
        (void)hipGetLastError();
        grid = cus;
        if (grid > 256) grid = 256;
        grid -= grid % 8;
    }
    if (grid <= 0) return;
    (void)hipMemsetAsync((char*)d_ws + WS_CTL, 0, CTL_ZERO_BYTES, stream);
    Args a{};
    a.x = (const float*)d_in[0]; a.pos = (const int*)d_in[1]; a.n1g = (const float*)d_in[2]; a.w_in = (const float*)d_in[3]; a.pool_w = (const float*)d_in[4];
    a.pool_scale = (const float*)d_in[5]; a.lb_logits = (const float*)d_in[6]; a.hgrn_g = (const float*)d_in[7]; a.w_out = (const float*)d_in[8]; a.n2g = (const float*)d_in[9];
    a.w_ff_in = (const float*)d_in[10]; a.w_ff_out = (const float*)d_in[11]; a.fng = (const float*)d_in[12];
    a.out = (float*)d_out; a.ws = (unsigned char*)d_ws;
    if (MK_SINGLE) {
        a.ph_lo = 0; a.ph_hi = NPHASE;
        hipLaunchKernelGGL(fwd, dim3(grid), dim3(NTHR), LDS_BYTES, stream, a);
    } else {
        for (int p = 0; p < NPHASE; ++p) { a.ph_lo = p; a.ph_hi = p + 1; hipLaunchKernelGGL(fwd, dim3(grid), dim3(NTHR), LDS_BYTES, stream, a); }
    }
}
```

```cpp
#include <hip/hip_runtime.h>
#include <cstdio>
#include <cstdint>
namespace pg8 {
#define PG8_LAS __attribute__((address_space(3)))
typedef unsigned short bf16_t;
typedef short bf16x8 __attribute__((ext_vector_type(8)));
typedef float f32x4 __attribute__((ext_vector_type(4)));
typedef unsigned u32x4 __attribute__((ext_vector_type(4)));
constexpr int BM = 256, BK = 64, HALF = 128, HTB = HALF * BK * 2  , STAGE_BYTES = 8 * HTB, NXCD = 8, WGM = 8;

__host__ __device__ __forceinline__ int lds_byte(int r, int c) { const int st = (r >> 4) * 2 + (c >> 5), rr = r & 15, cc = c & 31, ob = rr * 64 + cc * 2; return st * 1024 + (ob ^ (((ob >> 9) & 1) << 5)); }
__host__ __device__ __forceinline__ void stage_rc(int b, int& R, int& C) { const int st = b / 1024, sb = b % 1024, swz = sb ^ (((sb >> 9) & 1) << 5); R = (st >> 1) * 16 + swz / 64; C = (st & 1) * 32 + (swz % 64) / 2; }
__host__ __device__ __forceinline__ int perm32(int rho) { const int n = rho >> 4, i = rho & 15; return 8 * (i >> 2) + 4 * n + (i & 3); }

struct Unit { int pm, pn; };
struct Gemm { const bf16_t* A; const bf16_t* Bt; int M, N, K; };

struct StaticOrder {
    int nM, nN, nwg, G, c;
    __host__ __device__ void init(int M, int N, int G_, int c_) { nM = M / BM; nN = N / BM; nwg = nM * nN; G = G_; c = c_; }
    __host__ __device__ bool next(int i, Unit& u) const {
        const long L = (long)i * G + c; if (L >= nwg) return false;
        int wgid = (int)L; { const int q = nwg / NXCD, r = nwg % NXCD, xcd = wgid % NXCD, off = wgid / NXCD; wgid = (xcd < r ? xcd * (q + 1) : r * (q + 1) + (xcd - r) * q) + off; }
        const int nig = WGM * nN, gid = wgid / nig, fm = gid * WGM, gsz = (nM - fm) < WGM ? (nM - fm) : WGM;
        u.pm = fm + ((wgid % nig) % gsz); u.pn = (wgid % nig) / gsz; return true;
    }
    __device__ __forceinline__ void a_ready(const Unit&) const {}
    __device__ __forceinline__ void done(const Unit&) const {}
};

__device__ __forceinline__ unsigned cvt_pk_bf16(float lo, float hi) { unsigned r; asm volatile("v_cvt_pk_bf16_f32 %0, %1, %2" : "=v"(r) : "v"(lo), "v"(hi)); return r; }
typedef float f32x2 __attribute__((ext_vector_type(2)));

constexpr float RMS_EPS_F = 1e-5f;
#define PG8_GAS __attribute__((address_space(1)))
__device__ __forceinline__ float row_rstd(const float* ssq, int row) {
    const PG8_GAS f32x4* p = (const PG8_GAS f32x4*)(ssq + (size_t)row * 16);
    const f32x4 a = p[0], b = p[1], c = p[2], d = p[3];
    const float s = ((a[0] + a[1]) + (a[2] + a[3])) + ((b[0] + b[1]) + (b[2] + b[3])) + ((c[0] + c[1]) + (c[2] + c[3])) + ((d[0] + d[1]) + (d[2] + d[3]));
    return 1.0f / sqrtf(s * (1.0f / 1024.0f) + RMS_EPS_F);
}
__device__ __forceinline__ unsigned cvt_pk_rne(float lo, float hi) { typedef float f2 __attribute__((ext_vector_type(2))); typedef __bf16 b2 __attribute__((ext_vector_type(2))); f2 v = {lo, hi}; b2 b = __builtin_convertvector(v, b2); return __builtin_bit_cast(unsigned, b); }
__device__ __forceinline__ void split_hl(const f32x4 a, const f32x4 b, u32x4& h, u32x4& l) {
    h.x = cvt_pk_rne(a[0], a[1]); h.y = cvt_pk_rne(a[2], a[3]); h.z = cvt_pk_rne(b[0], b[1]); h.w = cvt_pk_rne(b[2], b[3]);
    l.x = cvt_pk_rne(a[0] - __builtin_bit_cast(float, h.x << 16), a[1] - __builtin_bit_cast(float, h.x & 0xffff0000u));
    l.y = cvt_pk_rne(a[2] - __builtin_bit_cast(float, h.y << 16), a[3] - __builtin_bit_cast(float, h.y & 0xffff0000u));
    l.z = cvt_pk_rne(b[0] - __builtin_bit_cast(float, h.z << 16), b[1] - __builtin_bit_cast(float, h.z & 0xffff0000u));
    l.w = cvt_pk_rne(b[2] - __builtin_bit_cast(float, h.w << 16), b[3] - __builtin_bit_cast(float, h.w & 0xffff0000u));
}
struct EpiIn {
    static constexpr bool PERM = true, AFTER_DRAIN = false;
    bf16_t* proj; bf16_t* qi_hl; bf16_t* ki_hl; float* wi; bf16_t* vT; const float* ssq; const float* rope;
    __device__ __forceinline__ void operator()(const f32x4 (&acc)[2][2][4][2], const Unit& u, int wr, int wc, int fr, int fq) const {
        const int row0 = u.pm * BM + wr * 64 + fr, pn = u.pn;
        const bool rot_lane = ((wc & 1) == 0) && (fq < 2);
        const float sgn = (fq == 0) ? -1.f : 1.f;
#pragma unroll
        for (int ai = 0; ai < 2; ++ai)
#pragma unroll
            for (int m = 0; m < 4; ++m) {
                const int row = row0 + ai * HALF + m * 16;
                const float rs = row_rstd(ssq, row);
                f32x4 c0 = {1.f, 1.f, 1.f, 1.f}, c1 = c0, s0 = {0.f, 0.f, 0.f, 0.f}, s1 = s0;
                if (pn >= 5) { const PG8_GAS f32x4* tp = (const PG8_GAS f32x4*)(rope + (size_t)row * 16); c0 = tp[0]; c1 = tp[1]; s0 = tp[2]; s1 = tp[3]; }
#pragma unroll
                for (int bj = 0; bj < 2; ++bj) {
                    f32x4 v0 = acc[ai][bj][m][0] * rs, v1 = acc[ai][bj][m][1] * rs;
                    const bool rope_tile = (pn == 5) || (pn == 6) || (pn == 8) || (pn == 7 && bj == 0) || (pn == 9 && bj == 0 && wc < 2);
                    if (rope_tile) {
                        f32x4 p0, p1;
#pragma unroll
                        for (int e = 0; e < 4; ++e) { p0[e] = __shfl_xor(v0[e], 16); p1[e] = __shfl_xor(v1[e], 16); }
                        if (rot_lane) { v0 = v0 * c0 + (p0 * s0) * sgn; v1 = v1 * c1 + (p1 * s1) * sgn; }
                    }
                    const int cl = bj * HALF + wc * 32 + 8 * fq;
                    if (pn < 7 || (pn == 7 && bj == 0)) {
                        u32x4 w; w.x = cvt_pk_bf16(v0[0], v0[1]); w.y = cvt_pk_bf16(v0[2], v0[3]); w.z = cvt_pk_bf16(v1[0], v1[1]); w.w = cvt_pk_bf16(v1[2], v1[3]);
                        *(PG8_GAS u32x4*)(proj + (size_t)row * 2048 + pn * BM + cl) = w;
                    } else if (pn == 7) {
                        const int vc = cl - HALF, kvh = vc >> 6, d = vc & 63, b = row >> 11, t = row & 2047;
                        PG8_GAS bf16_t* o = (PG8_GAS bf16_t*)vT + ((size_t)((b * 2 + kvh) * 64 + d)) * 2048 + t;
                        const u32x4 w = (u32x4){cvt_pk_bf16(v0[0], v0[1]), cvt_pk_bf16(v0[2], v0[3]), cvt_pk_bf16(v1[0], v1[1]), cvt_pk_bf16(v1[2], v1[3])};
                        o[0 * 2048] = (bf16_t)(w.x & 0xffffu); o[1 * 2048] = (bf16_t)(w.x >> 16); o[2 * 2048] = (bf16_t)(w.y & 0xffffu); o[3 * 2048] = (bf16_t)(w.y >> 16);
                        o[4 * 2048] = (bf16_t)(w.z & 0xffffu); o[5 * 2048] = (bf16_t)(w.z >> 16); o[6 * 2048] = (bf16_t)(w.w & 0xffffu); o[7 * 2048] = (bf16_t)(w.w >> 16);
                    } else if (pn == 8) {
                        u32x4 h, l; split_hl(v0, v1, h, l);
                        *(PG8_GAS u32x4*)(qi_hl + (size_t)row * 512 + cl) = h; *(PG8_GAS u32x4*)(qi_hl + (size_t)row * 512 + 256 + cl) = l;
                    } else if (bj == 0) {
                        if (wc < 2) { u32x4 h, l; split_hl(v0, v1, h, l); *(PG8_GAS u32x4*)(ki_hl + (size_t)row * 128 + cl) = h; *(PG8_GAS u32x4*)(ki_hl + (size_t)row * 128 + 64 + cl) = l; }
                        else if (wc == 2 && fq == 0) { *(PG8_GAS f32x4*)(wi + (size_t)row * 4) = v0; }
                    }
                }
            }
    }
};
struct EpiRes {
    static constexpr bool PERM = true, AFTER_DRAIN = false;
    const float* xin; float* xout; bf16_t* xb; float* ssq;
    __device__ __forceinline__ void operator()(const f32x4 (&acc)[2][2][4][2], const Unit& u, int wr, int wc, int fr, int fq) const {
        const int row0 = u.pm * BM + wr * 64 + fr;
        const int colt = u.pn * BM + wc * 32 + 8 * fq;
#pragma unroll
        for (int ai = 0; ai < 2; ++ai)
#pragma unroll
            for (int m = 0; m < 4; ++m) {
                const int row = row0 + ai * HALF + m * 16;
                float sq = 0.f;
#pragma unroll
                for (int bj = 0; bj < 2; ++bj) {
                    const size_t off = (size_t)row * 1024 + colt + bj * HALF;
                    const f32x4 a0 = *(const PG8_GAS f32x4*)(xin + off), a1 = *(const PG8_GAS f32x4*)(xin + off + 4);
                    const f32x4 v0 = a0 + acc[ai][bj][m][0], v1 = a1 + acc[ai][bj][m][1];
                    *(PG8_GAS f32x4*)(xout + off) = v0; *(PG8_GAS f32x4*)(xout + off + 4) = v1;
                    u32x4 w; w.x = cvt_pk_bf16(v0[0], v0[1]); w.y = cvt_pk_bf16(v0[2], v0[3]); w.z = cvt_pk_bf16(v1[0], v1[1]); w.w = cvt_pk_bf16(v1[2], v1[3]);
                    *(PG8_GAS u32x4*)(xb + off) = w;
                    sq += (v0[0] * v0[0] + v0[1] * v0[1]) + (v0[2] * v0[2] + v0[3] * v0[3]) + (v1[0] * v1[0] + v1[1] * v1[1]) + (v1[2] * v1[2] + v1[3] * v1[3]);
                }
                sq += __shfl_xor(sq, 16); sq += __shfl_xor(sq, 32);
                if (fq == 0) ((PG8_GAS float*)ssq)[(size_t)row * 16 + u.pn * 4 + wc] = sq;
            }
    }
};
struct EpiFfIn {
    static constexpr bool PERM = true, AFTER_DRAIN = false;
    bf16_t* hid; const float* ssq;
    __device__ __forceinline__ void operator()(const f32x4 (&acc)[2][2][4][2], const Unit& u, int wr, int wc, int fr, int fq) const {
        const int row0 = u.pm * BM + wr * 64 + fr;
        const int colt = u.pn * BM + wc * 32 + 8 * fq;
#pragma unroll
        for (int ai = 0; ai < 2; ++ai)
#pragma unroll
            for (int m = 0; m < 4; ++m) {
                const int row = row0 + ai * HALF + m * 16;
                const float rs = row_rstd(ssq, row);
#pragma unroll
                for (int bj = 0; bj < 2; ++bj) {
                    f32x4 v0 = acc[ai][bj][m][0] * rs, v1 = acc[ai][bj][m][1] * rs;
#pragma unroll
                    for (int e = 0; e < 4; ++e) { const float a = fmaxf(v0[e], 0.f), b = fmaxf(v1[e], 0.f); v0[e] = a * a; v1[e] = b * b; }
                    u32x4 w; w.x = cvt_pk_bf16(v0[0], v0[1]); w.y = cvt_pk_bf16(v0[2], v0[3]); w.z = cvt_pk_bf16(v1[0], v1[1]); w.w = cvt_pk_bf16(v1[2], v1[3]);
                    *(PG8_GAS u32x4*)(hid + (size_t)row * 4096 + colt + bj * HALF) = w;
                }
            }
    }
};
template <class Epi, class Sched, bool ALIGN_EPI = false, bool SP2 = false>
__device__ __forceinline__ void gemm_phase(PG8_LAS unsigned char* lds, const Gemm g, const Sched& S, const Epi& E) {
    int tid_ = threadIdx.x; asm volatile("" : "+v"(tid_));
    const int tid = tid_, wid = __builtin_amdgcn_readfirstlane(tid >> 6), lane = tid & 63, wr = wid >> 2, wc = wid & 3, fr = lane & 15, fq = lane >> 4;
    const int K = g.K, nt = K / BK;
    unsigned voffA[2], voffB[2];
#pragma unroll
    for (int i = 0; i < 2; ++i) { int R, C; stage_rc(tid * 16 + i * 8192, R, C); const int Rb = Epi::PERM ? ((R & ~31) + perm32(R & 31)) : R;
        voffA[i] = (unsigned)(R * K + C) * 2u; voffB[i] = (unsigned)(Rb * K + C) * 2u; }
    const size_t kstep = (size_t)(BK * 2);
    const size_t hstep = (size_t)HALF * K * 2;
    const size_t tstep = 2 * hstep;
    const unsigned ldsw = (unsigned)wid * 1024u;
    const int aoff = lds_byte(wr * 64 + fr, fq * 8), boff = lds_byte(wc * 32 + fr, fq * 8);
#define PG8_SA(b, h) (((b) * 2 + (h)) * HTB)
#define PG8_SB(b, h) ((4 + (b) * 2 + (h)) * HTB)
#define PG8_STAGE(bufoff, gbase, voff) do { _Pragma("unroll") for (int _i = 0; _i < 2; ++_i) \
        __builtin_amdgcn_global_load_lds((const unsigned*)((const char*)(gbase) + (voff)[_i]), (PG8_LAS unsigned*)(lds + (bufoff) + ldsw + _i * 8192), 16, 0, 0); } while (0)
#define PG8_LDA(dst, b, h) do { _Pragma("unroll") for (int m = 0; m < 4; ++m) _Pragma("unroll") for (int k = 0; k < 2; ++k) dst[m][k] = *(const PG8_LAS bf16x8*)(lds + PG8_SA(b, h) + aoff + m * 2048 + k * 1024); } while (0)
#define PG8_LDB(dst, b, h) do { _Pragma("unroll") for (int n = 0; n < 2; ++n) _Pragma("unroll") for (int k = 0; k < 2; ++k) dst[n][k] = *(const PG8_LAS bf16x8*)(lds + PG8_SB(b, h) + boff + n * 2048 + k * 1024); } while (0)
#define PG8_MMA(ai, bj, At, Bt) do { __builtin_amdgcn_s_setprio(1); _Pragma("unroll") for (int m = 0; m < 4; ++m) _Pragma("unroll") for (int n = 0; n < 2; ++n) _Pragma("unroll") for (int k = 0; k < 2; ++k) \
        acc[ai][bj][m][n] = __builtin_amdgcn_mfma_f32_16x16x32_bf16(Bt[n][k], At[m][k], acc[ai][bj][m][n], 0, 0, 0); __builtin_amdgcn_s_setprio(0); } while (0)
#define PG8_WAIT_V(n) asm volatile("s_waitcnt vmcnt(" #n ")" ::: "memory")
#define PG8_WAIT_L(n) asm volatile("s_waitcnt lgkmcnt(" #n ")" ::: "memory")
#define PG8_BAR __builtin_amdgcn_s_barrier()
#define PG8_SCHED __builtin_amdgcn_sched_barrier(0)
    Unit cur, nxt; int ui = 0;
    if (!S.next(0, cur)) return;
    f32x4 acc[2][2][4][2];
#pragma unroll
    for (int a = 0; a < 2; ++a)
#pragma unroll
        for (int b = 0; b < 2; ++b)
#pragma unroll
            for (int m = 0; m < 4; ++m)
#pragma unroll
                for (int n = 0; n < 2; ++n) acc[a][b][m][n] = (f32x4){0.f, 0.f, 0.f, 0.f};
    bf16x8 At[4][2], B0[2][2], B1[2][2];
    const char* cA = (const char*)g.A + (size_t)cur.pm * tstep; const char* cB = (const char*)g.Bt + (size_t)cur.pn * tstep;
    S.a_ready(cur);
    if constexpr (SP2) {
        PG8_STAGE(PG8_SB(0, 0), cB, voffB); PG8_STAGE(PG8_SB(0, 1), cB + hstep, voffB); PG8_STAGE(PG8_SA(0, 0), cA, voffA); PG8_STAGE(PG8_SA(0, 1), cA + hstep, voffA);
        if (wr == 1) PG8_BAR;
        PG8_WAIT_V(2); PG8_BAR;
        PG8_STAGE(PG8_SB(1, 0), cB + kstep, voffB); PG8_STAGE(PG8_SA(1, 0), cA + kstep, voffA); PG8_STAGE(PG8_SB(1, 1), cB + hstep + kstep, voffB);
        PG8_WAIT_V(6); PG8_BAR;
    } else {
        PG8_STAGE(PG8_SB(0, 0), cB, voffB); PG8_STAGE(PG8_SA(0, 0), cA, voffA); PG8_STAGE(PG8_SB(0, 1), cB + hstep, voffB); PG8_STAGE(PG8_SA(0, 1), cA + hstep, voffA);
        if (wr == 1) PG8_BAR;
        PG8_WAIT_V(4); PG8_BAR;
        PG8_STAGE(PG8_SB(1, 0), cB + kstep, voffB); PG8_STAGE(PG8_SA(1, 0), cA + kstep, voffA); PG8_STAGE(PG8_SB(1, 1), cB + hstep + kstep, voffB);
        PG8_WAIT_V(6); PG8_BAR;
    }
    for (;;) {
        const bool has_next = S.next(ui + 1, nxt);
        const char* nA = has_next ? (const char*)g.A + (size_t)nxt.pm * tstep : cA; const char* nB = has_next ? (const char*)g.Bt + (size_t)nxt.pn * tstep : cB;
        for (int t = 0; t < nt; t += 2) {
            const bool last = (t == nt - 2);
            const char* a1 = cA + (size_t)(t + 1) * kstep;
            const char* a2 = last ? nA : cA + (size_t)(t + 2) * kstep; const char* b2 = last ? nB : cB + (size_t)(t + 2) * kstep;
            const char* a3 = a2 + kstep; const char* b3 = b2 + kstep;
            if (last && has_next) S.a_ready(nxt);
            if constexpr (SP2) {
            PG8_LDB(B0, 0, 0); PG8_LDB(B1, 0, 1); PG8_SCHED; PG8_LDA(At, 0, 0); PG8_STAGE(PG8_SA(1, 1), a1 + hstep, voffA);
            PG8_WAIT_V(8); PG8_WAIT_L(0); PG8_BAR; PG8_MMA(0, 0, At, B0); PG8_MMA(0, 1, At, B1); PG8_BAR; PG8_SCHED;
            PG8_LDA(At, 0, 1); PG8_STAGE(PG8_SB(0, 0), b2, voffB); PG8_STAGE(PG8_SB(0, 1), b2 + hstep, voffB); PG8_STAGE(PG8_SA(0, 0), a2, voffA);
            PG8_WAIT_V(8); PG8_WAIT_L(0); PG8_BAR; PG8_MMA(1, 0, At, B0); PG8_MMA(1, 1, At, B1); PG8_BAR; PG8_SCHED;
            PG8_LDB(B0, 1, 0); PG8_LDB(B1, 1, 1); PG8_SCHED; PG8_LDA(At, 1, 0); PG8_STAGE(PG8_SA(0, 1), a2 + hstep, voffA);
            PG8_WAIT_V(8); PG8_WAIT_L(0); PG8_BAR; PG8_MMA(0, 0, At, B0); PG8_MMA(0, 1, At, B1); PG8_BAR; PG8_SCHED;
            PG8_LDA(At, 1, 1); PG8_STAGE(PG8_SB(1, 0), b3, voffB); PG8_STAGE(PG8_SB(1, 1), b3 + hstep, voffB); PG8_STAGE(PG8_SA(1, 0), a3, voffA);
            PG8_WAIT_V(8); PG8_WAIT_L(0); PG8_BAR; PG8_MMA(1, 0, At, B0); PG8_MMA(1, 1, At, B1); PG8_BAR; PG8_SCHED;
            } else {
            PG8_LDB(B0, 0, 0); PG8_SCHED; PG8_LDA(At, 0, 0); PG8_STAGE(PG8_SA(1, 1), a1 + hstep, voffA);
            PG8_WAIT_L(8); PG8_BAR; PG8_WAIT_L(0); PG8_MMA(0, 0, At, B0); PG8_BAR; PG8_SCHED;
            PG8_LDB(B1, 0, 1); PG8_STAGE(PG8_SB(0, 0), b2, voffB);
            PG8_BAR; PG8_WAIT_L(0); PG8_MMA(0, 1, At, B1); PG8_BAR;
            PG8_LDA(At, 0, 1); PG8_STAGE(PG8_SA(0, 0), a2, voffA);
            PG8_BAR; PG8_WAIT_L(0); PG8_MMA(1, 0, At, B0); PG8_BAR; PG8_SCHED;
            PG8_STAGE(PG8_SB(0, 1), b2 + hstep, voffB);
            PG8_WAIT_V(6); PG8_BAR; PG8_MMA(1, 1, At, B1); PG8_BAR;
            PG8_LDB(B0, 1, 0); PG8_SCHED; PG8_LDA(At, 1, 0); PG8_STAGE(PG8_SA(0, 1), a2 + hstep, voffA);
            PG8_WAIT_L(8); PG8_BAR; PG8_WAIT_L(0); PG8_MMA(0, 0, At, B0); PG8_BAR; PG8_SCHED;
            PG8_LDB(B1, 1, 1); PG8_STAGE(PG8_SB(1, 0), b3, voffB);
            PG8_BAR; PG8_WAIT_L(0); PG8_MMA(0, 1, At, B1); PG8_BAR;
            PG8_LDA(At, 1, 1); PG8_STAGE(PG8_SA(1, 0), a3, voffA);
            PG8_BAR; PG8_WAIT_L(0); PG8_MMA(1, 0, At, B0); PG8_BAR; PG8_SCHED;
            PG8_STAGE(PG8_SB(1, 1), b3 + hstep, voffB);
            PG8_WAIT_V(6); PG8_BAR; PG8_MMA(1, 1, At, B1); PG8_BAR;
            }
        }
        if constexpr (ALIGN_EPI) { if (wr == 0) PG8_BAR; }
        if constexpr (!Epi::AFTER_DRAIN) { E(acc, cur, wr, wc, fr, fq); S.done(cur); }
        if (!has_next) break;
#pragma unroll
        for (int a = 0; a < 2; ++a)
#pragma unroll
            for (int b = 0; b < 2; ++b)
#pragma unroll
                for (int m = 0; m < 4; ++m)
#pragma unroll
                    for (int n = 0; n < 2; ++n) acc[a][b][m][n] = (f32x4){0.f, 0.f, 0.f, 0.f};
        cur = nxt; cA = nA; cB = nB; ++ui;
        if constexpr (ALIGN_EPI) { if (wr == 1) PG8_BAR; }
    }
    PG8_WAIT_V(0);
    if constexpr (!ALIGN_EPI) { if (wr == 0) PG8_BAR; }
    PG8_BAR;
    if constexpr (Epi::AFTER_DRAIN) { E.fused(acc, cur, wr, wc, fr, fq, lds, wid, lane); S.done(cur); }
#undef PG8_SA
#undef PG8_SB
#undef PG8_STAGE
#undef PG8_LDA
#undef PG8_LDB
#undef PG8_MMA
#undef PG8_WAIT_V
#undef PG8_WAIT_L
#undef PG8_BAR
#undef PG8_SCHED
}
}

constexpr int BATCH = 8, SEQ = 2048, DM = 1024, DEPTH = 4, M = BATCH * SEQ, DIN = 2372, DINP = 2560, DFF = 4096;
constexpr int NWAVES = 8, NTHR = NWAVES * 64;
constexpr int TOPK = 256;
constexpr int PC_POOL = 0, PC_HQ = 256, PC_HF = 512, PC_HI = 768, PC_HG = 1024, PC_Q = 1280, PC_K = 1792, PC_V = 1920, PROJ_LD = 2048;
constexpr int MC_POOL = 0, MC_HGRN = 256, MC_ATTN = 512;

constexpr size_t MiB = 1u << 20;
constexpr size_t WS_CTL = 0, CTL_ZERO_BYTES = 1 * MiB;
constexpr size_t WS_ROPE = 1 * MiB;
constexpr size_t WS_SSQ = 2 * MiB;
constexpr size_t WS_LB = 3 * MiB;
constexpr size_t WS_MASK = 4 * MiB;
constexpr size_t WS_WIN = 8 * MiB;
constexpr size_t WS_WOUT = 13 * MiB;
constexpr size_t WS_WFI = 15 * MiB;
constexpr size_t WS_WFO = 23 * MiB;
constexpr size_t WS_XB = 32 * MiB;
constexpr size_t WS_HID = 64 * MiB;
constexpr size_t WS_PROJ = 64 * MiB;
constexpr size_t WS_MIXED = 128 * MiB;
constexpr size_t WS_HST = 160 * MiB;
constexpr size_t WS_HDN = 176 * MiB;
constexpr size_t WS_QIHL = 192 * MiB;
constexpr size_t WS_KIHL = 208 * MiB;
constexpr size_t WS_WI = 212 * MiB;
constexpr size_t WS_VT = 224 * MiB;
constexpr size_t WS_END = 256 * MiB;
constexpr int CW_TMO = 0, CW_BAR = 4096;

constexpr int RING_OFF = 0, RING_BYTES = 131072;
constexpr int LDS_BYTES = 147456;
constexpr int LDSCTL_OFF = LDS_BYTES - 1024, MISC_OFF = LDSCTL_OFF + 320;

#define GAS __attribute__((address_space(1)))
#define LAS __attribute__((address_space(3)))
typedef unsigned short bf16;
typedef unsigned v4u __attribute__((ext_vector_type(4)));
typedef unsigned v2u __attribute__((ext_vector_type(2)));
typedef float f32x4 __attribute__((ext_vector_type(4)));
typedef GAS unsigned gu32;
#define RLX_AGENT __ATOMIC_RELAXED, __HIP_MEMORY_SCOPE_AGENT
#define LDS_WAIT() asm volatile("s_waitcnt lgkmcnt(0)" ::: "memory")
__device__ __forceinline__ unsigned f2bf(float f) { unsigned u = __builtin_bit_cast(unsigned, f); return (u + 0x7fffu + ((u >> 16) & 1u)) >> 16; }
__device__ __forceinline__ unsigned pk2(float lo, float hi) { return f2bf(lo) | (f2bf(hi) << 16); }
__device__ __forceinline__ float bf2f(unsigned short h) { return __builtin_bit_cast(float, (unsigned)h << 16); }
__device__ __forceinline__ float wave_sum(float v) {
#pragma unroll
    for (int o = 1; o < 64; o <<= 1) v += __shfl_xor(v, o);
    return v;
}
__device__ __forceinline__ float wave_max(float v) {
#pragma unroll
    for (int o = 1; o < 64; o <<= 1) v = fmaxf(v, __shfl_xor(v, o));
    return v;
}
#define XB_TMO      128
#define XB_XCNT(j)  (256  + 64 * (j))
#define XB_XSUB(j)  (1280 + 64 * (j))
#define XB_XGEN(j)  (2304 + 64 * (j))
#define XB_TOP      3328
#define XB_TOPGEN   3392
#define XCD_BAR_WORDS 3456
#define XB_SPIN_CAP (1u << 18)

__device__ __forceinline__ unsigned xb_ld(unsigned* p)              { return __hip_atomic_load(p, __ATOMIC_RELAXED, __HIP_MEMORY_SCOPE_AGENT); }
__device__ __forceinline__ unsigned xb_add(unsigned* p, unsigned v) { return __hip_atomic_fetch_add(p, v, __ATOMIC_RELAXED, __HIP_MEMORY_SCOPE_AGENT); }
__device__ __forceinline__ unsigned xb_xcc_id() { return (unsigned)__builtin_amdgcn_s_getreg((3 << 11) | 20) & 0xFu; }
#define XB_SPIN(cond, bar) do { unsigned _sp = 0; while (cond) { __builtin_amdgcn_s_sleep(1); \
    if ((++_sp & 255u) == 0u) { if (xb_ld(&(bar)[XB_TMO])) break; if (_sp > XB_SPIN_CAP) { atomicAdd(&(bar)[XB_TMO], 1u); break; } } } } while (0)

struct XcdBarrier {
    unsigned* bar; unsigned x;
    volatile LAS unsigned* st;
};

__device__ __forceinline__ XcdBarrier xcd_barrier_post(unsigned* bar, volatile LAS unsigned* st) {
    XcdBarrier b; b.bar = bar; b.x = xb_xcc_id(); b.st = st;
    if (threadIdx.x == 0) (void)xb_add(&bar[XB_XCNT(b.x)], 1u);
    return b;
}
__device__ __forceinline__ void xcd_barrier_complete(unsigned* bar, unsigned x, unsigned& nloc, unsigned& nx) {
    const unsigned G = gridDim.x * gridDim.y * gridDim.z;
    unsigned sum, cnt, mine, sp = 0u;
    for (;;) {
        sum = 0u; cnt = 0u; mine = 0u;
#pragma unroll
        for (unsigned j = 0; j < 16; ++j) { const unsigned c = xb_ld(&bar[XB_XCNT(j)]); sum += c; cnt += (c > 0u) ? 1u : 0u; mine = (j == x) ? c : mine; }
        if (sum == G) break;
        __builtin_amdgcn_s_sleep(1);
        if ((++sp & 255u) == 0u) { if (xb_ld(&bar[XB_TMO])) break; if (sp > XB_SPIN_CAP) { atomicAdd(&bar[XB_TMO], 1u); break; } }
    }
    nloc = mine > 0u ? mine : 1u; nx = cnt > 0u ? cnt : 1u;
}

__device__ __forceinline__ void xcd_barrier(const XcdBarrier& b) {
    asm volatile("s_waitcnt vmcnt(0)" ::: "memory");
    __syncthreads();
    if (threadIdx.x == 0) {
        unsigned* bar = b.bar;
        __builtin_amdgcn_s_waitcnt(0);
        unsigned nloc = b.st[0], nx = b.st[1];
        if (nloc == 0u) { xcd_barrier_complete(bar, b.x, nloc, nx); b.st[0] = nloc; b.st[1] = nx; }
        const unsigned old = xb_add(&bar[XB_XSUB(b.x)], 1u);
        const unsigned gen = old / nloc;
        if (old + 1u == (gen + 1u) * nloc) {
            __builtin_amdgcn_fence(__ATOMIC_RELEASE, "agent");
            asm volatile("s_waitcnt vmcnt(0)" ::: "memory");
            const unsigned og = xb_add(&bar[XB_TOP], 1u);
            const unsigned tg = og / nx;
            if (og + 1u == (tg + 1u) * nx) xb_add(&bar[XB_TOPGEN], 1u);
            else XB_SPIN(xb_ld(&bar[XB_TOPGEN]) == tg, bar);
            __builtin_amdgcn_fence(__ATOMIC_ACQUIRE, "agent");
            xb_add(&bar[XB_XGEN(b.x)], 1u);
            asm volatile("s_waitcnt vmcnt(0)" ::: "memory");
        } else {
            XB_SPIN(xb_ld(&bar[XB_XGEN(b.x)]) == gen, bar);
            __builtin_amdgcn_fence(__ATOMIC_ACQUIRE, "agent");
            asm volatile("s_waitcnt vmcnt(0)" ::: "memory");
        }
    }
    __syncthreads();
}


struct Frame {
    LAS unsigned char* lds;
    volatile LAS unsigned* MISC;
    gu32* ctl;
    int tid, lane, wave, G, bid;
    const float* x_in; const int* pos;
    const float *n1g, *w_in, *pool_w, *pool_scale, *lb_logits, *hgrn_g, *w_out, *n2g, *w_ff_in, *w_ff_out, *fng;
    float* xres;
    unsigned char* ws;
};
__constant__ float c_invf[8] = {1.0f, 0.19392274474868576f, 0.03760603093086393f, 0.007292664737217109f, 0.001414213562373095f, 0.0002742481756762073f, 5.318295896944988e-05f, 1.031338537721246e-05f};

typedef float f32x16 __attribute__((ext_vector_type(16)));
typedef short bf16x8v __attribute__((ext_vector_type(8)));
typedef float f32x2v __attribute__((ext_vector_type(2))); typedef __bf16 bf16x2v __attribute__((ext_vector_type(2)));
__device__ __forceinline__ unsigned cvtpk(float lo, float hi) { f32x2v v = {lo, hi}; bf16x2v b = __builtin_convertvector(v, bf16x2v); return __builtin_bit_cast(unsigned, b); }

__device__ __forceinline__ void cvt_item(const GAS float* W, const GAS float* g, int K, int N, bf16* WT, LAS float* scr, int kb, int nb, int lane) {
    const int k0 = 64 * kb, n0 = 32 * nb;
    const int n = n0 + (lane & 31);
    float v[32];
#pragma unroll
    for (int i = 0; i < 32; ++i) { const int kk = 2 * i + (lane >> 5); v[i] = (n < N) ? W[(size_t)(k0 + kk) * N + n] : 0.f; }
    const int c = lane & 7;
    f32x4 g0 = {1.f, 1.f, 1.f, 1.f}, g1 = g0;
    if (g) { g0 = *(const GAS f32x4*)(g + k0 + 8 * c); g1 = *(const GAS f32x4*)(g + k0 + 8 * c + 4); }
    __builtin_amdgcn_sched_barrier(0);
#pragma unroll
    for (int i = 0; i < 32; ++i) { const int kk = 2 * i + (lane >> 5); scr[kk * 33 + (lane & 31)] = v[i]; }
    LDS_WAIT(); asm volatile("" ::: "memory");
#pragma unroll
    for (int j = 0; j < 4; ++j) { const int nl = (lane >> 3) + 8 * j; const LAS float* sp = scr + (8 * c) * 33 + nl;
        v4u o; o.x = pk2(sp[0 * 33] * g0[0], sp[1 * 33] * g0[1]); o.y = pk2(sp[2 * 33] * g0[2], sp[3 * 33] * g0[3]); o.z = pk2(sp[4 * 33] * g1[0], sp[5 * 33] * g1[1]); o.w = pk2(sp[6 * 33] * g1[2], sp[7 * 33] * g1[3]);
        *(GAS v4u*)(WT + (size_t)(n0 + nl) * K + k0 + 8 * c) = o; }
    LDS_WAIT(); asm volatile("" ::: "memory");
}
__device__ __forceinline__ void cvt_matrix(Frame& F, const float* W_, const float* g_, int K, int N, int Npad, bf16* WT) {
    const GAS float* W = (const GAS float*)W_; const GAS float* g = (const GAS float*)g_;
    LAS float* scr = (LAS float*)(F.lds + RING_OFF + F.wave * 16384);
    const int gw = F.bid * NWAVES + F.wave, NGW = F.G * NWAVES;
    const int nblk = Npad / 32, nitems = (K / 64) * nblk;
    for (int it = gw; it < nitems; it += NGW) cvt_item(W, g, K, N, WT, scr, it / nblk, it % nblk, F.lane);
}
__device__ __forceinline__ void cvt_layer_rest(Frame& F, int layer) {
    cvt_matrix(F, F.w_out + (size_t)layer * DM * DM, nullptr, DM, DM, DM, (bf16*)(F.ws + WS_WOUT));
    cvt_matrix(F, F.w_ff_in + (size_t)layer * DM * DFF, F.n2g + layer * DM, DM, DFF, DFF, (bf16*)(F.ws + WS_WFI));
    cvt_matrix(F, F.w_ff_out + (size_t)layer * DFF * DM, nullptr, DFF, DM, DM, (bf16*)(F.ws + WS_WFO));
    if (layer + 1 < DEPTH) cvt_matrix(F, F.w_in + (size_t)(layer + 1) * DM * DIN, F.n1g + (layer + 1) * DM, DM, DIN, DINP, (bf16*)(F.ws + WS_WIN));
}

__device__ __forceinline__ void p_prologue(Frame& F) {
    const int gtid = F.bid * NTHR + F.tid, NT = F.G * NTHR;
    GAS float* tab = (GAS float*)(F.ws + WS_ROPE);
    for (int idx = gtid; idx < M * 8; idx += NT) {
        const int row = idx >> 3, i = idx & 7;
        const float angf = (float)((const GAS int*)F.pos)[row] * c_invf[i];
        double r = (double)angf * 0.15915494309189535; r -= floor(r);
        const float a = (float)(r * 6.283185307179586);
        tab[row * 16 + i] = cosf(a); tab[row * 16 + 8 + i] = sinf(a);
    }
    if (gtid < 256) {
        const int c = gtid; GAS float* lb = (GAS float*)(F.ws + WS_LB); const GAS float* lbl = (const GAS float*)F.lb_logits;
        const float l0 = lbl[c], l1 = lbl[256 + c], l2 = lbl[512 + c], l3 = lbl[768 + c];
        const float mx = fmaxf(fmaxf(l0, l1), fmaxf(l2, l3));
        const float e0 = expf(l0 - mx), e1 = expf(l1 - mx), e2 = expf(l2 - mx), e3 = expf(l3 - mx);
        const float inv = 1.0f / (e0 + e1 + e2 + e3);
        lb[c] = 0.f; lb[256 + c] = e1 * inv; lb[512 + c] = (e1 + e2) * inv; lb[768 + c] = (e1 + e2 + e3) * inv;
    }
    const int gw = F.bid * NWAVES + F.wave, NGW = F.G * NWAVES;
    GAS bf16* xb = (GAS bf16*)(F.ws + WS_XB); GAS float* ssq = (GAS float*)(F.ws + WS_SSQ);
    for (int row = gw; row < M; row += NGW) {
        const GAS f32x4* xr = (const GAS f32x4*)(F.x_in + (size_t)row * DM) + F.lane;
        f32x4 v[4]; float s = 0.f;
#pragma unroll
        for (int j = 0; j < 4; ++j) { v[j] = xr[64 * j]; s += (v[j][0] * v[j][0] + v[j][1] * v[j][1]) + (v[j][2] * v[j][2] + v[j][3] * v[j][3]); }
        s = wave_sum(s);
        GAS unsigned long long* o8 = (GAS unsigned long long*)(xb + (size_t)row * DM) + F.lane;
#pragma unroll
        for (int j = 0; j < 4; ++j) o8[64 * j] = (unsigned long long)pk2(v[j][0], v[j][1]) | ((unsigned long long)pk2(v[j][2], v[j][3]) << 32);
        if (F.lane < 16) ssq[(size_t)row * 16 + F.lane] = (F.lane == 0) ? s : 0.f;
    }
    cvt_matrix(F, F.w_in, F.n1g, DM, DIN, DINP, (bf16*)(F.ws + WS_WIN));
}

constexpr int PL_WROW = 72, PL_PROW = 264, PL_WT_BYTES = 4 * 64 * PL_WROW * 2, PL_P_OFF = PL_WT_BYTES;
template <int WIN> __device__ __forceinline__ void pool_core(const GAS bf16* up, int tl0, LAS unsigned short* Pc) {
    float ps[49]; ps[0] = 0.f;
    float uv[48];
#pragma unroll
    for (int i = 0; i < 48; ++i) { const int tl = tl0 - 16 + i; uv[i] = (tl >= 0) ? bf2f(up[(long)(i - 16) * PROJ_LD]) : 0.f; }
    __builtin_amdgcn_sched_barrier(0);
#pragma unroll
    for (int i = 0; i < 48; ++i) ps[i + 1] = ps[i] + uv[i];
#pragma unroll
    for (int i = 16; i < 48; ++i) {
        const int tl = tl0 - 16 + i; const int cnt = (tl + 1 < WIN) ? tl + 1 : WIN;
        const float mean = (ps[i + 1] - ps[i + 1 - WIN]) / (float)cnt;
        Pc[(i - 16) * PL_PROW] = (unsigned short)f2bf(mean - uv[i]);
    }
}
__device__ __forceinline__ void p_pool(Frame& F, int layer) {
    LAS unsigned short* WT = (LAS unsigned short*)(F.lds + RING_OFF);
    LAS unsigned short* P = (LAS unsigned short*)(F.lds + RING_OFF + PL_P_OFF);
    const GAS bf16* proj = (const GAS bf16*)(F.ws + WS_PROJ); GAS bf16* mixed = (GAS bf16*)(F.ws + WS_MIXED);
    const GAS float* pw = (const GAS float*)F.pool_w + (size_t)layer * 4 * 64 * 64; const GAS float* ps_ = (const GAS float*)F.pool_scale + layer * 256;
    const int tid = F.tid, lane = F.lane, wave = F.wave;
#pragma unroll 8
    for (int i = 0; i < 32; ++i) { const int e = i * NTHR + tid; const int g = e >> 12, c = (e >> 6) & 63, d = e & 63; WT[(g * 64 + d) * PL_WROW + c] = (unsigned short)f2bf(pw[e]); }
    const int c = tid & 255, hf = tid >> 8, g = wave & 3;
    for (int unit = F.bid; unit < M / 64; unit += F.G) {
        const int t0 = unit * 64 + 32 * hf;
        { const GAS bf16* up = proj + (size_t)t0 * PROJ_LD + PC_POOL + c; LAS unsigned short* Pc = P + (32 * hf) * PL_PROW + c; const int tl0 = t0 & (SEQ - 1);
          if (g == 0) pool_core<2>(up, tl0, Pc); else if (g == 1) pool_core<4>(up, tl0, Pc); else if (g == 2) pool_core<8>(up, tl0, Pc); else pool_core<16>(up, tl0, Pc); }
        __syncthreads();
        { const int th = wave >> 2, fr = lane & 15, kg = lane >> 4;
#pragma unroll
          for (int tb = 0; tb < 2; ++tb) {
              bf16x8v af[2];
#pragma unroll
              for (int ks = 0; ks < 2; ++ks) af[ks] = *(const LAS bf16x8v*)(P + (32 * th + 16 * tb + fr) * PL_PROW + g * 64 + 32 * ks + 8 * kg);
#pragma unroll
              for (int db = 0; db < 4; ++db) {
                  f32x4 acc = {0.f, 0.f, 0.f, 0.f};
#pragma unroll
                  for (int ks = 0; ks < 2; ++ks) { const bf16x8v bfr = *(const LAS bf16x8v*)(WT + (g * 64 + 16 * db + fr) * PL_WROW + 32 * ks + 8 * kg);
                      acc = __builtin_amdgcn_mfma_f32_16x16x32_bf16(af[ks], bfr, acc, 0, 0, 0); }
                  const int dcol = g * 64 + 16 * db + fr; const float sc = ps_[dcol];
                  GAS bf16* op = mixed + (size_t)(unit * 64 + 32 * th + 16 * tb + 4 * kg) * DM + MC_POOL + dcol;
#pragma unroll
                  for (int r = 0; r < 4; ++r) op[(size_t)r * DM] = (bf16)f2bf(acc[r] * sc);
              }
          } }
        __syncthreads();
    }
}

__device__ __forceinline__ unsigned sort_key(float v) { if (v == 0.f) v = 0.f; const unsigned u = __builtin_bit_cast(unsigned, v); return (u & 0x80000000u) ? ~u : (u | 0x80000000u); }
constexpr int MK_STRIDE = 2049;
__device__ __forceinline__ void p_mask(Frame& F) {
    LAS unsigned* keys = (LAS unsigned*)(F.lds + RING_OFF);
    const GAS bf16* qi_hl = (const GAS bf16*)(F.ws + WS_QIHL); const GAS bf16* ki_hl = (const GAS bf16*)(F.ws + WS_KIHL); const GAS float* wi = (const GAS float*)(F.ws + WS_WI); GAS unsigned* mask = (GAS unsigned*)(F.ws + WS_MASK);
    const int tid = F.tid, lane = F.lane, wave = F.wave, q = lane & 15, kg = lane >> 4;
    for (int c = F.bid; c < 256; c += F.G) {
        for (int ui = 0; ui < 4; ++ui) {
            const int b = (c >> 6) * 2 + (ui >> 1), bq = c & 63, qb = (ui & 1) ? 127 - bq : bq;
            const int t0 = qb * 16; const size_t rowq0 = (size_t)b * SEQ + t0;
            if (qb < 16) {
                for (int w = tid; w < 1024; w += NTHR) { const int qq = w >> 6, j = w & 63, n = t0 + qq + 1, lo = j * 32;
                    mask[(rowq0 + qq) * 64 + j] = (n >= lo + 32) ? 0xffffffffu : (n > lo ? ((1u << (n - lo)) - 1u) : 0u); }
                continue;
            }
            bf16x8v bh[4][2], bl[4][2];
#pragma unroll
            for (int h = 0; h < 4; ++h)
#pragma unroll
                for (int dh = 0; dh < 2; ++dh) { const GAS bf16* pq = qi_hl + (rowq0 + q) * 512 + h * 64 + dh * 32 + kg * 8;
                    bh[h][dh] = *(const GAS bf16x8v*)pq; bl[h][dh] = *(const GAS bf16x8v*)(pq + 256); }
            const f32x4 wv = *(const GAS f32x4*)(wi + (rowq0 + q) * 4);
            const int ntile = qb + 1;
            bf16x8v ah[2], al[2];
            { const int kt0 = wave < ntile ? wave : 0;
#pragma unroll
              for (int dh = 0; dh < 2; ++dh) { const GAS bf16* pk = ki_hl + ((size_t)b * SEQ + kt0 * 16 + q) * 128 + dh * 32 + kg * 8;
                  ah[dh] = *(const GAS bf16x8v*)pk; al[dh] = *(const GAS bf16x8v*)(pk + 64); } }
            for (int kt = wave; kt < ntile; kt += NWAVES) {
                const int s0 = kt * 16;
                bf16x8v ahn[2], aln[2];
                { const int ktn = (kt + NWAVES < ntile) ? kt + NWAVES : kt;
#pragma unroll
                  for (int dh = 0; dh < 2; ++dh) { const GAS bf16* pk = ki_hl + ((size_t)b * SEQ + ktn * 16 + q) * 128 + dh * 32 + kg * 8;
                      ahn[dh] = *(const GAS bf16x8v*)pk; aln[dh] = *(const GAS bf16x8v*)(pk + 64); } }
                __builtin_amdgcn_sched_barrier(0);
                f32x4 acc[4];
#pragma unroll
                for (int h = 0; h < 4; ++h) { acc[h] = (f32x4){0.f, 0.f, 0.f, 0.f};
#pragma unroll
                    for (int dh = 0; dh < 2; ++dh) {
                        acc[h] = __builtin_amdgcn_mfma_f32_16x16x32_bf16(ah[dh], bh[h][dh], acc[h], 0, 0, 0);
                        acc[h] = __builtin_amdgcn_mfma_f32_16x16x32_bf16(ah[dh], bl[h][dh], acc[h], 0, 0, 0);
                        acc[h] = __builtin_amdgcn_mfma_f32_16x16x32_bf16(al[dh], bh[h][dh], acc[h], 0, 0, 0);
                    } }
#pragma unroll
                for (int r = 0; r < 4; ++r) {
                    const float I = wv[0] * fmaxf(acc[0][r], 0.f) + wv[1] * fmaxf(acc[1][r], 0.f) + wv[2] * fmaxf(acc[2][r], 0.f) + wv[3] * fmaxf(acc[3][r], 0.f);
                    const int s = s0 + 4 * kg + r;
                    keys[q * MK_STRIDE + s] = (s <= t0 + q) ? sort_key(I) : 0u;
                }
                __builtin_amdgcn_sched_barrier(0);
#pragma unroll
                for (int dh = 0; dh < 2; ++dh) { ah[dh] = ahn[dh]; al[dh] = aln[dh]; }
            }
            __syncthreads();
            const int nk = t0 + 16;
            for (int qq = 2 * wave; qq < 2 * wave + 2; ++qq) {
                unsigned k[32];
#pragma unroll
                for (int i = 0; i < 32; ++i) { const int s = lane + 64 * i; k[i] = (s < nk) ? keys[qq * MK_STRIDE + s] : 0u; }
                unsigned prefix = 0u; bool exact = false;
                for (int bit = 31; bit >= 0; --bit) {
                    const unsigned cand = prefix | (1u << bit);
                    unsigned cnt = 0u;
#pragma unroll
                    for (int i = 0; i < 32; ++i) cnt += (unsigned)__popcll(__ballot(k[i] >= cand));
                    if (cnt >= (unsigned)TOPK) { prefix = cand; if (cnt == (unsigned)TOPK) { exact = true; break; } }
                }
                GAS unsigned* mrow = mask + (rowq0 + qq) * 64;
                if (exact) {
#pragma unroll
                    for (int i = 0; i < 32; ++i) { const unsigned long long sb = __ballot(k[i] >= prefix); if (lane == 0) *(GAS v2u*)(mrow + 2 * i) = (v2u){(unsigned)sb, (unsigned)(sb >> 32)}; }
                } else {
                    const unsigned tau = prefix; unsigned cgt = 0u;
#pragma unroll
                    for (int i = 0; i < 32; ++i) cgt += (unsigned)__popcll(__ballot(k[i] > tau));
                    const unsigned need = (unsigned)TOPK - cgt; unsigned base = 0u;
#pragma unroll
                    for (int i = 0; i < 32; ++i) {
                        const unsigned long long eqb = __ballot(k[i] == tau);
                        const unsigned rank = base + (unsigned)__popcll(eqb & ((1ull << lane) - 1ull));
                        const unsigned long long sb = __ballot((k[i] > tau) || ((k[i] == tau) && (rank < need)));
                        if (lane == 0) *(GAS v2u*)(mrow + 2 * i) = (v2u){(unsigned)sb, (unsigned)(sb >> 32)};
                        base += (unsigned)__popcll(eqb);
                    }
                }
            }
            __syncthreads();
        }
    }
}

typedef short s16x4 __attribute__((ext_vector_type(4)));
#define MFMA16(a, b, c) __builtin_amdgcn_mfma_f32_16x16x16bf16_1k((a), (b), (c), 0, 0, 0)
__device__ __forceinline__ s16x4 pack4(const f32x4 v) { v2u t; t.x = cvtpk(v[0], v[1]); t.y = cvtpk(v[2], v[3]); return __builtin_bit_cast(s16x4, t); }
constexpr int HG_QT = 0, HG_KT = 2176, HG_KH = 4352, HG_IT = 7424, HG_DF = 10496, HG_WAVE_LDS = 10752;
template <bool FULL> __device__ __forceinline__ float hgrn_stage(const GAS bf16* pr, float lbv, LAS unsigned char* W, int lane) {
    unsigned short zr[16], ir[16], qr[16];
#pragma unroll
    for (int s_ = 0; s_ < 16; ++s_) { zr[s_] = pr[(size_t)s_ * PROJ_LD + PC_HF]; ir[s_] = pr[(size_t)s_ * PROJ_LD + PC_HI]; if (FULL) qr[s_] = pr[(size_t)s_ * PROJ_LD + PC_HQ]; }
    __builtin_amdgcn_sched_barrier(0);
    float f[16], kk[16]; float P = 1.0f;
    LAS unsigned short* QT = (LAS unsigned short*)(W + HG_QT); LAS unsigned short* KT = (LAS unsigned short*)(W + HG_KT);
#pragma unroll
    for (int s_ = 0; s_ < 16; ++s_) {
        const float z = bf2f(zr[s_]);
        const float sig = 1.0f / (1.0f + __expf(-z));
        f[s_] = fmaxf(lbv + (1.0f - lbv) * sig, 1e-30f); kk[s_] = (1.0f - lbv) * (1.0f - sig);
        P *= f[s_];
        if (FULL) { const float q = bf2f(qr[s_]); const float qs = q / (1.0f + __expf(-q));
            QT[s_ * 68 + lane] = (unsigned short)f2bf(qs * P); KT[s_ * 68 + lane] = (unsigned short)f2bf(kk[s_] / fmaxf(P, 1e-30f)); }
    }
    float E = 1.0f; unsigned kh[8];
#pragma unroll
    for (int s_ = 15; s_ >= 0; s_ -= 2) {
        const float hi = kk[s_] * E; E *= f[s_];
        const float lo = kk[s_ - 1] * E; E *= f[s_ - 1];
        kh[s_ >> 1] = cvtpk(lo, hi);
    }
    LAS v4u* KH = (LAS v4u*)(W + HG_KH + lane * 48); LAS v4u* IT = (LAS v4u*)(W + HG_IT + lane * 48);
    KH[0] = (v4u){kh[0], kh[1], kh[2], kh[3]}; KH[1] = (v4u){kh[4], kh[5], kh[6], kh[7]};
    IT[0] = (v4u){(unsigned)ir[0] | ((unsigned)ir[1] << 16), (unsigned)ir[2] | ((unsigned)ir[3] << 16), (unsigned)ir[4] | ((unsigned)ir[5] << 16), (unsigned)ir[6] | ((unsigned)ir[7] << 16)};
    IT[1] = (v4u){(unsigned)ir[8] | ((unsigned)ir[9] << 16), (unsigned)ir[10] | ((unsigned)ir[11] << 16), (unsigned)ir[12] | ((unsigned)ir[13] << 16), (unsigned)ir[14] | ((unsigned)ir[15] << 16)};
    ((LAS float*)(W + HG_DF))[lane] = P;
    return P;
}
__device__ __forceinline__ void hgrn_update(f32x4 (&S)[4][4], const LAS unsigned char* W, int fr, int kg) {
    s16x4 khf[4], itf[4]; f32x4 df[4];
#pragma unroll
    for (int i = 0; i < 4; ++i) { khf[i] = *(const LAS s16x4*)(W + HG_KH + (16 * i + fr) * 48 + 8 * kg); itf[i] = *(const LAS s16x4*)(W + HG_IT + (16 * i + fr) * 48 + 8 * kg);
        df[i] = *(const LAS f32x4*)(W + HG_DF + (16 * i + 4 * kg) * 4); }
#pragma unroll
    for (int kb = 0; kb < 4; ++kb)
#pragma unroll
        for (int vb = 0; vb < 4; ++vb) S[kb][vb] = MFMA16(khf[kb], itf[vb], S[kb][vb] * df[kb]);
}
__device__ __forceinline__ void p_hgrn_local(Frame& F, int layer) {
    const int lane = F.lane, fr = lane & 15, kg = lane >> 4;
    LAS unsigned char* W = F.lds + RING_OFF + F.wave * 16384;
    const GAS bf16* proj = (const GAS bf16*)(F.ws + WS_PROJ); GAS float* hst = (GAS float*)(F.ws + WS_HST); GAS float* hdn = (GAS float*)(F.ws + WS_HDN);
    for (int unit = F.wave * F.G + F.bid; unit < BATCH * 4 * (SEQ / 64); unit += NWAVES * F.G) {
        const int bh = unit >> 5, chunk = unit & 31, b = bh >> 2, h = bh & 3;
        const float lbv = ((const GAS float*)(F.ws + WS_LB))[layer * 256 + h * 64 + lane];
        const size_t row0 = (size_t)b * SEQ + chunk * 64;
        f32x4 S[4][4];
#pragma unroll
        for (int i = 0; i < 4; ++i)
#pragma unroll
            for (int j = 0; j < 4; ++j) S[i][j] = (f32x4){0.f, 0.f, 0.f, 0.f};
        float dprod = 1.0f;
        for (int sub = 0; sub < 4; ++sub) {
            dprod *= hgrn_stage<false>(proj + (row0 + sub * 16) * PROJ_LD + h * 64 + lane, lbv, W, lane);
            LDS_WAIT(); asm volatile("" ::: "memory");
            hgrn_update(S, W, fr, kg);
            LDS_WAIT(); asm volatile("" ::: "memory");
        }
        GAS float* U = hst + (size_t)unit * 4096;
#pragma unroll
        for (int kb = 0; kb < 4; ++kb)
#pragma unroll
            for (int vb = 0; vb < 4; ++vb)
#pragma unroll
                for (int r = 0; r < 4; ++r) U[(16 * kb + 4 * kg + r) * 64 + 16 * vb + fr] = S[kb][vb][r];
        hdn[unit * 64 + lane] = dprod;
    }
}
__device__ __forceinline__ void p_hgrn_scan(Frame& F) {
    GAS float* hst = (GAS float*)(F.ws + WS_HST); const GAS float* hdn = (const GAS float*)(F.ws + WS_HDN);
    for (int e = F.bid * NTHR + F.tid; e < BATCH * 4 * 4096; e += F.G * NTHR) {
        const int bh = e >> 12, kv = e & 4095, k = kv >> 6;
        float S = 0.f;
        for (int n = 0; n < SEQ / 64; ++n) {
            const size_t idx = ((size_t)(bh * 32 + n) << 12) + kv;
            const float u = hst[idx]; hst[idx] = S;
            S = hdn[(bh * 32 + n) * 64 + k] * S + u;
        }
    }
}
constexpr int HG_LDS_OFF = 40960;
__device__ __forceinline__ void p_hgrn_out(Frame& F, int layer) {
    const int lane = F.lane, fr = lane & 15, kg = lane >> 4;
    LAS unsigned char* W = F.lds + RING_OFF + HG_LDS_OFF + F.wave * HG_WAVE_LDS;
    const GAS bf16* proj = (const GAS bf16*)(F.ws + WS_PROJ); GAS bf16* mixed = (GAS bf16*)(F.ws + WS_MIXED); const GAS float* hst = (const GAS float*)(F.ws + WS_HST);
    for (int unit = F.wave * F.G + F.bid; unit < BATCH * 4 * (SEQ / 64); unit += NWAVES * F.G) {
        const int bh = unit >> 5, chunk = unit & 31, b = bh >> 2, h = bh & 3;
        const float lbv = ((const GAS float*)(F.ws + WS_LB))[layer * 256 + h * 64 + lane];
        const size_t row0 = (size_t)b * SEQ + chunk * 64;
        f32x4 S[4][4];
        { const GAS float* U = hst + (size_t)unit * 4096;
#pragma unroll
          for (int kb = 0; kb < 4; ++kb)
#pragma unroll
              for (int vb = 0; vb < 4; ++vb)
#pragma unroll
                  for (int r = 0; r < 4; ++r) S[kb][vb][r] = U[(16 * kb + 4 * kg + r) * 64 + 16 * vb + fr]; }
        f32x4 ng4[4];
#pragma unroll
        for (int vb = 0; vb < 4; ++vb) ng4[vb] = *(const GAS f32x4*)((const GAS float*)F.hgrn_g + layer * 256 + h * 64 + 16 * vb + 4 * kg);
        for (int sub = 0; sub < 4; ++sub) {
            const size_t rs = row0 + sub * 16;
            (void)hgrn_stage<true>(proj + rs * PROJ_LD + h * 64 + lane, lbv, W, lane);
            v2u g2[4];
#pragma unroll
            for (int vb = 0; vb < 4; ++vb) g2[vb] = *(const GAS v2u*)(proj + (rs + fr) * PROJ_LD + PC_HG + h * 64 + 16 * vb + 4 * kg);
            LDS_WAIT(); asm volatile("" ::: "memory");
            s16x4 qb[4];
#pragma unroll
            for (int kb = 0; kb < 4; ++kb) qb[kb] = *(const LAS s16x4*)(W + HG_QT + (fr * 68 + 16 * kb + 4 * kg) * 2);
            f32x4 o[4];
#pragma unroll
            for (int vb = 0; vb < 4; ++vb) { o[vb] = (f32x4){0.f, 0.f, 0.f, 0.f};
#pragma unroll
                for (int kb = 0; kb < 4; ++kb) o[vb] = MFMA16(pack4(S[kb][vb]), qb[kb], o[vb]); }
            f32x4 at = {0.f, 0.f, 0.f, 0.f};
#pragma unroll
            for (int kb = 0; kb < 4; ++kb) at = MFMA16(*(const LAS s16x4*)(W + HG_KT + (fr * 68 + 16 * kb + 4 * kg) * 2), qb[kb], at);
#pragma unroll
            for (int r = 0; r < 4; ++r) if (4 * kg + r > fr) at[r] = 0.f;
            const s16x4 ab = pack4(at);
#pragma unroll
            for (int vb = 0; vb < 4; ++vb) o[vb] = MFMA16(*(const LAS s16x4*)(W + HG_IT + (16 * vb + fr) * 48 + 8 * kg), ab, o[vb]);
            hgrn_update(S, W, fr, kg);
            float ssq = 0.f;
#pragma unroll
            for (int vb = 0; vb < 4; ++vb) ssq += (o[vb][0] * o[vb][0] + o[vb][1] * o[vb][1]) + (o[vb][2] * o[vb][2] + o[vb][3] * o[vb][3]);
            ssq += __shfl_xor(ssq, 16); ssq += __shfl_xor(ssq, 32);
            const float rstd = 1.0f / sqrtf(ssq * (1.0f / 64.0f) + 1e-5f);
#pragma unroll
            for (int vb = 0; vb < 4; ++vb) {
                const float g0 = __builtin_bit_cast(float, g2[vb].x << 16), g1 = __builtin_bit_cast(float, g2[vb].x & 0xffff0000u), g2f = __builtin_bit_cast(float, g2[vb].y << 16), g3 = __builtin_bit_cast(float, g2[vb].y & 0xffff0000u);
                const float y0 = o[vb][0] * rstd * ng4[vb][0] * (g0 / (1.0f + __expf(-g0))), y1 = o[vb][1] * rstd * ng4[vb][1] * (g1 / (1.0f + __expf(-g1)));
                const float y2 = o[vb][2] * rstd * ng4[vb][2] * (g2f / (1.0f + __expf(-g2f))), y3 = o[vb][3] * rstd * ng4[vb][3] * (g3 / (1.0f + __expf(-g3)));
                *(GAS v2u*)(mixed + (rs + fr) * DM + MC_HGRN + h * 64 + 16 * vb + 4 * kg) = (v2u){cvtpk(y0, y1), cvtpk(y2, y3)};
            }
            LDS_WAIT(); asm volatile("" ::: "memory");
        }
    }
}

constexpr int AT_KROW = 144, AT_VROW = 136, AT_KBYTES = 64 * AT_KROW, AT_VBYTES = 64 * AT_VROW, AT_BUF = AT_KBYTES + AT_VBYTES, AT_SCR = 2 * AT_BUF;
static_assert(AT_BUF % 16 == 0 && AT_SCR % 16 == 0, "attention LDS map alignment");
__device__ __forceinline__ void p_attn_flash(Frame& F) {
    const int tid = F.tid, lane = F.lane, wave = F.wave;
    const int r = lane & 31, hh = lane >> 5, g = wave & 3, qh = wave >> 2;
    LAS unsigned char* L = F.lds + RING_OFF;
    LAS float* scr = (LAS float*)(L + AT_SCR) + wave * 32;
    const GAS bf16* proj = (const GAS bf16*)(F.ws + WS_PROJ); const GAS bf16* vT = (const GAS bf16*)(F.ws + WS_VT); GAS bf16* mixed = (GAS bf16*)(F.ws + WS_MIXED);
    const GAS unsigned* mask = (const GAS unsigned*)(F.ws + WS_MASK);
    const int srow = tid >> 3, sch = tid & 7;
    const float C2 = 0.18033688011112042f, NEG = -1.0e30f;
    for (int pair = F.bid; pair < 256; pair += F.G) {
        const int bk = pair >> 4, b = bk >> 1, kvh = bk & 1, pp = pair & 15, h = kvh * 4 + g;
        for (int half = 0; half < 2; ++half) {
            const int qblk = half == 0 ? 31 - pp : pp;
            const int q0 = qblk * 64, nt = qblk + 1;
            const int tq = q0 + 32 * qh + r;
            bf16x8v qf[4];
            { const GAS bf16* qp = proj + (size_t)(b * SEQ + tq) * PROJ_LD + PC_Q + h * 64 + 8 * hh;
#pragma unroll
              for (int d0 = 0; d0 < 4; ++d0) qf[d0] = *(const GAS bf16x8v*)(qp + 16 * d0); }
            const GAS unsigned* mrow = mask + (size_t)(b * SEQ + tq) * 64;
            const GAS bf16* kg = proj + (size_t)(b * SEQ + srow) * PROJ_LD + PC_K + kvh * 64 + sch * 8;
            const GAS bf16* vg = vT + (size_t)(bk * 64 + srow) * SEQ + sch * 8;
            { const v4u kreg = *(const GAS v4u*)kg; const v4u vreg = *(const GAS v4u*)vg;
              *(LAS v4u*)(L + srow * AT_KROW + sch * 16) = kreg;
              LAS unsigned char* vd = L + AT_KBYTES + srow * AT_VROW + sch * 16;
              *(LAS v2u*)vd = (v2u){vreg.x, vreg.y}; *(LAS v2u*)(vd + 8) = (v2u){vreg.z, vreg.w}; }
            v2u mw = *(const GAS v2u*)mrow;
            __syncthreads();
            f32x16 o0, o1;
#pragma unroll
            for (int i = 0; i < 16; ++i) { o0[i] = 0.f; o1[i] = 0.f; }
            float m = -30000.0f, l = 0.f;
            for (int j = 0; j < nt; ++j) {
                LAS unsigned char* Kb = L + (j & 1) * AT_BUF; LAS unsigned char* Vb = Kb + AT_KBYTES;
                const bool more = (j + 1 < nt);
                const int jn = more ? j + 1 : j;
                const v4u kn = *(const GAS v4u*)(kg + (size_t)jn * 64 * PROJ_LD); const v4u vn = *(const GAS v4u*)(vg + jn * 64); const v2u mwn = *(const GAS v2u*)(mrow + 2 * jn);
                bf16x8v kf[8];
#pragma unroll
                for (int d0 = 0; d0 < 4; ++d0) { kf[2 * d0] = *(const LAS bf16x8v*)(Kb + r * AT_KROW + d0 * 32 + hh * 16); kf[2 * d0 + 1] = *(const LAS bf16x8v*)(Kb + (32 + r) * AT_KROW + d0 * 32 + hh * 16); }
                __builtin_amdgcn_sched_barrier(0);
                f32x16 p0, p1;
#pragma unroll
                for (int i = 0; i < 16; ++i) { p0[i] = 0.f; p1[i] = 0.f; }
#pragma unroll
                for (int d0 = 0; d0 < 4; ++d0) {
                    p0 = __builtin_amdgcn_mfma_f32_32x32x16_bf16(kf[2 * d0], qf[d0], p0, 0, 0, 0);
                    p1 = __builtin_amdgcn_mfma_f32_32x32x16_bf16(kf[2 * d0 + 1], qf[d0], p1, 0, 0, 0);
                }
                v2u vl[8], vh[8];
#pragma unroll
                for (int ks = 0; ks < 4; ++ks) {
                    const LAS unsigned char* vp = Vb + r * AT_VROW + (16 * ks + 4 * hh) * 2;
                    vl[2 * ks] = *(const LAS v2u*)vp; vh[2 * ks] = *(const LAS v2u*)(vp + 16);
                    vl[2 * ks + 1] = *(const LAS v2u*)(vp + 32 * AT_VROW); vh[2 * ks + 1] = *(const LAS v2u*)(vp + 32 * AT_VROW + 16);
                }
                __builtin_amdgcn_sched_barrier(0);
                const unsigned w0 = mw.x >> (4 * hh), w1 = mw.y >> (4 * hh);
                float mx = NEG;
#pragma unroll
                for (int i = 0; i < 16; ++i) {
                    const int cr = (i & 3) + 8 * (i >> 2);
                    p0[i] = ((w0 >> cr) & 1u) ? p0[i] : NEG; p1[i] = ((w1 >> cr) & 1u) ? p1[i] : NEG;
                    mx = fmaxf(mx, fmaxf(p0[i], p1[i]));
                }
                mx = fmaxf(mx, __shfl_xor(mx, 32));
                const float mxs = mx * C2;
                const bool need = mxs > m + 8.0f;
                if (__any(need)) {
                    const float mnew = need ? mxs : m;
                    const float alpha = __builtin_amdgcn_exp2f(m - mnew); m = mnew; l *= alpha;
                    if (hh == 0) scr[r] = alpha;
#pragma unroll
                    for (int gq = 0; gq < 4; ++gq) {
                        const f32x4 a4 = *(const LAS f32x4*)(scr + 8 * gq + 4 * hh);
#pragma unroll
                        for (int e = 0; e < 4; ++e) { o0[4 * gq + e] *= a4[e]; o1[4 * gq + e] *= a4[e]; }
                    }
                }
                float rs = 0.f;
#pragma unroll
                for (int i = 0; i < 16; ++i) {
                    p0[i] = __builtin_amdgcn_exp2f(__builtin_fmaf(p0[i], C2, -m)); p1[i] = __builtin_amdgcn_exp2f(__builtin_fmaf(p1[i], C2, -m));
                    rs += p0[i] + p1[i];
                }
                l += rs;
                bf16x8v pf[4];
                { v4u t;
                  t.x = cvtpk(p0[0], p0[1]); t.y = cvtpk(p0[2], p0[3]); t.z = cvtpk(p0[4], p0[5]); t.w = cvtpk(p0[6], p0[7]); pf[0] = __builtin_bit_cast(bf16x8v, t);
                  t.x = cvtpk(p0[8], p0[9]); t.y = cvtpk(p0[10], p0[11]); t.z = cvtpk(p0[12], p0[13]); t.w = cvtpk(p0[14], p0[15]); pf[1] = __builtin_bit_cast(bf16x8v, t);
                  t.x = cvtpk(p1[0], p1[1]); t.y = cvtpk(p1[2], p1[3]); t.z = cvtpk(p1[4], p1[5]); t.w = cvtpk(p1[6], p1[7]); pf[2] = __builtin_bit_cast(bf16x8v, t);
                  t.x = cvtpk(p1[8], p1[9]); t.y = cvtpk(p1[10], p1[11]); t.z = cvtpk(p1[12], p1[13]); t.w = cvtpk(p1[14], p1[15]); pf[3] = __builtin_bit_cast(bf16x8v, t); }
                __builtin_amdgcn_sched_barrier(0);
#pragma unroll
                for (int ks = 0; ks < 4; ++ks) {
                    const bf16x8v vf0 = __builtin_bit_cast(bf16x8v, (v4u){vl[2 * ks].x, vl[2 * ks].y, vh[2 * ks].x, vh[2 * ks].y});
                    const bf16x8v vf1 = __builtin_bit_cast(bf16x8v, (v4u){vl[2 * ks + 1].x, vl[2 * ks + 1].y, vh[2 * ks + 1].x, vh[2 * ks + 1].y});
                    o0 = __builtin_amdgcn_mfma_f32_32x32x16_bf16(pf[ks], vf0, o0, 0, 0, 0);
                    o1 = __builtin_amdgcn_mfma_f32_32x32x16_bf16(pf[ks], vf1, o1, 0, 0, 0);
                }
                __builtin_amdgcn_sched_barrier(0);
                if (more) {
                    LAS unsigned char* Kn = L + ((j + 1) & 1) * AT_BUF;
                    *(LAS v4u*)(Kn + srow * AT_KROW + sch * 16) = kn;
                    LAS unsigned char* vd = Kn + AT_KBYTES + srow * AT_VROW + sch * 16;
                    *(LAS v2u*)vd = (v2u){vn.x, vn.y}; *(LAS v2u*)(vd + 8) = (v2u){vn.z, vn.w};
                }
                mw = mwn;
                __syncthreads();
            }
            l += __shfl_xor(l, 32);
            if (hh == 0) scr[r] = 1.0f / l;
            GAS bf16* op = mixed + (size_t)(b * SEQ + q0 + 32 * qh) * DM + MC_ATTN + h * 64 + r;
#pragma unroll
            for (int gq = 0; gq < 4; ++gq) {
                const f32x4 a4 = *(const LAS f32x4*)(scr + 8 * gq + 4 * hh);
#pragma unroll
                for (int e = 0; e < 4; ++e) {
                    const int q = 8 * gq + 4 * hh + e;
                    op[(size_t)q * DM] = (bf16)f2bf(o0[4 * gq + e] * a4[e]); op[(size_t)q * DM + 32] = (bf16)f2bf(o1[4 * gq + e] * a4[e]);
                }
            }
        }
    }
}

__device__ __forceinline__ void p_final(Frame& F) {
    const int gw = F.bid * NWAVES + F.wave, NGW = F.G * NWAVES;
    for (int row = gw; row < M; row += NGW) {
        GAS f32x4* xr = (GAS f32x4*)(F.xres + (size_t)row * DM) + F.lane;
        const GAS f32x4* gr = (const GAS f32x4*)F.fng + F.lane;
        f32x4 v[4]; float s = 0.f;
#pragma unroll
        for (int j = 0; j < 4; ++j) { v[j] = xr[64 * j]; s += (v[j][0] * v[j][0] + v[j][1] * v[j][1]) + (v[j][2] * v[j][2] + v[j][3] * v[j][3]); }
        s = wave_sum(s);
        const float rs = 1.0f / sqrtf(s * (1.0f / 1024.0f) + 1e-5f);
#pragma unroll
        for (int j = 0; j < 4; ++j) xr[64 * j] = v[j] * rs * gr[64 * j];
    }
}

#ifndef MK_SINGLE
#define MK_SINGLE 1
#endif
constexpr int NPL = 7;
constexpr int NPHASE = 1 + DEPTH * NPL + 1;
struct Args { const float* x; const int* pos; const float *n1g, *w_in, *pool_w, *pool_scale, *lb_logits, *hgrn_g, *w_out, *n2g, *w_ff_in, *w_ff_out, *fng; float* out; unsigned char* ws; int ph_lo, ph_hi; };
static_assert(sizeof(Args) == 15 * 8 + 8, "Args has no padding");


#define PHASE_BEGIN() do { int t_ = threadIdx.x; asm volatile("" : "+v"(t_)); F.tid = t_; F.lane = t_ & 63; F.wave = __builtin_amdgcn_readfirstlane(t_ >> 6); \
    unsigned char* w_ = args.ws; asm volatile("" : "+s"(w_)); F.ws = w_; } while (0)
__global__ void __launch_bounds__(NTHR, 2) fwd(Args args) {
    extern __shared__ __attribute__((aligned(16))) unsigned char lds[];
    Frame F;
    F.lds = (LAS unsigned char*)lds;
    F.MISC = (volatile LAS unsigned*)(F.lds + MISC_OFF);
    F.tid = threadIdx.x; F.lane = F.tid & 63; F.wave = __builtin_amdgcn_readfirstlane(F.tid >> 6);
    F.G = gridDim.x; F.bid = blockIdx.x;
    F.ws = args.ws; F.ctl = (gu32*)(args.ws + WS_CTL);
    F.x_in = args.x; F.pos = args.pos; F.n1g = args.n1g; F.w_in = args.w_in; F.pool_w = args.pool_w; F.pool_scale = args.pool_scale; F.lb_logits = args.lb_logits;
    F.hgrn_g = args.hgrn_g; F.w_out = args.w_out; F.n2g = args.n2g; F.w_ff_in = args.w_ff_in; F.w_ff_out = args.w_ff_out; F.fng = args.fng; F.xres = args.out;
    for (int u = F.tid; u < (LDS_BYTES - LDSCTL_OFF) / 4; u += NTHR) ((LAS unsigned*)(F.lds + LDSCTL_OFF))[u] = 0u;
    __syncthreads();
    XcdBarrier bar; bar.bar = (unsigned*)(F.ctl + CW_BAR); bar.x = 0; bar.st = nullptr;
    if (MK_SINGLE) bar = xcd_barrier_post((unsigned*)(F.ctl + CW_BAR), F.MISC + 8);
    const int lo = args.ph_lo, hi = args.ph_hi;
#define IN(k) (lo <= (k) && (k) < hi)
#define SEAM(k) do { if (MK_SINGLE && IN(k) && IN((k) + 1)) xcd_barrier(bar); } while (0)
    bf16* const xb = (bf16*)(F.ws + WS_XB); float* const ssq = (float*)(F.ws + WS_SSQ);
    bf16* const proj = (bf16*)(F.ws + WS_PROJ); bf16* const mixed = (bf16*)(F.ws + WS_MIXED); bf16* const hid = (bf16*)(F.ws + WS_HID);

    if (IN(0)) { PHASE_BEGIN(); p_prologue(F); } SEAM(0);
    for (int layer = 0; layer < DEPTH; ++layer) {
        const int pb = 1 + layer * NPL;
        if (IN(pb + 0)) {
            pg8::Gemm g{xb, (const bf16*)(F.ws + WS_WIN), M, DINP, DM}; pg8::StaticOrder S; S.init(M, DINP, F.G, F.bid);
            pg8::EpiIn E{proj, (bf16*)(F.ws + WS_QIHL), (bf16*)(F.ws + WS_KIHL), (float*)(F.ws + WS_WI), (bf16*)(F.ws + WS_VT), ssq, (const float*)(F.ws + WS_ROPE)};
            pg8::gemm_phase<pg8::EpiIn, pg8::StaticOrder, true, true>(F.lds + RING_OFF, g, S, E);
        } SEAM(pb + 0);
        if (IN(pb + 1)) { PHASE_BEGIN(); cvt_layer_rest(F, layer); PHASE_BEGIN(); p_hgrn_local(F, layer); } SEAM(pb + 1);
        if (IN(pb + 2)) { PHASE_BEGIN(); p_pool(F, layer); PHASE_BEGIN(); p_mask(F); PHASE_BEGIN(); p_hgrn_scan(F); } SEAM(pb + 2);
        if (IN(pb + 3)) { PHASE_BEGIN(); p_hgrn_out(F, layer); PHASE_BEGIN(); p_attn_flash(F); } SEAM(pb + 3);
        if (IN(pb + 4)) {
            pg8::Gemm g{mixed, (const bf16*)(F.ws + WS_WOUT), M, DM, DM}; pg8::StaticOrder S; S.init(M, DM, F.G, F.bid);
            pg8::EpiRes E{layer == 0 ? F.x_in : (const float*)F.xres, F.xres, xb, ssq};
            pg8::gemm_phase<pg8::EpiRes, pg8::StaticOrder, true, true>(F.lds + RING_OFF, g, S, E);
        } SEAM(pb + 4);
        if (IN(pb + 5)) {
            pg8::Gemm g{xb, (const bf16*)(F.ws + WS_WFI), M, DFF, DM}; pg8::StaticOrder S; S.init(M, DFF, F.G, F.bid);
            pg8::EpiFfIn E{hid, ssq};
            pg8::gemm_phase<pg8::EpiFfIn, pg8::StaticOrder, true, true>(F.lds + RING_OFF, g, S, E);
        } SEAM(pb + 5);
        if (IN(pb + 6)) {
            pg8::Gemm g{hid, (const bf16*)(F.ws + WS_WFO), M, DM, DFF}; pg8::StaticOrder S; S.init(M, DM, F.G, F.bid);
            pg8::EpiRes E{(const float*)F.xres, F.xres, xb, ssq};
            pg8::gemm_phase<pg8::EpiRes, pg8::StaticOrder, true, true>(F.lds + RING_OFF, g, S, E);
        } SEAM(pb + 6);
    }
    if (IN(NPHASE - 1)) { PHASE_BEGIN(); p_final(F); }
#undef IN
#undef SEAM
}

extern "C" void kernel_launch(void* const* d_in, const int* in_sizes, int n_in, void* d_out, int out_size, void* d_ws, size_t ws_size, hipStream_t stream) {
    static int grid = 0;
    if (grid == 0) {
        if (n_in != 13 || out_size != M * DM || ws_size < WS_END) { fprintf(stderr, "kernel_launch: unexpected shapes (n_in %d, out %d, ws %zu)\n", n_in, out_size, ws_size); grid = -1; return; }
        int dev = 0, cus = 0, per_cu = 0;
        if (hipGetDevice(&dev) != hipSuccess || hipDeviceGetAttribute(&cus, hipDeviceAttributeMultiprocessorCount, dev) != hipSuccess) { grid = -1; return; }
        if (hipFuncSetAttribute((const void*)fwd, hipFuncAttributeMaxDynamicSharedMemorySize, LDS_BYTES) != hipSuccess) { fprintf(stderr, "kernel_launch: hipFuncSetAttribute failed\n"); grid = -1; return; }
        if (hipOccupancyMaxActiveBlocksPerMultiprocessor(&per_cu, (const void*)fwd, NTHR, LDS_BYTES) != hipSuccess || per_cu < 1) { fprintf(stderr, "kernel_launch: occupancy query says %d\n", per_cu); }
        (void)hipGetLastError();
        grid = cus;
        if (grid > 256) grid = 256;
        grid -= grid % 8;
    }
    if (grid <= 0) return;
    (void)hipMemsetAsync((char*)d_ws + WS_CTL, 0, CTL_ZERO_BYTES, stream);
    Args a{};
    a.x = (const float*)d_in[0]; a.pos = (const int*)d_in[1]; a.n1g = (const float*)d_in[2]; a.w_in = (const float*)d_in[3]; a.pool_w = (const float*)d_in[4];
    a.pool_scale = (const float*)d_in[5]; a.lb_logits = (const float*)d_in[6]; a.hgrn_g = (const float*)d_in[7]; a.w_out = (const float*)d_in[8]; a.n2g = (const float*)d_in[9];
    a.w_ff_in = (const float*)d_in[10]; a.w_ff_out = (const float*)d_in[11]; a.fng = (const float*)d_in[12];
    a.out = (float*)d_out; a.ws = (unsigned char*)d_ws;
    if (MK_SINGLE) {
        a.ph_lo = 0; a.ph_hi = NPHASE;
        hipLaunchKernelGGL(fwd, dim3(grid), dim3(NTHR), LDS_BYTES, stream, a);
    } else {
        for (int p = 0; p < NPHASE; ++p) { a.ph_lo = p; a.ph_hi = p + 1; hipLaunchKernelGGL(fwd, dim3(grid), dim3(NTHR), LDS_BYTES, stream, a); }
    }
}
```

```cpp
#include <hip/hip_runtime.h>
#include <cstdio>
#include <cstdint>

constexpr int BATCH = 8, SEQ = 2048, DM = 1024, DEPTH = 4, M = BATCH * SEQ, DIN = 2372, DINP = 2560, DFF = 4096;
constexpr int NWAVES = 8, NTHR = NWAVES * 64;
constexpr int TOPK = 256;
constexpr int PC_POOL = 0, PC_HQ = 256, PC_HF = 512, PC_HI = 768, PC_HG = 1024, PC_Q = 1280, PC_K = 1792, PC_V = 1920, PROJ_LD = 2048;
constexpr int MC_POOL = 0, MC_HGRN = 256, MC_ATTN = 512;

constexpr size_t MiB = 1u << 20;
constexpr size_t WS_CTL = 0, CTL_ZERO_BYTES = 1 * MiB;
constexpr size_t WS_ROPE = 1 * MiB;
constexpr size_t WS_SSQ = 2 * MiB;
constexpr size_t WS_LB = 3 * MiB;
constexpr size_t WS_MASK = 4 * MiB;
constexpr size_t WS_WIN = 8 * MiB;
constexpr size_t WS_WOUT = 13 * MiB;
constexpr size_t WS_WFI = 15 * MiB;
constexpr size_t WS_WFO = 23 * MiB;
constexpr size_t WS_XB = 32 * MiB;
constexpr size_t WS_HID = 64 * MiB;
constexpr size_t WS_PROJ = 64 * MiB;
constexpr size_t WS_MIXED = 128 * MiB;
constexpr size_t WS_HST = 160 * MiB;
constexpr size_t WS_HDN = 176 * MiB;
constexpr size_t WS_QIHL = 192 * MiB;
constexpr size_t WS_KIHL = 208 * MiB;
constexpr size_t WS_WI = 212 * MiB;
constexpr size_t WS_VT = 224 * MiB;
constexpr size_t WS_END = 256 * MiB;
constexpr int CW_TMO = 0, CW_BAR = 4096;

namespace pg8 {
#define PG8_LAS __attribute__((address_space(3)))
typedef unsigned short bf16_t;
typedef short bf16x8 __attribute__((ext_vector_type(8)));
typedef float f32x4 __attribute__((ext_vector_type(4)));
typedef unsigned u32x4 __attribute__((ext_vector_type(4)));
constexpr int BM = 256, BK = 64, HALF = 128, HTB = HALF * BK * 2  , STAGE_BYTES = 8 * HTB, NXCD = 8, WGM = 8;

__host__ __device__ __forceinline__ int lds_byte(int r, int c) { const int st = (r >> 4) * 2 + (c >> 5), rr = r & 15, cc = c & 31, ob = rr * 64 + cc * 2; return st * 1024 + (ob ^ (((ob >> 9) & 1) << 5)); }
__host__ __device__ __forceinline__ void stage_rc(int b, int& R, int& C) { const int st = b / 1024, sb = b % 1024, swz = sb ^ (((sb >> 9) & 1) << 5); R = (st >> 1) * 16 + swz / 64; C = (st & 1) * 32 + (swz % 64) / 2; }
__host__ __device__ __forceinline__ int perm32(int rho) { const int n = rho >> 4, i = rho & 15; return 8 * (i >> 2) + 4 * n + (i & 3); }

struct Unit { int pm, pn; };
struct Gemm { const bf16_t* A; const bf16_t* Bt; int M, N, K; };

struct StaticOrder {
    int nM, nN, nwg, G, c;
    __host__ __device__ void init(int M, int N, int G_, int c_) { nM = M / BM; nN = N / BM; nwg = nM * nN; G = G_; c = c_; }
    __host__ __device__ __forceinline__ bool next(int i, Unit& u) const {
        const long L = (long)i * G + c; if (L >= nwg) return false;
        int wgid = (int)L; { const int q = nwg / NXCD, r = nwg % NXCD, xcd = wgid % NXCD, off = wgid / NXCD; wgid = (xcd < r ? xcd * (q + 1) : r * (q + 1) + (xcd - r) * q) + off; }
        const int nig = WGM * nN, gid = wgid / nig, fm = gid * WGM, gsz = (nM - fm) < WGM ? (nM - fm) : WGM;
        u.pm = fm + ((wgid % nig) % gsz); u.pn = (wgid % nig) / gsz; return true;
    }
    __device__ __forceinline__ void a_ready(const Unit&) const {}
    __device__ __forceinline__ void done(const Unit&) const {}
};

__device__ __forceinline__ unsigned cvt_pk_bf16(float lo, float hi) { unsigned r; asm volatile("v_cvt_pk_bf16_f32 %0, %1, %2" : "=v"(r) : "v"(lo), "v"(hi)); return r; }
typedef float f32x2 __attribute__((ext_vector_type(2)));

constexpr float RMS_EPS_F = 1e-5f;
#define PG8_GAS __attribute__((address_space(1)))
__device__ __forceinline__ float row_rstd(const float* ssq, int row) {
    const PG8_GAS f32x4* p = (const PG8_GAS f32x4*)(ssq + (size_t)row * 16);
    const f32x4 a = p[0], b = p[1], c = p[2], d = p[3];
    const float s = ((a[0] + a[1]) + (a[2] + a[3])) + ((b[0] + b[1]) + (b[2] + b[3])) + ((c[0] + c[1]) + (c[2] + c[3])) + ((d[0] + d[1]) + (d[2] + d[3]));
    return 1.0f / sqrtf(s * (1.0f / 1024.0f) + RMS_EPS_F);
}
struct RstdTab { const PG8_LAS float* tab; int pm; unsigned char* ws;
    __device__ __forceinline__ float get(int, int rloc) const { return tab[rloc]; } };
__constant__ float c_rot16[2][8] = {{-0.95765948f, -0.999246258f, 0.824376517f, 0.993200301f, 0.999744011f, 0.999990373f, 0.999999638f, 0.999999986f}, {-0.287903317f, 0.0388190063f, 0.566041835f, 0.116418045f, 0.0226254862f, 0.00438795693f, 0.000850927215f, 0.000165014163f}};
__constant__ float c_rot80[2][8] = {{-0.110387244f, -0.981213211f, -0.991153911f, 0.834587283f, 0.993606824f, 0.999759331f, 0.999990949f, 0.99999966f}, {-0.993888654f, 0.192926503f, 0.132717464f, 0.550875727f, 0.11289588f, 0.021938095f, 0.00425462375f, 0.000825070726f}};
__device__ __forceinline__ unsigned cvt_pk_rne(float lo, float hi) { typedef float f2 __attribute__((ext_vector_type(2))); typedef __bf16 b2 __attribute__((ext_vector_type(2))); f2 v = {lo, hi}; b2 b = __builtin_convertvector(v, b2); return __builtin_bit_cast(unsigned, b); }
__device__ __forceinline__ void split_hl(const f32x4 a, const f32x4 b, u32x4& h, u32x4& l) {
    h.x = cvt_pk_rne(a[0], a[1]); h.y = cvt_pk_rne(a[2], a[3]); h.z = cvt_pk_rne(b[0], b[1]); h.w = cvt_pk_rne(b[2], b[3]);
    l.x = cvt_pk_rne(a[0] - __builtin_bit_cast(float, h.x << 16), a[1] - __builtin_bit_cast(float, h.x & 0xffff0000u));
    l.y = cvt_pk_rne(a[2] - __builtin_bit_cast(float, h.y << 16), a[3] - __builtin_bit_cast(float, h.y & 0xffff0000u));
    l.z = cvt_pk_rne(b[0] - __builtin_bit_cast(float, h.z << 16), b[1] - __builtin_bit_cast(float, h.z & 0xffff0000u));
    l.w = cvt_pk_rne(b[2] - __builtin_bit_cast(float, h.w << 16), b[3] - __builtin_bit_cast(float, h.w & 0xffff0000u));
}
struct EpiIn {
    static constexpr bool PERM = true, AFTER_DRAIN = false;
    unsigned char* ws; RstdTab rt;
    __device__ __forceinline__ void operator()(const f32x4 (&acc)[2][2][4][2], const Unit& u, int wr, int wc, int fr, int fq) const {
        bf16_t* const proj = (bf16_t*)(ws + WS_PROJ); bf16_t* const qi_hl = (bf16_t*)(ws + WS_QIHL); bf16_t* const ki_hl = (bf16_t*)(ws + WS_KIHL); float* const wi = (float*)(ws + WS_WI);
        bf16_t* const vT = (bf16_t*)(ws + WS_VT); const float* const rope = (const float*)(ws + WS_ROPE);
        const int rloc0 = wr * 64 + fr, row0 = u.pm * BM + rloc0, pn = u.pn;
        const bool rot_lane = ((wc & 1) == 0) && (fq < 2);
        const float sgn = (fq == 0) ? -1.f : 1.f;
        f32x4 c0 = {1.f, 1.f, 1.f, 1.f}, c1 = c0, s0 = {0.f, 0.f, 0.f, 0.f}, s1 = s0;
        if (pn >= 5) { const PG8_GAS f32x4* tp = (const PG8_GAS f32x4*)(rope + (size_t)row0 * 16); c0 = tp[0]; c1 = tp[1]; s0 = tp[2]; s1 = tp[3]; }
#pragma unroll
        for (int ai = 0; ai < 2; ++ai)
#pragma unroll
            for (int m = 0; m < 4; ++m) {
                const int row = row0 + ai * HALF + m * 16;
                const float rs = rt.get(u.pm, rloc0 + ai * HALF + m * 16);
#pragma unroll
                for (int bj = 0; bj < 2; ++bj) {
                    f32x4 v0 = acc[ai][bj][m][0] * rs, v1 = acc[ai][bj][m][1] * rs;
                    const bool rope_tile = (pn == 5) || (pn == 6) || (pn == 8) || (pn == 7 && bj == 0) || (pn == 9 && bj == 0 && wc < 2);
                    if (rope_tile) {
                        f32x4 p0, p1;
#pragma unroll
                        for (int e = 0; e < 4; ++e) { p0[e] = __shfl_xor(v0[e], 16); p1[e] = __shfl_xor(v1[e], 16); }
                        if (rot_lane) { v0 = v0 * c0 + (p0 * s0) * sgn; v1 = v1 * c1 + (p1 * s1) * sgn; }
                    }
                    const int cl = bj * HALF + wc * 32 + 8 * fq;
                    if (pn < 7 || (pn == 7 && bj == 0)) {
                        u32x4 w; w.x = cvt_pk_bf16(v0[0], v0[1]); w.y = cvt_pk_bf16(v0[2], v0[3]); w.z = cvt_pk_bf16(v1[0], v1[1]); w.w = cvt_pk_bf16(v1[2], v1[3]);
                        *(PG8_GAS u32x4*)(proj + (size_t)row * 2048 + pn * BM + cl) = w;
                    } else if (pn == 7) {
                        const int vc = cl - HALF, kvh = vc >> 6, d = vc & 63, b = row >> 11, t = row & 2047;
                        PG8_GAS bf16_t* o = (PG8_GAS bf16_t*)vT + ((size_t)((b * 2 + kvh) * 64 + d)) * 2048 + t;
                        const u32x4 w = (u32x4){cvt_pk_bf16(v0[0], v0[1]), cvt_pk_bf16(v0[2], v0[3]), cvt_pk_bf16(v1[0], v1[1]), cvt_pk_bf16(v1[2], v1[3])};
                        o[0 * 2048] = (bf16_t)(w.x & 0xffffu); o[1 * 2048] = (bf16_t)(w.x >> 16); o[2 * 2048] = (bf16_t)(w.y & 0xffffu); o[3 * 2048] = (bf16_t)(w.y >> 16);
                        o[4 * 2048] = (bf16_t)(w.z & 0xffffu); o[5 * 2048] = (bf16_t)(w.z >> 16); o[6 * 2048] = (bf16_t)(w.w & 0xffffu); o[7 * 2048] = (bf16_t)(w.w >> 16);
                    } else if (pn == 8) {
                        u32x4 h, l; split_hl(v0, v1, h, l);
                        *(PG8_GAS u32x4*)(qi_hl + (size_t)row * 512 + cl) = h; *(PG8_GAS u32x4*)(qi_hl + (size_t)row * 512 + 256 + cl) = l;
                    } else if (bj == 0) {
                        if (wc < 2) { u32x4 h, l; split_hl(v0, v1, h, l); *(PG8_GAS u32x4*)(ki_hl + (size_t)row * 128 + cl) = h; *(PG8_GAS u32x4*)(ki_hl + (size_t)row * 128 + 64 + cl) = l; }
                        else if (wc == 2 && fq == 0) { *(PG8_GAS f32x4*)(wi + (size_t)row * 4) = v0; }
                    }
                }
                if (pn >= 5 && (ai * 4 + m) < 7) {
#pragma unroll
                    for (int e = 0; e < 4; ++e) {
                        const float dc0 = (m == 3) ? c_rot80[0][e] : c_rot16[0][e], ds0 = (m == 3) ? c_rot80[1][e] : c_rot16[1][e];
                        const float dc1 = (m == 3) ? c_rot80[0][4 + e] : c_rot16[0][4 + e], ds1 = (m == 3) ? c_rot80[1][4 + e] : c_rot16[1][4 + e];
                        const float a0 = c0[e], a1 = c1[e];
                        c0[e] = a0 * dc0 - s0[e] * ds0; s0[e] = s0[e] * dc0 + a0 * ds0;
                        c1[e] = a1 * dc1 - s1[e] * ds1; s1[e] = s1[e] * dc1 + a1 * ds1;
                    }
                }
            }
    }
};
struct EpiRes {
    static constexpr bool PERM = true, AFTER_DRAIN = false;
    const float* xin; float* xout; unsigned char* ws;
    __device__ __forceinline__ void operator()(const f32x4 (&acc)[2][2][4][2], const Unit& u, int wr, int wc, int fr, int fq) const {
        bf16_t* const xb = (bf16_t*)(ws + WS_XB); float* const ssq = (float*)(ws + WS_SSQ);
        const int row0 = u.pm * BM + wr * 64 + fr;
        const int colt = u.pn * BM + wc * 32 + 8 * fq;
        f32x4 cur[2][2], nxt[2][2];
#pragma unroll
        for (int bj = 0; bj < 2; ++bj) { const size_t off = (size_t)row0 * 1024 + colt + bj * HALF; cur[bj][0] = *(const PG8_GAS f32x4*)(xin + off); cur[bj][1] = *(const PG8_GAS f32x4*)(xin + off + 4); }
#pragma unroll
        for (int g = 0; g < 8; ++g) {
            const int ai = g >> 2, m = g & 3;
            const int row = row0 + ai * HALF + m * 16;
            if (g + 1 < 8) { const int rown = row0 + ((g + 1) >> 2) * HALF + ((g + 1) & 3) * 16;
#pragma unroll
                for (int bj = 0; bj < 2; ++bj) { const size_t off = (size_t)rown * 1024 + colt + bj * HALF; nxt[bj][0] = *(const PG8_GAS f32x4*)(xin + off); nxt[bj][1] = *(const PG8_GAS f32x4*)(xin + off + 4); } }
            float sq = 0.f;
#pragma unroll
            for (int bj = 0; bj < 2; ++bj) {
                const size_t off = (size_t)row * 1024 + colt + bj * HALF;
                const f32x4 v0 = cur[bj][0] + acc[ai][bj][m][0], v1 = cur[bj][1] + acc[ai][bj][m][1];
                *(PG8_GAS f32x4*)(xout + off) = v0; *(PG8_GAS f32x4*)(xout + off + 4) = v1;
                u32x4 w; w.x = cvt_pk_bf16(v0[0], v0[1]); w.y = cvt_pk_bf16(v0[2], v0[3]); w.z = cvt_pk_bf16(v1[0], v1[1]); w.w = cvt_pk_bf16(v1[2], v1[3]);
                *(PG8_GAS u32x4*)(xb + off) = w;
                sq += (v0[0] * v0[0] + v0[1] * v0[1]) + (v0[2] * v0[2] + v0[3] * v0[3]) + (v1[0] * v1[0] + v1[1] * v1[1]) + (v1[2] * v1[2] + v1[3] * v1[3]);
            }
            sq += __shfl_xor(sq, 16); sq += __shfl_xor(sq, 32);
            if (fq == 0) ((PG8_GAS float*)ssq)[(size_t)row * 16 + u.pn * 4 + wc] = sq;
#pragma unroll
            for (int bj = 0; bj < 2; ++bj) { cur[bj][0] = nxt[bj][0]; cur[bj][1] = nxt[bj][1]; }
        }
    }
};
struct EpiFfIn {
    static constexpr bool PERM = true, AFTER_DRAIN = false;
    RstdTab rt;
    __device__ __forceinline__ void operator()(const f32x4 (&acc)[2][2][4][2], const Unit& u, int wr, int wc, int fr, int fq) const {
        bf16_t* const hid = (bf16_t*)(rt.ws + WS_HID);
        const int row0 = u.pm * BM + wr * 64 + fr;
        const int colt = u.pn * BM + wc * 32 + 8 * fq;
#pragma unroll
        for (int ai = 0; ai < 2; ++ai)
#pragma unroll
            for (int m = 0; m < 4; ++m) {
                const int row = row0 + ai * HALF + m * 16;
                const float rs = rt.get(u.pm, wr * 64 + fr + ai * HALF + m * 16);
#pragma unroll
                for (int bj = 0; bj < 2; ++bj) {
                    f32x4 v0 = acc[ai][bj][m][0] * rs, v1 = acc[ai][bj][m][1] * rs;
#pragma unroll
                    for (int e = 0; e < 4; ++e) { const float a = fmaxf(v0[e], 0.f), b = fmaxf(v1[e], 0.f); v0[e] = a * a; v1[e] = b * b; }
                    u32x4 w; w.x = cvt_pk_bf16(v0[0], v0[1]); w.y = cvt_pk_bf16(v0[2], v0[3]); w.z = cvt_pk_bf16(v1[0], v1[1]); w.w = cvt_pk_bf16(v1[2], v1[3]);
                    *(PG8_GAS u32x4*)(hid + (size_t)row * 4096 + colt + bj * HALF) = w;
                }
            }
    }
};
template <class Epi, class Sched, bool ALIGN_EPI = false, bool SP2 = false>
__device__ __forceinline__ void gemm_phase(PG8_LAS unsigned char* lds, const Gemm g, const Sched& S, const Epi& E) {
    int tid_ = threadIdx.x; asm volatile("" : "+v"(tid_));
    const int tid = tid_, wid = __builtin_amdgcn_readfirstlane(tid >> 6), lane = tid & 63, wr = wid >> 2, wc = wid & 3, fr = lane & 15, fq = lane >> 4;
    const int K = g.K, nt = K / BK;
    unsigned voffA[2], voffB[2];
#pragma unroll
    for (int i = 0; i < 2; ++i) { int R, C; stage_rc(tid * 16 + i * 8192, R, C); const int Rb = Epi::PERM ? ((R & ~31) + perm32(R & 31)) : R;
        voffA[i] = (unsigned)(R * K + C) * 2u; voffB[i] = (unsigned)(Rb * K + C) * 2u; }
    const size_t kstep = (size_t)(BK * 2);
    const size_t hstep = (size_t)HALF * K * 2;
    const size_t tstep = 2 * hstep;
    const unsigned ldsw = (unsigned)wid * 1024u;
    const int aoff = lds_byte(wr * 64 + fr, fq * 8), boff = lds_byte(wc * 32 + fr, fq * 8);
#define PG8_SA(b, h) (((b) * 2 + (h)) * HTB)
#define PG8_SB(b, h) ((4 + (b) * 2 + (h)) * HTB)
#define PG8_STAGE(bufoff, gbase, voff) do { _Pragma("unroll") for (int _i = 0; _i < 2; ++_i) \
        __builtin_amdgcn_global_load_lds((const unsigned*)((const char*)(gbase) + (voff)[_i]), (PG8_LAS unsigned*)(lds + (bufoff) + ldsw + _i * 8192), 16, 0, 0); } while (0)
#define PG8_LDA(dst, b, h) do { _Pragma("unroll") for (int m = 0; m < 4; ++m) _Pragma("unroll") for (int k = 0; k < 2; ++k) dst[m][k] = *(const PG8_LAS bf16x8*)(lds + PG8_SA(b, h) + aoff + m * 2048 + k * 1024); } while (0)
#define PG8_LDB(dst, b, h) do { _Pragma("unroll") for (int n = 0; n < 2; ++n) _Pragma("unroll") for (int k = 0; k < 2; ++k) dst[n][k] = *(const PG8_LAS bf16x8*)(lds + PG8_SB(b, h) + boff + n * 2048 + k * 1024); } while (0)
#define PG8_MMA(ai, bj, At, Bt) do { __builtin_amdgcn_s_setprio(1); _Pragma("unroll") for (int m = 0; m < 4; ++m) _Pragma("unroll") for (int n = 0; n < 2; ++n) _Pragma("unroll") for (int k = 0; k < 2; ++k) \
        acc[ai][bj][m][n] = __builtin_amdgcn_mfma_f32_16x16x32_bf16(Bt[n][k], At[m][k], acc[ai][bj][m][n], 0, 0, 0); __builtin_amdgcn_s_setprio(0); } while (0)
#define PG8_WAIT_V(n) asm volatile("s_waitcnt vmcnt(" #n ")" ::: "memory")
#define PG8_WAIT_L(n) asm volatile("s_waitcnt lgkmcnt(" #n ")" ::: "memory")
#define PG8_BAR __builtin_amdgcn_s_barrier()
#define PG8_SCHED __builtin_amdgcn_sched_barrier(0)
    Unit cur, nxt; int ui = 0;
    if (!S.next(0, cur)) return;
    f32x4 acc[2][2][4][2];
#pragma unroll
    for (int a = 0; a < 2; ++a)
#pragma unroll
        for (int b = 0; b < 2; ++b)
#pragma unroll
            for (int m = 0; m < 4; ++m)
#pragma unroll
                for (int n = 0; n < 2; ++n) acc[a][b][m][n] = (f32x4){0.f, 0.f, 0.f, 0.f};
    bf16x8 At[4][2], B0[2][2], B1[2][2];
    const char* cA = (const char*)g.A + (size_t)cur.pm * tstep; const char* cB = (const char*)g.Bt + (size_t)cur.pn * tstep;
    S.a_ready(cur);
    if constexpr (SP2) {
        PG8_STAGE(PG8_SB(0, 0), cB, voffB); PG8_STAGE(PG8_SB(0, 1), cB + hstep, voffB); PG8_STAGE(PG8_SA(0, 0), cA, voffA); PG8_STAGE(PG8_SA(0, 1), cA + hstep, voffA);
        if (wr == 1) PG8_BAR;
        PG8_WAIT_V(2); PG8_BAR;
        PG8_STAGE(PG8_SB(1, 0), cB + kstep, voffB); PG8_STAGE(PG8_SA(1, 0), cA + kstep, voffA); PG8_STAGE(PG8_SB(1, 1), cB + hstep + kstep, voffB);
        PG8_WAIT_V(6); PG8_BAR;
    } else {
        PG8_STAGE(PG8_SB(0, 0), cB, voffB); PG8_STAGE(PG8_SA(0, 0), cA, voffA); PG8_STAGE(PG8_SB(0, 1), cB + hstep, voffB); PG8_STAGE(PG8_SA(0, 1), cA + hstep, voffA);
        if (wr == 1) PG8_BAR;
        PG8_WAIT_V(4); PG8_BAR;
        PG8_STAGE(PG8_SB(1, 0), cB + kstep, voffB); PG8_STAGE(PG8_SA(1, 0), cA + kstep, voffA); PG8_STAGE(PG8_SB(1, 1), cB + hstep + kstep, voffB);
        PG8_WAIT_V(6); PG8_BAR;
    }
    for (;;) {
        const bool has_next = S.next(ui + 1, nxt);
        const char* nA = has_next ? (const char*)g.A + (size_t)nxt.pm * tstep : cA; const char* nB = has_next ? (const char*)g.Bt + (size_t)nxt.pn * tstep : cB;
        for (int t = 0; t < nt; t += 2) {
            const bool last = (t == nt - 2);
            const char* a1 = cA + (size_t)(t + 1) * kstep;
            const char* a2 = last ? nA : cA + (size_t)(t + 2) * kstep; const char* b2 = last ? nB : cB + (size_t)(t + 2) * kstep;
            const char* a3 = a2 + kstep; const char* b3 = b2 + kstep;
            if (last && has_next) S.a_ready(nxt);
            if constexpr (SP2) {
            PG8_LDB(B0, 0, 0); PG8_LDB(B1, 0, 1); PG8_SCHED; PG8_LDA(At, 0, 0); PG8_STAGE(PG8_SA(1, 1), a1 + hstep, voffA);
            PG8_WAIT_V(8); PG8_WAIT_L(0); PG8_BAR; PG8_MMA(0, 0, At, B0); PG8_MMA(0, 1, At, B1); PG8_BAR; PG8_SCHED;
            PG8_LDA(At, 0, 1); PG8_STAGE(PG8_SB(0, 0), b2, voffB); PG8_STAGE(PG8_SB(0, 1), b2 + hstep, voffB); PG8_STAGE(PG8_SA(0, 0), a2, voffA);
            PG8_WAIT_V(8); PG8_WAIT_L(0); PG8_BAR; PG8_MMA(1, 0, At, B0); PG8_MMA(1, 1, At, B1); PG8_BAR; PG8_SCHED;
            PG8_LDB(B0, 1, 0); PG8_LDB(B1, 1, 1); PG8_SCHED; PG8_LDA(At, 1, 0); PG8_STAGE(PG8_SA(0, 1), a2 + hstep, voffA);
            PG8_WAIT_V(8); PG8_WAIT_L(0); PG8_BAR; PG8_MMA(0, 0, At, B0); PG8_MMA(0, 1, At, B1); PG8_BAR; PG8_SCHED;
            PG8_LDA(At, 1, 1); PG8_STAGE(PG8_SB(1, 0), b3, voffB); PG8_STAGE(PG8_SB(1, 1), b3 + hstep, voffB); PG8_STAGE(PG8_SA(1, 0), a3, voffA);
            PG8_WAIT_V(8); PG8_WAIT_L(0); PG8_BAR; PG8_MMA(1, 0, At, B0); PG8_MMA(1, 1, At, B1); PG8_BAR; PG8_SCHED;
            } else {
            PG8_LDB(B0, 0, 0); PG8_SCHED; PG8_LDA(At, 0, 0); PG8_STAGE(PG8_SA(1, 1), a1 + hstep, voffA);
            PG8_WAIT_L(8); PG8_BAR; PG8_WAIT_L(0); PG8_MMA(0, 0, At, B0); PG8_BAR; PG8_SCHED;
            PG8_LDB(B1, 0, 1); PG8_STAGE(PG8_SB(0, 0), b2, voffB);
            PG8_BAR; PG8_WAIT_L(0); PG8_MMA(0, 1, At, B1); PG8_BAR;
            PG8_LDA(At, 0, 1); PG8_STAGE(PG8_SA(0, 0), a2, voffA);
            PG8_BAR; PG8_WAIT_L(0); PG8_MMA(1, 0, At, B0); PG8_BAR; PG8_SCHED;
            PG8_STAGE(PG8_SB(0, 1), b2 + hstep, voffB);
            PG8_WAIT_V(6); PG8_BAR; PG8_MMA(1, 1, At, B1); PG8_BAR;
            PG8_LDB(B0, 1, 0); PG8_SCHED; PG8_LDA(At, 1, 0); PG8_STAGE(PG8_SA(0, 1), a2 + hstep, voffA);
            PG8_WAIT_L(8); PG8_BAR; PG8_WAIT_L(0); PG8_MMA(0, 0, At, B0); PG8_BAR; PG8_SCHED;
            PG8_LDB(B1, 1, 1); PG8_STAGE(PG8_SB(1, 0), b3, voffB);
            PG8_BAR; PG8_WAIT_L(0); PG8_MMA(0, 1, At, B1); PG8_BAR;
            PG8_LDA(At, 1, 1); PG8_STAGE(PG8_SA(1, 0), a3, voffA);
            PG8_BAR; PG8_WAIT_L(0); PG8_MMA(1, 0, At, B0); PG8_BAR; PG8_SCHED;
            PG8_STAGE(PG8_SB(1, 1), b3 + hstep, voffB);
            PG8_WAIT_V(6); PG8_BAR; PG8_MMA(1, 1, At, B1); PG8_BAR;
            }
        }
        if constexpr (ALIGN_EPI) { if (wr == 0) PG8_BAR; }
        if constexpr (!Epi::AFTER_DRAIN) { E(acc, cur, wr, wc, fr, fq); S.done(cur); }
        if (!has_next) break;
#pragma unroll
        for (int a = 0; a < 2; ++a)
#pragma unroll
            for (int b = 0; b < 2; ++b)
#pragma unroll
                for (int m = 0; m < 4; ++m)
#pragma unroll
                    for (int n = 0; n < 2; ++n) acc[a][b][m][n] = (f32x4){0.f, 0.f, 0.f, 0.f};
        cur = nxt; cA = nA; cB = nB; ++ui;
        if constexpr (ALIGN_EPI) { if (wr == 1) PG8_BAR; }
    }
    PG8_WAIT_V(0);
    if constexpr (!ALIGN_EPI) { if (wr == 0) PG8_BAR; }
    PG8_BAR;
    if constexpr (Epi::AFTER_DRAIN) { E.fused(acc, cur, wr, wc, fr, fq, lds, wid, lane); S.done(cur); }
#undef PG8_SA
#undef PG8_SB
#undef PG8_STAGE
#undef PG8_LDA
#undef PG8_LDB
#undef PG8_MMA
#undef PG8_WAIT_V
#undef PG8_WAIT_L
#undef PG8_BAR
#undef PG8_SCHED
}
}

constexpr int RING_OFF = 0, RING_BYTES = 131072;
constexpr int LDS_BYTES = 147456;
constexpr int LDSCTL_OFF = LDS_BYTES - 1024, MISC_OFF = LDSCTL_OFF + 320;

#define GAS __attribute__((address_space(1)))
#define LAS __attribute__((address_space(3)))
typedef unsigned short bf16;
typedef unsigned v4u __attribute__((ext_vector_type(4)));
typedef unsigned v2u __attribute__((ext_vector_type(2)));
typedef float f32x4 __attribute__((ext_vector_type(4)));
typedef GAS unsigned gu32;
#define RLX_AGENT __ATOMIC_RELAXED, __HIP_MEMORY_SCOPE_AGENT
#define LDS_WAIT() asm volatile("s_waitcnt lgkmcnt(0)" ::: "memory")
__device__ __forceinline__ unsigned f2bf(float f) { unsigned u = __builtin_bit_cast(unsigned, f); return (u + 0x7fffu + ((u >> 16) & 1u)) >> 16; }
__device__ __forceinline__ unsigned pk2(float lo, float hi) { return f2bf(lo) | (f2bf(hi) << 16); }
__device__ __forceinline__ float bf2f(unsigned short h) { return __builtin_bit_cast(float, (unsigned)h << 16); }
__device__ __forceinline__ float wave_sum(float v) {
#pragma unroll
    for (int o = 1; o < 64; o <<= 1) v += __shfl_xor(v, o);
    return v;
}
__device__ __forceinline__ float wave_max(float v) {
#pragma unroll
    for (int o = 1; o < 64; o <<= 1) v = fmaxf(v, __shfl_xor(v, o));
    return v;
}
#define XB_TMO      128
#define XB_XCNT(j)  (256  + 64 * (j))
#define XB_XSUB(j)  (1280 + 64 * (j))
#define XB_XGEN(j)  (2304 + 64 * (j))
#define XB_TOP      3328
#define XB_TOPGEN   3392
#define XCD_BAR_WORDS 3456
#define XB_SPIN_CAP (1u << 18)

__device__ __forceinline__ unsigned xb_ld(unsigned* p)              { return __hip_atomic_load(p, __ATOMIC_RELAXED, __HIP_MEMORY_SCOPE_AGENT); }
__device__ __forceinline__ unsigned xb_add(unsigned* p, unsigned v) { return __hip_atomic_fetch_add(p, v, __ATOMIC_RELAXED, __HIP_MEMORY_SCOPE_AGENT); }
__device__ __forceinline__ unsigned xb_xcc_id() { return (unsigned)__builtin_amdgcn_s_getreg((3 << 11) | 20) & 0xFu; }
#define XB_SPIN(cond, bar) do { unsigned _sp = 0; while (cond) { __builtin_amdgcn_s_sleep(1); \
    if ((++_sp & 255u) == 0u) { if (xb_ld(&(bar)[XB_TMO])) break; if (_sp > XB_SPIN_CAP) { atomicAdd(&(bar)[XB_TMO], 1u); break; } } } } while (0)

struct XcdBarrier {
    unsigned* bar; unsigned x;
    volatile LAS unsigned* st;
};

__device__ __forceinline__ XcdBarrier xcd_barrier_post(unsigned* bar, volatile LAS unsigned* st) {
    XcdBarrier b; b.bar = bar; b.x = xb_xcc_id(); b.st = st;
    if (threadIdx.x == 0) (void)xb_add(&bar[XB_XCNT(b.x)], 1u);
    return b;
}
__device__ __forceinline__ void xcd_barrier_complete(unsigned* bar, unsigned x, unsigned& nloc, unsigned& nx) {
    const unsigned G = gridDim.x * gridDim.y * gridDim.z;
    unsigned sum, cnt, mine, sp = 0u;
    for (;;) {
        sum = 0u; cnt = 0u; mine = 0u;
#pragma unroll
        for (unsigned j = 0; j < 16; ++j) { const unsigned c = xb_ld(&bar[XB_XCNT(j)]); sum += c; cnt += (c > 0u) ? 1u : 0u; mine = (j == x) ? c : mine; }
        if (sum == G) break;
        __builtin_amdgcn_s_sleep(1);
        if ((++sp & 255u) == 0u) { if (xb_ld(&bar[XB_TMO])) break; if (sp > XB_SPIN_CAP) { atomicAdd(&bar[XB_TMO], 1u); break; } }
    }
    nloc = mine > 0u ? mine : 1u; nx = cnt > 0u ? cnt : 1u;
}

__device__ __forceinline__ void xcd_barrier(const XcdBarrier& b) {
    asm volatile("s_waitcnt vmcnt(0)" ::: "memory");
    __syncthreads();
    if (threadIdx.x == 0) {
        unsigned* bar = b.bar;
        __builtin_amdgcn_s_waitcnt(0);
        unsigned nloc = b.st[0], nx = b.st[1];
        if (nloc == 0u) { xcd_barrier_complete(bar, b.x, nloc, nx); b.st[0] = nloc; b.st[1] = nx; }
        const unsigned old = xb_add(&bar[XB_XSUB(b.x)], 1u);
        const unsigned gen = old / nloc;
        if (old + 1u == (gen + 1u) * nloc) {
            __builtin_amdgcn_fence(__ATOMIC_RELEASE, "agent");
            asm volatile("s_waitcnt vmcnt(0)" ::: "memory");
            const unsigned og = xb_add(&bar[XB_TOP], 1u);
            const unsigned tg = og / nx;
            if (og + 1u == (tg + 1u) * nx) xb_add(&bar[XB_TOPGEN], 1u);
            else XB_SPIN(xb_ld(&bar[XB_TOPGEN]) == tg, bar);
            __builtin_amdgcn_fence(__ATOMIC_ACQUIRE, "agent");
            xb_add(&bar[XB_XGEN(b.x)], 1u);
            asm volatile("s_waitcnt vmcnt(0)" ::: "memory");
        } else {
            XB_SPIN(xb_ld(&bar[XB_XGEN(b.x)]) == gen, bar);
            __builtin_amdgcn_fence(__ATOMIC_ACQUIRE, "agent");
            asm volatile("s_waitcnt vmcnt(0)" ::: "memory");
        }
    }
    __syncthreads();
}


struct Frame {
    LAS unsigned char* lds;
    volatile LAS unsigned* MISC;
    gu32* ctl;
    int tid, lane, wave, G, bid;
    const float* x_in; const int* pos;
    const float *n1g, *w_in, *pool_w, *pool_scale, *lb_logits, *hgrn_g, *w_out, *n2g, *w_ff_in, *w_ff_out, *fng;
    float* xres;
    unsigned char* ws;
};
__constant__ float c_invf[8] = {1.0f, 0.19392274474868576f, 0.03760603093086393f, 0.007292664737217109f, 0.001414213562373095f, 0.0002742481756762073f, 5.318295896944988e-05f, 1.031338537721246e-05f};

typedef float f32x16 __attribute__((ext_vector_type(16)));
typedef short bf16x8v __attribute__((ext_vector_type(8)));
typedef float f32x2v __attribute__((ext_vector_type(2))); typedef __bf16 bf16x2v __attribute__((ext_vector_type(2)));
__device__ __forceinline__ unsigned cvtpk(float lo, float hi) { f32x2v v = {lo, hi}; bf16x2v b = __builtin_convertvector(v, bf16x2v); return __builtin_bit_cast(unsigned, b); }

__device__ __forceinline__ void cvt_item(const GAS float* W, const GAS float* g, int K, int N, bf16* WT, LAS float* scr, int kb, int nb, int lane) {
    const int k0 = 64 * kb, n0 = 32 * nb;
    const int n = n0 + (lane & 31);
    float v[32];
#pragma unroll
    for (int i = 0; i < 32; ++i) { const int kk = 2 * i + (lane >> 5); v[i] = (n < N) ? W[(size_t)(k0 + kk) * N + n] : 0.f; }
    const int c = lane & 7;
    f32x4 g0 = {1.f, 1.f, 1.f, 1.f}, g1 = g0;
    if (g) { g0 = *(const GAS f32x4*)(g + k0 + 8 * c); g1 = *(const GAS f32x4*)(g + k0 + 8 * c + 4); }
    __builtin_amdgcn_sched_barrier(0);
#pragma unroll
    for (int i = 0; i < 32; ++i) { const int kk = 2 * i + (lane >> 5); scr[kk * 33 + (lane & 31)] = v[i]; }
    LDS_WAIT(); asm volatile("" ::: "memory");
#pragma unroll
    for (int j = 0; j < 4; ++j) { const int nl = (lane >> 3) + 8 * j; const LAS float* sp = scr + (8 * c) * 33 + nl;
        v4u o; o.x = pk2(sp[0 * 33] * g0[0], sp[1 * 33] * g0[1]); o.y = pk2(sp[2 * 33] * g0[2], sp[3 * 33] * g0[3]); o.z = pk2(sp[4 * 33] * g1[0], sp[5 * 33] * g1[1]); o.w = pk2(sp[6 * 33] * g1[2], sp[7 * 33] * g1[3]);
        *(GAS v4u*)(WT + (size_t)(n0 + nl) * K + k0 + 8 * c) = o; }
    LDS_WAIT(); asm volatile("" ::: "memory");
}
__device__ __forceinline__ void cvt_matrix(Frame& F, const float* W_, const float* g_, int K, int N, int Npad, bf16* WT) {
    const GAS float* W = (const GAS float*)W_; const GAS float* g = (const GAS float*)g_;
    LAS float* scr = (LAS float*)(F.lds + RING_OFF + F.wave * 16384);
    const int gw = F.bid * NWAVES + F.wave, NGW = F.G * NWAVES;
    const int nblk = Npad / 32, nitems = (K / 64) * nblk;
    for (int it = gw; it < nitems; it += NGW) cvt_item(W, g, K, N, WT, scr, it / nblk, it % nblk, F.lane);
}
__device__ __forceinline__ void cvt_layer_rest(Frame& F, int layer) {
    cvt_matrix(F, F.w_out + (size_t)layer * DM * DM, nullptr, DM, DM, DM, (bf16*)(F.ws + WS_WOUT));
    cvt_matrix(F, F.w_ff_in + (size_t)layer * DM * DFF, F.n2g + layer * DM, DM, DFF, DFF, (bf16*)(F.ws + WS_WFI));
    cvt_matrix(F, F.w_ff_out + (size_t)layer * DFF * DM, nullptr, DFF, DM, DM, (bf16*)(F.ws + WS_WFO));
    if (layer + 1 < DEPTH) cvt_matrix(F, F.w_in + (size_t)(layer + 1) * DM * DIN, F.n1g + (layer + 1) * DM, DM, DIN, DINP, (bf16*)(F.ws + WS_WIN));
}

__device__ __forceinline__ void p_prologue(Frame& F) {
    const int gtid = F.bid * NTHR + F.tid, NT = F.G * NTHR;
    GAS float* tab = (GAS float*)(F.ws + WS_ROPE);
    for (int idx = gtid; idx < M * 8; idx += NT) {
        const int row = idx >> 3, i = idx & 7;
        const float angf = (float)((const GAS int*)F.pos)[row] * c_invf[i];
        double r = (double)angf * 0.15915494309189535; r -= floor(r);
        const float a = (float)(r * 6.283185307179586);
        tab[row * 16 + i] = cosf(a); tab[row * 16 + 8 + i] = sinf(a);
    }
    if (gtid < 256) {
        const int c = gtid; GAS float* lb = (GAS float*)(F.ws + WS_LB); const GAS float* lbl = (const GAS float*)F.lb_logits;
        const float l0 = lbl[c], l1 = lbl[256 + c], l2 = lbl[512 + c], l3 = lbl[768 + c];
        const float mx = fmaxf(fmaxf(l0, l1), fmaxf(l2, l3));
        const float e0 = expf(l0 - mx), e1 = expf(l1 - mx), e2 = expf(l2 - mx), e3 = expf(l3 - mx);
        const float inv = 1.0f / (e0 + e1 + e2 + e3);
        lb[c] = 0.f; lb[256 + c] = e1 * inv; lb[512 + c] = (e1 + e2) * inv; lb[768 + c] = (e1 + e2 + e3) * inv;
    }
    const int gw = F.bid * NWAVES + F.wave, NGW = F.G * NWAVES;
    GAS bf16* xb = (GAS bf16*)(F.ws + WS_XB); GAS float* ssq = (GAS float*)(F.ws + WS_SSQ);
    for (int row = gw; row < M; row += NGW) {
        const GAS f32x4* xr = (const GAS f32x4*)(F.x_in + (size_t)row * DM) + F.lane;
        f32x4 v[4]; float s = 0.f;
#pragma unroll
        for (int j = 0; j < 4; ++j) { v[j] = xr[64 * j]; s += (v[j][0] * v[j][0] + v[j][1] * v[j][1]) + (v[j][2] * v[j][2] + v[j][3] * v[j][3]); }
        s = wave_sum(s);
        GAS unsigned long long* o8 = (GAS unsigned long long*)(xb + (size_t)row * DM) + F.lane;
#pragma unroll
        for (int j = 0; j < 4; ++j) o8[64 * j] = (unsigned long long)pk2(v[j][0], v[j][1]) | ((unsigned long long)pk2(v[j][2], v[j][3]) << 32);
        if (F.lane < 16) ssq[(size_t)row * 16 + F.lane] = (F.lane == 0) ? s : 0.f;
    }
    cvt_matrix(F, F.w_in, F.n1g, DM, DIN, DINP, (bf16*)(F.ws + WS_WIN));
}

constexpr int PL_WROW = 72, PL_PROW = 264, PL_WT_BYTES = 4 * 64 * PL_WROW * 2, PL_P_OFF = PL_WT_BYTES;
template <int WIN> __device__ __forceinline__ void pool_core(const GAS bf16* up, int tl0, LAS unsigned short* Pc) {
    float ps[49]; ps[0] = 0.f;
    float uv[48];
#pragma unroll
    for (int i = 0; i < 48; ++i) { const int tl = tl0 - 16 + i; uv[i] = (tl >= 0) ? bf2f(up[(long)(i - 16) * PROJ_LD]) : 0.f; }
    __builtin_amdgcn_sched_barrier(0);
#pragma unroll
    for (int i = 0; i < 48; ++i) ps[i + 1] = ps[i] + uv[i];
#pragma unroll
    for (int i = 16; i < 48; ++i) {
        const int tl = tl0 - 16 + i; const int cnt = (tl + 1 < WIN) ? tl + 1 : WIN;
        const float mean = (ps[i + 1] - ps[i + 1 - WIN]) / (float)cnt;
        Pc[(i - 16) * PL_PROW] = (unsigned short)f2bf(mean - uv[i]);
    }
}
__device__ __forceinline__ void p_pool(Frame& F, int layer) {
    LAS unsigned short* WT = (LAS unsigned short*)(F.lds + RING_OFF);
    LAS unsigned short* P = (LAS unsigned short*)(F.lds + RING_OFF + PL_P_OFF);
    const GAS bf16* proj = (const GAS bf16*)(F.ws + WS_PROJ); GAS bf16* mixed = (GAS bf16*)(F.ws + WS_MIXED);
    const GAS float* pw = (const GAS float*)F.pool_w + (size_t)layer * 4 * 64 * 64; const GAS float* ps_ = (const GAS float*)F.pool_scale + layer * 256;
    const int tid = F.tid, lane = F.lane, wave = F.wave;
#pragma unroll 8
    for (int i = 0; i < 32; ++i) { const int e = i * NTHR + tid; const int g = e >> 12, c = (e >> 6) & 63, d = e & 63; WT[(g * 64 + d) * PL_WROW + c] = (unsigned short)f2bf(pw[e]); }
    const int c = tid & 255, hf = tid >> 8, g = wave & 3;
    for (int unit = F.bid; unit < M / 64; unit += F.G) {
        const int t0 = unit * 64 + 32 * hf;
        { const GAS bf16* up = proj + (size_t)t0 * PROJ_LD + PC_POOL + c; LAS unsigned short* Pc = P + (32 * hf) * PL_PROW + c; const int tl0 = t0 & (SEQ - 1);
          if (g == 0) pool_core<2>(up, tl0, Pc); else if (g == 1) pool_core<4>(up, tl0, Pc); else if (g == 2) pool_core<8>(up, tl0, Pc); else pool_core<16>(up, tl0, Pc); }
        __syncthreads();
        { const int th = wave >> 2, fr = lane & 15, kg = lane >> 4;
#pragma unroll
          for (int tb = 0; tb < 2; ++tb) {
              bf16x8v af[2];
#pragma unroll
              for (int ks = 0; ks < 2; ++ks) af[ks] = *(const LAS bf16x8v*)(P + (32 * th + 16 * tb + fr) * PL_PROW + g * 64 + 32 * ks + 8 * kg);
#pragma unroll
              for (int db = 0; db < 4; ++db) {
                  f32x4 acc = {0.f, 0.f, 0.f, 0.f};
#pragma unroll
                  for (int ks = 0; ks < 2; ++ks) { const bf16x8v bfr = *(const LAS bf16x8v*)(WT + (g * 64 + 16 * db + fr) * PL_WROW + 32 * ks + 8 * kg);
                      acc = __builtin_amdgcn_mfma_f32_16x16x32_bf16(af[ks], bfr, acc, 0, 0, 0); }
                  const int dcol = g * 64 + 16 * db + fr; const float sc = ps_[dcol];
                  GAS bf16* op = mixed + (size_t)(unit * 64 + 32 * th + 16 * tb + 4 * kg) * DM + MC_POOL + dcol;
#pragma unroll
                  for (int r = 0; r < 4; ++r) op[(size_t)r * DM] = (bf16)f2bf(acc[r] * sc);
              }
          } }
        __syncthreads();
    }
}

__device__ __forceinline__ unsigned sort_key(float v) { if (v == 0.f) v = 0.f; const unsigned u = __builtin_bit_cast(unsigned, v); return (u & 0x80000000u) ? ~u : (u | 0x80000000u); }
__device__ __forceinline__ unsigned wave_total6(unsigned x) {
    unsigned t = 0;
#pragma unroll
    for (int b = 0; b < 6; ++b) t += (unsigned)__popcll(__ballot((x >> b) & 1u)) << b;
    return t;
}
template <int NI> __device__ __forceinline__ void emit_mask(const unsigned (&k)[NI], unsigned prefix, bool exact, GAS unsigned* mrow, int lane) {
    if (exact) {
#pragma unroll
        for (int i = 0; i < NI; ++i) { const unsigned long long sb = __ballot(k[i] >= prefix); if (lane == 0) *(GAS v2u*)(mrow + 2 * i) = (v2u){(unsigned)sb, (unsigned)(sb >> 32)}; }
    } else {
        const unsigned tau = prefix; unsigned c = 0u;
#pragma unroll
        for (int i = 0; i < NI; ++i) c += (unsigned)(k[i] > tau);
        const unsigned need = (unsigned)TOPK - wave_total6(c); unsigned base = 0u;
#pragma unroll
        for (int i = 0; i < NI; ++i) {
            const unsigned long long eqb = __ballot(k[i] == tau);
            const unsigned rank = base + (unsigned)__popcll(eqb & ((1ull << lane) - 1ull));
            const unsigned long long sb = __ballot((k[i] > tau) || ((k[i] == tau) && (rank < need)));
            if (lane == 0) *(GAS v2u*)(mrow + 2 * i) = (v2u){(unsigned)sb, (unsigned)(sb >> 32)};
            base += (unsigned)__popcll(eqb);
        }
    }
    if (NI < 32) { if (lane < 2 * (32 - NI)) mrow[2 * NI + lane] = 0u; }
}
template <int NI> __device__ __forceinline__ void select2(const LAS unsigned* ka_, const LAS unsigned* kb_, int nk, GAS unsigned* mrowA, GAS unsigned* mrowB, int lane) {
    unsigned ka[NI], kb[NI];
#pragma unroll
    for (int i = 0; i < NI; ++i) { const int sidx = lane + 64 * i; ka[i] = (sidx < nk) ? ka_[sidx] : 0u; kb[i] = (sidx < nk) ? kb_[sidx] : 0u; }
    unsigned pa = 0u, pb = 0u; bool ea = false, eb = false;
    for (int bit = 31; bit >= 0; --bit) {
        const unsigned ca = pa | (1u << bit), cb = pb | (1u << bit);
        unsigned c0 = 0u, c1 = 0u, d0 = 0u, d1 = 0u;
#pragma unroll
        for (int i = 0; i < NI; i += 2) { c0 += (unsigned)(ka[i] >= ca); c1 += (unsigned)(ka[i + 1] >= ca); d0 += (unsigned)(kb[i] >= cb); d1 += (unsigned)(kb[i + 1] >= cb); }
        const unsigned ta = wave_total6(c0 + c1), tb = wave_total6(d0 + d1);
        if (!ea && ta >= (unsigned)TOPK) { pa = ca; ea = (ta == (unsigned)TOPK); }
        if (!eb && tb >= (unsigned)TOPK) { pb = cb; eb = (tb == (unsigned)TOPK); }
        if (ea && eb) break;
    }
    emit_mask<NI>(ka, pa, ea, mrowA, lane);
    emit_mask<NI>(kb, pb, eb, mrowB, lane);
}
constexpr int MK_STRIDE = 2049;
__device__ __forceinline__ void p_mask(Frame& F) {
    LAS unsigned* keys = (LAS unsigned*)(F.lds + RING_OFF);
    const GAS bf16* qi_hl = (const GAS bf16*)(F.ws + WS_QIHL); const GAS bf16* ki_hl = (const GAS bf16*)(F.ws + WS_KIHL); const GAS float* wi = (const GAS float*)(F.ws + WS_WI); GAS unsigned* mask = (GAS unsigned*)(F.ws + WS_MASK);
    const int tid = F.tid, lane = F.lane, wave = F.wave, q = lane & 15, kg = lane >> 4;
    for (int c = F.bid; c < 256; c += F.G) {
        for (int ui = 0; ui < 4; ++ui) {
            const int b = (c >> 6) * 2 + (ui >> 1), bq = c & 63, qb = (ui & 1) ? 127 - bq : bq;
            const int t0 = qb * 16; const size_t rowq0 = (size_t)b * SEQ + t0;
            if (qb < 16) {
                for (int w = tid; w < 1024; w += NTHR) { const int qq = w >> 6, j = w & 63, n = t0 + qq + 1, lo = j * 32;
                    mask[(rowq0 + qq) * 64 + j] = (n >= lo + 32) ? 0xffffffffu : (n > lo ? ((1u << (n - lo)) - 1u) : 0u); }
                continue;
            }
            bf16x8v bh[4][2], bl[4][2];
#pragma unroll
            for (int h = 0; h < 4; ++h)
#pragma unroll
                for (int dh = 0; dh < 2; ++dh) { const GAS bf16* pq = qi_hl + (rowq0 + q) * 512 + h * 64 + dh * 32 + kg * 8;
                    bh[h][dh] = *(const GAS bf16x8v*)pq; bl[h][dh] = *(const GAS bf16x8v*)(pq + 256); }
            const f32x4 wv = *(const GAS f32x4*)(wi + (rowq0 + q) * 4);
            const int ntile = qb + 1;
            bf16x8v ah[2], al[2];
            { const int kt0 = wave < ntile ? wave : 0;
#pragma unroll
              for (int dh = 0; dh < 2; ++dh) { const GAS bf16* pk = ki_hl + ((size_t)b * SEQ + kt0 * 16 + q) * 128 + dh * 32 + kg * 8;
                  ah[dh] = *(const GAS bf16x8v*)pk; al[dh] = *(const GAS bf16x8v*)(pk + 64); } }
            for (int kt = wave; kt < ntile; kt += NWAVES) {
                const int s0 = kt * 16;
                bf16x8v ahn[2], aln[2];
                { const int ktn = (kt + NWAVES < ntile) ? kt + NWAVES : kt;
#pragma unroll
                  for (int dh = 0; dh < 2; ++dh) { const GAS bf16* pk = ki_hl + ((size_t)b * SEQ + ktn * 16 + q) * 128 + dh * 32 + kg * 8;
                      ahn[dh] = *(const GAS bf16x8v*)pk; aln[dh] = *(const GAS bf16x8v*)(pk + 64); } }
                __builtin_amdgcn_sched_barrier(0);
                f32x4 acc[4];
#pragma unroll
                for (int h = 0; h < 4; ++h) { acc[h] = (f32x4){0.f, 0.f, 0.f, 0.f};
#pragma unroll
                    for (int dh = 0; dh < 2; ++dh) {
                        acc[h] = __builtin_amdgcn_mfma_f32_16x16x32_bf16(ah[dh], bh[h][dh], acc[h], 0, 0, 0);
                        acc[h] = __builtin_amdgcn_mfma_f32_16x16x32_bf16(ah[dh], bl[h][dh], acc[h], 0, 0, 0);
                        acc[h] = __builtin_amdgcn_mfma_f32_16x16x32_bf16(al[dh], bh[h][dh], acc[h], 0, 0, 0);
                    } }
#pragma unroll
                for (int r = 0; r < 4; ++r) {
                    const float I = wv[0] * fmaxf(acc[0][r], 0.f) + wv[1] * fmaxf(acc[1][r], 0.f) + wv[2] * fmaxf(acc[2][r], 0.f) + wv[3] * fmaxf(acc[3][r], 0.f);
                    const int s = s0 + 4 * kg + r;
                    keys[q * MK_STRIDE + s] = (s <= t0 + q) ? sort_key(I) : 0u;
                }
                __builtin_amdgcn_sched_barrier(0);
#pragma unroll
                for (int dh = 0; dh < 2; ++dh) { ah[dh] = ahn[dh]; al[dh] = aln[dh]; }
            }
            __syncthreads();
            const int nk = t0 + 16;
            { const LAS unsigned* kA = keys + (2 * wave) * MK_STRIDE; const LAS unsigned* kB = kA + MK_STRIDE;
              GAS unsigned* mA = mask + (rowq0 + 2 * wave) * 64; GAS unsigned* mB = mA + 64;
              if (nk <= 512) select2<8>(kA, kB, nk, mA, mB, lane);
              else if (nk <= 1024) select2<16>(kA, kB, nk, mA, mB, lane);
              else if (nk <= 1536) select2<24>(kA, kB, nk, mA, mB, lane);
              else select2<32>(kA, kB, nk, mA, mB, lane); }
            __syncthreads();
        }
    }
}

typedef short s16x4 __attribute__((ext_vector_type(4)));
#define MFMA16(a, b, c) __builtin_amdgcn_mfma_f32_16x16x16bf16_1k((a), (b), (c), 0, 0, 0)
__device__ __forceinline__ s16x4 pack4(const f32x4 v) { v2u t; t.x = cvtpk(v[0], v[1]); t.y = cvtpk(v[2], v[3]); return __builtin_bit_cast(s16x4, t); }
constexpr int HG_QT = 0, HG_KT = 2176, HG_KH = 4352, HG_IT = 7424, HG_DF = 10496, HG_WAVE_LDS = 10752;
template <bool FULL> __device__ __forceinline__ float hgrn_stage(const GAS bf16* pr, float lbv, LAS unsigned char* W, int lane) {
    unsigned short zr[16], ir[16], qr[16];
#pragma unroll
    for (int s_ = 0; s_ < 16; ++s_) { zr[s_] = pr[(size_t)s_ * PROJ_LD + PC_HF]; ir[s_] = pr[(size_t)s_ * PROJ_LD + PC_HI]; if (FULL) qr[s_] = pr[(size_t)s_ * PROJ_LD + PC_HQ]; }
    __builtin_amdgcn_sched_barrier(0);
    float f[16], kk[16]; float P = 1.0f;
    LAS unsigned short* QT = (LAS unsigned short*)(W + HG_QT); LAS unsigned short* KT = (LAS unsigned short*)(W + HG_KT);
#pragma unroll
    for (int s_ = 0; s_ < 16; ++s_) {
        const float z = bf2f(zr[s_]);
        const float sig = 1.0f / (1.0f + __expf(-z));
        f[s_] = fmaxf(lbv + (1.0f - lbv) * sig, 1e-30f); kk[s_] = (1.0f - lbv) * (1.0f - sig);
        P *= f[s_];
        if (FULL) { const float q = bf2f(qr[s_]); const float qs = q / (1.0f + __expf(-q));
            QT[s_ * 68 + lane] = (unsigned short)f2bf(qs * P); KT[s_ * 68 + lane] = (unsigned short)f2bf(kk[s_] / fmaxf(P, 1e-30f)); }
    }
    float E = 1.0f; unsigned kh[8];
#pragma unroll
    for (int s_ = 15; s_ >= 0; s_ -= 2) {
        const float hi = kk[s_] * E; E *= f[s_];
        const float lo = kk[s_ - 1] * E; E *= f[s_ - 1];
        kh[s_ >> 1] = cvtpk(lo, hi);
    }
    LAS v4u* KH = (LAS v4u*)(W + HG_KH + lane * 48); LAS v4u* IT = (LAS v4u*)(W + HG_IT + lane * 48);
    KH[0] = (v4u){kh[0], kh[1], kh[2], kh[3]}; KH[1] = (v4u){kh[4], kh[5], kh[6], kh[7]};
    IT[0] = (v4u){(unsigned)ir[0] | ((unsigned)ir[1] << 16), (unsigned)ir[2] | ((unsigned)ir[3] << 16), (unsigned)ir[4] | ((unsigned)ir[5] << 16), (unsigned)ir[6] | ((unsigned)ir[7] << 16)};
    IT[1] = (v4u){(unsigned)ir[8] | ((unsigned)ir[9] << 16), (unsigned)ir[10] | ((unsigned)ir[11] << 16), (unsigned)ir[12] | ((unsigned)ir[13] << 16), (unsigned)ir[14] | ((unsigned)ir[15] << 16)};
    ((LAS float*)(W + HG_DF))[lane] = P;
    return P;
}
__device__ __forceinline__ void hgrn_update(f32x4 (&S)[4][4], const LAS unsigned char* W, int fr, int kg) {
    s16x4 khf[4], itf[4]; f32x4 df[4];
#pragma unroll
    for (int i = 0; i < 4; ++i) { khf[i] = *(const LAS s16x4*)(W + HG_KH + (16 * i + fr) * 48 + 8 * kg); itf[i] = *(const LAS s16x4*)(W + HG_IT + (16 * i + fr) * 48 + 8 * kg);
        df[i] = *(const LAS f32x4*)(W + HG_DF + (16 * i + 4 * kg) * 4); }
#pragma unroll
    for (int kb = 0; kb < 4; ++kb)
#pragma unroll
        for (int vb = 0; vb < 4; ++vb) S[kb][vb] = MFMA16(khf[kb], itf[vb], S[kb][vb] * df[kb]);
}
__device__ __forceinline__ void p_hgrn_local(Frame& F, int layer) {
    const int lane = F.lane, fr = lane & 15, kg = lane >> 4;
    LAS unsigned char* W = F.lds + RING_OFF + F.wave * 16384;
    const GAS bf16* proj = (const GAS bf16*)(F.ws + WS_PROJ); GAS float* hst = (GAS float*)(F.ws + WS_HST); GAS float* hdn = (GAS float*)(F.ws + WS_HDN);
    for (int unit = F.wave * F.G + F.bid; unit < BATCH * 4 * (SEQ / 64); unit += NWAVES * F.G) {
        const int bh = unit >> 5, chunk = unit & 31, b = bh >> 2, h = bh & 3;
        const float lbv = ((const GAS float*)(F.ws + WS_LB))[layer * 256 + h * 64 + lane];
        const size_t row0 = (size_t)b * SEQ + chunk * 64;
        f32x4 S[4][4];
#pragma unroll
        for (int i = 0; i < 4; ++i)
#pragma unroll
            for (int j = 0; j < 4; ++j) S[i][j] = (f32x4){0.f, 0.f, 0.f, 0.f};
        float dprod = 1.0f;
        for (int sub = 0; sub < 4; ++sub) {
            dprod *= hgrn_stage<false>(proj + (row0 + sub * 16) * PROJ_LD + h * 64 + lane, lbv, W, lane);
            LDS_WAIT(); asm volatile("" ::: "memory");
            hgrn_update(S, W, fr, kg);
            LDS_WAIT(); asm volatile("" ::: "memory");
        }
        GAS float* U = hst + (size_t)unit * 4096;
#pragma unroll
        for (int kb = 0; kb < 4; ++kb)
#pragma unroll
            for (int vb = 0; vb < 4; ++vb)
#pragma unroll
                for (int r = 0; r < 4; ++r) U[(16 * kb + 4 * kg + r) * 64 + 16 * vb + fr] = S[kb][vb][r];
        hdn[unit * 64 + lane] = dprod;
    }
}
__device__ __forceinline__ void p_hgrn_scan(Frame& F) {
    GAS float* hst = (GAS float*)(F.ws + WS_HST); const GAS float* hdn = (const GAS float*)(F.ws + WS_HDN);
    for (int e = F.bid * NTHR + F.tid; e < BATCH * 4 * 4096; e += F.G * NTHR) {
        const int bh = e >> 12, kv = e & 4095, k = kv >> 6;
        float S = 0.f;
        for (int n = 0; n < SEQ / 64; ++n) {
            const size_t idx = ((size_t)(bh * 32 + n) << 12) + kv;
            const float u = hst[idx]; hst[idx] = S;
            S = hdn[(bh * 32 + n) * 64 + k] * S + u;
        }
    }
}
constexpr int HG_LDS_OFF = 40960;
__device__ __forceinline__ void p_hgrn_out(Frame& F, int layer) {
    const int lane = F.lane, fr = lane & 15, kg = lane >> 4;
    LAS unsigned char* W = F.lds + RING_OFF + HG_LDS_OFF + F.wave * HG_WAVE_LDS;
    const GAS bf16* proj = (const GAS bf16*)(F.ws + WS_PROJ); GAS bf16* mixed = (GAS bf16*)(F.ws + WS_MIXED); const GAS float* hst = (const GAS float*)(F.ws + WS_HST);
    for (int unit = F.wave * F.G + F.bid; unit < BATCH * 4 * (SEQ / 64); unit += NWAVES * F.G) {
        const int bh = unit >> 5, chunk = unit & 31, b = bh >> 2, h = bh & 3;
        const float lbv = ((const GAS float*)(F.ws + WS_LB))[layer * 256 + h * 64 + lane];
        const size_t row0 = (size_t)b * SEQ + chunk * 64;
        f32x4 S[4][4];
        { const GAS float* U = hst + (size_t)unit * 4096;
#pragma unroll
          for (int kb = 0; kb < 4; ++kb)
#pragma unroll
              for (int vb = 0; vb < 4; ++vb)
#pragma unroll
                  for (int r = 0; r < 4; ++r) S[kb][vb][r] = U[(16 * kb + 4 * kg + r) * 64 + 16 * vb + fr]; }
        f32x4 ng4[4];
#pragma unroll
        for (int vb = 0; vb < 4; ++vb) ng4[vb] = *(const GAS f32x4*)((const GAS float*)F.hgrn_g + layer * 256 + h * 64 + 16 * vb + 4 * kg);
        for (int sub = 0; sub < 4; ++sub) {
            const size_t rs = row0 + sub * 16;
            (void)hgrn_stage<true>(proj + rs * PROJ_LD + h * 64 + lane, lbv, W, lane);
            v2u g2[4];
#pragma unroll
            for (int vb = 0; vb < 4; ++vb) g2[vb] = *(const GAS v2u*)(proj + (rs + fr) * PROJ_LD + PC_HG + h * 64 + 16 * vb + 4 * kg);
            LDS_WAIT(); asm volatile("" ::: "memory");
            s16x4 qb[4];
#pragma unroll
            for (int kb = 0; kb < 4; ++kb) qb[kb] = *(const LAS s16x4*)(W + HG_QT + (fr * 68 + 16 * kb + 4 * kg) * 2);
            f32x4 o[4];
#pragma unroll
            for (int vb = 0; vb < 4; ++vb) { o[vb] = (f32x4){0.f, 0.f, 0.f, 0.f};
#pragma unroll
                for (int kb = 0; kb < 4; ++kb) o[vb] = MFMA16(pack4(S[kb][vb]), qb[kb], o[vb]); }
            f32x4 at = {0.f, 0.f, 0.f, 0.f};
#pragma unroll
            for (int kb = 0; kb < 4; ++kb) at = MFMA16(*(const LAS s16x4*)(W + HG_KT + (fr * 68 + 16 * kb + 4 * kg) * 2), qb[kb], at);
#pragma unroll
            for (int r = 0; r < 4; ++r) if (4 * kg + r > fr) at[r] = 0.f;
            const s16x4 ab = pack4(at);
#pragma unroll
            for (int vb = 0; vb < 4; ++vb) o[vb] = MFMA16(*(const LAS s16x4*)(W + HG_IT + (16 * vb + fr) * 48 + 8 * kg), ab, o[vb]);
            hgrn_update(S, W, fr, kg);
            float ssq = 0.f;
#pragma unroll
            for (int vb = 0; vb < 4; ++vb) ssq += (o[vb][0] * o[vb][0] + o[vb][1] * o[vb][1]) + (o[vb][2] * o[vb][2] + o[vb][3] * o[vb][3]);
            ssq += __shfl_xor(ssq, 16); ssq += __shfl_xor(ssq, 32);
            const float rstd = 1.0f / sqrtf(ssq * (1.0f / 64.0f) + 1e-5f);
#pragma unroll
            for (int vb = 0; vb < 4; ++vb) {
                const float g0 = __builtin_bit_cast(float, g2[vb].x << 16), g1 = __builtin_bit_cast(float, g2[vb].x & 0xffff0000u), g2f = __builtin_bit_cast(float, g2[vb].y << 16), g3 = __builtin_bit_cast(float, g2[vb].y & 0xffff0000u);
                const float y0 = o[vb][0] * rstd * ng4[vb][0] * (g0 / (1.0f + __expf(-g0))), y1 = o[vb][1] * rstd * ng4[vb][1] * (g1 / (1.0f + __expf(-g1)));
                const float y2 = o[vb][2] * rstd * ng4[vb][2] * (g2f / (1.0f + __expf(-g2f))), y3 = o[vb][3] * rstd * ng4[vb][3] * (g3 / (1.0f + __expf(-g3)));
                *(GAS v2u*)(mixed + (rs + fr) * DM + MC_HGRN + h * 64 + 16 * vb + 4 * kg) = (v2u){cvtpk(y0, y1), cvtpk(y2, y3)};
            }
            LDS_WAIT(); asm volatile("" ::: "memory");
        }
    }
}

constexpr int AT_KROW = 144, AT_VROW = 136, AT_KBYTES = 64 * AT_KROW, AT_VBYTES = 64 * AT_VROW, AT_BUF = AT_KBYTES + AT_VBYTES, AT_SCR = 2 * AT_BUF;
static_assert(AT_BUF % 16 == 0 && AT_SCR % 16 == 0, "attention LDS map alignment");
__device__ __forceinline__ void p_attn_flash(Frame& F) {
    const int tid = F.tid, lane = F.lane, wave = F.wave;
    const int r = lane & 31, hh = lane >> 5, g = wave & 3, qh = wave >> 2;
    LAS unsigned char* L = F.lds + RING_OFF;
    LAS float* scr = (LAS float*)(L + AT_SCR) + wave * 32;
    const GAS bf16* proj = (const GAS bf16*)(F.ws + WS_PROJ); const GAS bf16* vT = (const GAS bf16*)(F.ws + WS_VT); GAS bf16* mixed = (GAS bf16*)(F.ws + WS_MIXED);
    const GAS unsigned* mask = (const GAS unsigned*)(F.ws + WS_MASK);
    const int srow = tid >> 3, sch = tid & 7;
    const float C2 = 0.18033688011112042f, NEG = -1.0e30f;
    for (int pair = F.bid; pair < 256; pair += F.G) {
        const int bk = pair >> 4, b = bk >> 1, kvh = bk & 1, pp = pair & 15, h = kvh * 4 + g;
        for (int half = 0; half < 2; ++half) {
            const int qblk = half == 0 ? 31 - pp : pp;
            const int q0 = qblk * 64, nt = qblk + 1;
            const int tq = q0 + 32 * qh + r;
            bf16x8v qf[4];
            { const GAS bf16* qp = proj + (size_t)(b * SEQ + tq) * PROJ_LD + PC_Q + h * 64 + 8 * hh;
#pragma unroll
              for (int d0 = 0; d0 < 4; ++d0) qf[d0] = *(const GAS bf16x8v*)(qp + 16 * d0); }
            const GAS unsigned* mrow = mask + (size_t)(b * SEQ + tq) * 64;
            const GAS bf16* kg = proj + (size_t)(b * SEQ + srow) * PROJ_LD + PC_K + kvh * 64 + sch * 8;
            const GAS bf16* vg = vT + (size_t)(bk * 64 + srow) * SEQ + sch * 8;
            { const v4u kreg = *(const GAS v4u*)kg; const v4u vreg = *(const GAS v4u*)vg;
              *(LAS v4u*)(L + srow * AT_KROW + sch * 16) = kreg;
              LAS unsigned char* vd = L + AT_KBYTES + srow * AT_VROW + sch * 16;
              *(LAS v2u*)vd = (v2u){vreg.x, vreg.y}; *(LAS v2u*)(vd + 8) = (v2u){vreg.z, vreg.w}; }
            v2u mw = *(const GAS v2u*)mrow;
            __syncthreads();
            f32x16 o0, o1;
#pragma unroll
            for (int i = 0; i < 16; ++i) { o0[i] = 0.f; o1[i] = 0.f; }
            float m = -30000.0f, l = 0.f;
            for (int j = 0; j < nt; ++j) {
                LAS unsigned char* Kb = L + (j & 1) * AT_BUF; LAS unsigned char* Vb = Kb + AT_KBYTES;
                const bool more = (j + 1 < nt);
                const int jn = more ? j + 1 : j;
                const v4u kn = *(const GAS v4u*)(kg + (size_t)jn * 64 * PROJ_LD); const v4u vn = *(const GAS v4u*)(vg + jn * 64); const v2u mwn = *(const GAS v2u*)(mrow + 2 * jn);
                bf16x8v kf[8];
#pragma unroll
                for (int d0 = 0; d0 < 4; ++d0) { kf[2 * d0] = *(const LAS bf16x8v*)(Kb + r * AT_KROW + d0 * 32 + hh * 16); kf[2 * d0 + 1] = *(const LAS bf16x8v*)(Kb + (32 + r) * AT_KROW + d0 * 32 + hh * 16); }
                __builtin_amdgcn_sched_barrier(0);
                f32x16 p0, p1;
#pragma unroll
                for (int i = 0; i < 16; ++i) { p0[i] = 0.f; p1[i] = 0.f; }
#pragma unroll
                for (int d0 = 0; d0 < 4; ++d0) {
                    p0 = __builtin_amdgcn_mfma_f32_32x32x16_bf16(kf[2 * d0], qf[d0], p0, 0, 0, 0);
                    p1 = __builtin_amdgcn_mfma_f32_32x32x16_bf16(kf[2 * d0 + 1], qf[d0], p1, 0, 0, 0);
                }
                v2u vl[8], vh[8];
#pragma unroll
                for (int ks = 0; ks < 4; ++ks) {
                    const LAS unsigned char* vp = Vb + r * AT_VROW + (16 * ks + 4 * hh) * 2;
                    vl[2 * ks] = *(const LAS v2u*)vp; vh[2 * ks] = *(const LAS v2u*)(vp + 16);
                    vl[2 * ks + 1] = *(const LAS v2u*)(vp + 32 * AT_VROW); vh[2 * ks + 1] = *(const LAS v2u*)(vp + 32 * AT_VROW + 16);
                }
                __builtin_amdgcn_sched_barrier(0);
                const unsigned w0 = mw.x >> (4 * hh), w1 = mw.y >> (4 * hh);
                float mx = NEG;
#pragma unroll
                for (int i = 0; i < 16; ++i) {
                    const int cr = (i & 3) + 8 * (i >> 2);
                    p0[i] = ((w0 >> cr) & 1u) ? p0[i] : NEG; p1[i] = ((w1 >> cr) & 1u) ? p1[i] : NEG;
                    mx = fmaxf(mx, fmaxf(p0[i], p1[i]));
                }
                mx = fmaxf(mx, __shfl_xor(mx, 32));
                const float mxs = mx * C2;
                const bool need = mxs > m + 8.0f;
                if (__any(need)) {
                    const float mnew = need ? mxs : m;
                    const float alpha = __builtin_amdgcn_exp2f(m - mnew); m = mnew; l *= alpha;
                    if (hh == 0) scr[r] = alpha;
#pragma unroll
                    for (int gq = 0; gq < 4; ++gq) {
                        const f32x4 a4 = *(const LAS f32x4*)(scr + 8 * gq + 4 * hh);
#pragma unroll
                        for (int e = 0; e < 4; ++e) { o0[4 * gq + e] *= a4[e]; o1[4 * gq + e] *= a4[e]; }
                    }
                }
                float rs = 0.f;
#pragma unroll
                for (int i = 0; i < 16; ++i) {
                    p0[i] = __builtin_amdgcn_exp2f(__builtin_fmaf(p0[i], C2, -m)); p1[i] = __builtin_amdgcn_exp2f(__builtin_fmaf(p1[i], C2, -m));
                    rs += p0[i] + p1[i];
                }
                l += rs;
                bf16x8v pf[4];
                { v4u t;
                  t.x = cvtpk(p0[0], p0[1]); t.y = cvtpk(p0[2], p0[3]); t.z = cvtpk(p0[4], p0[5]); t.w = cvtpk(p0[6], p0[7]); pf[0] = __builtin_bit_cast(bf16x8v, t);
                  t.x = cvtpk(p0[8], p0[9]); t.y = cvtpk(p0[10], p0[11]); t.z = cvtpk(p0[12], p0[13]); t.w = cvtpk(p0[14], p0[15]); pf[1] = __builtin_bit_cast(bf16x8v, t);
                  t.x = cvtpk(p1[0], p1[1]); t.y = cvtpk(p1[2], p1[3]); t.z = cvtpk(p1[4], p1[5]); t.w = cvtpk(p1[6], p1[7]); pf[2] = __builtin_bit_cast(bf16x8v, t);
                  t.x = cvtpk(p1[8], p1[9]); t.y = cvtpk(p1[10], p1[11]); t.z = cvtpk(p1[12], p1[13]); t.w = cvtpk(p1[14], p1[15]); pf[3] = __builtin_bit_cast(bf16x8v, t); }
                __builtin_amdgcn_sched_barrier(0);
#pragma unroll
                for (int ks = 0; ks < 4; ++ks) {
                    const bf16x8v vf0 = __builtin_bit_cast(bf16x8v, (v4u){vl[2 * ks].x, vl[2 * ks].y, vh[2 * ks].x, vh[2 * ks].y});
                    const bf16x8v vf1 = __builtin_bit_cast(bf16x8v, (v4u){vl[2 * ks + 1].x, vl[2 * ks + 1].y, vh[2 * ks + 1].x, vh[2 * ks + 1].y});
                    o0 = __builtin_amdgcn_mfma_f32_32x32x16_bf16(pf[ks], vf0, o0, 0, 0, 0);
                    o1 = __builtin_amdgcn_mfma_f32_32x32x16_bf16(pf[ks], vf1, o1, 0, 0, 0);
                }
                __builtin_amdgcn_sched_barrier(0);
                if (more) {
                    LAS unsigned char* Kn = L + ((j + 1) & 1) * AT_BUF;
                    *(LAS v4u*)(Kn + srow * AT_KROW + sch * 16) = kn;
                    LAS unsigned char* vd = Kn + AT_KBYTES + srow * AT_VROW + sch * 16;
                    *(LAS v2u*)vd = (v2u){vn.x, vn.y}; *(LAS v2u*)(vd + 8) = (v2u){vn.z, vn.w};
                }
                mw = mwn;
                __syncthreads();
            }
            l += __shfl_xor(l, 32);
            if (hh == 0) scr[r] = 1.0f / l;
            GAS bf16* op = mixed + (size_t)(b * SEQ + q0 + 32 * qh) * DM + MC_ATTN + h * 64 + r;
#pragma unroll
            for (int gq = 0; gq < 4; ++gq) {
                const f32x4 a4 = *(const LAS f32x4*)(scr + 8 * gq + 4 * hh);
#pragma unroll
                for (int e = 0; e < 4; ++e) {
                    const int q = 8 * gq + 4 * hh + e;
                    op[(size_t)q * DM] = (bf16)f2bf(o0[4 * gq + e] * a4[e]); op[(size_t)q * DM + 32] = (bf16)f2bf(o1[4 * gq + e] * a4[e]);
                }
            }
        }
    }
}

__device__ __forceinline__ void p_final(Frame& F) {
    const int gw = F.bid * NWAVES + F.wave, NGW = F.G * NWAVES;
    for (int row = gw; row < M; row += NGW) {
        GAS f32x4* xr = (GAS f32x4*)(F.xres + (size_t)row * DM) + F.lane;
        const GAS f32x4* gr = (const GAS f32x4*)F.fng + F.lane;
        f32x4 v[4]; float s = 0.f;
#pragma unroll
        for (int j = 0; j < 4; ++j) { v[j] = xr[64 * j]; s += (v[j][0] * v[j][0] + v[j][1] * v[j][1]) + (v[j][2] * v[j][2] + v[j][3] * v[j][3]); }
        s = wave_sum(s);
        const float rs = 1.0f / sqrtf(s * (1.0f / 1024.0f) + 1e-5f);
#pragma unroll
        for (int j = 0; j < 4; ++j) xr[64 * j] = v[j] * rs * gr[64 * j];
    }
}

#ifndef MK_SINGLE
#define MK_SINGLE 1
#endif
constexpr int NPL = 7;
constexpr int NPHASE = 1 + DEPTH * NPL + 1;
struct Args { const float* x; const int* pos; const float *n1g, *w_in, *pool_w, *pool_scale, *lb_logits, *hgrn_g, *w_out, *n2g, *w_ff_in, *w_ff_out, *fng; float* out; unsigned char* ws; int ph_lo, ph_hi; };
static_assert(sizeof(Args) == 15 * 8 + 8, "Args has no padding");


#define PHASE_BEGIN() do { int t_ = threadIdx.x; asm volatile("" : "+v"(t_)); F.tid = t_; F.lane = t_ & 63; F.wave = __builtin_amdgcn_readfirstlane(t_ >> 6); \
    unsigned char* w_ = args.ws; asm volatile("" : "+s"(w_)); F.ws = w_; int b_ = blockIdx.x; asm volatile("" : "+s"(b_)); F.bid = b_; } while (0)

#define RSTD_TAB_OFF RING_BYTES
#define FILL_RSTD(S_, pm_out) do { PHASE_BEGIN(); pg8::Unit u0_; pm_out = S_.next(0, u0_) ? u0_.pm : -1; \
    if (pm_out >= 0 && F.tid < 256) ((LAS float*)(F.lds + RSTD_TAB_OFF))[F.tid] = pg8::row_rstd((const float*)(F.ws + WS_SSQ), pm_out * 256 + F.tid); \
    __syncthreads(); } while (0)
__global__ void __launch_bounds__(NTHR, 2) fwd(Args args) {
    extern __shared__ __attribute__((aligned(16))) unsigned char lds[];
    Frame F;
    F.lds = (LAS unsigned char*)lds;
    F.MISC = (volatile LAS unsigned*)(F.lds + MISC_OFF);
    F.tid = threadIdx.x; F.lane = F.tid & 63; F.wave = __builtin_amdgcn_readfirstlane(F.tid >> 6);
    F.G = gridDim.x; F.bid = blockIdx.x;
    F.ws = args.ws; F.ctl = (gu32*)(args.ws + WS_CTL);
    F.x_in = args.x; F.pos = args.pos; F.n1g = args.n1g; F.w_in = args.w_in; F.pool_w = args.pool_w; F.pool_scale = args.pool_scale; F.lb_logits = args.lb_logits;
    F.hgrn_g = args.hgrn_g; F.w_out = args.w_out; F.n2g = args.n2g; F.w_ff_in = args.w_ff_in; F.w_ff_out = args.w_ff_out; F.fng = args.fng; F.xres = args.out;
    for (int u = F.tid; u < (LDS_BYTES - LDSCTL_OFF) / 4; u += NTHR) ((LAS unsigned*)(F.lds + LDSCTL_OFF))[u] = 0u;
    __syncthreads();
    XcdBarrier bar; bar.bar = (unsigned*)(F.ctl + CW_BAR); bar.x = 0; bar.st = nullptr;
    if (MK_SINGLE) bar = xcd_barrier_post((unsigned*)(F.ctl + CW_BAR), F.MISC + 8);
    const int lo = args.ph_lo, hi = args.ph_hi;
#define IN(k) (lo <= (k) && (k) < hi)
#define SEAM(k) do { if (MK_SINGLE && IN(k) && IN((k) + 1)) xcd_barrier(bar); } while (0)
    bf16* const xb = (bf16*)(F.ws + WS_XB); float* const ssq = (float*)(F.ws + WS_SSQ);
    bf16* const proj = (bf16*)(F.ws + WS_PROJ); bf16* const mixed = (bf16*)(F.ws + WS_MIXED); bf16* const hid = (bf16*)(F.ws + WS_HID);

    if (IN(0)) { PHASE_BEGIN(); p_prologue(F); } SEAM(0);
    for (int layer = 0; layer < DEPTH; ++layer) {
        const int pb = 1 + layer * NPL;
        if (IN(pb + 0)) {
            PHASE_BEGIN(); pg8::Gemm g{xb, (const bf16*)(F.ws + WS_WIN), M, DINP, DM}; pg8::StaticOrder S; S.init(M, DINP, F.G, F.bid);
            int pm0; FILL_RSTD(S, pm0);
            pg8::EpiIn E{F.ws, pg8::RstdTab{(const LAS float*)(F.lds + RSTD_TAB_OFF), pm0, F.ws}};
            pg8::gemm_phase<pg8::EpiIn, pg8::StaticOrder, true, true>(F.lds + RING_OFF, g, S, E);
        } SEAM(pb + 0);
        if (IN(pb + 1)) { PHASE_BEGIN(); cvt_layer_rest(F, layer); PHASE_BEGIN(); p_hgrn_local(F, layer); } SEAM(pb + 1);
        if (IN(pb + 2)) { PHASE_BEGIN(); p_pool(F, layer); PHASE_BEGIN(); p_mask(F); PHASE_BEGIN(); p_hgrn_scan(F); } SEAM(pb + 2);
        if (IN(pb + 3)) { PHASE_BEGIN(); p_hgrn_out(F, layer); PHASE_BEGIN(); p_attn_flash(F); } SEAM(pb + 3);
        if (IN(pb + 4)) {
            PHASE_BEGIN(); pg8::Gemm g{mixed, (const bf16*)(F.ws + WS_WOUT), M, DM, DM}; pg8::StaticOrder S; S.init(M, DM, F.G, F.bid);
            pg8::EpiRes E{layer == 0 ? F.x_in : (const float*)F.xres, F.xres, F.ws};
            pg8::gemm_phase<pg8::EpiRes, pg8::StaticOrder, true, true>(F.lds + RING_OFF, g, S, E);
        } SEAM(pb + 4);
        if (IN(pb + 5)) {
            PHASE_BEGIN(); pg8::Gemm g{xb, (const bf16*)(F.ws + WS_WFI), M, DFF, DM}; pg8::StaticOrder S; S.init(M, DFF, F.G, F.bid);
            int pm0; FILL_RSTD(S, pm0);
            pg8::EpiFfIn E{pg8::RstdTab{(const LAS float*)(F.lds + RSTD_TAB_OFF), pm0, F.ws}};
            pg8::gemm_phase<pg8::EpiFfIn, pg8::StaticOrder, true, true>(F.lds + RING_OFF, g, S, E);
        } SEAM(pb + 5);
        if (IN(pb + 6)) {
            PHASE_BEGIN(); pg8::Gemm g{hid, (const bf16*)(F.ws + WS_WFO), M, DM, DFF}; pg8::StaticOrder S; S.init(M, DM, F.G, F.bid);
            pg8::EpiRes E{(const float*)F.xres, F.xres, F.ws};
            pg8::gemm_phase<pg8::EpiRes, pg8::StaticOrder, true, true>(F.lds + RING_OFF, g, S, E);
        } SEAM(pb + 6);
    }
    if (IN(NPHASE - 1)) { PHASE_BEGIN(); p_final(F); }
#undef IN
#undef SEAM
}

extern "C" void kernel_launch(void* const* d_in, const int* in_sizes, int n_in, void* d_out, int out_size, void* d_ws, size_t ws_size, hipStream_t stream) {
    static int grid = 0;
    if (grid == 0) {
        if (n_in != 13 || out_size != M * DM || ws_size < WS_END) { fprintf(stderr, "kernel_launch: unexpected shapes (n_in %d, out %d, ws %zu)\n", n_in, out_size, ws_size); grid = -1; return; }
        int dev = 0, cus = 0, per_cu = 0;
        if (hipGetDevice(&dev) != hipSuccess || hipDeviceGetAttribute(&cus, hipDeviceAttributeMultiprocessorCount, dev) != hipSuccess) { grid = -1; return; }
        if (hipFuncSetAttribute((const void*)fwd, hipFuncAttributeMaxDynamicSharedMemorySize, LDS_BYTES) != hipSuccess) { fprintf(stderr, "kernel_launch: hipFuncSetAttribute failed\n"); grid = -1; return; }
        if (hipOccupancyMaxActiveBlocksPerMultiprocessor(&per_cu, (const void*)fwd, NTHR, LDS_BYTES) != hipSuccess || per_cu < 1) { fprintf(stderr, "kernel_launch: occupancy query says %d\n", per_cu); }
        (void)hipGetLastError();
        grid = cus;
        if (grid != 256) { fprintf(stderr, "kernel_launch: built for a 256-CU device (got %d)\n", cus); grid = -1; return; }
    }
    if (grid <= 0) return;
    (void)hipMemsetAsync((char*)d_ws + WS_CTL, 0, CTL_ZERO_BYTES, stream);
    Args a{};
    a.x = (const float*)d_in[0]; a.pos = (const int*)d_in[1]; a.n1g = (const float*)d_in[2]; a.w_in = (const float*)d_in[3]; a.pool_w = (const float*)d_in[4];
    a.pool_scale = (const float*)d_in[5]; a.lb_logits = (const float*)d_in[6]; a.hgrn_g = (const float*)d_in[7]; a.w_out = (const float*)d_in[8]; a.n2g = (const float*)d_in[9];
    a.w_ff_in = (const float*)d_in[10]; a.w_ff_out = (const float*)d_in[11]; a.fng = (const float*)d_in[12];
    a.out = (float*)d_out; a.ws = (unsigned char*)d_ws;
    if (MK_SINGLE) {
        a.ph_lo = 0; a.ph_hi = NPHASE;
        hipLaunchKernelGGL(fwd, dim3(grid), dim3(NTHR), LDS_BYTES, stream, a);
    } else {
        for (int p = 0; p < NPHASE; ++p) { a.ph_lo = p; a.ph_hi = p + 1; hipLaunchKernelGGL(fwd, dim3(grid), dim3(NTHR), LDS_BYTES, stream, a); }
    }
}
```

```cpp
#include <hip/hip_runtime.h>
#include <cstdio>
#include <cstdint>

constexpr int BATCH = 8, SEQ = 2048, DM = 1024, DEPTH = 4, M = BATCH * SEQ, DIN = 2372, DINP = 2560, DFF = 4096;
constexpr int NWAVES = 8, NTHR = NWAVES * 64;
constexpr int TOPK = 256;
constexpr int PC_POOL = 0, PC_HQ = 256, PC_HF = 512, PC_HI = 768, PC_HG = 1024, PC_Q = 1280, PC_K = 1792, PC_V = 1920, PROJ_LD = 2048;
constexpr int MC_POOL = 0, MC_HGRN = 256, MC_ATTN = 512;

constexpr size_t MiB = 1u << 20;
constexpr size_t WS_CTL = 0, CTL_ZERO_BYTES = 1 * MiB;
constexpr size_t WS_ROPE = 1 * MiB;
constexpr size_t WS_SSQ = 2 * MiB;
constexpr size_t WS_LB = 3 * MiB;
constexpr size_t WS_MASK = 4 * MiB;
constexpr size_t WS_WIN = 8 * MiB;
constexpr size_t WS_WOUT = 13 * MiB;
constexpr size_t WS_WFI = 15 * MiB;
constexpr size_t WS_WFO = 23 * MiB;
constexpr size_t WS_XB = 32 * MiB;
constexpr size_t WS_HID = 64 * MiB;
constexpr size_t WS_PROJ = 64 * MiB;
constexpr size_t WS_MIXED = 128 * MiB;
constexpr size_t WS_HST = 160 * MiB;
constexpr size_t WS_HDN = 176 * MiB;
constexpr size_t WS_QIHL = 192 * MiB;
constexpr size_t WS_KIHL = 208 * MiB;
constexpr size_t WS_WI = 212 * MiB;
constexpr size_t WS_VT = 224 * MiB;
constexpr size_t WS_WIN1 = 232 * MiB;
constexpr size_t WS_END = 256 * MiB;
constexpr int CW_TMO = 0, CW_BAR = 4096;

namespace pg8 {
#define PG8_LAS __attribute__((address_space(3)))
typedef unsigned short bf16_t;
typedef short bf16x8 __attribute__((ext_vector_type(8)));
typedef float f32x4 __attribute__((ext_vector_type(4)));
typedef unsigned u32x4 __attribute__((ext_vector_type(4)));
constexpr int BM = 256, BK = 64, HALF = 128, HTB = HALF * BK * 2  , STAGE_BYTES = 8 * HTB, NXCD = 8, WGM = 8;

__host__ __device__ __forceinline__ int lds_byte(int r, int c) { const int st = (r >> 4) * 2 + (c >> 5), rr = r & 15, cc = c & 31, ob = rr * 64 + cc * 2; return st * 1024 + (ob ^ (((ob >> 9) & 1) << 5)); }
__host__ __device__ __forceinline__ void stage_rc(int b, int& R, int& C) { const int st = b / 1024, sb = b % 1024, swz = sb ^ (((sb >> 9) & 1) << 5); R = (st >> 1) * 16 + swz / 64; C = (st & 1) * 32 + (swz % 64) / 2; }
__host__ __device__ __forceinline__ int perm32(int rho) { const int n = rho >> 4, i = rho & 15; return 8 * (i >> 2) + 4 * n + (i & 3); }

struct Unit { int pm, pn; };
struct Gemm { const bf16_t* A; const bf16_t* Bt; int M, N, K; };

struct StaticOrder {
    int nM, nN, nwg, G, c;
    __host__ __device__ void init(int M, int N, int G_, int c_) { nM = M / BM; nN = N / BM; nwg = nM * nN; G = G_; c = c_; }
    __host__ __device__ __forceinline__ bool next(int i, Unit& u) const {
        const long L = (long)i * G + c; if (L >= nwg) return false;
        int wgid = (int)L; { const int q = nwg / NXCD, r = nwg % NXCD, xcd = wgid % NXCD, off = wgid / NXCD; wgid = (xcd < r ? xcd * (q + 1) : r * (q + 1) + (xcd - r) * q) + off; }
        const int nig = WGM * nN, gid = wgid / nig, fm = gid * WGM, gsz = (nM - fm) < WGM ? (nM - fm) : WGM;
        u.pm = fm + ((wgid % nig) % gsz); u.pn = (wgid % nig) / gsz; return true;
    }
    __device__ __forceinline__ void a_ready(const Unit&) const {}
    __device__ __forceinline__ void done(const Unit&) const {}
};

__device__ __forceinline__ unsigned cvt_pk_bf16(float lo, float hi) { unsigned r; asm volatile("v_cvt_pk_bf16_f32 %0, %1, %2" : "=v"(r) : "v"(lo), "v"(hi)); return r; }
typedef float f32x2 __attribute__((ext_vector_type(2)));

constexpr float RMS_EPS_F = 1e-5f;
#define PG8_GAS __attribute__((address_space(1)))
__device__ __forceinline__ float row_rstd(const float* ssq, int row) {
    const PG8_GAS f32x4* p = (const PG8_GAS f32x4*)(ssq + (size_t)row * 16);
    const f32x4 a = p[0], b = p[1], c = p[2], d = p[3];
    const float s = ((a[0] + a[1]) + (a[2] + a[3])) + ((b[0] + b[1]) + (b[2] + b[3])) + ((c[0] + c[1]) + (c[2] + c[3])) + ((d[0] + d[1]) + (d[2] + d[3]));
    return 1.0f / sqrtf(s * (1.0f / 1024.0f) + RMS_EPS_F);
}
struct RstdTab { const PG8_LAS float* tab; int pm; unsigned char* ws;
    __device__ __forceinline__ float get(int, int rloc) const { return tab[rloc]; } };
__constant__ float c_rot16[2][8] = {{-0.95765948f, -0.999246258f, 0.824376517f, 0.993200301f, 0.999744011f, 0.999990373f, 0.999999638f, 0.999999986f}, {-0.287903317f, 0.0388190063f, 0.566041835f, 0.116418045f, 0.0226254862f, 0.00438795693f, 0.000850927215f, 0.000165014163f}};
__constant__ float c_rot80[2][8] = {{-0.110387244f, -0.981213211f, -0.991153911f, 0.834587283f, 0.993606824f, 0.999759331f, 0.999990949f, 0.99999966f}, {-0.993888654f, 0.192926503f, 0.132717464f, 0.550875727f, 0.11289588f, 0.021938095f, 0.00425462375f, 0.000825070726f}};
__device__ __forceinline__ unsigned cvt_pk_rne(float lo, float hi) { typedef float f2 __attribute__((ext_vector_type(2))); typedef __bf16 b2 __attribute__((ext_vector_type(2))); f2 v = {lo, hi}; b2 b = __builtin_convertvector(v, b2); return __builtin_bit_cast(unsigned, b); }
__device__ __forceinline__ void split_hl(const f32x4 a, const f32x4 b, u32x4& h, u32x4& l) {
    h.x = cvt_pk_rne(a[0], a[1]); h.y = cvt_pk_rne(a[2], a[3]); h.z = cvt_pk_rne(b[0], b[1]); h.w = cvt_pk_rne(b[2], b[3]);
    l.x = cvt_pk_rne(a[0] - __builtin_bit_cast(float, h.x << 16), a[1] - __builtin_bit_cast(float, h.x & 0xffff0000u));
    l.y = cvt_pk_rne(a[2] - __builtin_bit_cast(float, h.y << 16), a[3] - __builtin_bit_cast(float, h.y & 0xffff0000u));
    l.z = cvt_pk_rne(b[0] - __builtin_bit_cast(float, h.z << 16), b[1] - __builtin_bit_cast(float, h.z & 0xffff0000u));
    l.w = cvt_pk_rne(b[2] - __builtin_bit_cast(float, h.w << 16), b[3] - __builtin_bit_cast(float, h.w & 0xffff0000u));
}
struct EpiIn {
    static constexpr bool PERM = true, AFTER_DRAIN = false;
    unsigned char* ws; RstdTab rt;
    __device__ __forceinline__ void operator()(const f32x4 (&acc)[2][2][4][2], const Unit& u, int wr, int wc, int fr, int fq) const {
        bf16_t* const proj = (bf16_t*)(ws + WS_PROJ); bf16_t* const qi_hl = (bf16_t*)(ws + WS_QIHL); bf16_t* const ki_hl = (bf16_t*)(ws + WS_KIHL); float* const wi = (float*)(ws + WS_WI);
        bf16_t* const vT = (bf16_t*)(ws + WS_VT); const float* const rope = (const float*)(ws + WS_ROPE);
        const int rloc0 = wr * 64 + fr, row0 = u.pm * BM + rloc0, pn = u.pn;
        const bool rot_lane = ((wc & 1) == 0) && (fq < 2);
        const float sgn = (fq == 0) ? -1.f : 1.f;
        f32x4 c0 = {1.f, 1.f, 1.f, 1.f}, c1 = c0, s0 = {0.f, 0.f, 0.f, 0.f}, s1 = s0;
        if (pn >= 5) { const PG8_GAS f32x4* tp = (const PG8_GAS f32x4*)(rope + (size_t)row0 * 16); c0 = tp[0]; c1 = tp[1]; s0 = tp[2]; s1 = tp[3]; }
#pragma unroll
        for (int ai = 0; ai < 2; ++ai)
#pragma unroll
            for (int m = 0; m < 4; ++m) {
                const int row = row0 + ai * HALF + m * 16;
                const float rs = rt.get(u.pm, rloc0 + ai * HALF + m * 16);
#pragma unroll
                for (int bj = 0; bj < 2; ++bj) {
                    f32x4 v0 = acc[ai][bj][m][0] * rs, v1 = acc[ai][bj][m][1] * rs;
                    const bool rope_tile = (pn == 5) || (pn == 6) || (pn == 8) || (pn == 7 && bj == 0) || (pn == 9 && bj == 0 && wc < 2);
                    if (rope_tile) {
                        f32x4 p0, p1;
#pragma unroll
                        for (int e = 0; e < 4; ++e) { p0[e] = __shfl_xor(v0[e], 16); p1[e] = __shfl_xor(v1[e], 16); }
                        if (rot_lane) { v0 = v0 * c0 + (p0 * s0) * sgn; v1 = v1 * c1 + (p1 * s1) * sgn; }
                    }
                    const int cl = bj * HALF + wc * 32 + 8 * fq;
                    if (pn < 7 || (pn == 7 && bj == 0)) {
                        u32x4 w; w.x = cvt_pk_bf16(v0[0], v0[1]); w.y = cvt_pk_bf16(v0[2], v0[3]); w.z = cvt_pk_bf16(v1[0], v1[1]); w.w = cvt_pk_bf16(v1[2], v1[3]);
                        *(PG8_GAS u32x4*)(proj + (size_t)row * 2048 + pn * BM + cl) = w;
                    } else if (pn == 7) {
                        const int vc = cl - HALF, kvh = vc >> 6, d = vc & 63, b = row >> 11, t = row & 2047;
                        PG8_GAS bf16_t* o = (PG8_GAS bf16_t*)vT + ((size_t)((b * 2 + kvh) * 64 + d)) * 2048 + t;
                        const u32x4 w = (u32x4){cvt_pk_bf16(v0[0], v0[1]), cvt_pk_bf16(v0[2], v0[3]), cvt_pk_bf16(v1[0], v1[1]), cvt_pk_bf16(v1[2], v1[3])};
                        o[0 * 2048] = (bf16_t)(w.x & 0xffffu); o[1 * 2048] = (bf16_t)(w.x >> 16); o[2 * 2048] = (bf16_t)(w.y & 0xffffu); o[3 * 2048] = (bf16_t)(w.y >> 16);
                        o[4 * 2048] = (bf16_t)(w.z & 0xffffu); o[5 * 2048] = (bf16_t)(w.z >> 16); o[6 * 2048] = (bf16_t)(w.w & 0xffffu); o[7 * 2048] = (bf16_t)(w.w >> 16);
                    } else if (pn == 8) {
                        u32x4 h, l; split_hl(v0, v1, h, l);
                        *(PG8_GAS u32x4*)(qi_hl + (size_t)row * 512 + cl) = h; *(PG8_GAS u32x4*)(qi_hl + (size_t)row * 512 + 256 + cl) = l;
                    } else if (bj == 0) {
                        if (wc < 2) { u32x4 h, l; split_hl(v0, v1, h, l); *(PG8_GAS u32x4*)(ki_hl + (size_t)row * 128 + cl) = h; *(PG8_GAS u32x4*)(ki_hl + (size_t)row * 128 + 64 + cl) = l; }
                        else if (wc == 2 && fq == 0) { *(PG8_GAS f32x4*)(wi + (size_t)row * 4) = v0; }
                    }
                }
                if (pn >= 5 && (ai * 4 + m) < 7) {
#pragma unroll
                    for (int e = 0; e < 4; ++e) {
                        const float dc0 = (m == 3) ? c_rot80[0][e] : c_rot16[0][e], ds0 = (m == 3) ? c_rot80[1][e] : c_rot16[1][e];
                        const float dc1 = (m == 3) ? c_rot80[0][4 + e] : c_rot16[0][4 + e], ds1 = (m == 3) ? c_rot80[1][4 + e] : c_rot16[1][4 + e];
                        const float a0 = c0[e], a1 = c1[e];
                        c0[e] = a0 * dc0 - s0[e] * ds0; s0[e] = s0[e] * dc0 + a0 * ds0;
                        c1[e] = a1 * dc1 - s1[e] * ds1; s1[e] = s1[e] * dc1 + a1 * ds1;
                    }
                }
            }
    }
};
struct EpiRes {
    static constexpr bool PERM = true, AFTER_DRAIN = false;
    const float* xin; float* xout; unsigned char* ws;
    __device__ __forceinline__ void operator()(const f32x4 (&acc)[2][2][4][2], const Unit& u, int wr, int wc, int fr, int fq) const {
        bf16_t* const xb = (bf16_t*)(ws + WS_XB); float* const ssq = (float*)(ws + WS_SSQ);
        const int row0 = u.pm * BM + wr * 64 + fr;
        const int colt = u.pn * BM + wc * 32 + 8 * fq;
        f32x4 cur[2][2], nxt[2][2];
#pragma unroll
        for (int bj = 0; bj < 2; ++bj) { const size_t off = (size_t)row0 * 1024 + colt + bj * HALF; cur[bj][0] = *(const PG8_GAS f32x4*)(xin + off); cur[bj][1] = *(const PG8_GAS f32x4*)(xin + off + 4); }
#pragma unroll
        for (int g = 0; g < 8; ++g) {
            const int ai = g >> 2, m = g & 3;
            const int row = row0 + ai * HALF + m * 16;
            if (g + 1 < 8) { const int rown = row0 + ((g + 1) >> 2) * HALF + ((g + 1) & 3) * 16;
#pragma unroll
                for (int bj = 0; bj < 2; ++bj) { const size_t off = (size_t)rown * 1024 + colt + bj * HALF; nxt[bj][0] = *(const PG8_GAS f32x4*)(xin + off); nxt[bj][1] = *(const PG8_GAS f32x4*)(xin + off + 4); } }
            float sq = 0.f;
#pragma unroll
            for (int bj = 0; bj < 2; ++bj) {
                const size_t off = (size_t)row * 1024 + colt + bj * HALF;
                const f32x4 v0 = cur[bj][0] + acc[ai][bj][m][0], v1 = cur[bj][1] + acc[ai][bj][m][1];
                *(PG8_GAS f32x4*)(xout + off) = v0; *(PG8_GAS f32x4*)(xout + off + 4) = v1;
                u32x4 w; w.x = cvt_pk_bf16(v0[0], v0[1]); w.y = cvt_pk_bf16(v0[2], v0[3]); w.z = cvt_pk_bf16(v1[0], v1[1]); w.w = cvt_pk_bf16(v1[2], v1[3]);
                *(PG8_GAS u32x4*)(xb + off) = w;
                sq += (v0[0] * v0[0] + v0[1] * v0[1]) + (v0[2] * v0[2] + v0[3] * v0[3]) + (v1[0] * v1[0] + v1[1] * v1[1]) + (v1[2] * v1[2] + v1[3] * v1[3]);
            }
            sq += __shfl_xor(sq, 16); sq += __shfl_xor(sq, 32);
            if (fq == 0) ((PG8_GAS float*)ssq)[(size_t)row * 16 + u.pn * 4 + wc] = sq;
#pragma unroll
            for (int bj = 0; bj < 2; ++bj) { cur[bj][0] = nxt[bj][0]; cur[bj][1] = nxt[bj][1]; }
        }
    }
};
struct EpiFfIn {
    static constexpr bool PERM = true, AFTER_DRAIN = false;
    RstdTab rt;
    __device__ __forceinline__ void operator()(const f32x4 (&acc)[2][2][4][2], const Unit& u, int wr, int wc, int fr, int fq) const {
        bf16_t* const hid = (bf16_t*)(rt.ws + WS_HID);
        const int row0 = u.pm * BM + wr * 64 + fr;
        const int colt = u.pn * BM + wc * 32 + 8 * fq;
#pragma unroll
        for (int ai = 0; ai < 2; ++ai)
#pragma unroll
            for (int m = 0; m < 4; ++m) {
                const int row = row0 + ai * HALF + m * 16;
                const float rs = rt.get(u.pm, wr * 64 + fr + ai * HALF + m * 16);
#pragma unroll
                for (int bj = 0; bj < 2; ++bj) {
                    f32x4 v0 = acc[ai][bj][m][0] * rs, v1 = acc[ai][bj][m][1] * rs;
#pragma unroll
                    for (int e = 0; e < 4; ++e) { const float a = fmaxf(v0[e], 0.f), b = fmaxf(v1[e], 0.f); v0[e] = a * a; v1[e] = b * b; }
                    u32x4 w; w.x = cvt_pk_bf16(v0[0], v0[1]); w.y = cvt_pk_bf16(v0[2], v0[3]); w.z = cvt_pk_bf16(v1[0], v1[1]); w.w = cvt_pk_bf16(v1[2], v1[3]);
                    *(PG8_GAS u32x4*)(hid + (size_t)row * 4096 + colt + bj * HALF) = w;
                }
            }
    }
};
template <class Epi, class Sched, bool ALIGN_EPI = false, bool SP2 = false>
__device__ __forceinline__ void gemm_phase(PG8_LAS unsigned char* lds, const Gemm g, const Sched& S, const Epi& E) {
    int tid_ = threadIdx.x; asm volatile("" : "+v"(tid_));
    const int tid = tid_, wid = __builtin_amdgcn_readfirstlane(tid >> 6), lane = tid & 63, wr = wid >> 2, wc = wid & 3, fr = lane & 15, fq = lane >> 4;
    const int K = g.K, nt = K / BK;
    unsigned voffA[2], voffB[2];
#pragma unroll
    for (int i = 0; i < 2; ++i) { int R, C; stage_rc(tid * 16 + i * 8192, R, C); const int Rb = Epi::PERM ? ((R & ~31) + perm32(R & 31)) : R;
        voffA[i] = (unsigned)(R * K + C) * 2u; voffB[i] = (unsigned)(Rb * K + C) * 2u; }
    const size_t kstep = (size_t)(BK * 2);
    const size_t hstep = (size_t)HALF * K * 2;
    const size_t tstep = 2 * hstep;
    const unsigned ldsw = (unsigned)wid * 1024u;
    const int aoff = lds_byte(wr * 64 + fr, fq * 8), boff = lds_byte(wc * 32 + fr, fq * 8);
#define PG8_SA(b, h) (((b) * 2 + (h)) * HTB)
#define PG8_SB(b, h) ((4 + (b) * 2 + (h)) * HTB)
#define PG8_STAGE(bufoff, gbase, voff) do { _Pragma("unroll") for (int _i = 0; _i < 2; ++_i) \
        __builtin_amdgcn_global_load_lds((const unsigned*)((const char*)(gbase) + (voff)[_i]), (PG8_LAS unsigned*)(lds + (bufoff) + ldsw + _i * 8192), 16, 0, 0); } while (0)
#define PG8_LDA(dst, b, h) do { _Pragma("unroll") for (int m = 0; m < 4; ++m) _Pragma("unroll") for (int k = 0; k < 2; ++k) dst[m][k] = *(const PG8_LAS bf16x8*)(lds + PG8_SA(b, h) + aoff + m * 2048 + k * 1024); } while (0)
#define PG8_LDB(dst, b, h) do { _Pragma("unroll") for (int n = 0; n < 2; ++n) _Pragma("unroll") for (int k = 0; k < 2; ++k) dst[n][k] = *(const PG8_LAS bf16x8*)(lds + PG8_SB(b, h) + boff + n * 2048 + k * 1024); } while (0)
#define PG8_MMA(ai, bj, At, Bt) do { __builtin_amdgcn_s_setprio(1); _Pragma("unroll") for (int m = 0; m < 4; ++m) _Pragma("unroll") for (int n = 0; n < 2; ++n) _Pragma("unroll") for (int k = 0; k < 2; ++k) \
        acc[ai][bj][m][n] = __builtin_amdgcn_mfma_f32_16x16x32_bf16(Bt[n][k], At[m][k], acc[ai][bj][m][n], 0, 0, 0); __builtin_amdgcn_s_setprio(0); } while (0)
#define PG8_WAIT_V(n) asm volatile("s_waitcnt vmcnt(" #n ")" ::: "memory")
#define PG8_WAIT_L(n) asm volatile("s_waitcnt lgkmcnt(" #n ")" ::: "memory")
#define PG8_BAR __builtin_amdgcn_s_barrier()
#define PG8_SCHED __builtin_amdgcn_sched_barrier(0)
    Unit cur, nxt; int ui = 0;
    if (!S.next(0, cur)) return;
    f32x4 acc[2][2][4][2];
#pragma unroll
    for (int a = 0; a < 2; ++a)
#pragma unroll
        for (int b = 0; b < 2; ++b)
#pragma unroll
            for (int m = 0; m < 4; ++m)
#pragma unroll
                for (int n = 0; n < 2; ++n) acc[a][b][m][n] = (f32x4){0.f, 0.f, 0.f, 0.f};
    bf16x8 At[4][2], B0[2][2], B1[2][2];
    const char* cA = (const char*)g.A + (size_t)cur.pm * tstep; const char* cB = (const char*)g.Bt + (size_t)cur.pn * tstep;
    S.a_ready(cur);
    if constexpr (SP2) {
        PG8_STAGE(PG8_SB(0, 0), cB, voffB); PG8_STAGE(PG8_SB(0, 1), cB + hstep, voffB); PG8_STAGE(PG8_SA(0, 0), cA, voffA); PG8_STAGE(PG8_SA(0, 1), cA + hstep, voffA);
        if (wr == 1) PG8_BAR;
        PG8_WAIT_V(2); PG8_BAR;
        PG8_STAGE(PG8_SB(1, 0), cB + kstep, voffB); PG8_STAGE(PG8_SA(1, 0), cA + kstep, voffA); PG8_STAGE(PG8_SB(1, 1), cB + hstep + kstep, voffB);
        PG8_WAIT_V(6); PG8_BAR;
    } else {
        PG8_STAGE(PG8_SB(0, 0), cB, voffB); PG8_STAGE(PG8_SA(0, 0), cA, voffA); PG8_STAGE(PG8_SB(0, 1), cB + hstep, voffB); PG8_STAGE(PG8_SA(0, 1), cA + hstep, voffA);
        if (wr == 1) PG8_BAR;
        PG8_WAIT_V(4); PG8_BAR;
        PG8_STAGE(PG8_SB(1, 0), cB + kstep, voffB); PG8_STAGE(PG8_SA(1, 0), cA + kstep, voffA); PG8_STAGE(PG8_SB(1, 1), cB + hstep + kstep, voffB);
        PG8_WAIT_V(6); PG8_BAR;
    }
    for (;;) {
        const bool has_next = S.next(ui + 1, nxt);
        const char* nA = has_next ? (const char*)g.A + (size_t)nxt.pm * tstep : cA; const char* nB = has_next ? (const char*)g.Bt + (size_t)nxt.pn * tstep : cB;
        for (int t = 0; t < nt; t += 2) {
            const bool last = (t == nt - 2);
            const char* a1 = cA + (size_t)(t + 1) * kstep;
            const char* a2 = last ? nA : cA + (size_t)(t + 2) * kstep; const char* b2 = last ? nB : cB + (size_t)(t + 2) * kstep;
            const char* a3 = a2 + kstep; const char* b3 = b2 + kstep;
            if (last && has_next) S.a_ready(nxt);
            if constexpr (SP2) {
            PG8_LDB(B0, 0, 0); PG8_LDB(B1, 0, 1); PG8_SCHED; PG8_LDA(At, 0, 0); PG8_STAGE(PG8_SA(1, 1), a1 + hstep, voffA);
            PG8_WAIT_V(8); PG8_WAIT_L(0); PG8_BAR; PG8_MMA(0, 0, At, B0); PG8_MMA(0, 1, At, B1); PG8_BAR; PG8_SCHED;
            PG8_LDA(At, 0, 1); PG8_STAGE(PG8_SB(0, 0), b2, voffB); PG8_STAGE(PG8_SB(0, 1), b2 + hstep, voffB); PG8_STAGE(PG8_SA(0, 0), a2, voffA);
            PG8_WAIT_V(8); PG8_WAIT_L(0); PG8_BAR; PG8_MMA(1, 0, At, B0); PG8_MMA(1, 1, At, B1); PG8_BAR; PG8_SCHED;
            PG8_LDB(B0, 1, 0); PG8_LDB(B1, 1, 1); PG8_SCHED; PG8_LDA(At, 1, 0); PG8_STAGE(PG8_SA(0, 1), a2 + hstep, voffA);
            PG8_WAIT_V(8); PG8_WAIT_L(0); PG8_BAR; PG8_MMA(0, 0, At, B0); PG8_MMA(0, 1, At, B1); PG8_BAR; PG8_SCHED;
            PG8_LDA(At, 1, 1); PG8_STAGE(PG8_SB(1, 0), b3, voffB); PG8_STAGE(PG8_SB(1, 1), b3 + hstep, voffB); PG8_STAGE(PG8_SA(1, 0), a3, voffA);
            PG8_WAIT_V(8); PG8_WAIT_L(0); PG8_BAR; PG8_MMA(1, 0, At, B0); PG8_MMA(1, 1, At, B1); PG8_BAR; PG8_SCHED;
            } else {
            PG8_LDB(B0, 0, 0); PG8_SCHED; PG8_LDA(At, 0, 0); PG8_STAGE(PG8_SA(1, 1), a1 + hstep, voffA);
            PG8_WAIT_L(8); PG8_BAR; PG8_WAIT_L(0); PG8_MMA(0, 0, At, B0); PG8_BAR; PG8_SCHED;
            PG8_LDB(B1, 0, 1); PG8_STAGE(PG8_SB(0, 0), b2, voffB);
            PG8_BAR; PG8_WAIT_L(0); PG8_MMA(0, 1, At, B1); PG8_BAR;
            PG8_LDA(At, 0, 1); PG8_STAGE(PG8_SA(0, 0), a2, voffA);
            PG8_BAR; PG8_WAIT_L(0); PG8_MMA(1, 0, At, B0); PG8_BAR; PG8_SCHED;
            PG8_STAGE(PG8_SB(0, 1), b2 + hstep, voffB);
            PG8_WAIT_V(6); PG8_BAR; PG8_MMA(1, 1, At, B1); PG8_BAR;
            PG8_LDB(B0, 1, 0); PG8_SCHED; PG8_LDA(At, 1, 0); PG8_STAGE(PG8_SA(0, 1), a2 + hstep, voffA);
            PG8_WAIT_L(8); PG8_BAR; PG8_WAIT_L(0); PG8_MMA(0, 0, At, B0); PG8_BAR; PG8_SCHED;
            PG8_LDB(B1, 1, 1); PG8_STAGE(PG8_SB(1, 0), b3, voffB);
            PG8_BAR; PG8_WAIT_L(0); PG8_MMA(0, 1, At, B1); PG8_BAR;
            PG8_LDA(At, 1, 1); PG8_STAGE(PG8_SA(1, 0), a3, voffA);
            PG8_BAR; PG8_WAIT_L(0); PG8_MMA(1, 0, At, B0); PG8_BAR; PG8_SCHED;
            PG8_STAGE(PG8_SB(1, 1), b3 + hstep, voffB);
            PG8_WAIT_V(6); PG8_BAR; PG8_MMA(1, 1, At, B1); PG8_BAR;
            }
        }
        if constexpr (ALIGN_EPI) { if (wr == 0) PG8_BAR; }
        if constexpr (!Epi::AFTER_DRAIN) { E(acc, cur, wr, wc, fr, fq); S.done(cur); }
        if (!has_next) break;
#pragma unroll
        for (int a = 0; a < 2; ++a)
#pragma unroll
            for (int b = 0; b < 2; ++b)
#pragma unroll
                for (int m = 0; m < 4; ++m)
#pragma unroll
                    for (int n = 0; n < 2; ++n) acc[a][b][m][n] = (f32x4){0.f, 0.f, 0.f, 0.f};
        cur = nxt; cA = nA; cB = nB; ++ui;
        if constexpr (ALIGN_EPI) { if (wr == 1) PG8_BAR; }
    }
    PG8_WAIT_V(0);
    if constexpr (!ALIGN_EPI) { if (wr == 0) PG8_BAR; }
    PG8_BAR;
    if constexpr (Epi::AFTER_DRAIN) { E.fused(acc, cur, wr, wc, fr, fq, lds, wid, lane); S.done(cur); }
#undef PG8_SA
#undef PG8_SB
#undef PG8_STAGE
#undef PG8_LDA
#undef PG8_LDB
#undef PG8_MMA
#undef PG8_WAIT_V
#undef PG8_WAIT_L
#undef PG8_BAR
#undef PG8_SCHED
}
}

constexpr int RING_OFF = 0, RING_BYTES = 131072;
constexpr int LDS_BYTES = 147456;
constexpr int LDSCTL_OFF = LDS_BYTES - 1024, MISC_OFF = LDSCTL_OFF + 320;

#define GAS __attribute__((address_space(1)))
#define LAS __attribute__((address_space(3)))
typedef unsigned short bf16;
typedef unsigned v4u __attribute__((ext_vector_type(4)));
typedef unsigned v2u __attribute__((ext_vector_type(2)));
typedef float f32x4 __attribute__((ext_vector_type(4)));
typedef GAS unsigned gu32;
#define RLX_AGENT __ATOMIC_RELAXED, __HIP_MEMORY_SCOPE_AGENT
#define LDS_WAIT() asm volatile("s_waitcnt lgkmcnt(0)" ::: "memory")
__device__ __forceinline__ unsigned f2bf(float f) { unsigned u = __builtin_bit_cast(unsigned, f); return (u + 0x7fffu + ((u >> 16) & 1u)) >> 16; }
__device__ __forceinline__ unsigned pk2(float lo, float hi) { return f2bf(lo) | (f2bf(hi) << 16); }
__device__ __forceinline__ float bf2f(unsigned short h) { return __builtin_bit_cast(float, (unsigned)h << 16); }
__device__ __forceinline__ float wave_sum(float v) {
#pragma unroll
    for (int o = 1; o < 64; o <<= 1) v += __shfl_xor(v, o);
    return v;
}
__device__ __forceinline__ float wave_max(float v) {
#pragma unroll
    for (int o = 1; o < 64; o <<= 1) v = fmaxf(v, __shfl_xor(v, o));
    return v;
}
#define XB_TMO      128
#define XB_XCNT(j)  (256  + 64 * (j))
#define XB_XSUB(j)  (1280 + 64 * (j))
#define XB_XGEN(j)  (2304 + 64 * (j))
#define XB_TOP      3328
#define XB_TOPGEN   3392
#define XCD_BAR_WORDS 3456
#define XB_SPIN_CAP (1u << 18)

__device__ __forceinline__ unsigned xb_ld(unsigned* p)              { return __hip_atomic_load(p, __ATOMIC_RELAXED, __HIP_MEMORY_SCOPE_AGENT); }
__device__ __forceinline__ unsigned xb_add(unsigned* p, unsigned v) { return __hip_atomic_fetch_add(p, v, __ATOMIC_RELAXED, __HIP_MEMORY_SCOPE_AGENT); }
__device__ __forceinline__ unsigned xb_xcc_id() { return (unsigned)__builtin_amdgcn_s_getreg((3 << 11) | 20) & 0xFu; }
#define XB_SPIN(cond, bar) do { unsigned _sp = 0; while (cond) { __builtin_amdgcn_s_sleep(1); \
    if ((++_sp & 255u) == 0u) { if (xb_ld(&(bar)[XB_TMO])) break; if (_sp > XB_SPIN_CAP) { atomicAdd(&(bar)[XB_TMO], 1u); break; } } } } while (0)

struct XcdBarrier {
    unsigned* bar; unsigned x;
    volatile LAS unsigned* st;
};

__device__ __forceinline__ XcdBarrier xcd_barrier_post(unsigned* bar, volatile LAS unsigned* st) {
    XcdBarrier b; b.bar = bar; b.x = xb_xcc_id(); b.st = st;
    if (threadIdx.x == 0) (void)xb_add(&bar[XB_XCNT(b.x)], 1u);
    return b;
}
__device__ __forceinline__ void xcd_barrier_complete(unsigned* bar, unsigned x, unsigned& nloc, unsigned& nx) {
    const unsigned G = gridDim.x * gridDim.y * gridDim.z;
    unsigned sum, cnt, mine, sp = 0u;
    for (;;) {
        sum = 0u; cnt = 0u; mine = 0u;
#pragma unroll
        for (unsigned j = 0; j < 16; ++j) { const unsigned c = xb_ld(&bar[XB_XCNT(j)]); sum += c; cnt += (c > 0u) ? 1u : 0u; mine = (j == x) ? c : mine; }
        if (sum == G) break;
        __builtin_amdgcn_s_sleep(1);
        if ((++sp & 255u) == 0u) { if (xb_ld(&bar[XB_TMO])) break; if (sp > XB_SPIN_CAP) { atomicAdd(&bar[XB_TMO], 1u); break; } }
    }
    nloc = mine > 0u ? mine : 1u; nx = cnt > 0u ? cnt : 1u;
}

__device__ __forceinline__ void xcd_barrier(const XcdBarrier& b) {
    asm volatile("s_waitcnt vmcnt(0)" ::: "memory");
    __syncthreads();
    if (threadIdx.x == 0) {
        unsigned* bar = b.bar;
        __builtin_amdgcn_s_waitcnt(0);
        unsigned nloc = b.st[0], nx = b.st[1];
        if (nloc == 0u) { xcd_barrier_complete(bar, b.x, nloc, nx); b.st[0] = nloc; b.st[1] = nx; }
        const unsigned old = xb_add(&bar[XB_XSUB(b.x)], 1u);
        const unsigned gen = old / nloc;
        if (old + 1u == (gen + 1u) * nloc) {
            __builtin_amdgcn_fence(__ATOMIC_RELEASE, "agent");
            asm volatile("s_waitcnt vmcnt(0)" ::: "memory");
            const unsigned og = xb_add(&bar[XB_TOP], 1u);
            const unsigned tg = og / nx;
            if (og + 1u == (tg + 1u) * nx) xb_add(&bar[XB_TOPGEN], 1u);
            else XB_SPIN(xb_ld(&bar[XB_TOPGEN]) == tg, bar);
            __builtin_amdgcn_fence(__ATOMIC_ACQUIRE, "agent");
            xb_add(&bar[XB_XGEN(b.x)], 1u);
            asm volatile("s_waitcnt vmcnt(0)" ::: "memory");
        } else {
            XB_SPIN(xb_ld(&bar[XB_XGEN(b.x)]) == gen, bar);
            __builtin_amdgcn_fence(__ATOMIC_ACQUIRE, "agent");
            asm volatile("s_waitcnt vmcnt(0)" ::: "memory");
        }
    }
    __syncthreads();
}


struct Frame {
    LAS unsigned char* lds;
    volatile LAS unsigned* MISC;
    gu32* ctl;
    int tid, lane, wave, G, bid;
    const float* x_in; const int* pos;
    const float *n1g, *w_in, *pool_w, *pool_scale, *lb_logits, *hgrn_g, *w_out, *n2g, *w_ff_in, *w_ff_out, *fng;
    float* xres;
    unsigned char* ws;
};
__constant__ float c_invf[8] = {1.0f, 0.19392274474868576f, 0.03760603093086393f, 0.007292664737217109f, 0.001414213562373095f, 0.0002742481756762073f, 5.318295896944988e-05f, 1.031338537721246e-05f};

typedef float f32x16 __attribute__((ext_vector_type(16)));
typedef short bf16x8v __attribute__((ext_vector_type(8)));
typedef float f32x2v __attribute__((ext_vector_type(2))); typedef __bf16 bf16x2v __attribute__((ext_vector_type(2)));
__device__ __forceinline__ unsigned cvtpk(float lo, float hi) { f32x2v v = {lo, hi}; bf16x2v b = __builtin_convertvector(v, bf16x2v); return __builtin_bit_cast(unsigned, b); }

__device__ __forceinline__ void cvt_item(const GAS float* W, const GAS float* g, int K, int N, bf16* WT, LAS float* scr, int kb, int nb, int lane) {
    const int k0 = 64 * kb, n0 = 32 * nb;
    const int n = n0 + (lane & 31);
    float v[32];
#pragma unroll
    for (int i = 0; i < 32; ++i) { const int kk = 2 * i + (lane >> 5); v[i] = (n < N) ? W[(size_t)(k0 + kk) * N + n] : 0.f; }
    const int c = lane & 7;
    f32x4 g0 = {1.f, 1.f, 1.f, 1.f}, g1 = g0;
    if (g) { g0 = *(const GAS f32x4*)(g + k0 + 8 * c); g1 = *(const GAS f32x4*)(g + k0 + 8 * c + 4); }
    __builtin_amdgcn_sched_barrier(0);
#pragma unroll
    for (int i = 0; i < 32; ++i) { const int kk = 2 * i + (lane >> 5); scr[kk * 33 + (lane & 31)] = v[i]; }
    LDS_WAIT(); asm volatile("" ::: "memory");
#pragma unroll
    for (int j = 0; j < 4; ++j) { const int nl = (lane >> 3) + 8 * j; const LAS float* sp = scr + (8 * c) * 33 + nl;
        v4u o; o.x = pk2(sp[0 * 33] * g0[0], sp[1 * 33] * g0[1]); o.y = pk2(sp[2 * 33] * g0[2], sp[3 * 33] * g0[3]); o.z = pk2(sp[4 * 33] * g1[0], sp[5 * 33] * g1[1]); o.w = pk2(sp[6 * 33] * g1[2], sp[7 * 33] * g1[3]);
        *(GAS v4u*)(WT + (size_t)(n0 + nl) * K + k0 + 8 * c) = o; }
    LDS_WAIT(); asm volatile("" ::: "memory");
}
__device__ __forceinline__ void cvt_matrix(Frame& F, const float* W_, const float* g_, int K, int N, int Npad, bf16* WT) {
    const GAS float* W = (const GAS float*)W_; const GAS float* g = (const GAS float*)g_;
    LAS float* scr = (LAS float*)(F.lds + RING_OFF + F.wave * 16384);
    const int gw = F.bid * NWAVES + F.wave, NGW = F.G * NWAVES;
    const int nblk = Npad / 32, nitems = (K / 64) * nblk;
    for (int it = gw; it < nitems; it += NGW) cvt_item(W, g, K, N, WT, scr, it / nblk, it % nblk, F.lane);
}
__device__ __forceinline__ void cvt_layer_rest(Frame& F, int layer, int gw, int NGW) {
    LAS float* scr = (LAS float*)(F.lds + RING_OFF + F.wave * 16384);
    constexpr int I0 = (DM / 64) * (DM / 32), I1 = (DM / 64) * (DFF / 32), I2 = (DFF / 64) * (DM / 32), I3 = (DM / 64) * (DINP / 32);
    const int total = I0 + I1 + I2 + ((layer + 1 < DEPTH) ? I3 : 0);
    for (int it = gw; it < total; it += NGW) {
        int r = it;
        if (r < I0) { cvt_item((const GAS float*)(F.w_out + (size_t)layer * DM * DM), nullptr, DM, DM, (bf16*)(F.ws + WS_WOUT), scr, r / (DM / 32), r % (DM / 32), F.lane); continue; } r -= I0;
        if (r < I1) { cvt_item((const GAS float*)(F.w_ff_in + (size_t)layer * DM * DFF), (const GAS float*)(F.n2g + layer * DM), DM, DFF, (bf16*)(F.ws + WS_WFI), scr, r / (DFF / 32), r % (DFF / 32), F.lane); continue; } r -= I1;
        if (r < I2) { cvt_item((const GAS float*)(F.w_ff_out + (size_t)layer * DFF * DM), nullptr, DFF, DM, (bf16*)(F.ws + WS_WFO), scr, r / (DM / 32), r % (DM / 32), F.lane); continue; } r -= I2;
        cvt_item((const GAS float*)(F.w_in + (size_t)(layer + 1) * DM * DIN), (const GAS float*)(F.n1g + (layer + 1) * DM), DM, DIN, (bf16*)(F.ws + (((layer + 1) & 1) ? WS_WIN1 : WS_WIN)), scr, r / (DINP / 32), r % (DINP / 32), F.lane);
    }
}

__device__ __forceinline__ void p_prologue(Frame& F) {
    const int gtid = F.bid * NTHR + F.tid, NT = F.G * NTHR;
    GAS float* tab = (GAS float*)(F.ws + WS_ROPE);
    for (int idx = gtid; idx < M * 8; idx += NT) {
        const int row = idx >> 3, i = idx & 7;
        const float angf = (float)((const GAS int*)F.pos)[row] * c_invf[i];
        double r = (double)angf * 0.15915494309189535; r -= floor(r);
        const float a = (float)(r * 6.283185307179586);
        tab[row * 16 + i] = cosf(a); tab[row * 16 + 8 + i] = sinf(a);
    }
    if (gtid < 256) {
        const int c = gtid; GAS float* lb = (GAS float*)(F.ws + WS_LB); const GAS float* lbl = (const GAS float*)F.lb_logits;
        const float l0 = lbl[c], l1 = lbl[256 + c], l2 = lbl[512 + c], l3 = lbl[768 + c];
        const float mx = fmaxf(fmaxf(l0, l1), fmaxf(l2, l3));
        const float e0 = expf(l0 - mx), e1 = expf(l1 - mx), e2 = expf(l2 - mx), e3 = expf(l3 - mx);
        const float inv = 1.0f / (e0 + e1 + e2 + e3);
        lb[c] = 0.f; lb[256 + c] = e1 * inv; lb[512 + c] = (e1 + e2) * inv; lb[768 + c] = (e1 + e2 + e3) * inv;
    }
    const int gw = F.bid * NWAVES + F.wave, NGW = F.G * NWAVES;
    GAS bf16* xb = (GAS bf16*)(F.ws + WS_XB); GAS float* ssq = (GAS float*)(F.ws + WS_SSQ);
    for (int row = gw; row < M; row += NGW) {
        const GAS f32x4* xr = (const GAS f32x4*)(F.x_in + (size_t)row * DM) + F.lane;
        f32x4 v[4]; float s = 0.f;
#pragma unroll
        for (int j = 0; j < 4; ++j) { v[j] = xr[64 * j]; s += (v[j][0] * v[j][0] + v[j][1] * v[j][1]) + (v[j][2] * v[j][2] + v[j][3] * v[j][3]); }
        s = wave_sum(s);
        GAS unsigned long long* o8 = (GAS unsigned long long*)(xb + (size_t)row * DM) + F.lane;
#pragma unroll
        for (int j = 0; j < 4; ++j) o8[64 * j] = (unsigned long long)pk2(v[j][0], v[j][1]) | ((unsigned long long)pk2(v[j][2], v[j][3]) << 32);
        if (F.lane < 16) ssq[(size_t)row * 16 + F.lane] = (F.lane == 0) ? s : 0.f;
    }
    cvt_matrix(F, F.w_in, F.n1g, DM, DIN, DINP, (bf16*)(F.ws + WS_WIN));
}

constexpr int PL_WROW = 72, PL_PROW = 264, PL_WT_BYTES = 4 * 64 * PL_WROW * 2, PL_P_OFF = PL_WT_BYTES;
template <int WIN> __device__ __forceinline__ void pool_core(const GAS bf16* up, int tl0, LAS unsigned short* Pc) {
    float ps[49]; ps[0] = 0.f;
    float uv[48];
#pragma unroll
    for (int i = 0; i < 48; ++i) { const int tl = tl0 - 16 + i; uv[i] = (tl >= 0) ? bf2f(up[(long)(i - 16) * PROJ_LD]) : 0.f; }
    __builtin_amdgcn_sched_barrier(0);
#pragma unroll
    for (int i = 0; i < 48; ++i) ps[i + 1] = ps[i] + uv[i];
#pragma unroll
    for (int i = 16; i < 48; ++i) {
        const int tl = tl0 - 16 + i; const int cnt = (tl + 1 < WIN) ? tl + 1 : WIN;
        const float mean = (ps[i + 1] - ps[i + 1 - WIN]) / (float)cnt;
        Pc[(i - 16) * PL_PROW] = (unsigned short)f2bf(mean - uv[i]);
    }
}
__device__ __forceinline__ void p_pool(Frame& F, int layer) {
    LAS unsigned short* WT = (LAS unsigned short*)(F.lds + RING_OFF);
    LAS unsigned short* P = (LAS unsigned short*)(F.lds + RING_OFF + PL_P_OFF);
    const GAS bf16* proj = (const GAS bf16*)(F.ws + WS_PROJ); GAS bf16* mixed = (GAS bf16*)(F.ws + WS_MIXED);
    const GAS float* pw = (const GAS float*)F.pool_w + (size_t)layer * 4 * 64 * 64; const GAS float* ps_ = (const GAS float*)F.pool_scale + layer * 256;
    const int tid = F.tid, lane = F.lane, wave = F.wave;
#pragma unroll 8
    for (int i = 0; i < 32; ++i) { const int e = i * NTHR + tid; const int g = e >> 12, c = (e >> 6) & 63, d = e & 63; WT[(g * 64 + d) * PL_WROW + c] = (unsigned short)f2bf(pw[e]); }
    const int c = tid & 255, hf = tid >> 8, g = wave & 3;
    for (int unit = F.bid; unit < M / 64; unit += F.G) {
        const int t0 = unit * 64 + 32 * hf;
        { const GAS bf16* up = proj + (size_t)t0 * PROJ_LD + PC_POOL + c; LAS unsigned short* Pc = P + (32 * hf) * PL_PROW + c; const int tl0 = t0 & (SEQ - 1);
          if (g == 0) pool_core<2>(up, tl0, Pc); else if (g == 1) pool_core<4>(up, tl0, Pc); else if (g == 2) pool_core<8>(up, tl0, Pc); else pool_core<16>(up, tl0, Pc); }
        __syncthreads();
        { const int th = wave >> 2, fr = lane & 15, kg = lane >> 4;
#pragma unroll
          for (int tb = 0; tb < 2; ++tb) {
              bf16x8v af[2];
#pragma unroll
              for (int ks = 0; ks < 2; ++ks) af[ks] = *(const LAS bf16x8v*)(P + (32 * th + 16 * tb + fr) * PL_PROW + g * 64 + 32 * ks + 8 * kg);
#pragma unroll
              for (int db = 0; db < 4; ++db) {
                  f32x4 acc = {0.f, 0.f, 0.f, 0.f};
#pragma unroll
                  for (int ks = 0; ks < 2; ++ks) { const bf16x8v bfr = *(const LAS bf16x8v*)(WT + (g * 64 + 16 * db + fr) * PL_WROW + 32 * ks + 8 * kg);
                      acc = __builtin_amdgcn_mfma_f32_16x16x32_bf16(af[ks], bfr, acc, 0, 0, 0); }
                  const int dcol = g * 64 + 16 * db + fr; const float sc = ps_[dcol];
                  GAS bf16* op = mixed + (size_t)(unit * 64 + 32 * th + 16 * tb + 4 * kg) * DM + MC_POOL + dcol;
#pragma unroll
                  for (int r = 0; r < 4; ++r) op[(size_t)r * DM] = (bf16)f2bf(acc[r] * sc);
              }
          } }
        __syncthreads();
    }
}

__device__ __forceinline__ unsigned sort_key(float v) { if (v == 0.f) v = 0.f; const unsigned u = __builtin_bit_cast(unsigned, v); return (u & 0x80000000u) ? ~u : (u | 0x80000000u); }
__device__ __forceinline__ unsigned wave_total6(unsigned x) {
    unsigned t = 0;
#pragma unroll
    for (int b = 0; b < 6; ++b) t += (unsigned)__popcll(__ballot((x >> b) & 1u)) << b;
    return t;
}
template <int NI> __device__ __forceinline__ void emit_mask(const unsigned (&k)[NI], unsigned prefix, bool exact, GAS unsigned* mrow, int lane) {
    if (exact) {
#pragma unroll
        for (int i = 0; i < NI; ++i) { const unsigned long long sb = __ballot(k[i] >= prefix); if (lane == 0) *(GAS v2u*)(mrow + 2 * i) = (v2u){(unsigned)sb, (unsigned)(sb >> 32)}; }
    } else {
        const unsigned tau = prefix; unsigned c = 0u;
#pragma unroll
        for (int i = 0; i < NI; ++i) c += (unsigned)(k[i] > tau);
        const unsigned need = (unsigned)TOPK - wave_total6(c); unsigned base = 0u;
#pragma unroll
        for (int i = 0; i < NI; ++i) {
            const unsigned long long eqb = __ballot(k[i] == tau);
            const unsigned rank = base + (unsigned)__popcll(eqb & ((1ull << lane) - 1ull));
            const unsigned long long sb = __ballot((k[i] > tau) || ((k[i] == tau) && (rank < need)));
            if (lane == 0) *(GAS v2u*)(mrow + 2 * i) = (v2u){(unsigned)sb, (unsigned)(sb >> 32)};
            base += (unsigned)__popcll(eqb);
        }
    }
    if (NI < 32) { if (lane < 2 * (32 - NI)) mrow[2 * NI + lane] = 0u; }
}
template <int NI> __device__ __forceinline__ void select2(const LAS unsigned* ka_, const LAS unsigned* kb_, int nk, GAS unsigned* mrowA, GAS unsigned* mrowB, int lane) {
    unsigned ka[NI], kb[NI];
#pragma unroll
    for (int i = 0; i < NI; ++i) { const int sidx = lane + 64 * i; ka[i] = (sidx < nk) ? ka_[sidx] : 0u; kb[i] = (sidx < nk) ? kb_[sidx] : 0u; }
    unsigned pa = 0u, pb = 0u; bool ea = false, eb = false;
    for (int bit = 31; bit >= 0; --bit) {
        const unsigned ca = pa | (1u << bit), cb = pb | (1u << bit);
        unsigned ta = 0u, tb = 0u;
#pragma unroll
        for (int i0 = 0; i0 < NI; i0 += 8) {
            unsigned long long ma[8], mb[8];
#pragma unroll
            for (int i = 0; i < 8; ++i) { ma[i] = __ballot(ka[i0 + i] >= ca); mb[i] = __ballot(kb[i0 + i] >= cb); }
            __builtin_amdgcn_sched_barrier(0);
            unsigned ta1 = 0u, tb1 = 0u;
#pragma unroll
            for (int i = 0; i < 8; i += 2) { ta += (unsigned)__popcll(ma[i]); tb += (unsigned)__popcll(mb[i]); ta1 += (unsigned)__popcll(ma[i + 1]); tb1 += (unsigned)__popcll(mb[i + 1]); }
            ta += ta1; tb += tb1;
            __builtin_amdgcn_sched_barrier(0);
        }
        if (!ea && ta >= (unsigned)TOPK) { pa = ca; ea = (ta == (unsigned)TOPK); }
        if (!eb && tb >= (unsigned)TOPK) { pb = cb; eb = (tb == (unsigned)TOPK); }
        if (ea && eb) break;
    }
    emit_mask<NI>(ka, pa, ea, mrowA, lane);
    emit_mask<NI>(kb, pb, eb, mrowB, lane);
}
constexpr int MK_STRIDE = 2049;
__device__ __forceinline__ void p_mask(Frame& F) {
    LAS unsigned* keys = (LAS unsigned*)(F.lds + RING_OFF);
    const GAS bf16* qi_hl = (const GAS bf16*)(F.ws + WS_QIHL); const GAS bf16* ki_hl = (const GAS bf16*)(F.ws + WS_KIHL); const GAS float* wi = (const GAS float*)(F.ws + WS_WI); GAS unsigned* mask = (GAS unsigned*)(F.ws + WS_MASK);
    const int tid = F.tid, lane = F.lane, wave = F.wave, q = lane & 15, kg = lane >> 4;
    for (int c = F.bid; c < 256; c += F.G) {
        for (int ui = 0; ui < 4; ++ui) {
            const int b = (c >> 6) * 2 + (ui >> 1), bq = c & 63, qb = (ui & 1) ? 127 - bq : bq;
            const int t0 = qb * 16; const size_t rowq0 = (size_t)b * SEQ + t0;
            if (qb < 16) {
                for (int w = tid; w < 1024; w += NTHR) { const int qq = w >> 6, j = w & 63, n = t0 + qq + 1, lo = j * 32;
                    mask[(rowq0 + qq) * 64 + j] = (n >= lo + 32) ? 0xffffffffu : (n > lo ? ((1u << (n - lo)) - 1u) : 0u); }
                continue;
            }
            bf16x8v bh[4][2], bl[4][2];
#pragma unroll
            for (int h = 0; h < 4; ++h)
#pragma unroll
                for (int dh = 0; dh < 2; ++dh) { const GAS bf16* pq = qi_hl + (rowq0 + q) * 512 + h * 64 + dh * 32 + kg * 8;
                    bh[h][dh] = *(const GAS bf16x8v*)pq; bl[h][dh] = *(const GAS bf16x8v*)(pq + 256); }
            const f32x4 wv = *(const GAS f32x4*)(wi + (rowq0 + q) * 4);
            const int ntile = qb + 1;
            bf16x8v ah[2], al[2];
            { const int kt0 = wave < ntile ? wave : 0;
#pragma unroll
              for (int dh = 0; dh < 2; ++dh) { const GAS bf16* pk = ki_hl + ((size_t)b * SEQ + kt0 * 16 + q) * 128 + dh * 32 + kg * 8;
                  ah[dh] = *(const GAS bf16x8v*)pk; al[dh] = *(const GAS bf16x8v*)(pk + 64); } }
            for (int kt = wave; kt < ntile; kt += NWAVES) {
                const int s0 = kt * 16;
                bf16x8v ahn[2], aln[2];
                { const int ktn = (kt + NWAVES < ntile) ? kt + NWAVES : kt;
#pragma unroll
                  for (int dh = 0; dh < 2; ++dh) { const GAS bf16* pk = ki_hl + ((size_t)b * SEQ + ktn * 16 + q) * 128 + dh * 32 + kg * 8;
                      ahn[dh] = *(const GAS bf16x8v*)pk; aln[dh] = *(const GAS bf16x8v*)(pk + 64); } }
                __builtin_amdgcn_sched_barrier(0);
                f32x4 acc[4];
#pragma unroll
                for (int h = 0; h < 4; ++h) { acc[h] = (f32x4){0.f, 0.f, 0.f, 0.f};
#pragma unroll
                    for (int dh = 0; dh < 2; ++dh) {
                        acc[h] = __builtin_amdgcn_mfma_f32_16x16x32_bf16(ah[dh], bh[h][dh], acc[h], 0, 0, 0);
                        acc[h] = __builtin_amdgcn_mfma_f32_16x16x32_bf16(ah[dh], bl[h][dh], acc[h], 0, 0, 0);
                        acc[h] = __builtin_amdgcn_mfma_f32_16x16x32_bf16(al[dh], bh[h][dh], acc[h], 0, 0, 0);
                    } }
#pragma unroll
                for (int r = 0; r < 4; ++r) {
                    const float I = wv[0] * fmaxf(acc[0][r], 0.f) + wv[1] * fmaxf(acc[1][r], 0.f) + wv[2] * fmaxf(acc[2][r], 0.f) + wv[3] * fmaxf(acc[3][r], 0.f);
                    const int s = s0 + 4 * kg + r;
                    keys[q * MK_STRIDE + s] = (s <= t0 + q) ? sort_key(I) : 0u;
                }
                __builtin_amdgcn_sched_barrier(0);
#pragma unroll
                for (int dh = 0; dh < 2; ++dh) { ah[dh] = ahn[dh]; al[dh] = aln[dh]; }
            }
            __syncthreads();
            const int nk = t0 + 16;
            { const LAS unsigned* kA = keys + (2 * wave) * MK_STRIDE; const LAS unsigned* kB = kA + MK_STRIDE;
              GAS unsigned* mA = mask + (rowq0 + 2 * wave) * 64; GAS unsigned* mB = mA + 64;
              if (nk <= 512) select2<8>(kA, kB, nk, mA, mB, lane);
              else if (nk <= 1024) select2<16>(kA, kB, nk, mA, mB, lane);
              else if (nk <= 1536) select2<24>(kA, kB, nk, mA, mB, lane);
              else select2<32>(kA, kB, nk, mA, mB, lane); }
            __syncthreads();
        }
    }
}

typedef short s16x4 __attribute__((ext_vector_type(4)));
#define MFMA16(a, b, c) __builtin_amdgcn_mfma_f32_16x16x16bf16_1k((a), (b), (c), 0, 0, 0)
__device__ __forceinline__ s16x4 pack4(const f32x4 v) { v2u t; t.x = cvtpk(v[0], v[1]); t.y = cvtpk(v[2], v[3]); return __builtin_bit_cast(s16x4, t); }
constexpr int HG_QT = 0, HG_KT = 2176, HG_KH = 4352, HG_IT = 7424, HG_DF = 10496, HG_WAVE_LDS = 10752;
template <bool FULL> __device__ __forceinline__ float hgrn_stage(const GAS bf16* pr, float lbv, LAS unsigned char* W, int lane) {
    unsigned short zr[16], ir[16], qr[16];
#pragma unroll
    for (int s_ = 0; s_ < 16; ++s_) { zr[s_] = pr[(size_t)s_ * PROJ_LD + PC_HF]; ir[s_] = pr[(size_t)s_ * PROJ_LD + PC_HI]; if (FULL) qr[s_] = pr[(size_t)s_ * PROJ_LD + PC_HQ]; }
    __builtin_amdgcn_sched_barrier(0);
    float f[16], kk[16]; float P = 1.0f;
    LAS unsigned short* QT = (LAS unsigned short*)(W + HG_QT); LAS unsigned short* KT = (LAS unsigned short*)(W + HG_KT);
#pragma unroll
    for (int s_ = 0; s_ < 16; ++s_) {
        const float z = bf2f(zr[s_]);
        const float sig = 1.0f / (1.0f + __expf(-z));
        f[s_] = fmaxf(lbv + (1.0f - lbv) * sig, 1e-30f); kk[s_] = (1.0f - lbv) * (1.0f - sig);
        P *= f[s_];
        if (FULL) { const float q = bf2f(qr[s_]); const float qs = q / (1.0f + __expf(-q));
            QT[s_ * 68 + lane] = (unsigned short)f2bf(qs * P); KT[s_ * 68 + lane] = (unsigned short)f2bf(kk[s_] / fmaxf(P, 1e-30f)); }
    }
    float E = 1.0f; unsigned kh[8];
#pragma unroll
    for (int s_ = 15; s_ >= 0; s_ -= 2) {
        const float hi = kk[s_] * E; E *= f[s_];
        const float lo = kk[s_ - 1] * E; E *= f[s_ - 1];
        kh[s_ >> 1] = cvtpk(lo, hi);
    }
    LAS v4u* KH = (LAS v4u*)(W + HG_KH + lane * 48); LAS v4u* IT = (LAS v4u*)(W + HG_IT + lane * 48);
    KH[0] = (v4u){kh[0], kh[1], kh[2], kh[3]}; KH[1] = (v4u){kh[4], kh[5], kh[6], kh[7]};
    IT[0] = (v4u){(unsigned)ir[0] | ((unsigned)ir[1] << 16), (unsigned)ir[2] | ((unsigned)ir[3] << 16), (unsigned)ir[4] | ((unsigned)ir[5] << 16), (unsigned)ir[6] | ((unsigned)ir[7] << 16)};
    IT[1] = (v4u){(unsigned)ir[8] | ((unsigned)ir[9] << 16), (unsigned)ir[10] | ((unsigned)ir[11] << 16), (unsigned)ir[12] | ((unsigned)ir[13] << 16), (unsigned)ir[14] | ((unsigned)ir[15] << 16)};
    ((LAS float*)(W + HG_DF))[lane] = P;
    return P;
}
__device__ __forceinline__ void hgrn_update(f32x4 (&S)[4][4], const LAS unsigned char* W, int fr, int kg) {
    s16x4 khf[4], itf[4]; f32x4 df[4];
#pragma unroll
    for (int i = 0; i < 4; ++i) { khf[i] = *(const LAS s16x4*)(W + HG_KH + (16 * i + fr) * 48 + 8 * kg); itf[i] = *(const LAS s16x4*)(W + HG_IT + (16 * i + fr) * 48 + 8 * kg);
        df[i] = *(const LAS f32x4*)(W + HG_DF + (16 * i + 4 * kg) * 4); }
#pragma unroll
    for (int kb = 0; kb < 4; ++kb)
#pragma unroll
        for (int vb = 0; vb < 4; ++vb) S[kb][vb] = MFMA16(khf[kb], itf[vb], S[kb][vb] * df[kb]);
}
__device__ __forceinline__ void p_hgrn_local(Frame& F, int layer) {
    const int lane = F.lane, fr = lane & 15, kg = lane >> 4;
    LAS unsigned char* W = F.lds + RING_OFF + F.wave * 16384;
    const GAS bf16* proj = (const GAS bf16*)(F.ws + WS_PROJ); GAS float* hst = (GAS float*)(F.ws + WS_HST); GAS float* hdn = (GAS float*)(F.ws + WS_HDN);
    for (int unit = F.wave * F.G + F.bid; unit < BATCH * 4 * (SEQ / 64); unit += NWAVES * F.G) {
        const int bh = unit >> 5, chunk = unit & 31, b = bh >> 2, h = bh & 3;
        const float lbv = ((const GAS float*)(F.ws + WS_LB))[layer * 256 + h * 64 + lane];
        const size_t row0 = (size_t)b * SEQ + chunk * 64;
        f32x4 S[4][4];
#pragma unroll
        for (int i = 0; i < 4; ++i)
#pragma unroll
            for (int j = 0; j < 4; ++j) S[i][j] = (f32x4){0.f, 0.f, 0.f, 0.f};
        float dprod = 1.0f;
        for (int sub = 0; sub < 4; ++sub) {
            dprod *= hgrn_stage<false>(proj + (row0 + sub * 16) * PROJ_LD + h * 64 + lane, lbv, W, lane);
            LDS_WAIT(); asm volatile("" ::: "memory");
            hgrn_update(S, W, fr, kg);
            LDS_WAIT(); asm volatile("" ::: "memory");
        }
        GAS float* U = hst + (size_t)unit * 4096;
#pragma unroll
        for (int kb = 0; kb < 4; ++kb)
#pragma unroll
            for (int vb = 0; vb < 4; ++vb)
#pragma unroll
                for (int r = 0; r < 4; ++r) U[(16 * kb + 4 * kg + r) * 64 + 16 * vb + fr] = S[kb][vb][r];
        hdn[unit * 64 + lane] = dprod;
    }
}
__device__ __forceinline__ void p_hgrn_scan(Frame& F) {
    GAS float* hst = (GAS float*)(F.ws + WS_HST); const GAS float* hdn = (const GAS float*)(F.ws + WS_HDN);
    for (int e = F.bid * NTHR + F.tid; e < BATCH * 4 * 4096; e += F.G * NTHR) {
        const int bh = e >> 12, kv = e & 4095, k = kv >> 6;
        float S = 0.f;
        for (int n = 0; n < SEQ / 64; ++n) {
            const size_t idx = ((size_t)(bh * 32 + n) << 12) + kv;
            const float u = hst[idx]; hst[idx] = S;
            S = hdn[(bh * 32 + n) * 64 + k] * S + u;
        }
    }
}
constexpr int HG_LDS_OFF = 40960;
__device__ __forceinline__ void p_hgrn_out(Frame& F, int layer) {
    const int lane = F.lane, fr = lane & 15, kg = lane >> 4;
    LAS unsigned char* W = F.lds + RING_OFF + HG_LDS_OFF + F.wave * HG_WAVE_LDS;
    const GAS bf16* proj = (const GAS bf16*)(F.ws + WS_PROJ); GAS bf16* mixed = (GAS bf16*)(F.ws + WS_MIXED); const GAS float* hst = (const GAS float*)(F.ws + WS_HST);
    for (int unit = F.wave * F.G + F.bid; unit < BATCH * 4 * (SEQ / 64); unit += NWAVES * F.G) {
        const int bh = unit >> 5, chunk = unit & 31, b = bh >> 2, h = bh & 3;
        const float lbv = ((const GAS float*)(F.ws + WS_LB))[layer * 256 + h * 64 + lane];
        const size_t row0 = (size_t)b * SEQ + chunk * 64;
        f32x4 S[4][4];
        { const GAS float* U = hst + (size_t)unit * 4096;
#pragma unroll
          for (int kb = 0; kb < 4; ++kb)
#pragma unroll
              for (int vb = 0; vb < 4; ++vb)
#pragma unroll
                  for (int r = 0; r < 4; ++r) S[kb][vb][r] = U[(16 * kb + 4 * kg + r) * 64 + 16 * vb + fr]; }
        f32x4 ng4[4];
#pragma unroll
        for (int vb = 0; vb < 4; ++vb) ng4[vb] = *(const GAS f32x4*)((const GAS float*)F.hgrn_g + layer * 256 + h * 64 + 16 * vb + 4 * kg);
        for (int sub = 0; sub < 4; ++sub) {
            const size_t rs = row0 + sub * 16;
            (void)hgrn_stage<true>(proj + rs * PROJ_LD + h * 64 + lane, lbv, W, lane);
            v2u g2[4];
#pragma unroll
            for (int vb = 0; vb < 4; ++vb) g2[vb] = *(const GAS v2u*)(proj + (rs + fr) * PROJ_LD + PC_HG + h * 64 + 16 * vb + 4 * kg);
            LDS_WAIT(); asm volatile("" ::: "memory");
            s16x4 qb[4];
#pragma unroll
            for (int kb = 0; kb < 4; ++kb) qb[kb] = *(const LAS s16x4*)(W + HG_QT + (fr * 68 + 16 * kb + 4 * kg) * 2);
            f32x4 o[4];
#pragma unroll
            for (int vb = 0; vb < 4; ++vb) { o[vb] = (f32x4){0.f, 0.f, 0.f, 0.f};
#pragma unroll
                for (int kb = 0; kb < 4; ++kb) o[vb] = MFMA16(pack4(S[kb][vb]), qb[kb], o[vb]); }
            f32x4 at = {0.f, 0.f, 0.f, 0.f};
#pragma unroll
            for (int kb = 0; kb < 4; ++kb) at = MFMA16(*(const LAS s16x4*)(W + HG_KT + (fr * 68 + 16 * kb + 4 * kg) * 2), qb[kb], at);
#pragma unroll
            for (int r = 0; r < 4; ++r) if (4 * kg + r > fr) at[r] = 0.f;
            const s16x4 ab = pack4(at);
#pragma unroll
            for (int vb = 0; vb < 4; ++vb) o[vb] = MFMA16(*(const LAS s16x4*)(W + HG_IT + (16 * vb + fr) * 48 + 8 * kg), ab, o[vb]);
            hgrn_update(S, W, fr, kg);
            float ssq = 0.f;
#pragma unroll
            for (int vb = 0; vb < 4; ++vb) ssq += (o[vb][0] * o[vb][0] + o[vb][1] * o[vb][1]) + (o[vb][2] * o[vb][2] + o[vb][3] * o[vb][3]);
            ssq += __shfl_xor(ssq, 16); ssq += __shfl_xor(ssq, 32);
            const float rstd = 1.0f / sqrtf(ssq * (1.0f / 64.0f) + 1e-5f);
#pragma unroll
            for (int vb = 0; vb < 4; ++vb) {
                const float g0 = __builtin_bit_cast(float, g2[vb].x << 16), g1 = __builtin_bit_cast(float, g2[vb].x & 0xffff0000u), g2f = __builtin_bit_cast(float, g2[vb].y << 16), g3 = __builtin_bit_cast(float, g2[vb].y & 0xffff0000u);
                const float y0 = o[vb][0] * rstd * ng4[vb][0] * (g0 / (1.0f + __expf(-g0))), y1 = o[vb][1] * rstd * ng4[vb][1] * (g1 / (1.0f + __expf(-g1)));
                const float y2 = o[vb][2] * rstd * ng4[vb][2] * (g2f / (1.0f + __expf(-g2f))), y3 = o[vb][3] * rstd * ng4[vb][3] * (g3 / (1.0f + __expf(-g3)));
                *(GAS v2u*)(mixed + (rs + fr) * DM + MC_HGRN + h * 64 + 16 * vb + 4 * kg) = (v2u){cvtpk(y0, y1), cvtpk(y2, y3)};
            }
            LDS_WAIT(); asm volatile("" ::: "memory");
        }
    }
}

__device__ __forceinline__ float max3f_(float a, float b, float c) { float r; asm("v_max3_f32 %0, %1, %2, %3" : "=v"(r) : "v"(a), "v"(b), "v"(c)); return r; }
__device__ __forceinline__ float and_f32(float e, int selmask) { asm volatile("" : "+v"(selmask)); return __builtin_bit_cast(float, __builtin_bit_cast(unsigned, e) & (unsigned)selmask); }
typedef float f32x2p __attribute__((ext_vector_type(2)));
constexpr int AT_KROW = 144, AT_VROW = 136, AT_KBYTES = 64 * AT_KROW, AT_VBYTES = 64 * AT_VROW, AT_BUF = AT_KBYTES + AT_VBYTES, AT_SCR = 2 * AT_BUF;
static_assert(AT_BUF % 16 == 0 && AT_SCR % 16 == 0, "attention LDS map alignment");
__device__ __forceinline__ void p_attn_flash(Frame& F) {
    const int tid = F.tid, lane = F.lane, wave = F.wave;
    const int r = lane & 31, hh = lane >> 5, g = wave & 3, qh = wave >> 2;
    LAS unsigned char* L = F.lds + RING_OFF;
    LAS float* scr = (LAS float*)(L + AT_SCR) + wave * 32;
    const GAS bf16* proj = (const GAS bf16*)(F.ws + WS_PROJ); const GAS bf16* vT = (const GAS bf16*)(F.ws + WS_VT); GAS bf16* mixed = (GAS bf16*)(F.ws + WS_MIXED);
    const GAS unsigned* mask = (const GAS unsigned*)(F.ws + WS_MASK);
    const int srow = tid >> 3, sch = tid & 7;
    const float C2 = 0.18033688011112042f, NEG = -1.0e30f;
    for (int pair = F.bid; pair < 256; pair += F.G) {
        const int bk = pair >> 4, b = bk >> 1, kvh = bk & 1, pp = pair & 15, h = kvh * 4 + g;
        for (int half = 0; half < 2; ++half) {
            const int qblk = half == 0 ? 31 - pp : pp;
            const int q0 = qblk * 64, nt = qblk + 1;
            const int tq = q0 + 32 * qh + r;
            bf16x8v qf[4];
            { const GAS bf16* qp = proj + (size_t)(b * SEQ + tq) * PROJ_LD + PC_Q + h * 64 + 8 * hh;
#pragma unroll
              for (int d0 = 0; d0 < 4; ++d0) qf[d0] = *(const GAS bf16x8v*)(qp + 16 * d0); }
            const GAS unsigned* mrow = mask + (size_t)(b * SEQ + tq) * 64;
            const GAS bf16* kg = proj + (size_t)(b * SEQ + srow) * PROJ_LD + PC_K + kvh * 64 + sch * 8;
            const GAS bf16* vg = vT + (size_t)(bk * 64 + srow) * SEQ + sch * 8;
            { const v4u kreg = *(const GAS v4u*)kg; const v4u vreg = *(const GAS v4u*)vg;
              *(LAS v4u*)(L + srow * AT_KROW + sch * 16) = kreg;
              LAS unsigned char* vd = L + AT_KBYTES + srow * AT_VROW + sch * 16;
              *(LAS v2u*)vd = (v2u){vreg.x, vreg.y}; *(LAS v2u*)(vd + 8) = (v2u){vreg.z, vreg.w}; }
            v2u mw = *(const GAS v2u*)mrow;
            __syncthreads();
            f32x16 o0, o1;
#pragma unroll
            for (int i = 0; i < 16; ++i) { o0[i] = 0.f; o1[i] = 0.f; }
            float m = -30000.0f, l = 0.f;
            for (int j = 0; j < nt; ++j) {
                LAS unsigned char* Kb = L + (j & 1) * AT_BUF; LAS unsigned char* Vb = Kb + AT_KBYTES;
                const bool more = (j + 1 < nt);
                const int jn = more ? j + 1 : j;
                const v4u kn = *(const GAS v4u*)(kg + (size_t)jn * 64 * PROJ_LD); const v4u vn = *(const GAS v4u*)(vg + jn * 64); const v2u mwn = *(const GAS v2u*)(mrow + 2 * jn);
                bf16x8v kf[8];
#pragma unroll
                for (int d0 = 0; d0 < 4; ++d0) { kf[2 * d0] = *(const LAS bf16x8v*)(Kb + r * AT_KROW + d0 * 32 + hh * 16); kf[2 * d0 + 1] = *(const LAS bf16x8v*)(Kb + (32 + r) * AT_KROW + d0 * 32 + hh * 16); }
                __builtin_amdgcn_sched_barrier(0);
                f32x16 p0, p1;
#pragma unroll
                for (int i = 0; i < 16; ++i) { p0[i] = 0.f; p1[i] = 0.f; }
#pragma unroll
                for (int d0 = 0; d0 < 4; ++d0) {
                    p0 = __builtin_amdgcn_mfma_f32_32x32x16_bf16(kf[2 * d0], qf[d0], p0, 0, 0, 0);
                    p1 = __builtin_amdgcn_mfma_f32_32x32x16_bf16(kf[2 * d0 + 1], qf[d0], p1, 0, 0, 0);
                }
                v2u vl[8], vh[8];
#pragma unroll
                for (int ks = 0; ks < 4; ++ks) {
                    const LAS unsigned char* vp = Vb + r * AT_VROW + (16 * ks + 4 * hh) * 2;
                    vl[2 * ks] = *(const LAS v2u*)vp; vh[2 * ks] = *(const LAS v2u*)(vp + 16);
                    vl[2 * ks + 1] = *(const LAS v2u*)(vp + 32 * AT_VROW); vh[2 * ks + 1] = *(const LAS v2u*)(vp + 32 * AT_VROW + 16);
                }
                __builtin_amdgcn_sched_barrier(0);
                const unsigned w0 = mw.x >> (4 * hh), w1 = mw.y >> (4 * hh);
                asm volatile("s_nop 15\n\ts_nop 7" : "+v"(p0), "+v"(p1));
                float mx;
                { float a = max3f_(p0[0], p0[1], p1[0]), b = max3f_(p0[2], p0[3], p1[1]); a = max3f_(a, p1[2], p1[3]);
#pragma unroll
                  for (int i = 4; i < 16; i += 4) { a = max3f_(a, p0[i], p0[i + 1]); b = max3f_(b, p0[i + 2], p0[i + 3]); a = max3f_(a, p1[i], p1[i + 1]); b = max3f_(b, p1[i + 2], p1[i + 3]); }
                  mx = max3f_(a, b, NEG); }
                mx = fmaxf(mx, __shfl_xor(mx, 32));
                const float mxs = mx * C2;
                const bool need = mxs > m + 8.0f;
                if (__any(need)) {
                    const float mnew = need ? mxs : m;
                    const float alpha = __builtin_amdgcn_exp2f(m - mnew); m = mnew; l *= alpha;
                    if (hh == 0) scr[r] = alpha;
#pragma unroll
                    for (int gq = 0; gq < 4; ++gq) {
                        const f32x4 a4 = *(const LAS f32x4*)(scr + 8 * gq + 4 * hh);
#pragma unroll
                        for (int e = 0; e < 4; ++e) { o0[4 * gq + e] *= a4[e]; o1[4 * gq + e] *= a4[e]; }
                    }
                }
                f32x2p rs2 = {0.f, 0.f};
                const f32x2p c2v = {C2, C2}, nm2 = {-m, -m};
#pragma unroll
                for (int i = 0; i < 16; i += 2) {
                    const int cr0 = (i & 3) + 8 * (i >> 2), cr1 = cr0 + 1;
                    f32x2p t0 = (f32x2p){p0[i], p0[i + 1]} * c2v + nm2, t1 = (f32x2p){p1[i], p1[i + 1]} * c2v + nm2;
                    t0.x = and_f32(__builtin_amdgcn_exp2f(t0.x), __builtin_amdgcn_sbfe((int)w0, cr0, 1)); t0.y = and_f32(__builtin_amdgcn_exp2f(t0.y), __builtin_amdgcn_sbfe((int)w0, cr1, 1));
                    t1.x = and_f32(__builtin_amdgcn_exp2f(t1.x), __builtin_amdgcn_sbfe((int)w1, cr0, 1)); t1.y = and_f32(__builtin_amdgcn_exp2f(t1.y), __builtin_amdgcn_sbfe((int)w1, cr1, 1));
                    p0[i] = t0.x; p0[i + 1] = t0.y; p1[i] = t1.x; p1[i + 1] = t1.y;
                    rs2 += t0; rs2 += t1;
                }
                l += rs2.x + rs2.y;
                bf16x8v pf[4];
                { v4u t;
                  t.x = cvtpk(p0[0], p0[1]); t.y = cvtpk(p0[2], p0[3]); t.z = cvtpk(p0[4], p0[5]); t.w = cvtpk(p0[6], p0[7]); pf[0] = __builtin_bit_cast(bf16x8v, t);
                  t.x = cvtpk(p0[8], p0[9]); t.y = cvtpk(p0[10], p0[11]); t.z = cvtpk(p0[12], p0[13]); t.w = cvtpk(p0[14], p0[15]); pf[1] = __builtin_bit_cast(bf16x8v, t);
                  t.x = cvtpk(p1[0], p1[1]); t.y = cvtpk(p1[2], p1[3]); t.z = cvtpk(p1[4], p1[5]); t.w = cvtpk(p1[6], p1[7]); pf[2] = __builtin_bit_cast(bf16x8v, t);
                  t.x = cvtpk(p1[8], p1[9]); t.y = cvtpk(p1[10], p1[11]); t.z = cvtpk(p1[12], p1[13]); t.w = cvtpk(p1[14], p1[15]); pf[3] = __builtin_bit_cast(bf16x8v, t); }
                __builtin_amdgcn_sched_barrier(0);
#pragma unroll
                for (int ks = 0; ks < 4; ++ks) {
                    const bf16x8v vf0 = __builtin_bit_cast(bf16x8v, (v4u){vl[2 * ks].x, vl[2 * ks].y, vh[2 * ks].x, vh[2 * ks].y});
                    const bf16x8v vf1 = __builtin_bit_cast(bf16x8v, (v4u){vl[2 * ks + 1].x, vl[2 * ks + 1].y, vh[2 * ks + 1].x, vh[2 * ks + 1].y});
                    o0 = __builtin_amdgcn_mfma_f32_32x32x16_bf16(pf[ks], vf0, o0, 0, 0, 0);
                    o1 = __builtin_amdgcn_mfma_f32_32x32x16_bf16(pf[ks], vf1, o1, 0, 0, 0);
                }
                __builtin_amdgcn_sched_barrier(0);
                if (more) {
                    LAS unsigned char* Kn = L + ((j + 1) & 1) * AT_BUF;
                    *(LAS v4u*)(Kn + srow * AT_KROW + sch * 16) = kn;
                    LAS unsigned char* vd = Kn + AT_KBYTES + srow * AT_VROW + sch * 16;
                    *(LAS v2u*)vd = (v2u){vn.x, vn.y}; *(LAS v2u*)(vd + 8) = (v2u){vn.z, vn.w};
                }
                mw = mwn;
                __syncthreads();
            }
            l += __shfl_xor(l, 32);
            if (hh == 0) scr[r] = 1.0f / l;
            GAS bf16* op = mixed + (size_t)(b * SEQ + q0 + 32 * qh) * DM + MC_ATTN + h * 64 + r;
#pragma unroll
            for (int gq = 0; gq < 4; ++gq) {
                const f32x4 a4 = *(const LAS f32x4*)(scr + 8 * gq + 4 * hh);
#pragma unroll
                for (int e = 0; e < 4; ++e) {
                    const int q = 8 * gq + 4 * hh + e;
                    op[(size_t)q * DM] = (bf16)f2bf(o0[4 * gq + e] * a4[e]); op[(size_t)q * DM + 32] = (bf16)f2bf(o1[4 * gq + e] * a4[e]);
                }
            }
        }
    }
}

__device__ __forceinline__ void p_final(Frame& F) {
    const int gw = F.bid * NWAVES + F.wave, NGW = F.G * NWAVES;
    for (int row = gw; row < M; row += NGW) {
        GAS f32x4* xr = (GAS f32x4*)(F.xres + (size_t)row * DM) + F.lane;
        const GAS f32x4* gr = (const GAS f32x4*)F.fng + F.lane;
        f32x4 v[4]; float s = 0.f;
#pragma unroll
        for (int j = 0; j < 4; ++j) { v[j] = xr[64 * j]; s += (v[j][0] * v[j][0] + v[j][1] * v[j][1]) + (v[j][2] * v[j][2] + v[j][3] * v[j][3]); }
        s = wave_sum(s);
        const float rs = 1.0f / sqrtf(s * (1.0f / 1024.0f) + 1e-5f);
#pragma unroll
        for (int j = 0; j < 4; ++j) xr[64 * j] = v[j] * rs * gr[64 * j];
    }
}

#ifndef MK_SINGLE
#define MK_SINGLE 1
#endif
constexpr int NPL = 7;
constexpr int NPHASE = 1 + DEPTH * NPL + 1;
struct Args { const float* x; const int* pos; const float *n1g, *w_in, *pool_w, *pool_scale, *lb_logits, *hgrn_g, *w_out, *n2g, *w_ff_in, *w_ff_out, *fng; float* out; unsigned char* ws; int ph_lo, ph_hi; };
static_assert(sizeof(Args) == 15 * 8 + 8, "Args has no padding");


#define PHASE_BEGIN() do { int t_ = threadIdx.x; asm volatile("" : "+v"(t_)); F.tid = t_; F.lane = t_ & 63; F.wave = __builtin_amdgcn_readfirstlane(t_ >> 6); \
    unsigned char* w_ = args.ws; asm volatile("" : "+s"(w_)); F.ws = w_; int b_ = blockIdx.x; asm volatile("" : "+s"(b_)); F.bid = b_; } while (0)

#define RSTD_TAB_OFF RING_BYTES
#define FILL_RSTD(S_, pm_out) do { PHASE_BEGIN(); pg8::Unit u0_; pm_out = S_.next(0, u0_) ? u0_.pm : -1; \
    if (pm_out >= 0 && F.tid < 256) ((LAS float*)(F.lds + RSTD_TAB_OFF))[F.tid] = pg8::row_rstd((const float*)(F.ws + WS_SSQ), pm_out * 256 + F.tid); \
    __syncthreads(); } while (0)
__global__ void __launch_bounds__(NTHR, 2) fwd(Args args) {
    extern __shared__ __attribute__((aligned(16))) unsigned char lds[];
    Frame F;
    F.lds = (LAS unsigned char*)lds;
    F.MISC = (volatile LAS unsigned*)(F.lds + MISC_OFF);
    F.tid = threadIdx.x; F.lane = F.tid & 63; F.wave = __builtin_amdgcn_readfirstlane(F.tid >> 6);
    F.G = gridDim.x; F.bid = blockIdx.x;
    F.ws = args.ws; F.ctl = (gu32*)(args.ws + WS_CTL);
    F.x_in = args.x; F.pos = args.pos; F.n1g = args.n1g; F.w_in = args.w_in; F.pool_w = args.pool_w; F.pool_scale = args.pool_scale; F.lb_logits = args.lb_logits;
    F.hgrn_g = args.hgrn_g; F.w_out = args.w_out; F.n2g = args.n2g; F.w_ff_in = args.w_ff_in; F.w_ff_out = args.w_ff_out; F.fng = args.fng; F.xres = args.out;
    for (int u = F.tid; u < (LDS_BYTES - LDSCTL_OFF) / 4; u += NTHR) ((LAS unsigned*)(F.lds + LDSCTL_OFF))[u] = 0u;
    __syncthreads();
    XcdBarrier bar; bar.bar = (unsigned*)(F.ctl + CW_BAR); bar.x = 0; bar.st = nullptr;
    if (MK_SINGLE) bar = xcd_barrier_post((unsigned*)(F.ctl + CW_BAR), F.MISC + 8);
    const int lo = args.ph_lo, hi = args.ph_hi;
#define IN(k) (lo <= (k) && (k) < hi)
#define SEAM(k) do { if (MK_SINGLE && IN(k) && IN((k) + 1)) xcd_barrier(bar); } while (0)
    bf16* const xb = (bf16*)(F.ws + WS_XB); float* const ssq = (float*)(F.ws + WS_SSQ);
    bf16* const proj = (bf16*)(F.ws + WS_PROJ); bf16* const mixed = (bf16*)(F.ws + WS_MIXED); bf16* const hid = (bf16*)(F.ws + WS_HID);

    if (IN(0)) { PHASE_BEGIN(); p_prologue(F); } SEAM(0);
    for (int layer = 0; layer < DEPTH; ++layer) {
        const int pb = 1 + layer * NPL;
        if (IN(pb + 0)) {
            PHASE_BEGIN(); pg8::Gemm g{xb, (const bf16*)(F.ws + ((layer & 1) ? WS_WIN1 : WS_WIN)), M, DINP, DM}; pg8::StaticOrder S; S.init(M, DINP, F.G, F.bid);
            int pm0; FILL_RSTD(S, pm0);
            pg8::EpiIn E{F.ws, pg8::RstdTab{(const LAS float*)(F.lds + RSTD_TAB_OFF), pm0, F.ws}};
            pg8::gemm_phase<pg8::EpiIn, pg8::StaticOrder, true, true>(F.lds + RING_OFF, g, S, E);
            PHASE_BEGIN(); if (F.bid >= 128) cvt_layer_rest(F, layer, (F.bid - 128) * NWAVES + F.wave, 128 * NWAVES);
        } SEAM(pb + 0);
        if (IN(pb + 1)) { PHASE_BEGIN(); p_hgrn_local(F, layer); } SEAM(pb + 1);
        if (IN(pb + 2)) { PHASE_BEGIN(); p_pool(F, layer); PHASE_BEGIN(); p_mask(F); PHASE_BEGIN(); p_hgrn_scan(F); } SEAM(pb + 2);
        if (IN(pb + 3)) { PHASE_BEGIN(); p_hgrn_out(F, layer); PHASE_BEGIN(); p_attn_flash(F); } SEAM(pb + 3);
        if (IN(pb + 4)) {
            PHASE_BEGIN(); pg8::Gemm g{mixed, (const bf16*)(F.ws + WS_WOUT), M, DM, DM}; pg8::StaticOrder S; S.init(M, DM, F.G, F.bid);
            pg8::EpiRes E{layer == 0 ? F.x_in : (const float*)F.xres, F.xres, F.ws};
            pg8::gemm_phase<pg8::EpiRes, pg8::StaticOrder, true, true>(F.lds + RING_OFF, g, S, E);
        } SEAM(pb + 4);
        if (IN(pb + 5)) {
            PHASE_BEGIN(); pg8::Gemm g{xb, (const bf16*)(F.ws + WS_WFI), M, DFF, DM}; pg8::StaticOrder S; S.init(M, DFF, F.G, F.bid);
            int pm0; FILL_RSTD(S, pm0);
            pg8::EpiFfIn E{pg8::RstdTab{(const LAS float*)(F.lds + RSTD_TAB_OFF), pm0, F.ws}};
            pg8::gemm_phase<pg8::EpiFfIn, pg8::StaticOrder, true, true>(F.lds + RING_OFF, g, S, E);
        } SEAM(pb + 5);
        if (IN(pb + 6)) {
            PHASE_BEGIN(); pg8::Gemm g{hid, (const bf16*)(F.ws + WS_WFO), M, DM, DFF}; pg8::StaticOrder S; S.init(M, DM, F.G, F.bid);
            pg8::EpiRes E{(const float*)F.xres, F.xres, F.ws};
            pg8::gemm_phase<pg8::EpiRes, pg8::StaticOrder, true, true>(F.lds + RING_OFF, g, S, E);
        } SEAM(pb + 6);
    }
    if (IN(NPHASE - 1)) { PHASE_BEGIN(); p_final(F); }
#undef IN
#undef SEAM
}

extern "C" void kernel_launch(void* const* d_in, const int* in_sizes, int n_in, void* d_out, int out_size, void* d_ws, size_t ws_size, hipStream_t stream) {
    static int grid = 0;
    if (grid == 0) {
        if (n_in != 13 || out_size != M * DM || ws_size < WS_END) { fprintf(stderr, "kernel_launch: unexpected shapes (n_in %d, out %d, ws %zu)\n", n_in, out_size, ws_size); grid = -1; return; }
        int dev = 0, cus = 0, per_cu = 0;
        if (hipGetDevice(&dev) != hipSuccess || hipDeviceGetAttribute(&cus, hipDeviceAttributeMultiprocessorCount, dev) != hipSuccess) { grid = -1; return; }
        if (hipFuncSetAttribute((const void*)fwd, hipFuncAttributeMaxDynamicSharedMemorySize, LDS_BYTES) != hipSuccess) { fprintf(stderr, "kernel_launch: hipFuncSetAttribute failed\n"); grid = -1; return; }
        if (hipOccupancyMaxActiveBlocksPerMultiprocessor(&per_cu, (const void*)fwd, NTHR, LDS_BYTES) != hipSuccess || per_cu < 1) { fprintf(stderr, "kernel_launch: occupancy query says %d\n", per_cu); }
        (void)hipGetLastError();
        grid = cus;
        if (grid != 256) { fprintf(stderr, "kernel_launch: built for a 256-CU device (got %d)\n", cus); grid = -1; return; }
    }
    if (grid <= 0) return;
    (void)hipMemsetAsync((char*)d_ws + WS_CTL, 0, CTL_ZERO_BYTES, stream);
    Args a{};
    a.x = (const float*)d_in[0]; a.pos = (const int*)d_in[1]; a.n1g = (const float*)d_in[2]; a.w_in = (const float*)d_in[3]; a.pool_w = (const float*)d_in[4];
    a.pool_scale = (const float*)d_in[5]; a.lb_logits = (const float*)d_in[6]; a.hgrn_g = (const float*)d_in[7]; a.w_out = (const float*)d_in[8]; a.n2g = (const float*)d_in[9];
    a.w_ff_in = (const float*)d_in[10]; a.w_ff_out = (const float*)d_in[11]; a.fng = (const float*)d_in[12];
    a.out = (float*)d_out; a.ws = (unsigned char*)d_ws;
    if (MK_SINGLE) {
        a.ph_lo = 0; a.ph_hi = NPHASE;
        hipLaunchKernelGGL(fwd, dim3(grid), dim3(NTHR), LDS_BYTES, stream, a);
    } else {
        for (int p = 0; p < NPHASE; ++p) { a.ph_lo = p; a.ph_hi = p + 1; hipLaunchKernelGGL(fwd, dim3(grid), dim3(NTHR), LDS_BYTES, stream, a); }
    }
}
```

```cpp
#include <hip/hip_runtime.h>
#include <cstdio>
#include <cstdint>

constexpr int BATCH = 8, SEQ = 2048, DM = 1024, DEPTH = 4, M = BATCH * SEQ, DIN = 2372, DINP = 2560, DFF = 4096;
constexpr int NWAVES = 8, NTHR = NWAVES * 64;
constexpr int TOPK = 256;
constexpr int PC_POOL = 0, PC_HQ = 256, PC_HF = 512, PC_HI = 768, PC_HG = 1024, PC_Q = 1280, PC_K = 1792, PC_V = 1920, PROJ_LD = 2048;
constexpr int MC_POOL = 0, MC_HGRN = 256, MC_ATTN = 512;

constexpr size_t MiB = 1u << 20;
constexpr size_t WS_CTL = 0, CTL_ZERO_BYTES = 1 * MiB;
constexpr size_t WS_ROPE = 1 * MiB;
constexpr size_t WS_SSQ = 2 * MiB;
constexpr size_t WS_LB = 3 * MiB;
constexpr size_t WS_MASK = 4 * MiB;
constexpr size_t WS_WIN = 8 * MiB;
constexpr size_t WS_WOUT = 13 * MiB;
constexpr size_t WS_WFI = 15 * MiB;
constexpr size_t WS_WFO = 23 * MiB;
constexpr size_t WS_XB = 32 * MiB;
constexpr size_t WS_HID = 64 * MiB;
constexpr size_t WS_PROJ = 64 * MiB;
constexpr size_t WS_MIXED = 128 * MiB;
constexpr size_t WS_HST = 160 * MiB;
constexpr size_t WS_HDN = 176 * MiB;
constexpr size_t WS_QIHL = 192 * MiB;
constexpr size_t WS_KIHL = 208 * MiB;
constexpr size_t WS_WI = 212 * MiB;
constexpr size_t WS_VT = 224 * MiB;
constexpr size_t WS_WIN1 = 232 * MiB;
constexpr size_t WS_END = 256 * MiB;
constexpr int CW_TMO = 0, CW_BAR = 4096;

namespace pg8 {
#define PG8_LAS __attribute__((address_space(3)))
typedef unsigned short bf16_t;
typedef short bf16x8 __attribute__((ext_vector_type(8)));
typedef float f32x4 __attribute__((ext_vector_type(4)));
typedef unsigned u32x4 __attribute__((ext_vector_type(4)));
constexpr int BM = 256, BK = 64, HALF = 128, HTB = HALF * BK * 2  , STAGE_BYTES = 8 * HTB, NXCD = 8, WGM = 8;

__host__ __device__ __forceinline__ int lds_byte(int r, int c) { const int st = (r >> 4) * 2 + (c >> 5), rr = r & 15, cc = c & 31, ob = rr * 64 + cc * 2; return st * 1024 + (ob ^ (((ob >> 9) & 1) << 5)); }
__host__ __device__ __forceinline__ void stage_rc(int b, int& R, int& C) { const int st = b / 1024, sb = b % 1024, swz = sb ^ (((sb >> 9) & 1) << 5); R = (st >> 1) * 16 + swz / 64; C = (st & 1) * 32 + (swz % 64) / 2; }
__host__ __device__ __forceinline__ int perm32(int rho) { const int n = rho >> 4, i = rho & 15; return 8 * (i >> 2) + 4 * n + (i & 3); }

struct Unit { int pm, pn; };
struct Gemm { const bf16_t* A; const bf16_t* Bt; int M, N, K; };

struct StaticOrder {
    int nM, nN, nwg, G, c;
    __host__ __device__ void init(int M, int N, int G_, int c_) { nM = M / BM; nN = N / BM; nwg = nM * nN; G = G_; c = c_; }
    __host__ __device__ __forceinline__ bool next(int i, Unit& u) const {
        const long L = (long)i * G + c; if (L >= nwg) return false;
        int wgid = (int)L; { const int q = nwg / NXCD, r = nwg % NXCD, xcd = wgid % NXCD, off = wgid / NXCD; wgid = (xcd < r ? xcd * (q + 1) : r * (q + 1) + (xcd - r) * q) + off; }
        const int nig = WGM * nN, gid = wgid / nig, fm = gid * WGM, gsz = (nM - fm) < WGM ? (nM - fm) : WGM;
        u.pm = fm + ((wgid % nig) % gsz); u.pn = (wgid % nig) / gsz; return true;
    }
    __device__ __forceinline__ void a_ready(const Unit&) const {}
    __device__ __forceinline__ void done(const Unit&) const {}
};

__device__ __forceinline__ unsigned cvt_pk_bf16(float lo, float hi) { unsigned r; asm volatile("v_cvt_pk_bf16_f32 %0, %1, %2" : "=v"(r) : "v"(lo), "v"(hi)); return r; }
typedef float f32x2 __attribute__((ext_vector_type(2)));

constexpr float RMS_EPS_F = 1e-5f;
#define PG8_GAS __attribute__((address_space(1)))
__device__ __forceinline__ float row_rstd(const float* ssq, int row) {
    const PG8_GAS f32x4* p = (const PG8_GAS f32x4*)(ssq + (size_t)row * 16);
    const f32x4 a = p[0], b = p[1], c = p[2], d = p[3];
    const float s = ((a[0] + a[1]) + (a[2] + a[3])) + ((b[0] + b[1]) + (b[2] + b[3])) + ((c[0] + c[1]) + (c[2] + c[3])) + ((d[0] + d[1]) + (d[2] + d[3]));
    return 1.0f / sqrtf(s * (1.0f / 1024.0f) + RMS_EPS_F);
}
struct RstdTab { const PG8_LAS float* tab; int pm; unsigned char* ws;
    __device__ __forceinline__ float get(int, int rloc) const { return tab[rloc]; } };
__constant__ float c_rot16[2][8] = {{-0.95765948f, -0.999246258f, 0.824376517f, 0.993200301f, 0.999744011f, 0.999990373f, 0.999999638f, 0.999999986f}, {-0.287903317f, 0.0388190063f, 0.566041835f, 0.116418045f, 0.0226254862f, 0.00438795693f, 0.000850927215f, 0.000165014163f}};
__constant__ float c_rot80[2][8] = {{-0.110387244f, -0.981213211f, -0.991153911f, 0.834587283f, 0.993606824f, 0.999759331f, 0.999990949f, 0.99999966f}, {-0.993888654f, 0.192926503f, 0.132717464f, 0.550875727f, 0.11289588f, 0.021938095f, 0.00425462375f, 0.000825070726f}};
__device__ __forceinline__ unsigned cvt_pk_rne(float lo, float hi) { typedef float f2 __attribute__((ext_vector_type(2))); typedef __bf16 b2 __attribute__((ext_vector_type(2))); f2 v = {lo, hi}; b2 b = __builtin_convertvector(v, b2); return __builtin_bit_cast(unsigned, b); }
__device__ __forceinline__ void split_hl(const f32x4 a, const f32x4 b, u32x4& h, u32x4& l) {
    h.x = cvt_pk_rne(a[0], a[1]); h.y = cvt_pk_rne(a[2], a[3]); h.z = cvt_pk_rne(b[0], b[1]); h.w = cvt_pk_rne(b[2], b[3]);
    l.x = cvt_pk_rne(a[0] - __builtin_bit_cast(float, h.x << 16), a[1] - __builtin_bit_cast(float, h.x & 0xffff0000u));
    l.y = cvt_pk_rne(a[2] - __builtin_bit_cast(float, h.y << 16), a[3] - __builtin_bit_cast(float, h.y & 0xffff0000u));
    l.z = cvt_pk_rne(b[0] - __builtin_bit_cast(float, h.z << 16), b[1] - __builtin_bit_cast(float, h.z & 0xffff0000u));
    l.w = cvt_pk_rne(b[2] - __builtin_bit_cast(float, h.w << 16), b[3] - __builtin_bit_cast(float, h.w & 0xffff0000u));
}
struct EpiIn {
    static constexpr bool PERM = true, AFTER_DRAIN = false;
    unsigned char* ws; RstdTab rt;
    __device__ __forceinline__ void operator()(const f32x4 (&acc)[2][2][4][2], const Unit& u, int wr, int wc, int fr, int fq) const {
        bf16_t* const proj = (bf16_t*)(ws + WS_PROJ); bf16_t* const qi_hl = (bf16_t*)(ws + WS_QIHL); bf16_t* const ki_hl = (bf16_t*)(ws + WS_KIHL); float* const wi = (float*)(ws + WS_WI);
        bf16_t* const vT = (bf16_t*)(ws + WS_VT); const float* const rope = (const float*)(ws + WS_ROPE);
        const int rloc0 = wr * 64 + fr, row0 = u.pm * BM + rloc0, pn = u.pn;
        const bool rot_lane = ((wc & 1) == 0) && (fq < 2);
        const float sgn = (fq == 0) ? -1.f : 1.f;
        f32x4 c0 = {1.f, 1.f, 1.f, 1.f}, c1 = c0, s0 = {0.f, 0.f, 0.f, 0.f}, s1 = s0;
        if (pn >= 5) { const PG8_GAS f32x4* tp = (const PG8_GAS f32x4*)(rope + (size_t)row0 * 16); c0 = tp[0]; c1 = tp[1]; s0 = tp[2]; s1 = tp[3]; }
#pragma unroll
        for (int ai = 0; ai < 2; ++ai)
#pragma unroll
            for (int m = 0; m < 4; ++m) {
                const int row = row0 + ai * HALF + m * 16;
                const float rs = rt.get(u.pm, rloc0 + ai * HALF + m * 16);
#pragma unroll
                for (int bj = 0; bj < 2; ++bj) {
                    f32x4 v0 = acc[ai][bj][m][0] * rs, v1 = acc[ai][bj][m][1] * rs;
                    const bool rope_tile = (pn == 5) || (pn == 6) || (pn == 8) || (pn == 7 && bj == 0) || (pn == 9 && bj == 0 && wc < 2);
                    if (rope_tile) {
                        f32x4 p0, p1;
#pragma unroll
                        for (int e = 0; e < 4; ++e) { p0[e] = __shfl_xor(v0[e], 16); p1[e] = __shfl_xor(v1[e], 16); }
                        if (rot_lane) { v0 = v0 * c0 + (p0 * s0) * sgn; v1 = v1 * c1 + (p1 * s1) * sgn; }
                    }
                    const int cl = bj * HALF + wc * 32 + 8 * fq;
                    if (pn < 7 || (pn == 7 && bj == 0)) {
                        u32x4 w; w.x = cvt_pk_bf16(v0[0], v0[1]); w.y = cvt_pk_bf16(v0[2], v0[3]); w.z = cvt_pk_bf16(v1[0], v1[1]); w.w = cvt_pk_bf16(v1[2], v1[3]);
                        *(PG8_GAS u32x4*)(proj + (size_t)row * 2048 + pn * BM + cl) = w;
                    } else if (pn == 7) {
                        const int vc = cl - HALF, kvh = vc >> 6, d = vc & 63, b = row >> 11, t = row & 2047;
                        PG8_GAS bf16_t* o = (PG8_GAS bf16_t*)vT + ((size_t)((b * 2 + kvh) * 64 + d)) * 2048 + t;
                        const u32x4 w = (u32x4){cvt_pk_bf16(v0[0], v0[1]), cvt_pk_bf16(v0[2], v0[3]), cvt_pk_bf16(v1[0], v1[1]), cvt_pk_bf16(v1[2], v1[3])};
                        o[0 * 2048] = (bf16_t)(w.x & 0xffffu); o[1 * 2048] = (bf16_t)(w.x >> 16); o[2 * 2048] = (bf16_t)(w.y & 0xffffu); o[3 * 2048] = (bf16_t)(w.y >> 16);
                        o[4 * 2048] = (bf16_t)(w.z & 0xffffu); o[5 * 2048] = (bf16_t)(w.z >> 16); o[6 * 2048] = (bf16_t)(w.w & 0xffffu); o[7 * 2048] = (bf16_t)(w.w >> 16);
                    } else if (pn == 8) {
                        const u32x4 h = (u32x4){cvt_pk_bf16(v0[0], v0[1]), cvt_pk_bf16(v0[2], v0[3]), cvt_pk_bf16(v1[0], v1[1]), cvt_pk_bf16(v1[2], v1[3])};
                        *(PG8_GAS u32x4*)(qi_hl + (size_t)row * 512 + cl) = h;
                    } else if (bj == 0) {
                        if (wc < 2) { const u32x4 h = (u32x4){cvt_pk_bf16(v0[0], v0[1]), cvt_pk_bf16(v0[2], v0[3]), cvt_pk_bf16(v1[0], v1[1]), cvt_pk_bf16(v1[2], v1[3])}; *(PG8_GAS u32x4*)(ki_hl + (size_t)row * 128 + cl) = h; }
                        else if (wc == 2 && fq == 0) { *(PG8_GAS f32x4*)(wi + (size_t)row * 4) = v0; }
                    }
                }
                if (pn >= 5 && (ai * 4 + m) < 7) {
#pragma unroll
                    for (int e = 0; e < 4; ++e) {
                        const float dc0 = (m == 3) ? c_rot80[0][e] : c_rot16[0][e], ds0 = (m == 3) ? c_rot80[1][e] : c_rot16[1][e];
                        const float dc1 = (m == 3) ? c_rot80[0][4 + e] : c_rot16[0][4 + e], ds1 = (m == 3) ? c_rot80[1][4 + e] : c_rot16[1][4 + e];
                        const float a0 = c0[e], a1 = c1[e];
                        c0[e] = a0 * dc0 - s0[e] * ds0; s0[e] = s0[e] * dc0 + a0 * ds0;
                        c1[e] = a1 * dc1 - s1[e] * ds1; s1[e] = s1[e] * dc1 + a1 * ds1;
                    }
                }
            }
    }
};
struct EpiRes {
    static constexpr bool PERM = true, AFTER_DRAIN = false;
    const float* xin; float* xout; unsigned char* ws;
    __device__ __forceinline__ void operator()(const f32x4 (&acc)[2][2][4][2], const Unit& u, int wr, int wc, int fr, int fq) const {
        bf16_t* const xb = (bf16_t*)(ws + WS_XB); float* const ssq = (float*)(ws + WS_SSQ);
        const int row0 = u.pm * BM + wr * 64 + fr;
        const int colt = u.pn * BM + wc * 32 + 8 * fq;
        f32x4 cur[2][2], nxt[2][2];
#pragma unroll
        for (int bj = 0; bj < 2; ++bj) { const size_t off = (size_t)row0 * 1024 + colt + bj * HALF; cur[bj][0] = *(const PG8_GAS f32x4*)(xin + off); cur[bj][1] = *(const PG8_GAS f32x4*)(xin + off + 4); }
#pragma unroll
        for (int g = 0; g < 8; ++g) {
            const int ai = g >> 2, m = g & 3;
            const int row = row0 + ai * HALF + m * 16;
            if (g + 1 < 8) { const int rown = row0 + ((g + 1) >> 2) * HALF + ((g + 1) & 3) * 16;
#pragma unroll
                for (int bj = 0; bj < 2; ++bj) { const size_t off = (size_t)rown * 1024 + colt + bj * HALF; nxt[bj][0] = *(const PG8_GAS f32x4*)(xin + off); nxt[bj][1] = *(const PG8_GAS f32x4*)(xin + off + 4); } }
            float sq = 0.f;
#pragma unroll
            for (int bj = 0; bj < 2; ++bj) {
                const size_t off = (size_t)row * 1024 + colt + bj * HALF;
                const f32x4 v0 = cur[bj][0] + acc[ai][bj][m][0], v1 = cur[bj][1] + acc[ai][bj][m][1];
                *(PG8_GAS f32x4*)(xout + off) = v0; *(PG8_GAS f32x4*)(xout + off + 4) = v1;
                u32x4 w; w.x = cvt_pk_bf16(v0[0], v0[1]); w.y = cvt_pk_bf16(v0[2], v0[3]); w.z = cvt_pk_bf16(v1[0], v1[1]); w.w = cvt_pk_bf16(v1[2], v1[3]);
                *(PG8_GAS u32x4*)(xb + off) = w;
                sq += (v0[0] * v0[0] + v0[1] * v0[1]) + (v0[2] * v0[2] + v0[3] * v0[3]) + (v1[0] * v1[0] + v1[1] * v1[1]) + (v1[2] * v1[2] + v1[3] * v1[3]);
            }
            sq += __shfl_xor(sq, 16); sq += __shfl_xor(sq, 32);
            if (fq == 0) ((PG8_GAS float*)ssq)[(size_t)row * 16 + u.pn * 4 + wc] = sq;
#pragma unroll
            for (int bj = 0; bj < 2; ++bj) { cur[bj][0] = nxt[bj][0]; cur[bj][1] = nxt[bj][1]; }
        }
    }
};
struct EpiFfIn {
    static constexpr bool PERM = true, AFTER_DRAIN = false;
    RstdTab rt;
    __device__ __forceinline__ void operator()(const f32x4 (&acc)[2][2][4][2], const Unit& u, int wr, int wc, int fr, int fq) const {
        bf16_t* const hid = (bf16_t*)(rt.ws + WS_HID);
        const int row0 = u.pm * BM + wr * 64 + fr;
        const int colt = u.pn * BM + wc * 32 + 8 * fq;
#pragma unroll
        for (int ai = 0; ai < 2; ++ai)
#pragma unroll
            for (int m = 0; m < 4; ++m) {
                const int row = row0 + ai * HALF + m * 16;
                const float rs = rt.get(u.pm, wr * 64 + fr + ai * HALF + m * 16);
#pragma unroll
                for (int bj = 0; bj < 2; ++bj) {
                    f32x4 v0 = acc[ai][bj][m][0] * rs, v1 = acc[ai][bj][m][1] * rs;
#pragma unroll
                    for (int e = 0; e < 4; ++e) { const float a = fmaxf(v0[e], 0.f), b = fmaxf(v1[e], 0.f); v0[e] = a * a; v1[e] = b * b; }
                    u32x4 w; w.x = cvt_pk_bf16(v0[0], v0[1]); w.y = cvt_pk_bf16(v0[2], v0[3]); w.z = cvt_pk_bf16(v1[0], v1[1]); w.w = cvt_pk_bf16(v1[2], v1[3]);
                    *(PG8_GAS u32x4*)(hid + (size_t)row * 4096 + colt + bj * HALF) = w;
                }
            }
    }
};
template <class Epi, class Sched, bool ALIGN_EPI = false, bool SP2 = false>
__device__ __forceinline__ void gemm_phase(PG8_LAS unsigned char* lds, const Gemm g, const Sched& S, const Epi& E) {
    int tid_ = threadIdx.x; asm volatile("" : "+v"(tid_));
    const int tid = tid_, wid = __builtin_amdgcn_readfirstlane(tid >> 6), lane = tid & 63, wr = wid >> 2, wc = wid & 3, fr = lane & 15, fq = lane >> 4;
    const int K = g.K, nt = K / BK;
    unsigned voffA[2], voffB[2];
#pragma unroll
    for (int i = 0; i < 2; ++i) { int R, C; stage_rc(tid * 16 + i * 8192, R, C); const int Rb = Epi::PERM ? ((R & ~31) + perm32(R & 31)) : R;
        voffA[i] = (unsigned)(R * K + C) * 2u; voffB[i] = (unsigned)(Rb * K + C) * 2u; }
    const size_t kstep = (size_t)(BK * 2);
    const size_t hstep = (size_t)HALF * K * 2;
    const size_t tstep = 2 * hstep;
    const unsigned ldsw = (unsigned)wid * 1024u;
    const int aoff = lds_byte(wr * 64 + fr, fq * 8), boff = lds_byte(wc * 32 + fr, fq * 8);
#define PG8_SA(b, h) (((b) * 2 + (h)) * HTB)
#define PG8_SB(b, h) ((4 + (b) * 2 + (h)) * HTB)
#define PG8_STAGE(bufoff, gbase, voff) do { _Pragma("unroll") for (int _i = 0; _i < 2; ++_i) \
        __builtin_amdgcn_global_load_lds((const unsigned*)((const char*)(gbase) + (voff)[_i]), (PG8_LAS unsigned*)(lds + (bufoff) + ldsw + _i * 8192), 16, 0, 0); } while (0)
#define PG8_LDA(dst, b, h) do { _Pragma("unroll") for (int m = 0; m < 4; ++m) _Pragma("unroll") for (int k = 0; k < 2; ++k) dst[m][k] = *(const PG8_LAS bf16x8*)(lds + PG8_SA(b, h) + aoff + m * 2048 + k * 1024); } while (0)
#define PG8_LDB(dst, b, h) do { _Pragma("unroll") for (int n = 0; n < 2; ++n) _Pragma("unroll") for (int k = 0; k < 2; ++k) dst[n][k] = *(const PG8_LAS bf16x8*)(lds + PG8_SB(b, h) + boff + n * 2048 + k * 1024); } while (0)
#define PG8_MMA(ai, bj, At, Bt) do { __builtin_amdgcn_s_setprio(1); _Pragma("unroll") for (int m = 0; m < 4; ++m) _Pragma("unroll") for (int n = 0; n < 2; ++n) _Pragma("unroll") for (int k = 0; k < 2; ++k) \
        acc[ai][bj][m][n] = __builtin_amdgcn_mfma_f32_16x16x32_bf16(Bt[n][k], At[m][k], acc[ai][bj][m][n], 0, 0, 0); __builtin_amdgcn_s_setprio(0); } while (0)
#define PG8_WAIT_V(n) asm volatile("s_waitcnt vmcnt(" #n ")" ::: "memory")
#define PG8_WAIT_L(n) asm volatile("s_waitcnt lgkmcnt(" #n ")" ::: "memory")
#define PG8_BAR __builtin_amdgcn_s_barrier()
#define PG8_SCHED __builtin_amdgcn_sched_barrier(0)
    Unit cur, nxt; int ui = 0;
    if (!S.next(0, cur)) return;
    f32x4 acc[2][2][4][2];
#pragma unroll
    for (int a = 0; a < 2; ++a)
#pragma unroll
        for (int b = 0; b < 2; ++b)
#pragma unroll
            for (int m = 0; m < 4; ++m)
#pragma unroll
                for (int n = 0; n < 2; ++n) acc[a][b][m][n] = (f32x4){0.f, 0.f, 0.f, 0.f};
    bf16x8 At[4][2], B0[2][2], B1[2][2];
    const char* cA = (const char*)g.A + (size_t)cur.pm * tstep; const char* cB = (const char*)g.Bt + (size_t)cur.pn * tstep;
    S.a_ready(cur);
    if constexpr (SP2) {
        PG8_STAGE(PG8_SB(0, 0), cB, voffB); PG8_STAGE(PG8_SB(0, 1), cB + hstep, voffB); PG8_STAGE(PG8_SA(0, 0), cA, voffA); PG8_STAGE(PG8_SA(0, 1), cA + hstep, voffA);
        if (wr == 1) PG8_BAR;
        PG8_WAIT_V(2); PG8_BAR;
        PG8_STAGE(PG8_SB(1, 0), cB + kstep, voffB); PG8_STAGE(PG8_SA(1, 0), cA + kstep, voffA); PG8_STAGE(PG8_SB(1, 1), cB + hstep + kstep, voffB);
        PG8_WAIT_V(6); PG8_BAR;
    } else {
        PG8_STAGE(PG8_SB(0, 0), cB, voffB); PG8_STAGE(PG8_SA(0, 0), cA, voffA); PG8_STAGE(PG8_SB(0, 1), cB + hstep, voffB); PG8_STAGE(PG8_SA(0, 1), cA + hstep, voffA);
        if (wr == 1) PG8_BAR;
        PG8_WAIT_V(4); PG8_BAR;
        PG8_STAGE(PG8_SB(1, 0), cB + kstep, voffB); PG8_STAGE(PG8_SA(1, 0), cA + kstep, voffA); PG8_STAGE(PG8_SB(1, 1), cB + hstep + kstep, voffB);
        PG8_WAIT_V(6); PG8_BAR;
    }
    for (;;) {
        const bool has_next = S.next(ui + 1, nxt);
        const char* nA = has_next ? (const char*)g.A + (size_t)nxt.pm * tstep : cA; const char* nB = has_next ? (const char*)g.Bt + (size_t)nxt.pn * tstep : cB;
        for (int t = 0; t < nt; t += 2) {
            const bool last = (t == nt - 2);
            const char* a1 = cA + (size_t)(t + 1) * kstep;
            const char* a2 = last ? nA : cA + (size_t)(t + 2) * kstep; const char* b2 = last ? nB : cB + (size_t)(t + 2) * kstep;
            const char* a3 = a2 + kstep; const char* b3 = b2 + kstep;
            if (last && has_next) S.a_ready(nxt);
            if constexpr (SP2) {
            PG8_LDB(B0, 0, 0); PG8_LDB(B1, 0, 1); PG8_SCHED; PG8_LDA(At, 0, 0); PG8_STAGE(PG8_SA(1, 1), a1 + hstep, voffA);
            PG8_WAIT_V(8); PG8_WAIT_L(0); PG8_BAR; PG8_MMA(0, 0, At, B0); PG8_MMA(0, 1, At, B1); PG8_BAR; PG8_SCHED;
            PG8_LDA(At, 0, 1); PG8_STAGE(PG8_SB(0, 0), b2, voffB); PG8_STAGE(PG8_SB(0, 1), b2 + hstep, voffB); PG8_STAGE(PG8_SA(0, 0), a2, voffA);
            PG8_WAIT_V(8); PG8_WAIT_L(0); PG8_BAR; PG8_MMA(1, 0, At, B0); PG8_MMA(1, 1, At, B1); PG8_BAR; PG8_SCHED;
            PG8_LDB(B0, 1, 0); PG8_LDB(B1, 1, 1); PG8_SCHED; PG8_LDA(At, 1, 0); PG8_STAGE(PG8_SA(0, 1), a2 + hstep, voffA);
            PG8_WAIT_V(8); PG8_WAIT_L(0); PG8_BAR; PG8_MMA(0, 0, At, B0); PG8_MMA(0, 1, At, B1); PG8_BAR; PG8_SCHED;
            PG8_LDA(At, 1, 1); PG8_STAGE(PG8_SB(1, 0), b3, voffB); PG8_STAGE(PG8_SB(1, 1), b3 + hstep, voffB); PG8_STAGE(PG8_SA(1, 0), a3, voffA);
            PG8_WAIT_V(8); PG8_WAIT_L(0); PG8_BAR; PG8_MMA(1, 0, At, B0); PG8_MMA(1, 1, At, B1); PG8_BAR; PG8_SCHED;
            } else {
            PG8_LDB(B0, 0, 0); PG8_SCHED; PG8_LDA(At, 0, 0); PG8_STAGE(PG8_SA(1, 1), a1 + hstep, voffA);
            PG8_WAIT_L(8); PG8_BAR; PG8_WAIT_L(0); PG8_MMA(0, 0, At, B0); PG8_BAR; PG8_SCHED;
            PG8_LDB(B1, 0, 1); PG8_STAGE(PG8_SB(0, 0), b2, voffB);
            PG8_BAR; PG8_WAIT_L(0); PG8_MMA(0, 1, At, B1); PG8_BAR;
            PG8_LDA(At, 0, 1); PG8_STAGE(PG8_SA(0, 0), a2, voffA);
            PG8_BAR; PG8_WAIT_L(0); PG8_MMA(1, 0, At, B0); PG8_BAR; PG8_SCHED;
            PG8_STAGE(PG8_SB(0, 1), b2 + hstep, voffB);
            PG8_WAIT_V(6); PG8_BAR; PG8_MMA(1, 1, At, B1); PG8_BAR;
            PG8_LDB(B0, 1, 0); PG8_SCHED; PG8_LDA(At, 1, 0); PG8_STAGE(PG8_SA(0, 1), a2 + hstep, voffA);
            PG8_WAIT_L(8); PG8_BAR; PG8_WAIT_L(0); PG8_MMA(0, 0, At, B0); PG8_BAR; PG8_SCHED;
            PG8_LDB(B1, 1, 1); PG8_STAGE(PG8_SB(1, 0), b3, voffB);
            PG8_BAR; PG8_WAIT_L(0); PG8_MMA(0, 1, At, B1); PG8_BAR;
            PG8_LDA(At, 1, 1); PG8_STAGE(PG8_SA(1, 0), a3, voffA);
            PG8_BAR; PG8_WAIT_L(0); PG8_MMA(1, 0, At, B0); PG8_BAR; PG8_SCHED;
            PG8_STAGE(PG8_SB(1, 1), b3 + hstep, voffB);
            PG8_WAIT_V(6); PG8_BAR; PG8_MMA(1, 1, At, B1); PG8_BAR;
            }
        }
        if constexpr (ALIGN_EPI) { if (wr == 0) PG8_BAR; }
        if constexpr (!Epi::AFTER_DRAIN) { E(acc, cur, wr, wc, fr, fq); S.done(cur); }
        if (!has_next) break;
#pragma unroll
        for (int a = 0; a < 2; ++a)
#pragma unroll
            for (int b = 0; b < 2; ++b)
#pragma unroll
                for (int m = 0; m < 4; ++m)
#pragma unroll
                    for (int n = 0; n < 2; ++n) acc[a][b][m][n] = (f32x4){0.f, 0.f, 0.f, 0.f};
        cur = nxt; cA = nA; cB = nB; ++ui;
        if constexpr (ALIGN_EPI) { if (wr == 1) PG8_BAR; }
    }
    PG8_WAIT_V(0);
    if constexpr (!ALIGN_EPI) { if (wr == 0) PG8_BAR; }
    PG8_BAR;
    if constexpr (Epi::AFTER_DRAIN) { E.fused(acc, cur, wr, wc, fr, fq, lds, wid, lane); S.done(cur); }
#undef PG8_SA
#undef PG8_SB
#undef PG8_STAGE
#undef PG8_LDA
#undef PG8_LDB
#undef PG8_MMA
#undef PG8_WAIT_V
#undef PG8_WAIT_L
#undef PG8_BAR
#undef PG8_SCHED
}
}

constexpr int RING_OFF = 0, RING_BYTES = 131072;
constexpr int LDS_BYTES = 147456;
constexpr int LDSCTL_OFF = LDS_BYTES - 1024, MISC_OFF = LDSCTL_OFF + 320;

#define GAS __attribute__((address_space(1)))
#define LAS __attribute__((address_space(3)))
typedef unsigned short bf16;
typedef unsigned v4u __attribute__((ext_vector_type(4)));
typedef unsigned v2u __attribute__((ext_vector_type(2)));
typedef float f32x4 __attribute__((ext_vector_type(4)));
typedef GAS unsigned gu32;
#define RLX_AGENT __ATOMIC_RELAXED, __HIP_MEMORY_SCOPE_AGENT
#define LDS_WAIT() asm volatile("s_waitcnt lgkmcnt(0)" ::: "memory")
__device__ __forceinline__ unsigned f2bf(float f) { unsigned u = __builtin_bit_cast(unsigned, f); return (u + 0x7fffu + ((u >> 16) & 1u)) >> 16; }
__device__ __forceinline__ unsigned pk2(float lo, float hi) { return f2bf(lo) | (f2bf(hi) << 16); }
__device__ __forceinline__ float bf2f(unsigned short h) { return __builtin_bit_cast(float, (unsigned)h << 16); }
__device__ __forceinline__ float wave_sum(float v) {
#pragma unroll
    for (int o = 1; o < 64; o <<= 1) v += __shfl_xor(v, o);
    return v;
}
__device__ __forceinline__ float wave_max(float v) {
#pragma unroll
    for (int o = 1; o < 64; o <<= 1) v = fmaxf(v, __shfl_xor(v, o));
    return v;
}
#define XB_TMO      128
#define XB_XCNT(j)  (256  + 64 * (j))
#define XB_XSUB(j)  (1280 + 64 * (j))
#define XB_XGEN(j)  (2304 + 64 * (j))
#define XB_TOP      3328
#define XB_TOPGEN   3392
#define XCD_BAR_WORDS 3456
#define XB_SPIN_CAP (1u << 18)

__device__ __forceinline__ unsigned xb_ld(unsigned* p)              { return __hip_atomic_load(p, __ATOMIC_RELAXED, __HIP_MEMORY_SCOPE_AGENT); }
__device__ __forceinline__ unsigned xb_add(unsigned* p, unsigned v) { return __hip_atomic_fetch_add(p, v, __ATOMIC_RELAXED, __HIP_MEMORY_SCOPE_AGENT); }
__device__ __forceinline__ unsigned xb_xcc_id() { return (unsigned)__builtin_amdgcn_s_getreg((3 << 11) | 20) & 0xFu; }
#define XB_SPIN(cond, bar) do { unsigned _sp = 0; while (cond) { __builtin_amdgcn_s_sleep(1); \
    if ((++_sp & 255u) == 0u) { if (xb_ld(&(bar)[XB_TMO])) break; if (_sp > XB_SPIN_CAP) { atomicAdd(&(bar)[XB_TMO], 1u); break; } } } } while (0)

struct XcdBarrier {
    unsigned* bar; unsigned x;
    volatile LAS unsigned* st;
};

__device__ __forceinline__ XcdBarrier xcd_barrier_post(unsigned* bar, volatile LAS unsigned* st) {
    XcdBarrier b; b.bar = bar; b.x = xb_xcc_id(); b.st = st;
    if (threadIdx.x == 0) (void)xb_add(&bar[XB_XCNT(b.x)], 1u);
    return b;
}
__device__ __forceinline__ void xcd_barrier_complete(unsigned* bar, unsigned x, unsigned& nloc, unsigned& nx) {
    const unsigned G = gridDim.x * gridDim.y * gridDim.z;
    unsigned sum, cnt, mine, sp = 0u;
    for (;;) {
        sum = 0u; cnt = 0u; mine = 0u;
#pragma unroll
        for (unsigned j = 0; j < 16; ++j) { const unsigned c = xb_ld(&bar[XB_XCNT(j)]); sum += c; cnt += (c > 0u) ? 1u : 0u; mine = (j == x) ? c : mine; }
        if (sum == G) break;
        __builtin_amdgcn_s_sleep(1);
        if ((++sp & 255u) == 0u) { if (xb_ld(&bar[XB_TMO])) break; if (sp > XB_SPIN_CAP) { atomicAdd(&bar[XB_TMO], 1u); break; } }
    }
    nloc = mine > 0u ? mine : 1u; nx = cnt > 0u ? cnt : 1u;
}

__device__ __forceinline__ void xcd_barrier(const XcdBarrier& b) {
    asm volatile("s_waitcnt vmcnt(0)" ::: "memory");
    __syncthreads();
    if (threadIdx.x == 0) {
        unsigned* bar = b.bar;
        __builtin_amdgcn_s_waitcnt(0);
        unsigned nloc = b.st[0], nx = b.st[1];
        if (nloc == 0u) { xcd_barrier_complete(bar, b.x, nloc, nx); b.st[0] = nloc; b.st[1] = nx; }
        const unsigned old = xb_add(&bar[XB_XSUB(b.x)], 1u);
        const unsigned gen = old / nloc;
        if (old + 1u == (gen + 1u) * nloc) {
            __builtin_amdgcn_fence(__ATOMIC_RELEASE, "agent");
            asm volatile("s_waitcnt vmcnt(0)" ::: "memory");
            const unsigned og = xb_add(&bar[XB_TOP], 1u);
            const unsigned tg = og / nx;
            if (og + 1u == (tg + 1u) * nx) xb_add(&bar[XB_TOPGEN], 1u);
            else XB_SPIN(xb_ld(&bar[XB_TOPGEN]) == tg, bar);
            __builtin_amdgcn_fence(__ATOMIC_ACQUIRE, "agent");
            xb_add(&bar[XB_XGEN(b.x)], 1u);
            asm volatile("s_waitcnt vmcnt(0)" ::: "memory");
        } else {
            XB_SPIN(xb_ld(&bar[XB_XGEN(b.x)]) == gen, bar);
            __builtin_amdgcn_fence(__ATOMIC_ACQUIRE, "agent");
            asm volatile("s_waitcnt vmcnt(0)" ::: "memory");
        }
    }
    __syncthreads();
}


struct Frame {
    LAS unsigned char* lds;
    volatile LAS unsigned* MISC;
    gu32* ctl;
    int tid, lane, wave, G, bid;
    const float* x_in; const int* pos;
    const float *n1g, *w_in, *pool_w, *pool_scale, *lb_logits, *hgrn_g, *w_out, *n2g, *w_ff_in, *w_ff_out, *fng;
    float* xres;
    unsigned char* ws;
};
__constant__ float c_invf[8] = {1.0f, 0.19392274474868576f, 0.03760603093086393f, 0.007292664737217109f, 0.001414213562373095f, 0.0002742481756762073f, 5.318295896944988e-05f, 1.031338537721246e-05f};

typedef float f32x16 __attribute__((ext_vector_type(16)));
typedef short bf16x8v __attribute__((ext_vector_type(8)));
typedef float f32x2v __attribute__((ext_vector_type(2))); typedef __bf16 bf16x2v __attribute__((ext_vector_type(2)));
__device__ __forceinline__ unsigned cvtpk(float lo, float hi) { f32x2v v = {lo, hi}; bf16x2v b = __builtin_convertvector(v, bf16x2v); return __builtin_bit_cast(unsigned, b); }

__device__ __forceinline__ void cvt_item(const GAS float* W, const GAS float* g, int K, int N, bf16* WT, LAS float* scr, int kb, int nb, int lane) {
    const int k0 = 64 * kb, n0 = 32 * nb;
    const int n = n0 + (lane & 31);
    float v[32];
#pragma unroll
    for (int i = 0; i < 32; ++i) { const int kk = 2 * i + (lane >> 5); v[i] = (n < N) ? W[(size_t)(k0 + kk) * N + n] : 0.f; }
    const int c = lane & 7;
    f32x4 g0 = {1.f, 1.f, 1.f, 1.f}, g1 = g0;
    if (g) { g0 = *(const GAS f32x4*)(g + k0 + 8 * c); g1 = *(const GAS f32x4*)(g + k0 + 8 * c + 4); }
    __builtin_amdgcn_sched_barrier(0);
#pragma unroll
    for (int i = 0; i < 32; ++i) { const int kk = 2 * i + (lane >> 5); scr[kk * 33 + (lane & 31)] = v[i]; }
    LDS_WAIT(); asm volatile("" ::: "memory");
#pragma unroll
    for (int j = 0; j < 4; ++j) { const int nl = (lane >> 3) + 8 * j; const LAS float* sp = scr + (8 * c) * 33 + nl;
        v4u o; o.x = pk2(sp[0 * 33] * g0[0], sp[1 * 33] * g0[1]); o.y = pk2(sp[2 * 33] * g0[2], sp[3 * 33] * g0[3]); o.z = pk2(sp[4 * 33] * g1[0], sp[5 * 33] * g1[1]); o.w = pk2(sp[6 * 33] * g1[2], sp[7 * 33] * g1[3]);
        *(GAS v4u*)(WT + (size_t)(n0 + nl) * K + k0 + 8 * c) = o; }
    LDS_WAIT(); asm volatile("" ::: "memory");
}
__device__ __forceinline__ void cvt_matrix(Frame& F, const float* W_, const float* g_, int K, int N, int Npad, bf16* WT) {
    const GAS float* W = (const GAS float*)W_; const GAS float* g = (const GAS float*)g_;
    LAS float* scr = (LAS float*)(F.lds + RING_OFF + F.wave * 16384);
    const int gw = F.bid * NWAVES + F.wave, NGW = F.G * NWAVES;
    const int nblk = Npad / 32, nitems = (K / 64) * nblk;
    for (int it = gw; it < nitems; it += NGW) cvt_item(W, g, K, N, WT, scr, it / nblk, it % nblk, F.lane);
}
__device__ __forceinline__ void cvt_layer_rest(Frame& F, int layer, int gw, int NGW) {
    LAS float* scr = (LAS float*)(F.lds + RING_OFF + F.wave * 16384);
    constexpr int I0 = (DM / 64) * (DM / 32), I1 = (DM / 64) * (DFF / 32), I2 = (DFF / 64) * (DM / 32), I3 = (DM / 64) * (DINP / 32);
    const int total = I0 + I1 + I2 + ((layer + 1 < DEPTH) ? I3 : 0);
    for (int it = gw; it < total; it += NGW) {
        int r = it;
        if (r < I0) { cvt_item((const GAS float*)(F.w_out + (size_t)layer * DM * DM), nullptr, DM, DM, (bf16*)(F.ws + WS_WOUT), scr, r / (DM / 32), r % (DM / 32), F.lane); continue; } r -= I0;
        if (r < I1) { cvt_item((const GAS float*)(F.w_ff_in + (size_t)layer * DM * DFF), (const GAS float*)(F.n2g + layer * DM), DM, DFF, (bf16*)(F.ws + WS_WFI), scr, r / (DFF / 32), r % (DFF / 32), F.lane); continue; } r -= I1;
        if (r < I2) { cvt_item((const GAS float*)(F.w_ff_out + (size_t)layer * DFF * DM), nullptr, DFF, DM, (bf16*)(F.ws + WS_WFO), scr, r / (DM / 32), r % (DM / 32), F.lane); continue; } r -= I2;
        cvt_item((const GAS float*)(F.w_in + (size_t)(layer + 1) * DM * DIN), (const GAS float*)(F.n1g + (layer + 1) * DM), DM, DIN, (bf16*)(F.ws + (((layer + 1) & 1) ? WS_WIN1 : WS_WIN)), scr, r / (DINP / 32), r % (DINP / 32), F.lane);
    }
}

__device__ __forceinline__ void p_prologue(Frame& F) {
    const int gtid = F.bid * NTHR + F.tid, NT = F.G * NTHR;
    GAS float* tab = (GAS float*)(F.ws + WS_ROPE);
    for (int idx = gtid; idx < M * 8; idx += NT) {
        const int row = idx >> 3, i = idx & 7;
        const float angf = (float)((const GAS int*)F.pos)[row] * c_invf[i];
        double r = (double)angf * 0.15915494309189535; r -= floor(r);
        const float a = (float)(r * 6.283185307179586);
        tab[row * 16 + i] = cosf(a); tab[row * 16 + 8 + i] = sinf(a);
    }
    if (gtid < 256) {
        const int c = gtid; GAS float* lb = (GAS float*)(F.ws + WS_LB); const GAS float* lbl = (const GAS float*)F.lb_logits;
        const float l0 = lbl[c], l1 = lbl[256 + c], l2 = lbl[512 + c], l3 = lbl[768 + c];
        const float mx = fmaxf(fmaxf(l0, l1), fmaxf(l2, l3));
        const float e0 = expf(l0 - mx), e1 = expf(l1 - mx), e2 = expf(l2 - mx), e3 = expf(l3 - mx);
        const float inv = 1.0f / (e0 + e1 + e2 + e3);
        lb[c] = 0.f; lb[256 + c] = e1 * inv; lb[512 + c] = (e1 + e2) * inv; lb[768 + c] = (e1 + e2 + e3) * inv;
    }
    const int gw = F.bid * NWAVES + F.wave, NGW = F.G * NWAVES;
    GAS bf16* xb = (GAS bf16*)(F.ws + WS_XB); GAS float* ssq = (GAS float*)(F.ws + WS_SSQ);
    for (int row = gw; row < M; row += NGW) {
        const GAS f32x4* xr = (const GAS f32x4*)(F.x_in + (size_t)row * DM) + F.lane;
        f32x4 v[4]; float s = 0.f;
#pragma unroll
        for (int j = 0; j < 4; ++j) { v[j] = xr[64 * j]; s += (v[j][0] * v[j][0] + v[j][1] * v[j][1]) + (v[j][2] * v[j][2] + v[j][3] * v[j][3]); }
        s = wave_sum(s);
        GAS unsigned long long* o8 = (GAS unsigned long long*)(xb + (size_t)row * DM) + F.lane;
#pragma unroll
        for (int j = 0; j < 4; ++j) o8[64 * j] = (unsigned long long)pk2(v[j][0], v[j][1]) | ((unsigned long long)pk2(v[j][2], v[j][3]) << 32);
        if (F.lane < 16) ssq[(size_t)row * 16 + F.lane] = (F.lane == 0) ? s : 0.f;
    }
    cvt_matrix(F, F.w_in, F.n1g, DM, DIN, DINP, (bf16*)(F.ws + WS_WIN));
}

constexpr int PL_WROW = 72, PL_PROW = 264, PL_WT_BYTES = 4 * 64 * PL_WROW * 2, PL_P_OFF = PL_WT_BYTES;
template <int WIN> __device__ __forceinline__ void pool_core(const GAS bf16* up, int tl0, LAS unsigned short* Pc) {
    float ps[49]; ps[0] = 0.f;
    float uv[48];
#pragma unroll
    for (int i = 0; i < 48; ++i) { const int tl = tl0 - 16 + i; uv[i] = (tl >= 0) ? bf2f(up[(long)(i - 16) * PROJ_LD]) : 0.f; }
    __builtin_amdgcn_sched_barrier(0);
#pragma unroll
    for (int i = 0; i < 48; ++i) ps[i + 1] = ps[i] + uv[i];
#pragma unroll
    for (int i = 16; i < 48; ++i) {
        const int tl = tl0 - 16 + i; const int cnt = (tl + 1 < WIN) ? tl + 1 : WIN;
        const float mean = (ps[i + 1] - ps[i + 1 - WIN]) / (float)cnt;
        Pc[(i - 16) * PL_PROW] = (unsigned short)f2bf(mean - uv[i]);
    }
}
__device__ __forceinline__ void p_pool(Frame& F, int layer) {
    LAS unsigned short* WT = (LAS unsigned short*)(F.lds + RING_OFF);
    LAS unsigned short* P = (LAS unsigned short*)(F.lds + RING_OFF + PL_P_OFF);
    const GAS bf16* proj = (const GAS bf16*)(F.ws + WS_PROJ); GAS bf16* mixed = (GAS bf16*)(F.ws + WS_MIXED);
    const GAS float* pw = (const GAS float*)F.pool_w + (size_t)layer * 4 * 64 * 64; const GAS float* ps_ = (const GAS float*)F.pool_scale + layer * 256;
    const int tid = F.tid, lane = F.lane, wave = F.wave;
#pragma unroll 8
    for (int i = 0; i < 32; ++i) { const int e = i * NTHR + tid; const int g = e >> 12, c = (e >> 6) & 63, d = e & 63; WT[(g * 64 + d) * PL_WROW + c] = (unsigned short)f2bf(pw[e]); }
    const int c = tid & 255, hf = tid >> 8, g = wave & 3;
    for (int unit = F.bid; unit < M / 64; unit += F.G) {
        const int t0 = unit * 64 + 32 * hf;
        { const GAS bf16* up = proj + (size_t)t0 * PROJ_LD + PC_POOL + c; LAS unsigned short* Pc = P + (32 * hf) * PL_PROW + c; const int tl0 = t0 & (SEQ - 1);
          if (g == 0) pool_core<2>(up, tl0, Pc); else if (g == 1) pool_core<4>(up, tl0, Pc); else if (g == 2) pool_core<8>(up, tl0, Pc); else pool_core<16>(up, tl0, Pc); }
        __syncthreads();
        { const int th = wave >> 2, fr = lane & 15, kg = lane >> 4;
#pragma unroll
          for (int tb = 0; tb < 2; ++tb) {
              bf16x8v af[2];
#pragma unroll
              for (int ks = 0; ks < 2; ++ks) af[ks] = *(const LAS bf16x8v*)(P + (32 * th + 16 * tb + fr) * PL_PROW + g * 64 + 32 * ks + 8 * kg);
#pragma unroll
              for (int db = 0; db < 4; ++db) {
                  f32x4 acc = {0.f, 0.f, 0.f, 0.f};
#pragma unroll
                  for (int ks = 0; ks < 2; ++ks) { const bf16x8v bfr = *(const LAS bf16x8v*)(WT + (g * 64 + 16 * db + fr) * PL_WROW + 32 * ks + 8 * kg);
                      acc = __builtin_amdgcn_mfma_f32_16x16x32_bf16(af[ks], bfr, acc, 0, 0, 0); }
                  const int dcol = g * 64 + 16 * db + fr; const float sc = ps_[dcol];
                  GAS bf16* op = mixed + (size_t)(unit * 64 + 32 * th + 16 * tb + 4 * kg) * DM + MC_POOL + dcol;
#pragma unroll
                  for (int r = 0; r < 4; ++r) op[(size_t)r * DM] = (bf16)f2bf(acc[r] * sc);
              }
          } }
        __syncthreads();
    }
}

__device__ __forceinline__ unsigned sort_key(float v) { if (v == 0.f) v = 0.f; const unsigned u = __builtin_bit_cast(unsigned, v); return (u & 0x80000000u) ? ~u : (u | 0x80000000u); }
__device__ __forceinline__ unsigned wave_total6(unsigned x) {
    unsigned t = 0;
#pragma unroll
    for (int b = 0; b < 6; ++b) t += (unsigned)__popcll(__ballot((x >> b) & 1u)) << b;
    return t;
}
template <int NI> __device__ __forceinline__ void emit_mask(const unsigned (&k)[NI], unsigned prefix, bool exact, GAS unsigned* mrow, int lane) {
    if (exact) {
#pragma unroll
        for (int i = 0; i < NI; ++i) { const unsigned long long sb = __ballot(k[i] >= prefix); if (lane == 0) *(GAS v2u*)(mrow + 2 * i) = (v2u){(unsigned)sb, (unsigned)(sb >> 32)}; }
    } else {
        const unsigned tau = prefix; unsigned c = 0u;
#pragma unroll
        for (int i = 0; i < NI; ++i) c += (unsigned)(k[i] > tau);
        const unsigned need = (unsigned)TOPK - wave_total6(c); unsigned base = 0u;
#pragma unroll
        for (int i = 0; i < NI; ++i) {
            const unsigned long long eqb = __ballot(k[i] == tau);
            const unsigned rank = base + (unsigned)__popcll(eqb & ((1ull << lane) - 1ull));
            const unsigned long long sb = __ballot((k[i] > tau) || ((k[i] == tau) && (rank < need)));
            if (lane == 0) *(GAS v2u*)(mrow + 2 * i) = (v2u){(unsigned)sb, (unsigned)(sb >> 32)};
            base += (unsigned)__popcll(eqb);
        }
    }
    if (NI < 32) { if (lane < 2 * (32 - NI)) mrow[2 * NI + lane] = 0u; }
}
__device__ __forceinline__ unsigned wave_max_u32(unsigned v) {
#pragma unroll
    for (int o = 1; o < 64; o <<= 1) { const unsigned t = (unsigned)__shfl_xor((int)v, o); v = v > t ? v : t; }
    return v;
}
template <int NI> __device__ __forceinline__ unsigned count_ge(const unsigned (&k)[NI], unsigned cand) {
    unsigned t = 0u;
#pragma unroll
    for (int i0 = 0; i0 < NI; i0 += 8) {
        unsigned long long mk[8];
#pragma unroll
        for (int i = 0; i < 8; ++i) mk[i] = __ballot(k[i0 + i] >= cand);
        __builtin_amdgcn_sched_barrier(0);
        unsigned t1 = 0u;
#pragma unroll
        for (int i = 0; i < 8; i += 2) { t += (unsigned)__popcll(mk[i]); t1 += (unsigned)__popcll(mk[i + 1]); }
        t += t1;
        __builtin_amdgcn_sched_barrier(0);
    }
    return t;
}
template <int NI> __device__ __forceinline__ void select2(const LAS unsigned* ka_, const LAS unsigned* kb_, int nk, GAS unsigned* mrowA, GAS unsigned* mrowB, int lane) {
    unsigned ka[NI], kb[NI];
#pragma unroll
    for (int i = 0; i < NI; ++i) { const int sidx = lane + 64 * i; ka[i] = (sidx < nk) ? ka_[sidx] : 0u; kb[i] = (sidx < nk) ? kb_[sidx] : 0u; }
    unsigned ma = 0u, mb = 0u;
#pragma unroll
    for (int i = 0; i < NI; ++i) { ma = ka[i] > ma ? ka[i] : ma; mb = kb[i] > mb ? kb[i] : mb; }
    ma = (unsigned)__builtin_amdgcn_readfirstlane((int)wave_max_u32(ma)); mb = (unsigned)__builtin_amdgcn_readfirstlane((int)wave_max_u32(mb));
    unsigned pa = 0u, pb = 0u; bool ea = false, eb = false;
    for (int bit = 31; bit >= 0; --bit) {
        const unsigned ca = pa | (1u << bit), cb = pb | (1u << bit);
        if (!ea && ca <= ma) { const unsigned ta = count_ge<NI>(ka, ca); if (ta >= (unsigned)TOPK) { pa = ca; ea = (ta == (unsigned)TOPK); } }
        if (!eb && cb <= mb) { const unsigned tb = count_ge<NI>(kb, cb); if (tb >= (unsigned)TOPK) { pb = cb; eb = (tb == (unsigned)TOPK); } }
        if (ea && eb) break;
    }
    emit_mask<NI>(ka, pa, ea, mrowA, lane);
    emit_mask<NI>(kb, pb, eb, mrowB, lane);
}
constexpr int MK_STRIDE = 2049;
__device__ __forceinline__ void p_mask(Frame& F) {
    LAS unsigned* keys = (LAS unsigned*)(F.lds + RING_OFF);
    const GAS bf16* qi_hl = (const GAS bf16*)(F.ws + WS_QIHL); const GAS bf16* ki_hl = (const GAS bf16*)(F.ws + WS_KIHL); const GAS float* wi = (const GAS float*)(F.ws + WS_WI); GAS unsigned* mask = (GAS unsigned*)(F.ws + WS_MASK);
    const int tid = F.tid, lane = F.lane, wave = F.wave, q = lane & 15, kg = lane >> 4;
    for (int c = F.bid; c < 256; c += F.G) {
        for (int ui = 0; ui < 4; ++ui) {
            const int b = (c >> 6) * 2 + (ui >> 1), bq = c & 63, qb = (ui & 1) ? 127 - bq : bq;
            const int t0 = qb * 16; const size_t rowq0 = (size_t)b * SEQ + t0;
            if (qb < 16) {
                for (int w = tid; w < 1024; w += NTHR) { const int qq = w >> 6, j = w & 63, n = t0 + qq + 1, lo = j * 32;
                    mask[(rowq0 + qq) * 64 + j] = (n >= lo + 32) ? 0xffffffffu : (n > lo ? ((1u << (n - lo)) - 1u) : 0u); }
                continue;
            }
            bf16x8v bh[4][2];
#pragma unroll
            for (int h = 0; h < 4; ++h)
#pragma unroll
                for (int dh = 0; dh < 2; ++dh) { const GAS bf16* pq = qi_hl + (rowq0 + q) * 512 + h * 64 + dh * 32 + kg * 8;
                    bh[h][dh] = *(const GAS bf16x8v*)pq; }
            const f32x4 wv = *(const GAS f32x4*)(wi + (rowq0 + q) * 4);
            const int ntile = qb + 1;
            bf16x8v ah[2];
            { const int kt0 = wave < ntile ? wave : 0;
#pragma unroll
              for (int dh = 0; dh < 2; ++dh) { const GAS bf16* pk = ki_hl + ((size_t)b * SEQ + kt0 * 16 + q) * 128 + dh * 32 + kg * 8;
                  ah[dh] = *(const GAS bf16x8v*)pk; } }
            for (int kt = wave; kt < ntile; kt += NWAVES) {
                const int s0 = kt * 16;
                bf16x8v ahn[2];
                { const int ktn = (kt + NWAVES < ntile) ? kt + NWAVES : kt;
#pragma unroll
                  for (int dh = 0; dh < 2; ++dh) { const GAS bf16* pk = ki_hl + ((size_t)b * SEQ + ktn * 16 + q) * 128 + dh * 32 + kg * 8;
                      ahn[dh] = *(const GAS bf16x8v*)pk; } }
                __builtin_amdgcn_sched_barrier(0);
                f32x4 acc[4];
#pragma unroll
                for (int h = 0; h < 4; ++h) { acc[h] = (f32x4){0.f, 0.f, 0.f, 0.f};
#pragma unroll
                    for (int dh = 0; dh < 2; ++dh) {
                        acc[h] = __builtin_amdgcn_mfma_f32_16x16x32_bf16(ah[dh], bh[h][dh], acc[h], 0, 0, 0);
                    } }
#pragma unroll
                for (int r = 0; r < 4; ++r) {
                    const float I = wv[0] * fmaxf(acc[0][r], 0.f) + wv[1] * fmaxf(acc[1][r], 0.f) + wv[2] * fmaxf(acc[2][r], 0.f) + wv[3] * fmaxf(acc[3][r], 0.f);
                    const int s = s0 + 4 * kg + r;
                    keys[q * MK_STRIDE + s] = (s <= t0 + q) ? sort_key(I) : 0u;
                }
                __builtin_amdgcn_sched_barrier(0);
#pragma unroll
                for (int dh = 0; dh < 2; ++dh) ah[dh] = ahn[dh];
            }
            __syncthreads();
            const int nk = t0 + 16;
            { const LAS unsigned* kA = keys + (2 * wave) * MK_STRIDE; const LAS unsigned* kB = kA + MK_STRIDE;
              GAS unsigned* mA = mask + (rowq0 + 2 * wave) * 64; GAS unsigned* mB = mA + 64;
              if (nk <= 512) select2<8>(kA, kB, nk, mA, mB, lane);
              else if (nk <= 1024) select2<16>(kA, kB, nk, mA, mB, lane);
              else if (nk <= 1536) select2<24>(kA, kB, nk, mA, mB, lane);
              else select2<32>(kA, kB, nk, mA, mB, lane); }
            __syncthreads();
        }
    }
}

typedef short s16x4 __attribute__((ext_vector_type(4)));
#define MFMA16(a, b, c) __builtin_amdgcn_mfma_f32_16x16x16bf16_1k((a), (b), (c), 0, 0, 0)
__device__ __forceinline__ s16x4 pack4(const f32x4 v) { v2u t; t.x = cvtpk(v[0], v[1]); t.y = cvtpk(v[2], v[3]); return __builtin_bit_cast(s16x4, t); }
constexpr int HG_QT = 0, HG_KT = 2176, HG_KH = 4352, HG_IT = 7424, HG_DF = 10496, HG_WAVE_LDS = 10752;
template <bool FULL> __device__ __forceinline__ float hgrn_stage(const GAS bf16* pr, float lbv, LAS unsigned char* W, int lane) {
    unsigned short zr[16], ir[16], qr[16];
#pragma unroll
    for (int s_ = 0; s_ < 16; ++s_) { zr[s_] = pr[(size_t)s_ * PROJ_LD + PC_HF]; ir[s_] = pr[(size_t)s_ * PROJ_LD + PC_HI]; if (FULL) qr[s_] = pr[(size_t)s_ * PROJ_LD + PC_HQ]; }
    __builtin_amdgcn_sched_barrier(0);
    float f[16], kk[16]; float P = 1.0f;
    LAS unsigned short* QT = (LAS unsigned short*)(W + HG_QT); LAS unsigned short* KT = (LAS unsigned short*)(W + HG_KT);
#pragma unroll
    for (int s_ = 0; s_ < 16; ++s_) {
        const float z = bf2f(zr[s_]);
        const float sig = 1.0f / (1.0f + __expf(-z));
        f[s_] = fmaxf(lbv + (1.0f - lbv) * sig, 1e-30f); kk[s_] = (1.0f - lbv) * (1.0f - sig);
        P *= f[s_];
        if (FULL) { const float q = bf2f(qr[s_]); const float qs = q / (1.0f + __expf(-q));
            QT[s_ * 68 + lane] = (unsigned short)f2bf(qs * P); KT[s_ * 68 + lane] = (unsigned short)f2bf(kk[s_] / fmaxf(P, 1e-30f)); }
    }
    float E = 1.0f; unsigned kh[8];
#pragma unroll
    for (int s_ = 15; s_ >= 0; s_ -= 2) {
        const float hi = kk[s_] * E; E *= f[s_];
        const float lo = kk[s_ - 1] * E; E *= f[s_ - 1];
        kh[s_ >> 1] = cvtpk(lo, hi);
    }
    LAS v4u* KH = (LAS v4u*)(W + HG_KH + lane * 48); LAS v4u* IT = (LAS v4u*)(W + HG_IT + lane * 48);
    KH[0] = (v4u){kh[0], kh[1], kh[2], kh[3]}; KH[1] = (v4u){kh[4], kh[5], kh[6], kh[7]};
    IT[0] = (v4u){(unsigned)ir[0] | ((unsigned)ir[1] << 16), (unsigned)ir[2] | ((unsigned)ir[3] << 16), (unsigned)ir[4] | ((unsigned)ir[5] << 16), (unsigned)ir[6] | ((unsigned)ir[7] << 16)};
    IT[1] = (v4u){(unsigned)ir[8] | ((unsigned)ir[9] << 16), (unsigned)ir[10] | ((unsigned)ir[11] << 16), (unsigned)ir[12] | ((unsigned)ir[13] << 16), (unsigned)ir[14] | ((unsigned)ir[15] << 16)};
    ((LAS float*)(W + HG_DF))[lane] = P;
    return P;
}
__device__ __forceinline__ void hgrn_update(f32x4 (&S)[4][4], const LAS unsigned char* W, int fr, int kg) {
    s16x4 khf[4], itf[4]; f32x4 df[4];
#pragma unroll
    for (int i = 0; i < 4; ++i) { khf[i] = *(const LAS s16x4*)(W + HG_KH + (16 * i + fr) * 48 + 8 * kg); itf[i] = *(const LAS s16x4*)(W + HG_IT + (16 * i + fr) * 48 + 8 * kg);
        df[i] = *(const LAS f32x4*)(W + HG_DF + (16 * i + 4 * kg) * 4); }
#pragma unroll
    for (int kb = 0; kb < 4; ++kb)
#pragma unroll
        for (int vb = 0; vb < 4; ++vb) S[kb][vb] = MFMA16(khf[kb], itf[vb], S[kb][vb] * df[kb]);
}
__device__ __forceinline__ void p_hgrn_local(Frame& F, int layer) {
    const int lane = F.lane, fr = lane & 15, kg = lane >> 4;
    LAS unsigned char* W = F.lds + RING_OFF + F.wave * 16384;
    const GAS bf16* proj = (const GAS bf16*)(F.ws + WS_PROJ); GAS float* hst = (GAS float*)(F.ws + WS_HST); GAS float* hdn = (GAS float*)(F.ws + WS_HDN);
    for (int unit = F.wave * F.G + F.bid; unit < BATCH * 4 * (SEQ / 64); unit += NWAVES * F.G) {
        const int bh = unit >> 5, chunk = unit & 31, b = bh >> 2, h = bh & 3;
        const float lbv = ((const GAS float*)(F.ws + WS_LB))[layer * 256 + h * 64 + lane];
        const size_t row0 = (size_t)b * SEQ + chunk * 64;
        f32x4 S[4][4];
#pragma unroll
        for (int i = 0; i < 4; ++i)
#pragma unroll
            for (int j = 0; j < 4; ++j) S[i][j] = (f32x4){0.f, 0.f, 0.f, 0.f};
        float dprod = 1.0f;
        for (int sub = 0; sub < 4; ++sub) {
            dprod *= hgrn_stage<false>(proj + (row0 + sub * 16) * PROJ_LD + h * 64 + lane, lbv, W, lane);
            LDS_WAIT(); asm volatile("" ::: "memory");
            hgrn_update(S, W, fr, kg);
            LDS_WAIT(); asm volatile("" ::: "memory");
        }
        GAS float* U = hst + (size_t)unit * 4096;
#pragma unroll
        for (int kb = 0; kb < 4; ++kb)
#pragma unroll
            for (int vb = 0; vb < 4; ++vb)
#pragma unroll
                for (int r = 0; r < 4; ++r) U[(16 * kb + 4 * kg + r) * 64 + 16 * vb + fr] = S[kb][vb][r];
        hdn[unit * 64 + lane] = dprod;
    }
}
__device__ __forceinline__ void p_hgrn_scan(Frame& F) {
    GAS float* hst = (GAS float*)(F.ws + WS_HST); const GAS float* hdn = (const GAS float*)(F.ws + WS_HDN);
    for (int e = F.bid * NTHR + F.tid; e < BATCH * 4 * 4096; e += F.G * NTHR) {
        const int bh = e >> 12, kv = e & 4095, k = kv >> 6;
        float S = 0.f;
        for (int n = 0; n < SEQ / 64; ++n) {
            const size_t idx = ((size_t)(bh * 32 + n) << 12) + kv;
            const float u = hst[idx]; hst[idx] = S;
            S = hdn[(bh * 32 + n) * 64 + k] * S + u;
        }
    }
}
constexpr int HG_LDS_OFF = 40960;
__device__ __forceinline__ void p_hgrn_out(Frame& F, int layer) {
    const int lane = F.lane, fr = lane & 15, kg = lane >> 4;
    LAS unsigned char* W = F.lds + RING_OFF + HG_LDS_OFF + F.wave * HG_WAVE_LDS;
    const GAS bf16* proj = (const GAS bf16*)(F.ws + WS_PROJ); GAS bf16* mixed = (GAS bf16*)(F.ws + WS_MIXED); const GAS float* hst = (const GAS float*)(F.ws + WS_HST);
    for (int unit = F.wave * F.G + F.bid; unit < BATCH * 4 * (SEQ / 64); unit += NWAVES * F.G) {
        const int bh = unit >> 5, chunk = unit & 31, b = bh >> 2, h = bh & 3;
        const float lbv = ((const GAS float*)(F.ws + WS_LB))[layer * 256 + h * 64 + lane];
        const size_t row0 = (size_t)b * SEQ + chunk * 64;
        f32x4 S[4][4];
        { const GAS float* U = hst + (size_t)unit * 4096;
#pragma unroll
          for (int kb = 0; kb < 4; ++kb)
#pragma unroll
              for (int vb = 0; vb < 4; ++vb)
#pragma unroll
                  for (int r = 0; r < 4; ++r) S[kb][vb][r] = U[(16 * kb + 4 * kg + r) * 64 + 16 * vb + fr]; }
        f32x4 ng4[4];
#pragma unroll
        for (int vb = 0; vb < 4; ++vb) ng4[vb] = *(const GAS f32x4*)((const GAS float*)F.hgrn_g + layer * 256 + h * 64 + 16 * vb + 4 * kg);
        for (int sub = 0; sub < 4; ++sub) {
            const size_t rs = row0 + sub * 16;
            (void)hgrn_stage<true>(proj + rs * PROJ_LD + h * 64 + lane, lbv, W, lane);
            v2u g2[4];
#pragma unroll
            for (int vb = 0; vb < 4; ++vb) g2[vb] = *(const GAS v2u*)(proj + (rs + fr) * PROJ_LD + PC_HG + h * 64 + 16 * vb + 4 * kg);
            LDS_WAIT(); asm volatile("" ::: "memory");
            s16x4 qb[4];
#pragma unroll
            for (int kb = 0; kb < 4; ++kb) qb[kb] = *(const LAS s16x4*)(W + HG_QT + (fr * 68 + 16 * kb + 4 * kg) * 2);
            f32x4 o[4];
#pragma unroll
            for (int vb = 0; vb < 4; ++vb) { o[vb] = (f32x4){0.f, 0.f, 0.f, 0.f};
#pragma unroll
                for (int kb = 0; kb < 4; ++kb) o[vb] = MFMA16(pack4(S[kb][vb]), qb[kb], o[vb]); }
            f32x4 at = {0.f, 0.f, 0.f, 0.f};
#pragma unroll
            for (int kb = 0; kb < 4; ++kb) at = MFMA16(*(const LAS s16x4*)(W + HG_KT + (fr * 68 + 16 * kb + 4 * kg) * 2), qb[kb], at);
#pragma unroll
            for (int r = 0; r < 4; ++r) if (4 * kg + r > fr) at[r] = 0.f;
            const s16x4 ab = pack4(at);
#pragma unroll
            for (int vb = 0; vb < 4; ++vb) o[vb] = MFMA16(*(const LAS s16x4*)(W + HG_IT + (16 * vb + fr) * 48 + 8 * kg), ab, o[vb]);
            hgrn_update(S, W, fr, kg);
            float ssq = 0.f;
#pragma unroll
            for (int vb = 0; vb < 4; ++vb) ssq += (o[vb][0] * o[vb][0] + o[vb][1] * o[vb][1]) + (o[vb][2] * o[vb][2] + o[vb][3] * o[vb][3]);
            ssq += __shfl_xor(ssq, 16); ssq += __shfl_xor(ssq, 32);
            const float rstd = 1.0f / sqrtf(ssq * (1.0f / 64.0f) + 1e-5f);
#pragma unroll
            for (int vb = 0; vb < 4; ++vb) {
                const float g0 = __builtin_bit_cast(float, g2[vb].x << 16), g1 = __builtin_bit_cast(float, g2[vb].x & 0xffff0000u), g2f = __builtin_bit_cast(float, g2[vb].y << 16), g3 = __builtin_bit_cast(float, g2[vb].y & 0xffff0000u);
                const float y0 = o[vb][0] * rstd * ng4[vb][0] * (g0 / (1.0f + __expf(-g0))), y1 = o[vb][1] * rstd * ng4[vb][1] * (g1 / (1.0f + __expf(-g1)));
                const float y2 = o[vb][2] * rstd * ng4[vb][2] * (g2f / (1.0f + __expf(-g2f))), y3 = o[vb][3] * rstd * ng4[vb][3] * (g3 / (1.0f + __expf(-g3)));
                *(GAS v2u*)(mixed + (rs + fr) * DM + MC_HGRN + h * 64 + 16 * vb + 4 * kg) = (v2u){cvtpk(y0, y1), cvtpk(y2, y3)};
            }
            LDS_WAIT(); asm volatile("" ::: "memory");
        }
    }
}

__device__ __forceinline__ float max3f_(float a, float b, float c) { float r; asm("v_max3_f32 %0, %1, %2, %3" : "=v"(r) : "v"(a), "v"(b), "v"(c)); return r; }
__device__ __forceinline__ float and_f32(float e, int selmask) { asm volatile("" : "+v"(selmask)); return __builtin_bit_cast(float, __builtin_bit_cast(unsigned, e) & (unsigned)selmask); }
typedef float f32x2p __attribute__((ext_vector_type(2)));
constexpr int AT_KROW = 144, AT_VROW = 136, AT_KBYTES = 64 * AT_KROW, AT_VBYTES = 64 * AT_VROW, AT_BUF = AT_KBYTES + AT_VBYTES, AT_SCR = 2 * AT_BUF;
static_assert(AT_BUF % 16 == 0 && AT_SCR % 16 == 0, "attention LDS map alignment");
__device__ __forceinline__ void p_attn_flash(Frame& F) {
    const int tid = F.tid, lane = F.lane, wave = F.wave;
    const int r = lane & 31, hh = lane >> 5, g = wave & 3, qh = wave >> 2;
    LAS unsigned char* L = F.lds + RING_OFF;
    LAS float* scr = (LAS float*)(L + AT_SCR) + wave * 32;
    const GAS bf16* proj = (const GAS bf16*)(F.ws + WS_PROJ); const GAS bf16* vT = (const GAS bf16*)(F.ws + WS_VT); GAS bf16* mixed = (GAS bf16*)(F.ws + WS_MIXED);
    const GAS unsigned* mask = (const GAS unsigned*)(F.ws + WS_MASK);
    const int srow = tid >> 3, sch = tid & 7;
    const float C2 = 0.18033688011112042f, NEG = -1.0e30f;
    for (int pair = F.bid; pair < 256; pair += F.G) {
        const int bk = pair >> 4, b = bk >> 1, kvh = bk & 1, pp = pair & 15, h = kvh * 4 + g;
        for (int half = 0; half < 2; ++half) {
            const int qblk = half == 0 ? 31 - pp : pp;
            const int q0 = qblk * 64, nt = qblk + 1;
            const int tq = q0 + 32 * qh + r;
            bf16x8v qf[4];
            { const GAS bf16* qp = proj + (size_t)(b * SEQ + tq) * PROJ_LD + PC_Q + h * 64 + 8 * hh;
#pragma unroll
              for (int d0 = 0; d0 < 4; ++d0) qf[d0] = *(const GAS bf16x8v*)(qp + 16 * d0); }
            const GAS unsigned* mrow = mask + (size_t)(b * SEQ + tq) * 64;
            const GAS bf16* kg = proj + (size_t)(b * SEQ + srow) * PROJ_LD + PC_K + kvh * 64 + sch * 8;
            const GAS bf16* vg = vT + (size_t)(bk * 64 + srow) * SEQ + sch * 8;
            { const v4u kreg = *(const GAS v4u*)kg; const v4u vreg = *(const GAS v4u*)vg;
              *(LAS v4u*)(L + srow * AT_KROW + sch * 16) = kreg;
              LAS unsigned char* vd = L + AT_KBYTES + srow * AT_VROW + sch * 16;
              *(LAS v2u*)vd = (v2u){vreg.x, vreg.y}; *(LAS v2u*)(vd + 8) = (v2u){vreg.z, vreg.w}; }
            v2u mw = *(const GAS v2u*)mrow;
            __syncthreads();
            f32x16 o0, o1;
#pragma unroll
            for (int i = 0; i < 16; ++i) { o0[i] = 0.f; o1[i] = 0.f; }
            float m = -30000.0f, l = 0.f;
            for (int j = 0; j < nt; ++j) {
                LAS unsigned char* Kb = L + (j & 1) * AT_BUF; LAS unsigned char* Vb = Kb + AT_KBYTES;
                const bool more = (j + 1 < nt);
                const int jn = more ? j + 1 : j;
                const v4u kn = *(const GAS v4u*)(kg + (size_t)jn * 64 * PROJ_LD); const v4u vn = *(const GAS v4u*)(vg + jn * 64); const v2u mwn = *(const GAS v2u*)(mrow + 2 * jn);
                bf16x8v kf[8];
#pragma unroll
                for (int d0 = 0; d0 < 4; ++d0) { kf[2 * d0] = *(const LAS bf16x8v*)(Kb + r * AT_KROW + d0 * 32 + hh * 16); kf[2 * d0 + 1] = *(const LAS bf16x8v*)(Kb + (32 + r) * AT_KROW + d0 * 32 + hh * 16); }
                __builtin_amdgcn_sched_barrier(0);
                f32x16 p0, p1;
#pragma unroll
                for (int i = 0; i < 16; ++i) { p0[i] = 0.f; p1[i] = 0.f; }
#pragma unroll
                for (int d0 = 0; d0 < 4; ++d0) {
                    p0 = __builtin_amdgcn_mfma_f32_32x32x16_bf16(kf[2 * d0], qf[d0], p0, 0, 0, 0);
                    p1 = __builtin_amdgcn_mfma_f32_32x32x16_bf16(kf[2 * d0 + 1], qf[d0], p1, 0, 0, 0);
                }
                v2u vl[8], vh[8];
#pragma unroll
                for (int ks = 0; ks < 4; ++ks) {
                    const LAS unsigned char* vp = Vb + r * AT_VROW + (16 * ks + 4 * hh) * 2;
                    vl[2 * ks] = *(const LAS v2u*)vp; vh[2 * ks] = *(const LAS v2u*)(vp + 16);
                    vl[2 * ks + 1] = *(const LAS v2u*)(vp + 32 * AT_VROW); vh[2 * ks + 1] = *(const LAS v2u*)(vp + 32 * AT_VROW + 16);
                }
                __builtin_amdgcn_sched_barrier(0);
                const unsigned w0 = mw.x >> (4 * hh), w1 = mw.y >> (4 * hh);
                asm volatile("s_nop 15\n\ts_nop 7" : "+v"(p0), "+v"(p1));
                float mx;
                { float a = max3f_(p0[0], p0[1], p1[0]), b = max3f_(p0[2], p0[3], p1[1]); a = max3f_(a, p1[2], p1[3]);
#pragma unroll
                  for (int i = 4; i < 16; i += 4) { a = max3f_(a, p0[i], p0[i + 1]); b = max3f_(b, p0[i + 2], p0[i + 3]); a = max3f_(a, p1[i], p1[i + 1]); b = max3f_(b, p1[i + 2], p1[i + 3]); }
                  mx = max3f_(a, b, NEG); }
                mx = fmaxf(mx, __shfl_xor(mx, 32));
                const float mxs = mx * C2;
                const bool need = mxs > m + 8.0f;
                if (__any(need)) {
                    const float mnew = need ? mxs : m;
                    const float alpha = __builtin_amdgcn_exp2f(m - mnew); m = mnew; l *= alpha;
                    if (hh == 0) scr[r] = alpha;
#pragma unroll
                    for (int gq = 0; gq < 4; ++gq) {
                        const f32x4 a4 = *(const LAS f32x4*)(scr + 8 * gq + 4 * hh);
#pragma unroll
                        for (int e = 0; e < 4; ++e) { o0[4 * gq + e] *= a4[e]; o1[4 * gq + e] *= a4[e]; }
                    }
                }
                f32x2p rs2 = {0.f, 0.f};
                const f32x2p c2v = {C2, C2}, nm2 = {-m, -m};
#pragma unroll
                for (int i = 0; i < 16; i += 2) {
                    const int cr0 = (i & 3) + 8 * (i >> 2), cr1 = cr0 + 1;
                    f32x2p t0 = (f32x2p){p0[i], p0[i + 1]} * c2v + nm2, t1 = (f32x2p){p1[i], p1[i + 1]} * c2v + nm2;
                    t0.x = and_f32(__builtin_amdgcn_exp2f(t0.x), __builtin_amdgcn_sbfe((int)w0, cr0, 1)); t0.y = and_f32(__builtin_amdgcn_exp2f(t0.y), __builtin_amdgcn_sbfe((int)w0, cr1, 1));
                    t1.x = and_f32(__builtin_amdgcn_exp2f(t1.x), __builtin_amdgcn_sbfe((int)w1, cr0, 1)); t1.y = and_f32(__builtin_amdgcn_exp2f(t1.y), __builtin_amdgcn_sbfe((int)w1, cr1, 1));
                    p0[i] = t0.x; p0[i + 1] = t0.y; p1[i] = t1.x; p1[i + 1] = t1.y;
                    rs2 += t0; rs2 += t1;
                }
                l += rs2.x + rs2.y;
                bf16x8v pf[4];
                { v4u t;
                  t.x = cvtpk(p0[0], p0[1]); t.y = cvtpk(p0[2], p0[3]); t.z = cvtpk(p0[4], p0[5]); t.w = cvtpk(p0[6], p0[7]); pf[0] = __builtin_bit_cast(bf16x8v, t);
                  t.x = cvtpk(p0[8], p0[9]); t.y = cvtpk(p0[10], p0[11]); t.z = cvtpk(p0[12], p0[13]); t.w = cvtpk(p0[14], p0[15]); pf[1] = __builtin_bit_cast(bf16x8v, t);
                  t.x = cvtpk(p1[0], p1[1]); t.y = cvtpk(p1[2], p1[3]); t.z = cvtpk(p1[4], p1[5]); t.w = cvtpk(p1[6], p1[7]); pf[2] = __builtin_bit_cast(bf16x8v, t);
                  t.x = cvtpk(p1[8], p1[9]); t.y = cvtpk(p1[10], p1[11]); t.z = cvtpk(p1[12], p1[13]); t.w = cvtpk(p1[14], p1[15]); pf[3] = __builtin_bit_cast(bf16x8v, t); }
                __builtin_amdgcn_sched_barrier(0);
#pragma unroll
                for (int ks = 0; ks < 4; ++ks) {
                    const bf16x8v vf0 = __builtin_bit_cast(bf16x8v, (v4u){vl[2 * ks].x, vl[2 * ks].y, vh[2 * ks].x, vh[2 * ks].y});
                    const bf16x8v vf1 = __builtin_bit_cast(bf16x8v, (v4u){vl[2 * ks + 1].x, vl[2 * ks + 1].y, vh[2 * ks + 1].x, vh[2 * ks + 1].y});
                    o0 = __builtin_amdgcn_mfma_f32_32x32x16_bf16(pf[ks], vf0, o0, 0, 0, 0);
                    o1 = __builtin_amdgcn_mfma_f32_32x32x16_bf16(pf[ks], vf1, o1, 0, 0, 0);
                }
                __builtin_amdgcn_sched_barrier(0);
                if (more) {
                    LAS unsigned char* Kn = L + ((j + 1) & 1) * AT_BUF;
                    *(LAS v4u*)(Kn + srow * AT_KROW + sch * 16) = kn;
                    LAS unsigned char* vd = Kn + AT_KBYTES + srow * AT_VROW + sch * 16;
                    *(LAS v2u*)vd = (v2u){vn.x, vn.y}; *(LAS v2u*)(vd + 8) = (v2u){vn.z, vn.w};
                }
                mw = mwn;
                __syncthreads();
            }
            l += __shfl_xor(l, 32);
            if (hh == 0) scr[r] = 1.0f / l;
            GAS bf16* op = mixed + (size_t)(b * SEQ + q0 + 32 * qh) * DM + MC_ATTN + h * 64 + r;
#pragma unroll
            for (int gq = 0; gq < 4; ++gq) {
                const f32x4 a4 = *(const LAS f32x4*)(scr + 8 * gq + 4 * hh);
#pragma unroll
                for (int e = 0; e < 4; ++e) {
                    const int q = 8 * gq + 4 * hh + e;
                    op[(size_t)q * DM] = (bf16)f2bf(o0[4 * gq + e] * a4[e]); op[(size_t)q * DM + 32] = (bf16)f2bf(o1[4 * gq + e] * a4[e]);
                }
            }
        }
    }
}

__device__ __forceinline__ void p_final(Frame& F) {
    const int gw = F.bid * NWAVES + F.wave, NGW = F.G * NWAVES;
    for (int row = gw; row < M; row += NGW) {
        GAS f32x4* xr = (GAS f32x4*)(F.xres + (size_t)row * DM) + F.lane;
        const GAS f32x4* gr = (const GAS f32x4*)F.fng + F.lane;
        f32x4 v[4]; float s = 0.f;
#pragma unroll
        for (int j = 0; j < 4; ++j) { v[j] = xr[64 * j]; s += (v[j][0] * v[j][0] + v[j][1] * v[j][1]) + (v[j][2] * v[j][2] + v[j][3] * v[j][3]); }
        s = wave_sum(s);
        const float rs = 1.0f / sqrtf(s * (1.0f / 1024.0f) + 1e-5f);
#pragma unroll
        for (int j = 0; j < 4; ++j) xr[64 * j] = v[j] * rs * gr[64 * j];
    }
}

#ifndef MK_SINGLE
#define MK_SINGLE 1
#endif
constexpr int NPL = 7;
constexpr int NPHASE = 1 + DEPTH * NPL + 1;
struct Args { const float* x; const int* pos; const float *n1g, *w_in, *pool_w, *pool_scale, *lb_logits, *hgrn_g, *w_out, *n2g, *w_ff_in, *w_ff_out, *fng; float* out; unsigned char* ws; int ph_lo, ph_hi; };
static_assert(sizeof(Args) == 15 * 8 + 8, "Args has no padding");


#define PHASE_BEGIN() do { int t_ = threadIdx.x; asm volatile("" : "+v"(t_)); F.tid = t_; F.lane = t_ & 63; F.wave = __builtin_amdgcn_readfirstlane(t_ >> 6); \
    unsigned char* w_ = args.ws; asm volatile("" : "+s"(w_)); F.ws = w_; int b_ = blockIdx.x; asm volatile("" : "+s"(b_)); F.bid = b_; } while (0)

#define RSTD_TAB_OFF RING_BYTES
#define FILL_RSTD(S_, pm_out) do { PHASE_BEGIN(); pg8::Unit u0_; pm_out = S_.next(0, u0_) ? u0_.pm : -1; \
    if (pm_out >= 0 && F.tid < 256) ((LAS float*)(F.lds + RSTD_TAB_OFF))[F.tid] = pg8::row_rstd((const float*)(F.ws + WS_SSQ), pm_out * 256 + F.tid); \
    __syncthreads(); } while (0)
__global__ void __launch_bounds__(NTHR, 2) fwd(Args args) {
    extern __shared__ __attribute__((aligned(16))) unsigned char lds[];
    Frame F;
    F.lds = (LAS unsigned char*)lds;
    F.MISC = (volatile LAS unsigned*)(F.lds + MISC_OFF);
    F.tid = threadIdx.x; F.lane = F.tid & 63; F.wave = __builtin_amdgcn_readfirstlane(F.tid >> 6);
    F.G = gridDim.x; F.bid = blockIdx.x;
    F.ws = args.ws; F.ctl = (gu32*)(args.ws + WS_CTL);
    F.x_in = args.x; F.pos = args.pos; F.n1g = args.n1g; F.w_in = args.w_in; F.pool_w = args.pool_w; F.pool_scale = args.pool_scale; F.lb_logits = args.lb_logits;
    F.hgrn_g = args.hgrn_g; F.w_out = args.w_out; F.n2g = args.n2g; F.w_ff_in = args.w_ff_in; F.w_ff_out = args.w_ff_out; F.fng = args.fng; F.xres = args.out;
    for (int u = F.tid; u < (LDS_BYTES - LDSCTL_OFF) / 4; u += NTHR) ((LAS unsigned*)(F.lds + LDSCTL_OFF))[u] = 0u;
    __syncthreads();
    XcdBarrier bar; bar.bar = (unsigned*)(F.ctl + CW_BAR); bar.x = 0; bar.st = nullptr;
    if (MK_SINGLE) bar = xcd_barrier_post((unsigned*)(F.ctl + CW_BAR), F.MISC + 8);
    const int lo = args.ph_lo, hi = args.ph_hi;
#define IN(k) (lo <= (k) && (k) < hi)
#define SEAM(k) do { if (MK_SINGLE && IN(k) && IN((k) + 1)) xcd_barrier(bar); } while (0)
    bf16* const xb = (bf16*)(F.ws + WS_XB); float* const ssq = (float*)(F.ws + WS_SSQ);
    bf16* const proj = (bf16*)(F.ws + WS_PROJ); bf16* const mixed = (bf16*)(F.ws + WS_MIXED); bf16* const hid = (bf16*)(F.ws + WS_HID);

    if (IN(0)) { PHASE_BEGIN(); p_prologue(F); } SEAM(0);
    for (int layer = 0; layer < DEPTH; ++layer) {
        const int pb = 1 + layer * NPL;
        if (IN(pb + 0)) {
            PHASE_BEGIN(); pg8::Gemm g{xb, (const bf16*)(F.ws + ((layer & 1) ? WS_WIN1 : WS_WIN)), M, DINP, DM}; pg8::StaticOrder S; S.init(M, DINP, F.G, F.bid);
            int pm0; FILL_RSTD(S, pm0);
            pg8::EpiIn E{F.ws, pg8::RstdTab{(const LAS float*)(F.lds + RSTD_TAB_OFF), pm0, F.ws}};
            pg8::gemm_phase<pg8::EpiIn, pg8::StaticOrder, true, true>(F.lds + RING_OFF, g, S, E);
            PHASE_BEGIN(); if (F.bid >= 128) cvt_layer_rest(F, layer, (F.bid - 128) * NWAVES + F.wave, 128 * NWAVES);
        } SEAM(pb + 0);
        if (IN(pb + 1)) { PHASE_BEGIN(); p_hgrn_local(F, layer); } SEAM(pb + 1);
        if (IN(pb + 2)) { PHASE_BEGIN(); p_pool(F, layer); PHASE_BEGIN(); p_mask(F); PHASE_BEGIN(); p_hgrn_scan(F); } SEAM(pb + 2);
        if (IN(pb + 3)) { PHASE_BEGIN(); p_hgrn_out(F, layer); PHASE_BEGIN(); p_attn_flash(F); } SEAM(pb + 3);
        if (IN(pb + 4)) {
            PHASE_BEGIN(); pg8::Gemm g{mixed, (const bf16*)(F.ws + WS_WOUT), M, DM, DM}; pg8::StaticOrder S; S.init(M, DM, F.G, F.bid);
            pg8::EpiRes E{layer == 0 ? F.x_in : (const float*)F.xres, F.xres, F.ws};
            pg8::gemm_phase<pg8::EpiRes, pg8::StaticOrder, true, true>(F.lds + RING_OFF, g, S, E);
        } SEAM(pb + 4);
        if (IN(pb + 5)) {
            PHASE_BEGIN(); pg8::Gemm g{xb, (const bf16*)(F.ws + WS_WFI), M, DFF, DM}; pg8::StaticOrder S; S.init(M, DFF, F.G, F.bid);
            int pm0; FILL_RSTD(S, pm0);
            pg8::EpiFfIn E{pg8::RstdTab{(const LAS float*)(F.lds + RSTD_TAB_OFF), pm0, F.ws}};
            pg8::gemm_phase<pg8::EpiFfIn, pg8::StaticOrder, true, true>(F.lds + RING_OFF, g, S, E);
        } SEAM(pb + 5);
        if (IN(pb + 6)) {
            PHASE_BEGIN(); pg8::Gemm g{hid, (const bf16*)(F.ws + WS_WFO), M, DM, DFF}; pg8::StaticOrder S; S.init(M, DM, F.G, F.bid);
            pg8::EpiRes E{(const float*)F.xres, F.xres, F.ws};
            pg8::gemm_phase<pg8::EpiRes, pg8::StaticOrder, true, true>(F.lds + RING_OFF, g, S, E);
        } SEAM(pb + 6);
    }
    if (IN(NPHASE - 1)) { PHASE_BEGIN(); p_final(F); }
#undef IN
#undef SEAM
}

extern "C" void kernel_launch(void* const* d_in, const int* in_sizes, int n_in, void* d_out, int out_size, void* d_ws, size_t ws_size, hipStream_t stream) {
    static int grid = 0;
    if (grid == 0) {
        if (n_in != 13 || out_size != M * DM || ws_size < WS_END) { fprintf(stderr, "kernel_launch: unexpected shapes (n_in %d, out %d, ws %zu)\n", n_in, out_size, ws_size); grid = -1; return; }
        int dev = 0, cus = 0, per_cu = 0;
        if (hipGetDevice(&dev) != hipSuccess || hipDeviceGetAttribute(&cus, hipDeviceAttributeMultiprocessorCount, dev) != hipSuccess) { grid = -1; return; }
        if (hipFuncSetAttribute((const void*)fwd, hipFuncAttributeMaxDynamicSharedMemorySize, LDS_BYTES) != hipSuccess) { fprintf(stderr, "kernel_launch: hipFuncSetAttribute failed\n"); grid = -1; return; }
        if (hipOccupancyMaxActiveBlocksPerMultiprocessor(&per_cu, (const void*)fwd, NTHR, LDS_BYTES) != hipSuccess || per_cu < 1) { fprintf(stderr, "kernel_launch: occupancy query says %d\n", per_cu); }
        (void)hipGetLastError();
        grid = cus;
        if (grid != 256) { fprintf(stderr, "kernel_launch: built for a 256-CU device (got %d)\n", cus); grid = -1; return; }
    }
    if (grid <= 0) return;
    (void)hipMemsetAsync((char*)d_ws + WS_CTL, 0, CTL_ZERO_BYTES, stream);
    Args a{};
    a.x = (const float*)d_in[0]; a.pos = (const int*)d_in[1]; a.n1g = (const float*)d_in[2]; a.w_in = (const float*)d_in[3]; a.pool_w = (const float*)d_in[4];
    a.pool_scale = (const float*)d_in[5]; a.lb_logits = (const float*)d_in[6]; a.hgrn_g = (const float*)d_in[7]; a.w_out = (const float*)d_in[8]; a.n2g = (const float*)d_in[9];
    a.w_ff_in = (const float*)d_in[10]; a.w_ff_out = (const float*)d_in[11]; a.fng = (const float*)d_in[12];
    a.out = (float*)d_out; a.ws = (unsigned char*)d_ws;
    if (MK_SINGLE) {
        a.ph_lo = 0; a.ph_hi = NPHASE;
        hipLaunchKernelGGL(fwd, dim3(grid), dim3(NTHR), LDS_BYTES, stream, a);
    } else {
        for (int p = 0; p < NPHASE; ++p) { a.ph_lo = p; a.ph_hi = p + 1; hipLaunchKernelGGL(fwd, dim3(grid), dim3(NTHR), LDS_BYTES, stream, a); }
    }
}
```

```cpp
#include <hip/hip_runtime.h>
#include <cstdio>
#include <cstdint>

constexpr int BATCH = 8, SEQ = 2048, DM = 1024, DEPTH = 4, M = BATCH * SEQ, DIN = 2372, DINP = 2560, DFF = 4096;
constexpr int NWAVES = 8, NTHR = NWAVES * 64;
constexpr int TOPK = 256;
constexpr int PC_POOL = 0, PC_HQ = 256, PC_HF = 512, PC_HI = 768, PC_HG = 1024, PC_Q = 1280, PC_K = 1792, PC_V = 1920, PROJ_LD = 2048;
constexpr int MC_POOL = 0, MC_HGRN = 256, MC_ATTN = 512;

constexpr size_t MiB = 1u << 20;
constexpr size_t WS_CTL = 0, CTL_ZERO_BYTES = 1 * MiB;
constexpr size_t WS_ROPE = 1 * MiB;
constexpr size_t WS_SSQ = 2 * MiB;
constexpr size_t WS_LB = 3 * MiB;
constexpr size_t WS_MASK = 4 * MiB;
constexpr size_t WS_WIN = 8 * MiB;
constexpr size_t WS_WOUT = 13 * MiB;
constexpr size_t WS_WFI = 15 * MiB;
constexpr size_t WS_WFO = 23 * MiB;
constexpr size_t WS_XB = 32 * MiB;
constexpr size_t WS_HID = 64 * MiB;
constexpr size_t WS_PROJ = 64 * MiB;
constexpr size_t WS_MIXED = 128 * MiB;
constexpr size_t WS_HST = 160 * MiB;
constexpr size_t WS_HDN = 176 * MiB;
constexpr size_t WS_QIHL = 192 * MiB;
constexpr size_t WS_KIHL = 208 * MiB;
constexpr size_t WS_WI = 212 * MiB;
constexpr size_t WS_VT = 224 * MiB;
constexpr size_t WS_WIN1 = 232 * MiB;
constexpr size_t WS_END = 256 * MiB;
constexpr int CW_TMO = 0, CW_BAR = 4096;

namespace pg8 {
#define PG8_LAS __attribute__((address_space(3)))
typedef unsigned short bf16_t;
typedef short bf16x8 __attribute__((ext_vector_type(8)));
typedef float f32x4 __attribute__((ext_vector_type(4)));
typedef unsigned u32x4 __attribute__((ext_vector_type(4)));
constexpr int BM = 256, BK = 64, HALF = 128, HTB = HALF * BK * 2  , STAGE_BYTES = 8 * HTB, NXCD = 8, WGM = 8;

__host__ __device__ __forceinline__ int lds_byte(int r, int c) { const int st = (r >> 4) * 2 + (c >> 5), rr = r & 15, cc = c & 31, ob = rr * 64 + cc * 2; return st * 1024 + (ob ^ (((ob >> 9) & 1) << 5)); }
__host__ __device__ __forceinline__ void stage_rc(int b, int& R, int& C) { const int st = b / 1024, sb = b % 1024, swz = sb ^ (((sb >> 9) & 1) << 5); R = (st >> 1) * 16 + swz / 64; C = (st & 1) * 32 + (swz % 64) / 2; }
__host__ __device__ __forceinline__ int perm32(int rho) { const int n = rho >> 4, i = rho & 15; return 8 * (i >> 2) + 4 * n + (i & 3); }

struct Unit { int pm, pn; };
struct Gemm { const bf16_t* A; const bf16_t* Bt; int M, N, K; };

struct StaticOrder {
    int nM, nN, nwg, G, c;
    __host__ __device__ void init(int M, int N, int G_, int c_) { nM = M / BM; nN = N / BM; nwg = nM * nN; G = G_; c = c_; }
    __host__ __device__ __forceinline__ bool next(int i, Unit& u) const {
        const long L = (long)i * G + c; if (L >= nwg) return false;
        int wgid = (int)L; { const int q = nwg / NXCD, r = nwg % NXCD, xcd = wgid % NXCD, off = wgid / NXCD; wgid = (xcd < r ? xcd * (q + 1) : r * (q + 1) + (xcd - r) * q) + off; }
        const int nig = WGM * nN, gid = wgid / nig, fm = gid * WGM, gsz = (nM - fm) < WGM ? (nM - fm) : WGM;
        u.pm = fm + ((wgid % nig) % gsz); u.pn = (wgid % nig) / gsz; return true;
    }
    __device__ __forceinline__ void a_ready(const Unit&) const {}
    __device__ __forceinline__ void done(const Unit&) const {}
};

__device__ __forceinline__ unsigned cvt_pk_bf16(float lo, float hi) { unsigned r; asm volatile("v_cvt_pk_bf16_f32 %0, %1, %2" : "=v"(r) : "v"(lo), "v"(hi)); return r; }
typedef float f32x2 __attribute__((ext_vector_type(2)));

constexpr float RMS_EPS_F = 1e-5f;
#define PG8_GAS __attribute__((address_space(1)))
__device__ __forceinline__ float row_rstd(const float* ssq, int row) {
    const PG8_GAS f32x4* p = (const PG8_GAS f32x4*)(ssq + (size_t)row * 16);
    const f32x4 a = p[0], b = p[1], c = p[2], d = p[3];
    const float s = ((a[0] + a[1]) + (a[2] + a[3])) + ((b[0] + b[1]) + (b[2] + b[3])) + ((c[0] + c[1]) + (c[2] + c[3])) + ((d[0] + d[1]) + (d[2] + d[3]));
    return 1.0f / sqrtf(s * (1.0f / 1024.0f) + RMS_EPS_F);
}
struct RstdTab { const PG8_LAS float* tab; int pm; unsigned char* ws;
    __device__ __forceinline__ float get(int, int rloc) const { return tab[rloc]; } };
__constant__ float c_rot16[2][8] = {{-0.95765948f, -0.999246258f, 0.824376517f, 0.993200301f, 0.999744011f, 0.999990373f, 0.999999638f, 0.999999986f}, {-0.287903317f, 0.0388190063f, 0.566041835f, 0.116418045f, 0.0226254862f, 0.00438795693f, 0.000850927215f, 0.000165014163f}};
__constant__ float c_rot80[2][8] = {{-0.110387244f, -0.981213211f, -0.991153911f, 0.834587283f, 0.993606824f, 0.999759331f, 0.999990949f, 0.99999966f}, {-0.993888654f, 0.192926503f, 0.132717464f, 0.550875727f, 0.11289588f, 0.021938095f, 0.00425462375f, 0.000825070726f}};
__device__ __forceinline__ unsigned cvt_pk_rne(float lo, float hi) { typedef float f2 __attribute__((ext_vector_type(2))); typedef __bf16 b2 __attribute__((ext_vector_type(2))); f2 v = {lo, hi}; b2 b = __builtin_convertvector(v, b2); return __builtin_bit_cast(unsigned, b); }
__device__ __forceinline__ void split_hl(const f32x4 a, const f32x4 b, u32x4& h, u32x4& l) {
    h.x = cvt_pk_rne(a[0], a[1]); h.y = cvt_pk_rne(a[2], a[3]); h.z = cvt_pk_rne(b[0], b[1]); h.w = cvt_pk_rne(b[2], b[3]);
    l.x = cvt_pk_rne(a[0] - __builtin_bit_cast(float, h.x << 16), a[1] - __builtin_bit_cast(float, h.x & 0xffff0000u));
    l.y = cvt_pk_rne(a[2] - __builtin_bit_cast(float, h.y << 16), a[3] - __builtin_bit_cast(float, h.y & 0xffff0000u));
    l.z = cvt_pk_rne(b[0] - __builtin_bit_cast(float, h.z << 16), b[1] - __builtin_bit_cast(float, h.z & 0xffff0000u));
    l.w = cvt_pk_rne(b[2] - __builtin_bit_cast(float, h.w << 16), b[3] - __builtin_bit_cast(float, h.w & 0xffff0000u));
}
struct EpiIn {
    static constexpr bool PERM = true, AFTER_DRAIN = false;
    unsigned char* ws; RstdTab rt;
    __device__ __forceinline__ void operator()(const f32x4 (&acc)[2][2][4][2], const Unit& u, int wr, int wc, int fr, int fq) const {
        bf16_t* const proj = (bf16_t*)(ws + WS_PROJ); bf16_t* const qi_hl = (bf16_t*)(ws + WS_QIHL); bf16_t* const ki_hl = (bf16_t*)(ws + WS_KIHL); float* const wi = (float*)(ws + WS_WI);
        bf16_t* const vT = (bf16_t*)(ws + WS_VT); const float* const rope = (const float*)(ws + WS_ROPE);
        const int rloc0 = wr * 64 + fr, row0 = u.pm * BM + rloc0, pn = u.pn;
        const bool rot_lane = ((wc & 1) == 0) && (fq < 2);
        const float sgn = (fq == 0) ? -1.f : 1.f;
        f32x4 c0 = {1.f, 1.f, 1.f, 1.f}, c1 = c0, s0 = {0.f, 0.f, 0.f, 0.f}, s1 = s0;
        if (pn >= 5) { const PG8_GAS f32x4* tp = (const PG8_GAS f32x4*)(rope + (size_t)row0 * 16); c0 = tp[0]; c1 = tp[1]; s0 = tp[2]; s1 = tp[3]; }
#pragma unroll
        for (int ai = 0; ai < 2; ++ai)
#pragma unroll
            for (int m = 0; m < 4; ++m) {
                const int row = row0 + ai * HALF + m * 16;
                const float rs = rt.get(u.pm, rloc0 + ai * HALF + m * 16);
#pragma unroll
                for (int bj = 0; bj < 2; ++bj) {
                    f32x4 v0 = acc[ai][bj][m][0] * rs, v1 = acc[ai][bj][m][1] * rs;
                    const bool rope_tile = (pn == 5) || (pn == 6) || (pn == 8) || (pn == 7 && bj == 0) || (pn == 9 && bj == 0 && wc < 2);
                    if (rope_tile) {
                        f32x4 p0, p1;
#pragma unroll
                        for (int e = 0; e < 4; ++e) { p0[e] = __shfl_xor(v0[e], 16); p1[e] = __shfl_xor(v1[e], 16); }
                        if (rot_lane) { v0 = v0 * c0 + (p0 * s0) * sgn; v1 = v1 * c1 + (p1 * s1) * sgn; }
                    }
                    const int cl = bj * HALF + wc * 32 + 8 * fq;
                    if (pn < 7 || (pn == 7 && bj == 0)) {
                        u32x4 w; w.x = cvt_pk_bf16(v0[0], v0[1]); w.y = cvt_pk_bf16(v0[2], v0[3]); w.z = cvt_pk_bf16(v1[0], v1[1]); w.w = cvt_pk_bf16(v1[2], v1[3]);
                        *(PG8_GAS u32x4*)(proj + (size_t)row * 2048 + pn * BM + cl) = w;
                    } else if (pn == 7) {
                        const int vc = cl - HALF, kvh = vc >> 6, d = vc & 63, b = row >> 11, t = row & 2047;
                        PG8_GAS bf16_t* o = (PG8_GAS bf16_t*)vT + ((size_t)((b * 2 + kvh) * 64 + d)) * 2048 + t;
                        const u32x4 w = (u32x4){cvt_pk_bf16(v0[0], v0[1]), cvt_pk_bf16(v0[2], v0[3]), cvt_pk_bf16(v1[0], v1[1]), cvt_pk_bf16(v1[2], v1[3])};
                        o[0 * 2048] = (bf16_t)(w.x & 0xffffu); o[1 * 2048] = (bf16_t)(w.x >> 16); o[2 * 2048] = (bf16_t)(w.y & 0xffffu); o[3 * 2048] = (bf16_t)(w.y >> 16);
                        o[4 * 2048] = (bf16_t)(w.z & 0xffffu); o[5 * 2048] = (bf16_t)(w.z >> 16); o[6 * 2048] = (bf16_t)(w.w & 0xffffu); o[7 * 2048] = (bf16_t)(w.w >> 16);
                    } else if (pn == 8) {
                        const u32x4 h = (u32x4){cvt_pk_bf16(v0[0], v0[1]), cvt_pk_bf16(v0[2], v0[3]), cvt_pk_bf16(v1[0], v1[1]), cvt_pk_bf16(v1[2], v1[3])};
                        *(PG8_GAS u32x4*)(qi_hl + (size_t)row * 512 + cl) = h;
                    } else if (bj == 0) {
                        if (wc < 2) { const u32x4 h = (u32x4){cvt_pk_bf16(v0[0], v0[1]), cvt_pk_bf16(v0[2], v0[3]), cvt_pk_bf16(v1[0], v1[1]), cvt_pk_bf16(v1[2], v1[3])}; *(PG8_GAS u32x4*)(ki_hl + (size_t)row * 128 + cl) = h; }
                        else if (wc == 2 && fq == 0) { *(PG8_GAS f32x4*)(wi + (size_t)row * 4) = v0; }
                    }
                }
                if (pn >= 5 && (ai * 4 + m) < 7) {
#pragma unroll
                    for (int e = 0; e < 4; ++e) {
                        const float dc0 = (m == 3) ? c_rot80[0][e] : c_rot16[0][e], ds0 = (m == 3) ? c_rot80[1][e] : c_rot16[1][e];
                        const float dc1 = (m == 3) ? c_rot80[0][4 + e] : c_rot16[0][4 + e], ds1 = (m == 3) ? c_rot80[1][4 + e] : c_rot16[1][4 + e];
                        const float a0 = c0[e], a1 = c1[e];
                        c0[e] = a0 * dc0 - s0[e] * ds0; s0[e] = s0[e] * dc0 + a0 * ds0;
                        c1[e] = a1 * dc1 - s1[e] * ds1; s1[e] = s1[e] * dc1 + a1 * ds1;
                    }
                }
            }
    }
};
struct EpiRes {
    static constexpr bool PERM = true, AFTER_DRAIN = false;
    const float* xin; float* xout; unsigned char* ws;
    __device__ __forceinline__ void operator()(const f32x4 (&acc)[2][2][4][2], const Unit& u, int wr, int wc, int fr, int fq) const {
        bf16_t* const xb = (bf16_t*)(ws + WS_XB); float* const ssq = (float*)(ws + WS_SSQ);
        const int row0 = u.pm * BM + wr * 64 + fr;
        const int colt = u.pn * BM + wc * 32 + 8 * fq;
        f32x4 cur[2][2], nxt[2][2];
#pragma unroll
        for (int bj = 0; bj < 2; ++bj) { const size_t off = (size_t)row0 * 1024 + colt + bj * HALF; cur[bj][0] = *(const PG8_GAS f32x4*)(xin + off); cur[bj][1] = *(const PG8_GAS f32x4*)(xin + off + 4); }
#pragma unroll
        for (int g = 0; g < 8; ++g) {
            const int ai = g >> 2, m = g & 3;
            const int row = row0 + ai * HALF + m * 16;
            if (g + 1 < 8) { const int rown = row0 + ((g + 1) >> 2) * HALF + ((g + 1) & 3) * 16;
#pragma unroll
                for (int bj = 0; bj < 2; ++bj) { const size_t off = (size_t)rown * 1024 + colt + bj * HALF; nxt[bj][0] = *(const PG8_GAS f32x4*)(xin + off); nxt[bj][1] = *(const PG8_GAS f32x4*)(xin + off + 4); } }
            float sq = 0.f;
#pragma unroll
            for (int bj = 0; bj < 2; ++bj) {
                const size_t off = (size_t)row * 1024 + colt + bj * HALF;
                const f32x4 v0 = cur[bj][0] + acc[ai][bj][m][0], v1 = cur[bj][1] + acc[ai][bj][m][1];
                *(PG8_GAS f32x4*)(xout + off) = v0; *(PG8_GAS f32x4*)(xout + off + 4) = v1;
                u32x4 w; w.x = cvt_pk_bf16(v0[0], v0[1]); w.y = cvt_pk_bf16(v0[2], v0[3]); w.z = cvt_pk_bf16(v1[0], v1[1]); w.w = cvt_pk_bf16(v1[2], v1[3]);
                *(PG8_GAS u32x4*)(xb + off) = w;
                sq += (v0[0] * v0[0] + v0[1] * v0[1]) + (v0[2] * v0[2] + v0[3] * v0[3]) + (v1[0] * v1[0] + v1[1] * v1[1]) + (v1[2] * v1[2] + v1[3] * v1[3]);
            }
            sq += __shfl_xor(sq, 16); sq += __shfl_xor(sq, 32);
            if (fq == 0) ((PG8_GAS float*)ssq)[(size_t)row * 16 + u.pn * 4 + wc] = sq;
#pragma unroll
            for (int bj = 0; bj < 2; ++bj) { cur[bj][0] = nxt[bj][0]; cur[bj][1] = nxt[bj][1]; }
        }
    }
};
struct EpiFfIn {
    static constexpr bool PERM = true, AFTER_DRAIN = false;
    RstdTab rt;
    __device__ __forceinline__ void operator()(const f32x4 (&acc)[2][2][4][2], const Unit& u, int wr, int wc, int fr, int fq) const {
        bf16_t* const hid = (bf16_t*)(rt.ws + WS_HID);
        const int row0 = u.pm * BM + wr * 64 + fr;
        const int colt = u.pn * BM + wc * 32 + 8 * fq;
#pragma unroll
        for (int ai = 0; ai < 2; ++ai)
#pragma unroll
            for (int m = 0; m < 4; ++m) {
                const int row = row0 + ai * HALF + m * 16;
                const float rs = rt.get(u.pm, wr * 64 + fr + ai * HALF + m * 16);
#pragma unroll
                for (int bj = 0; bj < 2; ++bj) {
                    f32x4 v0 = acc[ai][bj][m][0] * rs, v1 = acc[ai][bj][m][1] * rs;
#pragma unroll
                    for (int e = 0; e < 4; ++e) { const float a = fmaxf(v0[e], 0.f), b = fmaxf(v1[e], 0.f); v0[e] = a * a; v1[e] = b * b; }
                    u32x4 w; w.x = cvt_pk_bf16(v0[0], v0[1]); w.y = cvt_pk_bf16(v0[2], v0[3]); w.z = cvt_pk_bf16(v1[0], v1[1]); w.w = cvt_pk_bf16(v1[2], v1[3]);
                    *(PG8_GAS u32x4*)(hid + (size_t)row * 4096 + colt + bj * HALF) = w;
                }
            }
    }
};
template <class Epi, class Sched, bool ALIGN_EPI = false, bool SP2 = false>
__device__ __forceinline__ void gemm_phase(PG8_LAS unsigned char* lds, const Gemm g, const Sched& S, const Epi& E) {
    int tid_ = threadIdx.x; asm volatile("" : "+v"(tid_));
    const int tid = tid_, wid = __builtin_amdgcn_readfirstlane(tid >> 6), lane = tid & 63, wr = wid >> 2, wc = wid & 3, fr = lane & 15, fq = lane >> 4;
    const int K = g.K, nt = K / BK;
    unsigned voffA[2], voffB[2];
#pragma unroll
    for (int i = 0; i < 2; ++i) { int R, C; stage_rc(tid * 16 + i * 8192, R, C); const int Rb = Epi::PERM ? ((R & ~31) + perm32(R & 31)) : R;
        voffA[i] = (unsigned)(R * K + C) * 2u; voffB[i] = (unsigned)(Rb * K + C) * 2u; }
    const size_t kstep = (size_t)(BK * 2);
    const size_t hstep = (size_t)HALF * K * 2;
    const size_t tstep = 2 * hstep;
    const unsigned ldsw = (unsigned)wid * 1024u;
    const int aoff = lds_byte(wr * 64 + fr, fq * 8), boff = lds_byte(wc * 32 + fr, fq * 8);
#define PG8_SA(b, h) (((b) * 2 + (h)) * HTB)
#define PG8_SB(b, h) ((4 + (b) * 2 + (h)) * HTB)
#define PG8_STAGE(bufoff, gbase, voff) do { _Pragma("unroll") for (int _i = 0; _i < 2; ++_i) \
        __builtin_amdgcn_global_load_lds((const unsigned*)((const char*)(gbase) + (voff)[_i]), (PG8_LAS unsigned*)(lds + (bufoff) + ldsw + _i * 8192), 16, 0, 0); } while (0)
#define PG8_LDA(dst, b, h) do { _Pragma("unroll") for (int m = 0; m < 4; ++m) _Pragma("unroll") for (int k = 0; k < 2; ++k) dst[m][k] = *(const PG8_LAS bf16x8*)(lds + PG8_SA(b, h) + aoff + m * 2048 + k * 1024); } while (0)
#define PG8_LDB(dst, b, h) do { _Pragma("unroll") for (int n = 0; n < 2; ++n) _Pragma("unroll") for (int k = 0; k < 2; ++k) dst[n][k] = *(const PG8_LAS bf16x8*)(lds + PG8_SB(b, h) + boff + n * 2048 + k * 1024); } while (0)
#define PG8_MMA(ai, bj, At, Bt) do { __builtin_amdgcn_s_setprio(1); _Pragma("unroll") for (int m = 0; m < 4; ++m) _Pragma("unroll") for (int n = 0; n < 2; ++n) _Pragma("unroll") for (int k = 0; k < 2; ++k) \
        acc[ai][bj][m][n] = __builtin_amdgcn_mfma_f32_16x16x32_bf16(Bt[n][k], At[m][k], acc[ai][bj][m][n], 0, 0, 0); __builtin_amdgcn_s_setprio(0); } while (0)
#define PG8_WAIT_V(n) asm volatile("s_waitcnt vmcnt(" #n ")" ::: "memory")
#define PG8_WAIT_L(n) asm volatile("s_waitcnt lgkmcnt(" #n ")" ::: "memory")
#define PG8_BAR __builtin_amdgcn_s_barrier()
#define PG8_SCHED __builtin_amdgcn_sched_barrier(0)
    Unit cur, nxt; int ui = 0;
    if (!S.next(0, cur)) return;
    f32x4 acc[2][2][4][2];
#pragma unroll
    for (int a = 0; a < 2; ++a)
#pragma unroll
        for (int b = 0; b < 2; ++b)
#pragma unroll
            for (int m = 0; m < 4; ++m)
#pragma unroll
                for (int n = 0; n < 2; ++n) acc[a][b][m][n] = (f32x4){0.f, 0.f, 0.f, 0.f};
    bf16x8 At[4][2], B0[2][2], B1[2][2];
    const char* cA = (const char*)g.A + (size_t)cur.pm * tstep; const char* cB = (const char*)g.Bt + (size_t)cur.pn * tstep;
    S.a_ready(cur);
    if constexpr (SP2) {
        PG8_STAGE(PG8_SB(0, 0), cB, voffB); PG8_STAGE(PG8_SB(0, 1), cB + hstep, voffB); PG8_STAGE(PG8_SA(0, 0), cA, voffA); PG8_STAGE(PG8_SA(0, 1), cA + hstep, voffA);
        if (wr == 1) PG8_BAR;
        PG8_WAIT_V(2); PG8_BAR;
        PG8_STAGE(PG8_SB(1, 0), cB + kstep, voffB); PG8_STAGE(PG8_SA(1, 0), cA + kstep, voffA); PG8_STAGE(PG8_SB(1, 1), cB + hstep + kstep, voffB);
        PG8_WAIT_V(6); PG8_BAR;
    } else {
        PG8_STAGE(PG8_SB(0, 0), cB, voffB); PG8_STAGE(PG8_SA(0, 0), cA, voffA); PG8_STAGE(PG8_SB(0, 1), cB + hstep, voffB); PG8_STAGE(PG8_SA(0, 1), cA + hstep, voffA);
        if (wr == 1) PG8_BAR;
        PG8_WAIT_V(4); PG8_BAR;
        PG8_STAGE(PG8_SB(1, 0), cB + kstep, voffB); PG8_STAGE(PG8_SA(1, 0), cA + kstep, voffA); PG8_STAGE(PG8_SB(1, 1), cB + hstep + kstep, voffB);
        PG8_WAIT_V(6); PG8_BAR;
    }
    for (;;) {
        const bool has_next = S.next(ui + 1, nxt);
        const char* nA = has_next ? (const char*)g.A + (size_t)nxt.pm * tstep : cA; const char* nB = has_next ? (const char*)g.Bt + (size_t)nxt.pn * tstep : cB;
        for (int t = 0; t < nt; t += 2) {
            const bool last = (t == nt - 2);
            const char* a1 = cA + (size_t)(t + 1) * kstep;
            const char* a2 = last ? nA : cA + (size_t)(t + 2) * kstep; const char* b2 = last ? nB : cB + (size_t)(t + 2) * kstep;
            const char* a3 = a2 + kstep; const char* b3 = b2 + kstep;
            if (last && has_next) S.a_ready(nxt);
            if constexpr (SP2) {
            PG8_LDB(B0, 0, 0); PG8_LDB(B1, 0, 1); PG8_SCHED; PG8_LDA(At, 0, 0); PG8_STAGE(PG8_SA(1, 1), a1 + hstep, voffA);
            PG8_WAIT_V(8); PG8_WAIT_L(0); PG8_BAR; PG8_MMA(0, 0, At, B0); PG8_MMA(0, 1, At, B1); PG8_BAR; PG8_SCHED;
            PG8_LDA(At, 0, 1); PG8_STAGE(PG8_SB(0, 0), b2, voffB); PG8_STAGE(PG8_SB(0, 1), b2 + hstep, voffB); PG8_STAGE(PG8_SA(0, 0), a2, voffA);
            PG8_WAIT_V(8); PG8_WAIT_L(0); PG8_BAR; PG8_MMA(1, 0, At, B0); PG8_MMA(1, 1, At, B1); PG8_BAR; PG8_SCHED;
            PG8_LDB(B0, 1, 0); PG8_LDB(B1, 1, 1); PG8_SCHED; PG8_LDA(At, 1, 0); PG8_STAGE(PG8_SA(0, 1), a2 + hstep, voffA);
            PG8_WAIT_V(8); PG8_WAIT_L(0); PG8_BAR; PG8_MMA(0, 0, At, B0); PG8_MMA(0, 1, At, B1); PG8_BAR; PG8_SCHED;
            PG8_LDA(At, 1, 1); PG8_STAGE(PG8_SB(1, 0), b3, voffB); PG8_STAGE(PG8_SB(1, 1), b3 + hstep, voffB); PG8_STAGE(PG8_SA(1, 0), a3, voffA);
            PG8_WAIT_V(8); PG8_WAIT_L(0); PG8_BAR; PG8_MMA(1, 0, At, B0); PG8_MMA(1, 1, At, B1); PG8_BAR; PG8_SCHED;
            } else {
            PG8_LDB(B0, 0, 0); PG8_SCHED; PG8_LDA(At, 0, 0); PG8_STAGE(PG8_SA(1, 1), a1 + hstep, voffA);
            PG8_WAIT_L(8); PG8_BAR; PG8_WAIT_L(0); PG8_MMA(0, 0, At, B0); PG8_BAR; PG8_SCHED;
            PG8_LDB(B1, 0, 1); PG8_STAGE(PG8_SB(0, 0), b2, voffB);
            PG8_BAR; PG8_WAIT_L(0); PG8_MMA(0, 1, At, B1); PG8_BAR;
            PG8_LDA(At, 0, 1); PG8_STAGE(PG8_SA(0, 0), a2, voffA);
            PG8_BAR; PG8_WAIT_L(0); PG8_MMA(1, 0, At, B0); PG8_BAR; PG8_SCHED;
            PG8_STAGE(PG8_SB(0, 1), b2 + hstep, voffB);
            PG8_WAIT_V(6); PG8_BAR; PG8_MMA(1, 1, At, B1); PG8_BAR;
            PG8_LDB(B0, 1, 0); PG8_SCHED; PG8_LDA(At, 1, 0); PG8_STAGE(PG8_SA(0, 1), a2 + hstep, voffA);
            PG8_WAIT_L(8); PG8_BAR; PG8_WAIT_L(0); PG8_MMA(0, 0, At, B0); PG8_BAR; PG8_SCHED;
            PG8_LDB(B1, 1, 1); PG8_STAGE(PG8_SB(1, 0), b3, voffB);
            PG8_BAR; PG8_WAIT_L(0); PG8_MMA(0, 1, At, B1); PG8_BAR;
            PG8_LDA(At, 1, 1); PG8_STAGE(PG8_SA(1, 0), a3, voffA);
            PG8_BAR; PG8_WAIT_L(0); PG8_MMA(1, 0, At, B0); PG8_BAR; PG8_SCHED;
            PG8_STAGE(PG8_SB(1, 1), b3 + hstep, voffB);
            PG8_WAIT_V(6); PG8_BAR; PG8_MMA(1, 1, At, B1); PG8_BAR;
            }
        }
        if constexpr (ALIGN_EPI) { if (wr == 0) PG8_BAR; }
        if constexpr (!Epi::AFTER_DRAIN) { E(acc, cur, wr, wc, fr, fq); S.done(cur); }
        if (!has_next) break;
#pragma unroll
        for (int a = 0; a < 2; ++a)
#pragma unroll
            for (int b = 0; b < 2; ++b)
#pragma unroll
                for (int m = 0; m < 4; ++m)
#pragma unroll
                    for (int n = 0; n < 2; ++n) acc[a][b][m][n] = (f32x4){0.f, 0.f, 0.f, 0.f};
        cur = nxt; cA = nA; cB = nB; ++ui;
        if constexpr (ALIGN_EPI) { if (wr == 1) PG8_BAR; }
    }
    PG8_WAIT_V(0);
    if constexpr (!ALIGN_EPI) { if (wr == 0) PG8_BAR; }
    PG8_BAR;
    if constexpr (Epi::AFTER_DRAIN) { E.fused(acc, cur, wr, wc, fr, fq, lds, wid, lane); S.done(cur); }
#undef PG8_SA
#undef PG8_SB
#undef PG8_STAGE
#undef PG8_LDA
#undef PG8_LDB
#undef PG8_MMA
#undef PG8_WAIT_V
#undef PG8_WAIT_L
#undef PG8_BAR
#undef PG8_SCHED
}
}

constexpr int RING_OFF = 0, RING_BYTES = 131072;
constexpr int LDS_BYTES = 147456;
constexpr int LDSCTL_OFF = LDS_BYTES - 1024, MISC_OFF = LDSCTL_OFF + 320;

#define GAS __attribute__((address_space(1)))
#define LAS __attribute__((address_space(3)))
typedef unsigned short bf16;
typedef unsigned v4u __attribute__((ext_vector_type(4)));
typedef unsigned v2u __attribute__((ext_vector_type(2)));
typedef float f32x4 __attribute__((ext_vector_type(4)));
typedef GAS unsigned gu32;
#define RLX_AGENT __ATOMIC_RELAXED, __HIP_MEMORY_SCOPE_AGENT
#define LDS_WAIT() asm volatile("s_waitcnt lgkmcnt(0)" ::: "memory")
__device__ __forceinline__ unsigned f2bf(float f) { unsigned u = __builtin_bit_cast(unsigned, f); return (u + 0x7fffu + ((u >> 16) & 1u)) >> 16; }
__device__ __forceinline__ unsigned pk2(float lo, float hi) { return f2bf(lo) | (f2bf(hi) << 16); }
__device__ __forceinline__ float bf2f(unsigned short h) { return __builtin_bit_cast(float, (unsigned)h << 16); }
__device__ __forceinline__ float wave_sum(float v) {
#pragma unroll
    for (int o = 1; o < 64; o <<= 1) v += __shfl_xor(v, o);
    return v;
}
__device__ __forceinline__ float wave_max(float v) {
#pragma unroll
    for (int o = 1; o < 64; o <<= 1) v = fmaxf(v, __shfl_xor(v, o));
    return v;
}
#define XB_TMO      128
#define XB_XCNT(j)  (256  + 64 * (j))
#define XB_XSUB(j)  (1280 + 64 * (j))
#define XB_XGEN(j)  (2304 + 64 * (j))
#define XB_TOP      3328
#define XB_TOPGEN   3392
#define XCD_BAR_WORDS 3456
#define XB_SPIN_CAP (1u << 18)

__device__ __forceinline__ unsigned xb_ld(unsigned* p)              { return __hip_atomic_load(p, __ATOMIC_RELAXED, __HIP_MEMORY_SCOPE_AGENT); }
__device__ __forceinline__ unsigned xb_add(unsigned* p, unsigned v) { return __hip_atomic_fetch_add(p, v, __ATOMIC_RELAXED, __HIP_MEMORY_SCOPE_AGENT); }
__device__ __forceinline__ unsigned xb_xcc_id() { return (unsigned)__builtin_amdgcn_s_getreg((3 << 11) | 20) & 0xFu; }
#define XB_SPIN(cond, bar) do { unsigned _sp = 0; while (cond) { __builtin_amdgcn_s_sleep(1); \
    if ((++_sp & 255u) == 0u) { if (xb_ld(&(bar)[XB_TMO])) break; if (_sp > XB_SPIN_CAP) { atomicAdd(&(bar)[XB_TMO], 1u); break; } } } } while (0)

struct XcdBarrier {
    unsigned* bar; unsigned x;
    volatile LAS unsigned* st;
};

__device__ __forceinline__ XcdBarrier xcd_barrier_post(unsigned* bar, volatile LAS unsigned* st) {
    XcdBarrier b; b.bar = bar; b.x = xb_xcc_id(); b.st = st;
    if (threadIdx.x == 0) (void)xb_add(&bar[XB_XCNT(b.x)], 1u);
    return b;
}
__device__ __forceinline__ void xcd_barrier_complete(unsigned* bar, unsigned x, unsigned& nloc, unsigned& nx) {
    const unsigned G = gridDim.x * gridDim.y * gridDim.z;
    unsigned sum, cnt, mine, sp = 0u;
    for (;;) {
        sum = 0u; cnt = 0u; mine = 0u;
#pragma unroll
        for (unsigned j = 0; j < 16; ++j) { const unsigned c = xb_ld(&bar[XB_XCNT(j)]); sum += c; cnt += (c > 0u) ? 1u : 0u; mine = (j == x) ? c : mine; }
        if (sum == G) break;
        __builtin_amdgcn_s_sleep(1);
        if ((++sp & 255u) == 0u) { if (xb_ld(&bar[XB_TMO])) break; if (sp > XB_SPIN_CAP) { atomicAdd(&bar[XB_TMO], 1u); break; } }
    }
    nloc = mine > 0u ? mine : 1u; nx = cnt > 0u ? cnt : 1u;
}

__device__ __forceinline__ void xcd_barrier(const XcdBarrier& b) {
    asm volatile("s_waitcnt vmcnt(0)" ::: "memory");
    __syncthreads();
    if (threadIdx.x == 0) {
        unsigned* bar = b.bar;
        __builtin_amdgcn_s_waitcnt(0);
        unsigned nloc = b.st[0], nx = b.st[1];
        if (nloc == 0u) { xcd_barrier_complete(bar, b.x, nloc, nx); b.st[0] = nloc; b.st[1] = nx; }
        const unsigned old = xb_add(&bar[XB_XSUB(b.x)], 1u);
        const unsigned gen = old / nloc;
        if (old + 1u == (gen + 1u) * nloc) {
            __builtin_amdgcn_fence(__ATOMIC_RELEASE, "agent");
            asm volatile("s_waitcnt vmcnt(0)" ::: "memory");
            const unsigned og = xb_add(&bar[XB_TOP], 1u);
            const unsigned tg = og / nx;
            if (og + 1u == (tg + 1u) * nx) xb_add(&bar[XB_TOPGEN], 1u);
            else XB_SPIN(xb_ld(&bar[XB_TOPGEN]) == tg, bar);
            __builtin_amdgcn_fence(__ATOMIC_ACQUIRE, "agent");
            xb_add(&bar[XB_XGEN(b.x)], 1u);
            asm volatile("s_waitcnt vmcnt(0)" ::: "memory");
        } else {
            XB_SPIN(xb_ld(&bar[XB_XGEN(b.x)]) == gen, bar);
            __builtin_amdgcn_fence(__ATOMIC_ACQUIRE, "agent");
            asm volatile("s_waitcnt vmcnt(0)" ::: "memory");
        }
    }
    __syncthreads();
}


struct Frame {
    LAS unsigned char* lds;
    volatile LAS unsigned* MISC;
    gu32* ctl;
    int tid, lane, wave, G, bid;
    const float* x_in; const int* pos;
    const float *n1g, *w_in, *pool_w, *pool_scale, *lb_logits, *hgrn_g, *w_out, *n2g, *w_ff_in, *w_ff_out, *fng;
    float* xres;
    unsigned char* ws;
};
__constant__ float c_invf[8] = {1.0f, 0.19392274474868576f, 0.03760603093086393f, 0.007292664737217109f, 0.001414213562373095f, 0.0002742481756762073f, 5.318295896944988e-05f, 1.031338537721246e-05f};

typedef float f32x16 __attribute__((ext_vector_type(16)));
typedef short bf16x8v __attribute__((ext_vector_type(8)));
typedef float f32x2v __attribute__((ext_vector_type(2))); typedef __bf16 bf16x2v __attribute__((ext_vector_type(2)));
__device__ __forceinline__ unsigned cvtpk(float lo, float hi) { f32x2v v = {lo, hi}; bf16x2v b = __builtin_convertvector(v, bf16x2v); return __builtin_bit_cast(unsigned, b); }

__device__ __forceinline__ void cvt_item(const GAS float* W, const GAS float* g, int K, int N, bf16* WT, LAS float* scr, int kb, int nb, int lane) {
    const int k0 = 64 * kb, n0 = 32 * nb;
    const int n = n0 + (lane & 31);
    float v[32];
#pragma unroll
    for (int i = 0; i < 32; ++i) { const int kk = 2 * i + (lane >> 5); v[i] = (n < N) ? W[(size_t)(k0 + kk) * N + n] : 0.f; }
    const int c = lane & 7;
    f32x4 g0 = {1.f, 1.f, 1.f, 1.f}, g1 = g0;
    if (g) { g0 = *(const GAS f32x4*)(g + k0 + 8 * c); g1 = *(const GAS f32x4*)(g + k0 + 8 * c + 4); }
    __builtin_amdgcn_sched_barrier(0);
#pragma unroll
    for (int i = 0; i < 32; ++i) { const int kk = 2 * i + (lane >> 5); scr[kk * 33 + (lane & 31)] = v[i]; }
    LDS_WAIT(); asm volatile("" ::: "memory");
#pragma unroll
    for (int j = 0; j < 4; ++j) { const int nl = (lane >> 3) + 8 * j; const LAS float* sp = scr + (8 * c) * 33 + nl;
        v4u o; o.x = pk2(sp[0 * 33] * g0[0], sp[1 * 33] * g0[1]); o.y = pk2(sp[2 * 33] * g0[2], sp[3 * 33] * g0[3]); o.z = pk2(sp[4 * 33] * g1[0], sp[5 * 33] * g1[1]); o.w = pk2(sp[6 * 33] * g1[2], sp[7 * 33] * g1[3]);
        *(GAS v4u*)(WT + (size_t)(n0 + nl) * K + k0 + 8 * c) = o; }
    LDS_WAIT(); asm volatile("" ::: "memory");
}
__device__ __forceinline__ void cvt_matrix(Frame& F, const float* W_, const float* g_, int K, int N, int Npad, bf16* WT) {
    const GAS float* W = (const GAS float*)W_; const GAS float* g = (const GAS float*)g_;
    LAS float* scr = (LAS float*)(F.lds + RING_OFF + F.wave * 16384);
    const int gw = F.bid * NWAVES + F.wave, NGW = F.G * NWAVES;
    const int nblk = Npad / 32, nitems = (K / 64) * nblk;
    for (int it = gw; it < nitems; it += NGW) cvt_item(W, g, K, N, WT, scr, it / nblk, it % nblk, F.lane);
}
__device__ __forceinline__ void cvt_layer_rest(Frame& F, int layer, int gw, int NGW) {
    LAS float* scr = (LAS float*)(F.lds + RING_OFF + F.wave * 16384);
    constexpr int I0 = (DM / 64) * (DM / 32), I1 = (DM / 64) * (DFF / 32), I2 = (DFF / 64) * (DM / 32), I3 = (DM / 64) * (DINP / 32);
    const int total = I0 + I1 + I2 + ((layer + 1 < DEPTH) ? I3 : 0);
    for (int it = gw; it < total; it += NGW) {
        int r = it;
        if (r < I0) { cvt_item((const GAS float*)(F.w_out + (size_t)layer * DM * DM), nullptr, DM, DM, (bf16*)(F.ws + WS_WOUT), scr, r / (DM / 32), r % (DM / 32), F.lane); continue; } r -= I0;
        if (r < I1) { cvt_item((const GAS float*)(F.w_ff_in + (size_t)layer * DM * DFF), (const GAS float*)(F.n2g + layer * DM), DM, DFF, (bf16*)(F.ws + WS_WFI), scr, r / (DFF / 32), r % (DFF / 32), F.lane); continue; } r -= I1;
        if (r < I2) { cvt_item((const GAS float*)(F.w_ff_out + (size_t)layer * DFF * DM), nullptr, DFF, DM, (bf16*)(F.ws + WS_WFO), scr, r / (DM / 32), r % (DM / 32), F.lane); continue; } r -= I2;
        cvt_item((const GAS float*)(F.w_in + (size_t)(layer + 1) * DM * DIN), (const GAS float*)(F.n1g + (layer + 1) * DM), DM, DIN, (bf16*)(F.ws + (((layer + 1) & 1) ? WS_WIN1 : WS_WIN)), scr, r / (DINP / 32), r % (DINP / 32), F.lane);
    }
}

__device__ __forceinline__ void p_prologue(Frame& F) {
    const int gtid = F.bid * NTHR + F.tid, NT = F.G * NTHR;
    GAS float* tab = (GAS float*)(F.ws + WS_ROPE);
    for (int idx = gtid; idx < M * 8; idx += NT) {
        const int row = idx >> 3, i = idx & 7;
        const float angf = (float)((const GAS int*)F.pos)[row] * c_invf[i];
        double r = (double)angf * 0.15915494309189535; r -= floor(r);
        const float a = (float)(r * 6.283185307179586);
        tab[row * 16 + i] = cosf(a); tab[row * 16 + 8 + i] = sinf(a);
    }
    if (gtid < 256) {
        const int c = gtid; GAS float* lb = (GAS float*)(F.ws + WS_LB); const GAS float* lbl = (const GAS float*)F.lb_logits;
        const float l0 = lbl[c], l1 = lbl[256 + c], l2 = lbl[512 + c], l3 = lbl[768 + c];
        const float mx = fmaxf(fmaxf(l0, l1), fmaxf(l2, l3));
        const float e0 = expf(l0 - mx), e1 = expf(l1 - mx), e2 = expf(l2 - mx), e3 = expf(l3 - mx);
        const float inv = 1.0f / (e0 + e1 + e2 + e3);
        lb[c] = 0.f; lb[256 + c] = e1 * inv; lb[512 + c] = (e1 + e2) * inv; lb[768 + c] = (e1 + e2 + e3) * inv;
    }
    const int gw = F.bid * NWAVES + F.wave, NGW = F.G * NWAVES;
    GAS bf16* xb = (GAS bf16*)(F.ws + WS_XB); GAS float* ssq = (GAS float*)(F.ws + WS_SSQ);
    for (int row0 = gw * 4; row0 < M; row0 += NGW * 4) {
        f32x4 v[4][4]; float sq[4];
#pragma unroll
        for (int rr = 0; rr < 4; ++rr) { const GAS f32x4* xr = (const GAS f32x4*)(F.x_in + (size_t)(row0 + rr) * DM) + F.lane;
#pragma unroll
            for (int j = 0; j < 4; ++j) v[rr][j] = xr[64 * j]; }
#pragma unroll
        for (int rr = 0; rr < 4; ++rr) { float a = 0.f;
#pragma unroll
            for (int j = 0; j < 4; ++j) a += (v[rr][j][0] * v[rr][j][0] + v[rr][j][1] * v[rr][j][1]) + (v[rr][j][2] * v[rr][j][2] + v[rr][j][3] * v[rr][j][3]);
            sq[rr] = a; }
#pragma unroll
        for (int o = 1; o < 64; o <<= 1)
#pragma unroll
            for (int rr = 0; rr < 4; ++rr) sq[rr] += __shfl_xor(sq[rr], o);
#pragma unroll
        for (int rr = 0; rr < 4; ++rr) {
            GAS unsigned long long* o8 = (GAS unsigned long long*)(xb + (size_t)(row0 + rr) * DM) + F.lane;
#pragma unroll
            for (int j = 0; j < 4; ++j) o8[64 * j] = (unsigned long long)pk2(v[rr][j][0], v[rr][j][1]) | ((unsigned long long)pk2(v[rr][j][2], v[rr][j][3]) << 32);
            if (F.lane < 16) ssq[(size_t)(row0 + rr) * 16 + F.lane] = (F.lane == 0) ? sq[rr] : 0.f;
        }
    }
    cvt_matrix(F, F.w_in, F.n1g, DM, DIN, DINP, (bf16*)(F.ws + WS_WIN));
}

constexpr int PL_WROW = 72, PL_PROW = 264, PL_WT_BYTES = 4 * 64 * PL_WROW * 2, PL_P_OFF = PL_WT_BYTES;
template <int WIN> __device__ __forceinline__ void pool_core(const GAS bf16* up, int tl0, LAS unsigned short* Pc) {
    float ps[49]; ps[0] = 0.f;
    float uv[48];
#pragma unroll
    for (int i = 0; i < 48; ++i) { const int tl = tl0 - 16 + i; uv[i] = (tl >= 0) ? bf2f(up[(long)(i - 16) * PROJ_LD]) : 0.f; }
    __builtin_amdgcn_sched_barrier(0);
#pragma unroll
    for (int i = 0; i < 48; ++i) ps[i + 1] = ps[i] + uv[i];
#pragma unroll
    for (int i = 16; i < 48; ++i) {
        const int tl = tl0 - 16 + i; const int cnt = (tl + 1 < WIN) ? tl + 1 : WIN;
        const float mean = (ps[i + 1] - ps[i + 1 - WIN]) / (float)cnt;
        Pc[(i - 16) * PL_PROW] = (unsigned short)f2bf(mean - uv[i]);
    }
}
__device__ __forceinline__ void p_pool(Frame& F, int layer) {
    LAS unsigned short* WT = (LAS unsigned short*)(F.lds + RING_OFF);
    LAS unsigned short* P = (LAS unsigned short*)(F.lds + RING_OFF + PL_P_OFF);
    const GAS bf16* proj = (const GAS bf16*)(F.ws + WS_PROJ); GAS bf16* mixed = (GAS bf16*)(F.ws + WS_MIXED);
    const GAS float* pw = (const GAS float*)F.pool_w + (size_t)layer * 4 * 64 * 64; const GAS float* ps_ = (const GAS float*)F.pool_scale + layer * 256;
    const int tid = F.tid, lane = F.lane, wave = F.wave;
#pragma unroll 8
    for (int i = 0; i < 32; ++i) { const int e = i * NTHR + tid; const int g = e >> 12, c = (e >> 6) & 63, d = e & 63; WT[(g * 64 + d) * PL_WROW + c] = (unsigned short)f2bf(pw[e]); }
    const int c = tid & 255, hf = tid >> 8, g = wave & 3;
    for (int unit = F.bid; unit < M / 64; unit += F.G) {
        const int t0 = unit * 64 + 32 * hf;
        { const GAS bf16* up = proj + (size_t)t0 * PROJ_LD + PC_POOL + c; LAS unsigned short* Pc = P + (32 * hf) * PL_PROW + c; const int tl0 = t0 & (SEQ - 1);
          if (g == 0) pool_core<2>(up, tl0, Pc); else if (g == 1) pool_core<4>(up, tl0, Pc); else if (g == 2) pool_core<8>(up, tl0, Pc); else pool_core<16>(up, tl0, Pc); }
        __syncthreads();
        { const int th = wave >> 2, fr = lane & 15, kg = lane >> 4;
#pragma unroll
          for (int tb = 0; tb < 2; ++tb) {
              bf16x8v af[2];
#pragma unroll
              for (int ks = 0; ks < 2; ++ks) af[ks] = *(const LAS bf16x8v*)(P + (32 * th + 16 * tb + fr) * PL_PROW + g * 64 + 32 * ks + 8 * kg);
#pragma unroll
              for (int db = 0; db < 4; ++db) {
                  f32x4 acc = {0.f, 0.f, 0.f, 0.f};
#pragma unroll
                  for (int ks = 0; ks < 2; ++ks) { const bf16x8v bfr = *(const LAS bf16x8v*)(WT + (g * 64 + 16 * db + fr) * PL_WROW + 32 * ks + 8 * kg);
                      acc = __builtin_amdgcn_mfma_f32_16x16x32_bf16(af[ks], bfr, acc, 0, 0, 0); }
                  const int dcol = g * 64 + 16 * db + fr; const float sc = ps_[dcol];
                  GAS bf16* op = mixed + (size_t)(unit * 64 + 32 * th + 16 * tb + 4 * kg) * DM + MC_POOL + dcol;
#pragma unroll
                  for (int r = 0; r < 4; ++r) op[(size_t)r * DM] = (bf16)f2bf(acc[r] * sc);
              }
          } }
        __syncthreads();
    }
}

__device__ __forceinline__ unsigned sort_key(float v) { if (v == 0.f) v = 0.f; const unsigned u = __builtin_bit_cast(unsigned, v); return (u & 0x80000000u) ? ~u : (u | 0x80000000u); }
__device__ __forceinline__ unsigned wave_total6(unsigned x) {
    unsigned t = 0;
#pragma unroll
    for (int b = 0; b < 6; ++b) t += (unsigned)__popcll(__ballot((x >> b) & 1u)) << b;
    return t;
}
template <int NI> __device__ __forceinline__ void emit_mask(const unsigned (&k)[NI], unsigned prefix, bool exact, GAS unsigned* mrow, int lane) {
    if (exact) {
#pragma unroll
        for (int i = 0; i < NI; ++i) { const unsigned long long sb = __ballot(k[i] >= prefix); if (lane == 0) *(GAS v2u*)(mrow + 2 * i) = (v2u){(unsigned)sb, (unsigned)(sb >> 32)}; }
    } else {
        const unsigned tau = prefix; unsigned c = 0u;
#pragma unroll
        for (int i = 0; i < NI; ++i) c += (unsigned)(k[i] > tau);
        const unsigned need = (unsigned)TOPK - wave_total6(c); unsigned base = 0u;
#pragma unroll
        for (int i = 0; i < NI; ++i) {
            const unsigned long long eqb = __ballot(k[i] == tau);
            const unsigned rank = base + (unsigned)__popcll(eqb & ((1ull << lane) - 1ull));
            const unsigned long long sb = __ballot((k[i] > tau) || ((k[i] == tau) && (rank < need)));
            if (lane == 0) *(GAS v2u*)(mrow + 2 * i) = (v2u){(unsigned)sb, (unsigned)(sb >> 32)};
            base += (unsigned)__popcll(eqb);
        }
    }
    if (NI < 32) { if (lane < 2 * (32 - NI)) mrow[2 * NI + lane] = 0u; }
}
__device__ __forceinline__ unsigned wave_max_u32(unsigned v) {
#pragma unroll
    for (int o = 1; o < 64; o <<= 1) { const unsigned t = (unsigned)__shfl_xor((int)v, o); v = v > t ? v : t; }
    return v;
}
template <int NI> __device__ __forceinline__ unsigned count_ge(const unsigned (&k)[NI], unsigned cand) {
    unsigned t = 0u;
#pragma unroll
    for (int i0 = 0; i0 < NI; i0 += 8) {
        unsigned long long mk[8];
#pragma unroll
        for (int i = 0; i < 8; ++i) mk[i] = __ballot(k[i0 + i] >= cand);
        __builtin_amdgcn_sched_barrier(0);
        unsigned t1 = 0u;
#pragma unroll
        for (int i = 0; i < 8; i += 2) { t += (unsigned)__popcll(mk[i]); t1 += (unsigned)__popcll(mk[i + 1]); }
        t += t1;
        __builtin_amdgcn_sched_barrier(0);
    }
    return t;
}
template <int NI> __device__ __forceinline__ void select2(const LAS unsigned* ka_, const LAS unsigned* kb_, int nk, GAS unsigned* mrowA, GAS unsigned* mrowB, int lane) {
    unsigned ka[NI], kb[NI];
#pragma unroll
    for (int i = 0; i < NI; ++i) { const int sidx = lane + 64 * i; ka[i] = (sidx < nk) ? ka_[sidx] : 0u; kb[i] = (sidx < nk) ? kb_[sidx] : 0u; }
    unsigned ma = 0u, mb = 0u;
#pragma unroll
    for (int i = 0; i < NI; ++i) { ma = ka[i] > ma ? ka[i] : ma; mb = kb[i] > mb ? kb[i] : mb; }
    ma = (unsigned)__builtin_amdgcn_readfirstlane((int)wave_max_u32(ma)); mb = (unsigned)__builtin_amdgcn_readfirstlane((int)wave_max_u32(mb));
    unsigned pa = 0u, pb = 0u; bool ea = false, eb = false;
    for (int bit = 31; bit >= 0; --bit) {
        const unsigned ca = pa | (1u << bit), cb = pb | (1u << bit);
        if (!ea && ca <= ma) { const unsigned ta = count_ge<NI>(ka, ca); if (ta >= (unsigned)TOPK) { pa = ca; ea = (ta == (unsigned)TOPK); } }
        if (!eb && cb <= mb) { const unsigned tb = count_ge<NI>(kb, cb); if (tb >= (unsigned)TOPK) { pb = cb; eb = (tb == (unsigned)TOPK); } }
        if (ea && eb) break;
    }
    emit_mask<NI>(ka, pa, ea, mrowA, lane);
    emit_mask<NI>(kb, pb, eb, mrowB, lane);
}
constexpr int MK_STRIDE = 2049;
__device__ __forceinline__ void p_mask(Frame& F) {
    LAS unsigned* keys = (LAS unsigned*)(F.lds + RING_OFF);
    const GAS bf16* qi_hl = (const GAS bf16*)(F.ws + WS_QIHL); const GAS bf16* ki_hl = (const GAS bf16*)(F.ws + WS_KIHL); const GAS float* wi = (const GAS float*)(F.ws + WS_WI); GAS unsigned* mask = (GAS unsigned*)(F.ws + WS_MASK);
    const int tid = F.tid, lane = F.lane, wave = F.wave, q = lane & 15, kg = lane >> 4;
#define MK_UNIT_PARAMS(ui_, b_, qb_) const int b_ = (c >> 6) * 2 + ((ui_) >> 1), qb_ = ((ui_) & 1) ? 127 - (c & 63) : (c & 63)
#define MK_UNIT_LOAD(b_, qb_, BH, WV, AH) do { const size_t rq_ = (size_t)(b_) * SEQ + (qb_) * 16 + q; \
        _Pragma("unroll") for (int h = 0; h < 4; ++h) _Pragma("unroll") for (int dh = 0; dh < 2; ++dh) BH[h][dh] = *(const GAS bf16x8v*)(qi_hl + rq_ * 512 + h * 64 + dh * 32 + kg * 8); \
        WV = *(const GAS f32x4*)(wi + rq_ * 4); \
        { const int kt0_ = wave < (qb_) + 1 ? wave : 0; \
          _Pragma("unroll") for (int dh = 0; dh < 2; ++dh) AH[dh] = *(const GAS bf16x8v*)(ki_hl + ((size_t)(b_) * SEQ + kt0_ * 16 + q) * 128 + dh * 32 + kg * 8); } } while (0)
    for (int c = F.bid; c < 256; c += F.G) {
        bf16x8v bh[4][2], bhn[4][2]; f32x4 wv, wvn; bf16x8v ah[2], ahq[2];
        { MK_UNIT_PARAMS(0, b0_, qb0_); MK_UNIT_LOAD(b0_, qb0_, bh, wv, ah); }
        for (int ui = 0; ui < 4; ++ui) {
            MK_UNIT_PARAMS(ui, b, qb);
            const int t0 = qb * 16; const size_t rowq0 = (size_t)b * SEQ + t0;
            const int uin = ui < 3 ? ui + 1 : 3;
            MK_UNIT_PARAMS(uin, bnx, qbnx);
            if (qb < 16) {
                for (int w = tid; w < 1024; w += NTHR) { const int qq = w >> 6, j = w & 63, n = t0 + qq + 1, lo = j * 32;
                    mask[(rowq0 + qq) * 64 + j] = (n >= lo + 32) ? 0xffffffffu : (n > lo ? ((1u << (n - lo)) - 1u) : 0u); }
                MK_UNIT_LOAD(bnx, qbnx, bh, wv, ah);
                continue;
            }
            const int ntile = qb + 1;
            for (int kt = wave; kt < ntile; kt += NWAVES) {
                const int s0 = kt * 16;
                bf16x8v ahn[2];
                { const int ktn = (kt + NWAVES < ntile) ? kt + NWAVES : kt;
#pragma unroll
                  for (int dh = 0; dh < 2; ++dh) { const GAS bf16* pk = ki_hl + ((size_t)b * SEQ + ktn * 16 + q) * 128 + dh * 32 + kg * 8;
                      ahn[dh] = *(const GAS bf16x8v*)pk; } }
                __builtin_amdgcn_sched_barrier(0);
                f32x4 acc[4];
#pragma unroll
                for (int h = 0; h < 4; ++h) { acc[h] = (f32x4){0.f, 0.f, 0.f, 0.f};
#pragma unroll
                    for (int dh = 0; dh < 2; ++dh) {
                        acc[h] = __builtin_amdgcn_mfma_f32_16x16x32_bf16(ah[dh], bh[h][dh], acc[h], 0, 0, 0);
                    } }
#pragma unroll
                for (int r = 0; r < 4; ++r) {
                    const float I = wv[0] * fmaxf(acc[0][r], 0.f) + wv[1] * fmaxf(acc[1][r], 0.f) + wv[2] * fmaxf(acc[2][r], 0.f) + wv[3] * fmaxf(acc[3][r], 0.f);
                    const int s = s0 + 4 * kg + r;
                    keys[q * MK_STRIDE + s] = (s <= t0 + q) ? sort_key(I) : 0u;
                }
                __builtin_amdgcn_sched_barrier(0);
#pragma unroll
                for (int dh = 0; dh < 2; ++dh) ah[dh] = ahn[dh];
            }
            MK_UNIT_LOAD(bnx, qbnx, bhn, wvn, ahq);
            __syncthreads();
            const int nk = t0 + 16;
            { const LAS unsigned* kA = keys + (2 * wave) * MK_STRIDE; const LAS unsigned* kB = kA + MK_STRIDE;
              GAS unsigned* mA = mask + (rowq0 + 2 * wave) * 64; GAS unsigned* mB = mA + 64;
              if (nk <= 512) select2<8>(kA, kB, nk, mA, mB, lane);
              else if (nk <= 1024) select2<16>(kA, kB, nk, mA, mB, lane);
              else if (nk <= 1536) select2<24>(kA, kB, nk, mA, mB, lane);
              else select2<32>(kA, kB, nk, mA, mB, lane); }
#pragma unroll
            for (int h = 0; h < 4; ++h) { bh[h][0] = bhn[h][0]; bh[h][1] = bhn[h][1]; }
            wv = wvn; ah[0] = ahq[0]; ah[1] = ahq[1];
            __syncthreads();
        }
    }
#undef MK_UNIT_PARAMS
#undef MK_UNIT_LOAD
}

typedef short s16x4 __attribute__((ext_vector_type(4)));
#define MFMA16(a, b, c) __builtin_amdgcn_mfma_f32_16x16x16bf16_1k((a), (b), (c), 0, 0, 0)
__device__ __forceinline__ s16x4 pack4(const f32x4 v) { v2u t; t.x = cvtpk(v[0], v[1]); t.y = cvtpk(v[2], v[3]); return __builtin_bit_cast(s16x4, t); }
constexpr int HG_QT = 0, HG_KT = 2176, HG_KH = 4352, HG_IT = 7424, HG_DF = 10496, HG_WAVE_LDS = 10752;
struct HgRaw { unsigned short z[16], i[16], q[16]; };
template <bool FULL> __device__ __forceinline__ void hgrn_load(const GAS bf16* pr, HgRaw& R) {
#pragma unroll
    for (int s_ = 0; s_ < 16; ++s_) { R.z[s_] = pr[(size_t)s_ * PROJ_LD + PC_HF]; R.i[s_] = pr[(size_t)s_ * PROJ_LD + PC_HI]; if (FULL) R.q[s_] = pr[(size_t)s_ * PROJ_LD + PC_HQ]; }
}
template <bool FULL> __device__ __forceinline__ float hgrn_stage(const HgRaw& R, float lbv, LAS unsigned char* W, int lane) {
    const unsigned short (&zr)[16] = R.z; const unsigned short (&ir)[16] = R.i; const unsigned short (&qr)[16] = R.q;
    float f[16], kk[16]; float P = 1.0f;
    LAS unsigned short* QT = (LAS unsigned short*)(W + HG_QT); LAS unsigned short* KT = (LAS unsigned short*)(W + HG_KT);
#pragma unroll
    for (int s_ = 0; s_ < 16; ++s_) {
        const float z = bf2f(zr[s_]);
        const float sig = 1.0f / (1.0f + __expf(-z));
        f[s_] = fmaxf(lbv + (1.0f - lbv) * sig, 1e-30f); kk[s_] = (1.0f - lbv) * (1.0f - sig);
        P *= f[s_];
        if (FULL) { const float q = bf2f(qr[s_]); const float qs = q / (1.0f + __expf(-q));
            QT[s_ * 68 + lane] = (unsigned short)f2bf(qs * P); KT[s_ * 68 + lane] = (unsigned short)f2bf(kk[s_] / fmaxf(P, 1e-30f)); }
    }
    float E = 1.0f; unsigned kh[8];
#pragma unroll
    for (int s_ = 15; s_ >= 0; s_ -= 2) {
        const float hi = kk[s_] * E; E *= f[s_];
        const float lo = kk[s_ - 1] * E; E *= f[s_ - 1];
        kh[s_ >> 1] = cvtpk(lo, hi);
    }
    LAS v4u* KH = (LAS v4u*)(W + HG_KH + lane * 48); LAS v4u* IT = (LAS v4u*)(W + HG_IT + lane * 48);
    KH[0] = (v4u){kh[0], kh[1], kh[2], kh[3]}; KH[1] = (v4u){kh[4], kh[5], kh[6], kh[7]};
    IT[0] = (v4u){(unsigned)ir[0] | ((unsigned)ir[1] << 16), (unsigned)ir[2] | ((unsigned)ir[3] << 16), (unsigned)ir[4] | ((unsigned)ir[5] << 16), (unsigned)ir[6] | ((unsigned)ir[7] << 16)};
    IT[1] = (v4u){(unsigned)ir[8] | ((unsigned)ir[9] << 16), (unsigned)ir[10] | ((unsigned)ir[11] << 16), (unsigned)ir[12] | ((unsigned)ir[13] << 16), (unsigned)ir[14] | ((unsigned)ir[15] << 16)};
    ((LAS float*)(W + HG_DF))[lane] = P;
    return P;
}
__device__ __forceinline__ void hgrn_update(f32x4 (&S)[4][4], const LAS unsigned char* W, int fr, int kg) {
    s16x4 khf[4], itf[4]; f32x4 df[4];
#pragma unroll
    for (int i = 0; i < 4; ++i) { khf[i] = *(const LAS s16x4*)(W + HG_KH + (16 * i + fr) * 48 + 8 * kg); itf[i] = *(const LAS s16x4*)(W + HG_IT + (16 * i + fr) * 48 + 8 * kg);
        df[i] = *(const LAS f32x4*)(W + HG_DF + (16 * i + 4 * kg) * 4); }
#pragma unroll
    for (int kb = 0; kb < 4; ++kb)
#pragma unroll
        for (int vb = 0; vb < 4; ++vb) S[kb][vb] = MFMA16(khf[kb], itf[vb], S[kb][vb] * df[kb]);
}
__device__ __forceinline__ void p_hgrn_local(Frame& F, int layer) {
    const int lane = F.lane, fr = lane & 15, kg = lane >> 4;
    LAS unsigned char* W = F.lds + RING_OFF + F.wave * 16384;
    const GAS bf16* proj = (const GAS bf16*)(F.ws + WS_PROJ); GAS float* hst = (GAS float*)(F.ws + WS_HST); GAS float* hdn = (GAS float*)(F.ws + WS_HDN);
    for (int unit = F.wave * F.G + F.bid; unit < BATCH * 4 * (SEQ / 64); unit += NWAVES * F.G) {
        const int bh = unit >> 5, chunk = unit & 31, b = bh >> 2, h = bh & 3;
        const float lbv = ((const GAS float*)(F.ws + WS_LB))[layer * 256 + h * 64 + lane];
        const size_t row0 = (size_t)b * SEQ + chunk * 64;
        f32x4 S[4][4];
#pragma unroll
        for (int i = 0; i < 4; ++i)
#pragma unroll
            for (int j = 0; j < 4; ++j) S[i][j] = (f32x4){0.f, 0.f, 0.f, 0.f};
        float dprod = 1.0f;
        HgRaw R;
        hgrn_load<false>(proj + row0 * PROJ_LD + h * 64 + lane, R);
        for (int sub = 0; sub < 4; ++sub) {
            dprod *= hgrn_stage<false>(R, lbv, W, lane);
            { const int sn = sub < 3 ? sub + 1 : 3; hgrn_load<false>(proj + (row0 + sn * 16) * PROJ_LD + h * 64 + lane, R); }
            LDS_WAIT(); asm volatile("" ::: "memory");
            hgrn_update(S, W, fr, kg);
            LDS_WAIT(); asm volatile("" ::: "memory");
        }
        GAS float* U = hst + (size_t)unit * 4096;
#pragma unroll
        for (int kb = 0; kb < 4; ++kb)
#pragma unroll
            for (int vb = 0; vb < 4; ++vb)
#pragma unroll
                for (int r = 0; r < 4; ++r) U[(16 * kb + 4 * kg + r) * 64 + 16 * vb + fr] = S[kb][vb][r];
        hdn[unit * 64 + lane] = dprod;
    }
}
__device__ __forceinline__ void p_hgrn_scan(Frame& F) {
    GAS float* hst = (GAS float*)(F.ws + WS_HST); const GAS float* hdn = (const GAS float*)(F.ws + WS_HDN);
    for (int e = F.bid * NTHR + F.tid; e < BATCH * 4 * 4096; e += F.G * NTHR) {
        const int bh = e >> 12, kv = e & 4095, k = kv >> 6;
        float S = 0.f;
        for (int n = 0; n < SEQ / 64; ++n) {
            const size_t idx = ((size_t)(bh * 32 + n) << 12) + kv;
            const float u = hst[idx]; hst[idx] = S;
            S = hdn[(bh * 32 + n) * 64 + k] * S + u;
        }
    }
}
constexpr int HG_LDS_OFF = 40960;
__device__ __forceinline__ void p_hgrn_out(Frame& F, int layer) {
    const int lane = F.lane, fr = lane & 15, kg = lane >> 4;
    LAS unsigned char* W = F.lds + RING_OFF + HG_LDS_OFF + F.wave * HG_WAVE_LDS;
    const GAS bf16* proj = (const GAS bf16*)(F.ws + WS_PROJ); GAS bf16* mixed = (GAS bf16*)(F.ws + WS_MIXED); const GAS float* hst = (const GAS float*)(F.ws + WS_HST);
    for (int unit = F.wave * F.G + F.bid; unit < BATCH * 4 * (SEQ / 64); unit += NWAVES * F.G) {
        const int bh = unit >> 5, chunk = unit & 31, b = bh >> 2, h = bh & 3;
        const float lbv = ((const GAS float*)(F.ws + WS_LB))[layer * 256 + h * 64 + lane];
        const size_t row0 = (size_t)b * SEQ + chunk * 64;
        f32x4 S[4][4];
        { const GAS float* U = hst + (size_t)unit * 4096;
#pragma unroll
          for (int kb = 0; kb < 4; ++kb)
#pragma unroll
              for (int vb = 0; vb < 4; ++vb)
#pragma unroll
                  for (int r = 0; r < 4; ++r) S[kb][vb][r] = U[(16 * kb + 4 * kg + r) * 64 + 16 * vb + fr]; }
        f32x4 ng4[4];
#pragma unroll
        for (int vb = 0; vb < 4; ++vb) ng4[vb] = *(const GAS f32x4*)((const GAS float*)F.hgrn_g + layer * 256 + h * 64 + 16 * vb + 4 * kg);
        for (int sub = 0; sub < 4; ++sub) {
            const size_t rs = row0 + sub * 16;
            { HgRaw R; hgrn_load<true>(proj + rs * PROJ_LD + h * 64 + lane, R); __builtin_amdgcn_sched_barrier(0); (void)hgrn_stage<true>(R, lbv, W, lane); }
            v2u g2[4];
#pragma unroll
            for (int vb = 0; vb < 4; ++vb) g2[vb] = *(const GAS v2u*)(proj + (rs + fr) * PROJ_LD + PC_HG + h * 64 + 16 * vb + 4 * kg);
            LDS_WAIT(); asm volatile("" ::: "memory");
            s16x4 qb[4];
#pragma unroll
            for (int kb = 0; kb < 4; ++kb) qb[kb] = *(const LAS s16x4*)(W + HG_QT + (fr * 68 + 16 * kb + 4 * kg) * 2);
            f32x4 o[4];
#pragma unroll
            for (int vb = 0; vb < 4; ++vb) { o[vb] = (f32x4){0.f, 0.f, 0.f, 0.f};
#pragma unroll
                for (int kb = 0; kb < 4; ++kb) o[vb] = MFMA16(pack4(S[kb][vb]), qb[kb], o[vb]); }
            f32x4 at = {0.f, 0.f, 0.f, 0.f};
#pragma unroll
            for (int kb = 0; kb < 4; ++kb) at = MFMA16(*(const LAS s16x4*)(W + HG_KT + (fr * 68 + 16 * kb + 4 * kg) * 2), qb[kb], at);
#pragma unroll
            for (int r = 0; r < 4; ++r) if (4 * kg + r > fr) at[r] = 0.f;
            const s16x4 ab = pack4(at);
#pragma unroll
            for (int vb = 0; vb < 4; ++vb) o[vb] = MFMA16(*(const LAS s16x4*)(W + HG_IT + (16 * vb + fr) * 48 + 8 * kg), ab, o[vb]);
            hgrn_update(S, W, fr, kg);
            float ssq = 0.f;
#pragma unroll
            for (int vb = 0; vb < 4; ++vb) ssq += (o[vb][0] * o[vb][0] + o[vb][1] * o[vb][1]) + (o[vb][2] * o[vb][2] + o[vb][3] * o[vb][3]);
            ssq += __shfl_xor(ssq, 16); ssq += __shfl_xor(ssq, 32);
            const float rstd = 1.0f / sqrtf(ssq * (1.0f / 64.0f) + 1e-5f);
#pragma unroll
            for (int vb = 0; vb < 4; ++vb) {
                const float g0 = __builtin_bit_cast(float, g2[vb].x << 16), g1 = __builtin_bit_cast(float, g2[vb].x & 0xffff0000u), g2f = __builtin_bit_cast(float, g2[vb].y << 16), g3 = __builtin_bit_cast(float, g2[vb].y & 0xffff0000u);
                const float y0 = o[vb][0] * rstd * ng4[vb][0] * (g0 / (1.0f + __expf(-g0))), y1 = o[vb][1] * rstd * ng4[vb][1] * (g1 / (1.0f + __expf(-g1)));
                const float y2 = o[vb][2] * rstd * ng4[vb][2] * (g2f / (1.0f + __expf(-g2f))), y3 = o[vb][3] * rstd * ng4[vb][3] * (g3 / (1.0f + __expf(-g3)));
                *(GAS v2u*)(mixed + (rs + fr) * DM + MC_HGRN + h * 64 + 16 * vb + 4 * kg) = (v2u){cvtpk(y0, y1), cvtpk(y2, y3)};
            }
            LDS_WAIT(); asm volatile("" ::: "memory");
        }
    }
}

__device__ __forceinline__ float max3f_(float a, float b, float c) { float r; asm("v_max3_f32 %0, %1, %2, %3" : "=v"(r) : "v"(a), "v"(b), "v"(c)); return r; }
__device__ __forceinline__ float and_f32(float e, int selmask) { asm volatile("" : "+v"(selmask)); return __builtin_bit_cast(float, __builtin_bit_cast(unsigned, e) & (unsigned)selmask); }
typedef float f32x2p __attribute__((ext_vector_type(2)));
constexpr int AT_KROW = 144, AT_VROW = 136, AT_KBYTES = 64 * AT_KROW, AT_VBYTES = 64 * AT_VROW, AT_BUF = AT_KBYTES + AT_VBYTES, AT_SCR = 2 * AT_BUF;
static_assert(AT_BUF % 16 == 0 && AT_SCR % 16 == 0, "attention LDS map alignment");
__device__ __forceinline__ void p_attn_flash(Frame& F) {
    const int tid = F.tid, lane = F.lane, wave = F.wave;
    const int r = lane & 31, hh = lane >> 5, g = wave & 3, qh = wave >> 2;
    LAS unsigned char* L = F.lds + RING_OFF;
    LAS float* scr = (LAS float*)(L + AT_SCR) + wave * 32;
    const GAS bf16* proj = (const GAS bf16*)(F.ws + WS_PROJ); const GAS bf16* vT = (const GAS bf16*)(F.ws + WS_VT); GAS bf16* mixed = (GAS bf16*)(F.ws + WS_MIXED);
    const GAS unsigned* mask = (const GAS unsigned*)(F.ws + WS_MASK);
    const int srow = tid >> 3, sch = tid & 7;
    const float C2 = 0.18033688011112042f, NEG = -1.0e30f;
    for (int pair = F.bid; pair < 256; pair += F.G) {
        const int bk = pair >> 4, b = bk >> 1, kvh = bk & 1, pp = pair & 15, h = kvh * 4 + g;
        for (int half = 0; half < 2; ++half) {
            const int qblk = half == 0 ? 31 - pp : pp;
            const int q0 = qblk * 64, nt = qblk + 1;
            const int tq = q0 + 32 * qh + r;
            bf16x8v qf[4];
            { const GAS bf16* qp = proj + (size_t)(b * SEQ + tq) * PROJ_LD + PC_Q + h * 64 + 8 * hh;
#pragma unroll
              for (int d0 = 0; d0 < 4; ++d0) qf[d0] = *(const GAS bf16x8v*)(qp + 16 * d0); }
            const GAS unsigned* mrow = mask + (size_t)(b * SEQ + tq) * 64;
            const GAS bf16* kg = proj + (size_t)(b * SEQ + srow) * PROJ_LD + PC_K + kvh * 64 + sch * 8;
            const GAS bf16* vg = vT + (size_t)(bk * 64 + srow) * SEQ + sch * 8;
            { const v4u kreg = *(const GAS v4u*)kg; const v4u vreg = *(const GAS v4u*)vg;
              *(LAS v4u*)(L + srow * AT_KROW + sch * 16) = kreg;
              LAS unsigned char* vd = L + AT_KBYTES + srow * AT_VROW + sch * 16;
              *(LAS v2u*)vd = (v2u){vreg.x, vreg.y}; *(LAS v2u*)(vd + 8) = (v2u){vreg.z, vreg.w}; }
            v2u mw = *(const GAS v2u*)mrow;
            __syncthreads();
            f32x16 o0, o1;
#pragma unroll
            for (int i = 0; i < 16; ++i) { o0[i] = 0.f; o1[i] = 0.f; }
            float m = -30000.0f, l = 0.f;
            for (int j = 0; j < nt; ++j) {
                LAS unsigned char* Kb = L + (j & 1) * AT_BUF; LAS unsigned char* Vb = Kb + AT_KBYTES;
                const bool more = (j + 1 < nt);
                const int jn = more ? j + 1 : j;
                const v4u kn = *(const GAS v4u*)(kg + (size_t)jn * 64 * PROJ_LD); const v4u vn = *(const GAS v4u*)(vg + jn * 64); const v2u mwn = *(const GAS v2u*)(mrow + 2 * jn);
                bf16x8v kf[8];
#pragma unroll
                for (int d0 = 0; d0 < 4; ++d0) { kf[2 * d0] = *(const LAS bf16x8v*)(Kb + r * AT_KROW + d0 * 32 + hh * 16); kf[2 * d0 + 1] = *(const LAS bf16x8v*)(Kb + (32 + r) * AT_KROW + d0 * 32 + hh * 16); }
                __builtin_amdgcn_sched_barrier(0);
                f32x16 p0, p1;
#pragma unroll
                for (int i = 0; i < 16; ++i) { p0[i] = 0.f; p1[i] = 0.f; }
#pragma unroll
                for (int d0 = 0; d0 < 4; ++d0) {
                    p0 = __builtin_amdgcn_mfma_f32_32x32x16_bf16(kf[2 * d0], qf[d0], p0, 0, 0, 0);
                    p1 = __builtin_amdgcn_mfma_f32_32x32x16_bf16(kf[2 * d0 + 1], qf[d0], p1, 0, 0, 0);
                }
                v2u vl[8], vh[8];
#pragma unroll
                for (int ks = 0; ks < 4; ++ks) {
                    const LAS unsigned char* vp = Vb + r * AT_VROW + (16 * ks + 4 * hh) * 2;
                    vl[2 * ks] = *(const LAS v2u*)vp; vh[2 * ks] = *(const LAS v2u*)(vp + 16);
                    vl[2 * ks + 1] = *(const LAS v2u*)(vp + 32 * AT_VROW); vh[2 * ks + 1] = *(const LAS v2u*)(vp + 32 * AT_VROW + 16);
                }
                __builtin_amdgcn_sched_barrier(0);
                const unsigned w0 = mw.x >> (4 * hh), w1 = mw.y >> (4 * hh);
                asm volatile("s_nop 15\n\ts_nop 7" : "+v"(p0), "+v"(p1));
                float mx;
                { float a = max3f_(p0[0], p0[1], p1[0]), b = max3f_(p0[2], p0[3], p1[1]); a = max3f_(a, p1[2], p1[3]);
#pragma unroll
                  for (int i = 4; i < 16; i += 4) { a = max3f_(a, p0[i], p0[i + 1]); b = max3f_(b, p0[i + 2], p0[i + 3]); a = max3f_(a, p1[i], p1[i + 1]); b = max3f_(b, p1[i + 2], p1[i + 3]); }
                  mx = max3f_(a, b, NEG); }
                mx = fmaxf(mx, __shfl_xor(mx, 32));
                const float mxs = mx * C2;
                const bool need = mxs > m + 8.0f;
                if (__any(need)) {
                    const float mnew = need ? mxs : m;
                    const float alpha = __builtin_amdgcn_exp2f(m - mnew); m = mnew; l *= alpha;
                    if (hh == 0) scr[r] = alpha;
#pragma unroll
                    for (int gq = 0; gq < 4; ++gq) {
                        const f32x4 a4 = *(const LAS f32x4*)(scr + 8 * gq + 4 * hh);
#pragma unroll
                        for (int e = 0; e < 4; ++e) { o0[4 * gq + e] *= a4[e]; o1[4 * gq + e] *= a4[e]; }
                    }
                }
                f32x2p rs2 = {0.f, 0.f};
                const f32x2p c2v = {C2, C2}, nm2 = {-m, -m};
#pragma unroll
                for (int i = 0; i < 16; i += 2) {
                    const int cr0 = (i & 3) + 8 * (i >> 2), cr1 = cr0 + 1;
                    f32x2p t0 = (f32x2p){p0[i], p0[i + 1]} * c2v + nm2, t1 = (f32x2p){p1[i], p1[i + 1]} * c2v + nm2;
                    t0.x = and_f32(__builtin_amdgcn_exp2f(t0.x), __builtin_amdgcn_sbfe((int)w0, cr0, 1)); t0.y = and_f32(__builtin_amdgcn_exp2f(t0.y), __builtin_amdgcn_sbfe((int)w0, cr1, 1));
                    t1.x = and_f32(__builtin_amdgcn_exp2f(t1.x), __builtin_amdgcn_sbfe((int)w1, cr0, 1)); t1.y = and_f32(__builtin_amdgcn_exp2f(t1.y), __builtin_amdgcn_sbfe((int)w1, cr1, 1));
                    p0[i] = t0.x; p0[i + 1] = t0.y; p1[i] = t1.x; p1[i + 1] = t1.y;
                    rs2 += t0; rs2 += t1;
                }
                l += rs2.x + rs2.y;
                bf16x8v pf[4];
                { v4u t;
                  t.x = cvtpk(p0[0], p0[1]); t.y = cvtpk(p0[2], p0[3]); t.z = cvtpk(p0[4], p0[5]); t.w = cvtpk(p0[6], p0[7]); pf[0] = __builtin_bit_cast(bf16x8v, t);
                  t.x = cvtpk(p0[8], p0[9]); t.y = cvtpk(p0[10], p0[11]); t.z = cvtpk(p0[12], p0[13]); t.w = cvtpk(p0[14], p0[15]); pf[1] = __builtin_bit_cast(bf16x8v, t);
                  t.x = cvtpk(p1[0], p1[1]); t.y = cvtpk(p1[2], p1[3]); t.z = cvtpk(p1[4], p1[5]); t.w = cvtpk(p1[6], p1[7]); pf[2] = __builtin_bit_cast(bf16x8v, t);
                  t.x = cvtpk(p1[8], p1[9]); t.y = cvtpk(p1[10], p1[11]); t.z = cvtpk(p1[12], p1[13]); t.w = cvtpk(p1[14], p1[15]); pf[3] = __builtin_bit_cast(bf16x8v, t); }
                __builtin_amdgcn_sched_barrier(0);
#pragma unroll
                for (int ks = 0; ks < 4; ++ks) {
                    const bf16x8v vf0 = __builtin_bit_cast(bf16x8v, (v4u){vl[2 * ks].x, vl[2 * ks].y, vh[2 * ks].x, vh[2 * ks].y});
                    const bf16x8v vf1 = __builtin_bit_cast(bf16x8v, (v4u){vl[2 * ks + 1].x, vl[2 * ks + 1].y, vh[2 * ks + 1].x, vh[2 * ks + 1].y});
                    o0 = __builtin_amdgcn_mfma_f32_32x32x16_bf16(pf[ks], vf0, o0, 0, 0, 0);
                    o1 = __builtin_amdgcn_mfma_f32_32x32x16_bf16(pf[ks], vf1, o1, 0, 0, 0);
                }
                __builtin_amdgcn_sched_barrier(0);
                if (more) {
                    LAS unsigned char* Kn = L + ((j + 1) & 1) * AT_BUF;
                    *(LAS v4u*)(Kn + srow * AT_KROW + sch * 16) = kn;
                    LAS unsigned char* vd = Kn + AT_KBYTES + srow * AT_VROW + sch * 16;
                    *(LAS v2u*)vd = (v2u){vn.x, vn.y}; *(LAS v2u*)(vd + 8) = (v2u){vn.z, vn.w};
                }
                mw = mwn;
                __syncthreads();
            }
            l += __shfl_xor(l, 32);
            if (hh == 0) scr[r] = 1.0f / l;
            GAS bf16* op = mixed + (size_t)(b * SEQ + q0 + 32 * qh) * DM + MC_ATTN + h * 64 + r;
#pragma unroll
            for (int gq = 0; gq < 4; ++gq) {
                const f32x4 a4 = *(const LAS f32x4*)(scr + 8 * gq + 4 * hh);
#pragma unroll
                for (int e = 0; e < 4; ++e) {
                    const int q = 8 * gq + 4 * hh + e;
                    op[(size_t)q * DM] = (bf16)f2bf(o0[4 * gq + e] * a4[e]); op[(size_t)q * DM + 32] = (bf16)f2bf(o1[4 * gq + e] * a4[e]);
                }
            }
        }
    }
}

__device__ __forceinline__ void p_final(Frame& F) {
    const int gw = F.bid * NWAVES + F.wave, NGW = F.G * NWAVES;
    const GAS f32x4* gr = (const GAS f32x4*)F.fng + F.lane;
    f32x4 gv[4];
#pragma unroll
    for (int j = 0; j < 4; ++j) gv[j] = gr[64 * j];
    for (int row0 = gw * 4; row0 < M; row0 += NGW * 4) {
        f32x4 v[4][4]; float sq[4];
#pragma unroll
        for (int rr = 0; rr < 4; ++rr) { const GAS f32x4* xr = (const GAS f32x4*)(F.xres + (size_t)(row0 + rr) * DM) + F.lane;
#pragma unroll
            for (int j = 0; j < 4; ++j) v[rr][j] = xr[64 * j]; }
#pragma unroll
        for (int rr = 0; rr < 4; ++rr) { float a = 0.f;
#pragma unroll
            for (int j = 0; j < 4; ++j) a += (v[rr][j][0] * v[rr][j][0] + v[rr][j][1] * v[rr][j][1]) + (v[rr][j][2] * v[rr][j][2] + v[rr][j][3] * v[rr][j][3]);
            sq[rr] = a; }
#pragma unroll
        for (int o = 1; o < 64; o <<= 1)
#pragma unroll
            for (int rr = 0; rr < 4; ++rr) sq[rr] += __shfl_xor(sq[rr], o);
#pragma unroll
        for (int rr = 0; rr < 4; ++rr) {
            const float rs = 1.0f / sqrtf(sq[rr] * (1.0f / 1024.0f) + 1e-5f);
            GAS f32x4* xo = (GAS f32x4*)(F.xres + (size_t)(row0 + rr) * DM) + F.lane;
#pragma unroll
            for (int j = 0; j < 4; ++j) xo[64 * j] = v[rr][j] * rs * gv[j];
        }
    }
}

#ifndef MK_SINGLE
#define MK_SINGLE 1
#endif
constexpr int NPL = 7;
constexpr int NPHASE = 1 + DEPTH * NPL + 1;
struct Args { const float* x; const int* pos; const float *n1g, *w_in, *pool_w, *pool_scale, *lb_logits, *hgrn_g, *w_out, *n2g, *w_ff_in, *w_ff_out, *fng; float* out; unsigned char* ws; int ph_lo, ph_hi; };
static_assert(sizeof(Args) == 15 * 8 + 8, "Args has no padding");


#define PHASE_BEGIN() do { int t_ = threadIdx.x; asm volatile("" : "+v"(t_)); F.tid = t_; F.lane = t_ & 63; F.wave = __builtin_amdgcn_readfirstlane(t_ >> 6); \
    unsigned char* w_ = args.ws; asm volatile("" : "+s"(w_)); F.ws = w_; int b_ = blockIdx.x; asm volatile("" : "+s"(b_)); F.bid = b_; } while (0)

#define RSTD_TAB_OFF RING_BYTES
#define FILL_RSTD(S_, pm_out) do { PHASE_BEGIN(); pg8::Unit u0_; pm_out = S_.next(0, u0_) ? u0_.pm : -1; \
    if (pm_out >= 0 && F.tid < 256) ((LAS float*)(F.lds + RSTD_TAB_OFF))[F.tid] = pg8::row_rstd((const float*)(F.ws + WS_SSQ), pm_out * 256 + F.tid); \
    __syncthreads(); } while (0)
__global__ void __launch_bounds__(NTHR, 2) fwd(Args args) {
    extern __shared__ __attribute__((aligned(16))) unsigned char lds[];
    Frame F;
    F.lds = (LAS unsigned char*)lds;
    F.MISC = (volatile LAS unsigned*)(F.lds + MISC_OFF);
    F.tid = threadIdx.x; F.lane = F.tid & 63; F.wave = __builtin_amdgcn_readfirstlane(F.tid >> 6);
    F.G = gridDim.x; F.bid = blockIdx.x;
    F.ws = args.ws; F.ctl = (gu32*)(args.ws + WS_CTL);
    F.x_in = args.x; F.pos = args.pos; F.n1g = args.n1g; F.w_in = args.w_in; F.pool_w = args.pool_w; F.pool_scale = args.pool_scale; F.lb_logits = args.lb_logits;
    F.hgrn_g = args.hgrn_g; F.w_out = args.w_out; F.n2g = args.n2g; F.w_ff_in = args.w_ff_in; F.w_ff_out = args.w_ff_out; F.fng = args.fng; F.xres = args.out;
    for (int u = F.tid; u < (LDS_BYTES - LDSCTL_OFF) / 4; u += NTHR) ((LAS unsigned*)(F.lds + LDSCTL_OFF))[u] = 0u;
    __syncthreads();
    XcdBarrier bar; bar.bar = (unsigned*)(F.ctl + CW_BAR); bar.x = 0; bar.st = nullptr;
    if (MK_SINGLE) bar = xcd_barrier_post((unsigned*)(F.ctl + CW_BAR), F.MISC + 8);
    const int lo = args.ph_lo, hi = args.ph_hi;
#define IN(k) (lo <= (k) && (k) < hi)
#define SEAM(k) do { if (MK_SINGLE && IN(k) && IN((k) + 1)) xcd_barrier(bar); } while (0)
    bf16* const xb = (bf16*)(F.ws + WS_XB); float* const ssq = (float*)(F.ws + WS_SSQ);
    bf16* const proj = (bf16*)(F.ws + WS_PROJ); bf16* const mixed = (bf16*)(F.ws + WS_MIXED); bf16* const hid = (bf16*)(F.ws + WS_HID);

    if (IN(0)) { PHASE_BEGIN(); p_prologue(F); } SEAM(0);
    for (int layer = 0; layer < DEPTH; ++layer) {
        const int pb = 1 + layer * NPL;
        if (IN(pb + 0)) {
            PHASE_BEGIN(); pg8::Gemm g{xb, (const bf16*)(F.ws + ((layer & 1) ? WS_WIN1 : WS_WIN)), M, DINP, DM}; pg8::StaticOrder S; S.init(M, DINP, F.G, F.bid);
            int pm0; FILL_RSTD(S, pm0);
            pg8::EpiIn E{F.ws, pg8::RstdTab{(const LAS float*)(F.lds + RSTD_TAB_OFF), pm0, F.ws}};
            pg8::gemm_phase<pg8::EpiIn, pg8::StaticOrder, true, true>(F.lds + RING_OFF, g, S, E);
            PHASE_BEGIN(); if (F.bid >= 128) cvt_layer_rest(F, layer, (F.bid - 128) * NWAVES + F.wave, 128 * NWAVES);
        } SEAM(pb + 0);
        if (IN(pb + 1)) { PHASE_BEGIN(); p_hgrn_local(F, layer); } SEAM(pb + 1);
        if (IN(pb + 2)) { PHASE_BEGIN(); p_pool(F, layer); PHASE_BEGIN(); p_mask(F); PHASE_BEGIN(); p_hgrn_scan(F); } SEAM(pb + 2);
        if (IN(pb + 3)) { PHASE_BEGIN(); p_hgrn_out(F, layer); PHASE_BEGIN(); p_attn_flash(F); } SEAM(pb + 3);
        if (IN(pb + 4)) {
            PHASE_BEGIN(); pg8::Gemm g{mixed, (const bf16*)(F.ws + WS_WOUT), M, DM, DM}; pg8::StaticOrder S; S.init(M, DM, F.G, F.bid);
            pg8::EpiRes E{layer == 0 ? F.x_in : (const float*)F.xres, F.xres, F.ws};
            pg8::gemm_phase<pg8::EpiRes, pg8::StaticOrder, true, true>(F.lds + RING_OFF, g, S, E);
        } SEAM(pb + 4);
        if (IN(pb + 5)) {
            PHASE_BEGIN(); pg8::Gemm g{xb, (const bf16*)(F.ws + WS_WFI), M, DFF, DM}; pg8::StaticOrder S; S.init(M, DFF, F.G, F.bid);
            int pm0; FILL_RSTD(S, pm0);
            pg8::EpiFfIn E{pg8::RstdTab{(const LAS float*)(F.lds + RSTD_TAB_OFF), pm0, F.ws}};
            pg8::gemm_phase<pg8::EpiFfIn, pg8::StaticOrder, true, true>(F.lds + RING_OFF, g, S, E);
        } SEAM(pb + 5);
        if (IN(pb + 6)) {
            PHASE_BEGIN(); pg8::Gemm g{hid, (const bf16*)(F.ws + WS_WFO), M, DM, DFF}; pg8::StaticOrder S; S.init(M, DM, F.G, F.bid);
            pg8::EpiRes E{(const float*)F.xres, F.xres, F.ws};
            pg8::gemm_phase<pg8::EpiRes, pg8::StaticOrder, true, true>(F.lds + RING_OFF, g, S, E);
        } SEAM(pb + 6);
    }
    if (IN(NPHASE - 1)) { PHASE_BEGIN(); p_final(F); }
#undef IN
#undef SEAM
}

extern "C" void kernel_launch(void* const* d_in, const int* in_sizes, int n_in, void* d_out, int out_size, void* d_ws, size_t ws_size, hipStream_t stream) {
    static int grid = 0;
    if (grid == 0) {
        if (n_in != 13 || out_size != M * DM || ws_size < WS_END) { fprintf(stderr, "kernel_launch: unexpected shapes (n_in %d, out %d, ws %zu)\n", n_in, out_size, ws_size); grid = -1; return; }
        int dev = 0, cus = 0, per_cu = 0;
        if (hipGetDevice(&dev) != hipSuccess || hipDeviceGetAttribute(&cus, hipDeviceAttributeMultiprocessorCount, dev) != hipSuccess) { grid = -1; return; }
        if (hipFuncSetAttribute((const void*)fwd, hipFuncAttributeMaxDynamicSharedMemorySize, LDS_BYTES) != hipSuccess) { fprintf(stderr, "kernel_launch: hipFuncSetAttribute failed\n"); grid = -1; return; }
        if (hipOccupancyMaxActiveBlocksPerMultiprocessor(&per_cu, (const void*)fwd, NTHR, LDS_BYTES) != hipSuccess || per_cu < 1) { fprintf(stderr, "kernel_launch: occupancy query says %d\n", per_cu); }
        (void)hipGetLastError();
        grid = cus;
        if (grid != 256) { fprintf(stderr, "kernel_launch: built for a 256-CU device (got %d)\n", cus); grid = -1; return; }
    }
    if (grid <= 0) return;
    (void)hipMemsetAsync((char*)d_ws + WS_CTL, 0, CTL_ZERO_BYTES, stream);
    Args a{};
    a.x = (const float*)d_in[0]; a.pos = (const int*)d_in[1]; a.n1g = (const float*)d_in[2]; a.w_in = (const float*)d_in[3]; a.pool_w = (const float*)d_in[4];
    a.pool_scale = (const float*)d_in[5]; a.lb_logits = (const float*)d_in[6]; a.hgrn_g = (const float*)d_in[7]; a.w_out = (const float*)d_in[8]; a.n2g = (const float*)d_in[9];
    a.w_ff_in = (const float*)d_in[10]; a.w_ff_out = (const float*)d_in[11]; a.fng = (const float*)d_in[12];
    a.out = (float*)d_out; a.ws = (unsigned char*)d_ws;
    if (MK_SINGLE) {
        a.ph_lo = 0; a.ph_hi = NPHASE;
        hipLaunchKernelGGL(fwd, dim3(grid), dim3(NTHR), LDS_BYTES, stream, a);
    } else {
        for (int p = 0; p < NPHASE; ++p) { a.ph_lo = p; a.ph_hi = p + 1; hipLaunchKernelGGL(fwd, dim3(grid), dim3(NTHR), LDS_BYTES, stream, a); }
    }
}
```

```cpp
#include <hip/hip_runtime.h>
#include <cstdio>
#include <cstdint>

constexpr int BATCH = 8, SEQ = 2048, DM = 1024, DEPTH = 4, M = BATCH * SEQ, DIN = 2372, DINP = 2560, DFF = 4096;
constexpr int NWAVES = 8, NTHR = NWAVES * 64;
constexpr int TOPK = 256;
constexpr int PC_POOL = 0, PC_HQ = 256, PC_HF = 512, PC_HI = 768, PC_HG = 1024, PC_Q = 1280, PC_K = 1792, PC_V = 1920, PROJ_LD = 2048;
constexpr int MC_POOL = 0, MC_HGRN = 256, MC_ATTN = 512;

constexpr size_t MiB = 1u << 20;
constexpr size_t WS_CTL = 0, CTL_ZERO_BYTES = 1 * MiB;
constexpr size_t WS_ROPE = 1 * MiB;
constexpr size_t WS_SSQ = 2 * MiB;
constexpr size_t WS_LB = 3 * MiB;
constexpr size_t WS_MASK = 4 * MiB;
constexpr size_t WS_WIN = 8 * MiB;
constexpr size_t WS_WOUT = 13 * MiB;
constexpr size_t WS_WFI = 15 * MiB;
constexpr size_t WS_WFO = 23 * MiB;
constexpr size_t WS_XB = 32 * MiB;
constexpr size_t WS_HID = 64 * MiB;
constexpr size_t WS_PROJ = 64 * MiB;
constexpr size_t WS_MIXED = 128 * MiB;
constexpr size_t WS_HST = 160 * MiB;
constexpr size_t WS_HDN = 176 * MiB;
constexpr size_t WS_QIHL = 192 * MiB;
constexpr size_t WS_KIHL = 208 * MiB;
constexpr size_t WS_WI = 212 * MiB;
constexpr size_t WS_VT = 224 * MiB;
constexpr size_t WS_WIN1 = 232 * MiB;
constexpr size_t WS_PWT = 245 * MiB;
constexpr size_t WS_END = 256 * MiB;
constexpr int CW_TMO = 0, CW_BAR = 4096;

namespace pg8 {
#define PG8_LAS __attribute__((address_space(3)))
typedef unsigned short bf16_t;
typedef short bf16x8 __attribute__((ext_vector_type(8)));
typedef float f32x4 __attribute__((ext_vector_type(4)));
typedef unsigned u32x4 __attribute__((ext_vector_type(4)));
constexpr int BM = 256, BK = 64, HALF = 128, HTB = HALF * BK * 2  , STAGE_BYTES = 8 * HTB, NXCD = 8, WGM = 8;

__host__ __device__ __forceinline__ int lds_byte(int r, int c) { const int st = (r >> 4) * 2 + (c >> 5), rr = r & 15, cc = c & 31, ob = rr * 64 + cc * 2; return st * 1024 + (ob ^ (((ob >> 9) & 1) << 5)); }
__host__ __device__ __forceinline__ void stage_rc(int b, int& R, int& C) { const int st = b / 1024, sb = b % 1024, swz = sb ^ (((sb >> 9) & 1) << 5); R = (st >> 1) * 16 + swz / 64; C = (st & 1) * 32 + (swz % 64) / 2; }
__host__ __device__ __forceinline__ int perm32(int rho) { const int n = rho >> 4, i = rho & 15; return 8 * (i >> 2) + 4 * n + (i & 3); }

struct Unit { int pm, pn; };
struct Gemm { const bf16_t* A; const bf16_t* Bt; int M, N, K; };

struct StaticOrder {
    int nM, nN, nwg, G, c;
    __host__ __device__ void init(int M, int N, int G_, int c_) { nM = M / BM; nN = N / BM; nwg = nM * nN; G = G_; c = c_; }
    __host__ __device__ __forceinline__ bool next(int i, Unit& u) const {
        const long L = (long)i * G + c; if (L >= nwg) return false;
        int wgid = (int)L; { const int q = nwg / NXCD, r = nwg % NXCD, xcd = wgid % NXCD, off = wgid / NXCD; wgid = (xcd < r ? xcd * (q + 1) : r * (q + 1) + (xcd - r) * q) + off; }
        const int nig = WGM * nN, gid = wgid / nig, fm = gid * WGM, gsz = (nM - fm) < WGM ? (nM - fm) : WGM;
        u.pm = fm + ((wgid % nig) % gsz); u.pn = (wgid % nig) / gsz; return true;
    }
    __device__ __forceinline__ void a_ready(const Unit&) const {}
    __device__ __forceinline__ void done(const Unit&) const {}
};

struct TabOrder {
    StaticOrder base; const float* ssq; PG8_LAS float* tab; int pm;
    __device__ __forceinline__ bool next(int i, Unit& u) const {
        if (i == 1 && pm >= 0) { int t_ = threadIdx.x; asm volatile("" : "+v"(t_));
            if (t_ < 256) { const __attribute__((address_space(1))) f32x4* p = (const __attribute__((address_space(1))) f32x4*)(ssq + ((size_t)pm * 256 + t_) * 16);
                const f32x4 a = p[0], b = p[1], c = p[2], d = p[3];
                const float s = ((a[0] + a[1]) + (a[2] + a[3])) + ((b[0] + b[1]) + (b[2] + b[3])) + ((c[0] + c[1]) + (c[2] + c[3])) + ((d[0] + d[1]) + (d[2] + d[3]));
                tab[t_] = 1.0f / sqrtf(s * (1.0f / 1024.0f) + 1e-5f); } }
        return base.next(i, u);
    }
    __device__ __forceinline__ void a_ready(const Unit&) const {}
    __device__ __forceinline__ void done(const Unit&) const {}
};

__device__ __forceinline__ unsigned cvt_pk_bf16(float lo, float hi) { unsigned r; asm volatile("v_cvt_pk_bf16_f32 %0, %1, %2" : "=v"(r) : "v"(lo), "v"(hi)); return r; }
typedef float f32x2 __attribute__((ext_vector_type(2)));

constexpr float RMS_EPS_F = 1e-5f;
#define PG8_GAS __attribute__((address_space(1)))
__device__ __forceinline__ float row_rstd(const float* ssq, int row) {
    const PG8_GAS f32x4* p = (const PG8_GAS f32x4*)(ssq + (size_t)row * 16);
    const f32x4 a = p[0], b = p[1], c = p[2], d = p[3];
    const float s = ((a[0] + a[1]) + (a[2] + a[3])) + ((b[0] + b[1]) + (b[2] + b[3])) + ((c[0] + c[1]) + (c[2] + c[3])) + ((d[0] + d[1]) + (d[2] + d[3]));
    return 1.0f / sqrtf(s * (1.0f / 1024.0f) + RMS_EPS_F);
}
struct RstdTab { const PG8_LAS float* tab; int pm; unsigned char* ws;
    __device__ __forceinline__ float get(int, int rloc) const { return tab[rloc]; } };
__constant__ float c_rot16[2][8] = {{-0.95765948f, -0.999246258f, 0.824376517f, 0.993200301f, 0.999744011f, 0.999990373f, 0.999999638f, 0.999999986f}, {-0.287903317f, 0.0388190063f, 0.566041835f, 0.116418045f, 0.0226254862f, 0.00438795693f, 0.000850927215f, 0.000165014163f}};
__constant__ float c_rot80[2][8] = {{-0.110387244f, -0.981213211f, -0.991153911f, 0.834587283f, 0.993606824f, 0.999759331f, 0.999990949f, 0.99999966f}, {-0.993888654f, 0.192926503f, 0.132717464f, 0.550875727f, 0.11289588f, 0.021938095f, 0.00425462375f, 0.000825070726f}};
__device__ __forceinline__ unsigned cvt_pk_rne(float lo, float hi) { typedef float f2 __attribute__((ext_vector_type(2))); typedef __bf16 b2 __attribute__((ext_vector_type(2))); f2 v = {lo, hi}; b2 b = __builtin_convertvector(v, b2); return __builtin_bit_cast(unsigned, b); }
struct EpiIn {
    static constexpr bool PERM = true, AFTER_DRAIN = false;
    unsigned char* ws; RstdTab rt;
    __device__ __forceinline__ void operator()(const f32x4 (&acc)[2][2][4][2], const Unit& u, int wr, int wc, int fr, int fq) const {
        bf16_t* const proj = (bf16_t*)(ws + WS_PROJ); bf16_t* const qi_hl = (bf16_t*)(ws + WS_QIHL); bf16_t* const ki_hl = (bf16_t*)(ws + WS_KIHL); float* const wi = (float*)(ws + WS_WI);
        bf16_t* const vT = (bf16_t*)(ws + WS_VT); const float* const rope = (const float*)(ws + WS_ROPE);
        const int rloc0 = wr * 64 + fr, row0 = u.pm * BM + rloc0, pn = u.pn;
        const bool rot_lane = ((wc & 1) == 0) && (fq < 2);
        const float sgn = (fq == 0) ? -1.f : 1.f;
        f32x4 c0 = {1.f, 1.f, 1.f, 1.f}, c1 = c0, s0 = {0.f, 0.f, 0.f, 0.f}, s1 = s0;
        if (pn >= 5) { const PG8_GAS f32x4* tp = (const PG8_GAS f32x4*)(rope + (size_t)row0 * 16); c0 = tp[0]; c1 = tp[1]; s0 = tp[2]; s1 = tp[3]; }
#pragma unroll
        for (int ai = 0; ai < 2; ++ai)
#pragma unroll
            for (int m = 0; m < 4; ++m) {
                const int row = row0 + ai * HALF + m * 16;
                const float rs = rt.get(u.pm, rloc0 + ai * HALF + m * 16);
#pragma unroll
                for (int bj = 0; bj < 2; ++bj) {
                    f32x4 v0 = acc[ai][bj][m][0] * rs, v1 = acc[ai][bj][m][1] * rs;
                    const bool rope_tile = (pn == 5) || (pn == 6) || (pn == 8) || (pn == 7 && bj == 0) || (pn == 9 && bj == 0 && wc < 2);
                    if (rope_tile) {
                        f32x4 p0, p1;
#pragma unroll
                        for (int e = 0; e < 4; ++e) { p0[e] = __shfl_xor(v0[e], 16); p1[e] = __shfl_xor(v1[e], 16); }
                        if (rot_lane) { v0 = v0 * c0 + (p0 * s0) * sgn; v1 = v1 * c1 + (p1 * s1) * sgn; }
                    }
                    const int cl = bj * HALF + wc * 32 + 8 * fq;
                    if (pn < 7 || (pn == 7 && bj == 0)) {
                        u32x4 w; w.x = cvt_pk_bf16(v0[0], v0[1]); w.y = cvt_pk_bf16(v0[2], v0[3]); w.z = cvt_pk_bf16(v1[0], v1[1]); w.w = cvt_pk_bf16(v1[2], v1[3]);
                        *(PG8_GAS u32x4*)(proj + (size_t)row * 2048 + pn * BM + cl) = w;
                    } else if (pn == 7) {
                        const int vc = cl - HALF, kvh = vc >> 6, d = vc & 63, b = row >> 11, t = row & 2047;
                        PG8_GAS bf16_t* o = (PG8_GAS bf16_t*)vT + ((size_t)((b * 2 + kvh) * 64 + d)) * 2048 + t;
                        const u32x4 w = (u32x4){cvt_pk_bf16(v0[0], v0[1]), cvt_pk_bf16(v0[2], v0[3]), cvt_pk_bf16(v1[0], v1[1]), cvt_pk_bf16(v1[2], v1[3])};
                        o[0 * 2048] = (bf16_t)(w.x & 0xffffu); o[1 * 2048] = (bf16_t)(w.x >> 16); o[2 * 2048] = (bf16_t)(w.y & 0xffffu); o[3 * 2048] = (bf16_t)(w.y >> 16);
                        o[4 * 2048] = (bf16_t)(w.z & 0xffffu); o[5 * 2048] = (bf16_t)(w.z >> 16); o[6 * 2048] = (bf16_t)(w.w & 0xffffu); o[7 * 2048] = (bf16_t)(w.w >> 16);
                    } else if (pn == 8) {
                        const u32x4 h = (u32x4){cvt_pk_bf16(v0[0], v0[1]), cvt_pk_bf16(v0[2], v0[3]), cvt_pk_bf16(v1[0], v1[1]), cvt_pk_bf16(v1[2], v1[3])};
                        *(PG8_GAS u32x4*)(qi_hl + (size_t)row * 512 + cl) = h;
                    } else if (bj == 0) {
                        if (wc < 2) { const u32x4 h = (u32x4){cvt_pk_bf16(v0[0], v0[1]), cvt_pk_bf16(v0[2], v0[3]), cvt_pk_bf16(v1[0], v1[1]), cvt_pk_bf16(v1[2], v1[3])}; *(PG8_GAS u32x4*)(ki_hl + (size_t)row * 128 + cl) = h; }
                        else if (wc == 2 && fq == 0) { *(PG8_GAS f32x4*)(wi + (size_t)row * 4) = v0; }
                    }
                }
                if (pn >= 5 && (ai * 4 + m) < 7) {
#pragma unroll
                    for (int e = 0; e < 4; ++e) {
                        const float dc0 = (m == 3) ? c_rot80[0][e] : c_rot16[0][e], ds0 = (m == 3) ? c_rot80[1][e] : c_rot16[1][e];
                        const float dc1 = (m == 3) ? c_rot80[0][4 + e] : c_rot16[0][4 + e], ds1 = (m == 3) ? c_rot80[1][4 + e] : c_rot16[1][4 + e];
                        const float a0 = c0[e], a1 = c1[e];
                        c0[e] = a0 * dc0 - s0[e] * ds0; s0[e] = s0[e] * dc0 + a0 * ds0;
                        c1[e] = a1 * dc1 - s1[e] * ds1; s1[e] = s1[e] * dc1 + a1 * ds1;
                    }
                }
            }
    }
};
struct EpiRes {
    static constexpr bool PERM = true, AFTER_DRAIN = false;
    const float* xin; float* xout; unsigned char* ws;
    __device__ __forceinline__ void operator()(const f32x4 (&acc)[2][2][4][2], const Unit& u, int wr, int wc, int fr, int fq) const {
        bf16_t* const xb = (bf16_t*)(ws + WS_XB); float* const ssq = (float*)(ws + WS_SSQ);
        const int row0 = u.pm * BM + wr * 64 + fr;
        const int colt = u.pn * BM + wc * 32 + 8 * fq;
        f32x4 cur[2][2], nxt[2][2];
#pragma unroll
        for (int bj = 0; bj < 2; ++bj) { const size_t off = (size_t)row0 * 1024 + colt + bj * HALF; cur[bj][0] = *(const PG8_GAS f32x4*)(xin + off); cur[bj][1] = *(const PG8_GAS f32x4*)(xin + off + 4); }
#pragma unroll
        for (int g = 0; g < 8; ++g) {
            const int ai = g >> 2, m = g & 3;
            const int row = row0 + ai * HALF + m * 16;
            if (g + 1 < 8) { const int rown = row0 + ((g + 1) >> 2) * HALF + ((g + 1) & 3) * 16;
#pragma unroll
                for (int bj = 0; bj < 2; ++bj) { const size_t off = (size_t)rown * 1024 + colt + bj * HALF; nxt[bj][0] = *(const PG8_GAS f32x4*)(xin + off); nxt[bj][1] = *(const PG8_GAS f32x4*)(xin + off + 4); } }
            float sq = 0.f;
#pragma unroll
            for (int bj = 0; bj < 2; ++bj) {
                const size_t off = (size_t)row * 1024 + colt + bj * HALF;
                const f32x4 v0 = cur[bj][0] + acc[ai][bj][m][0], v1 = cur[bj][1] + acc[ai][bj][m][1];
                *(PG8_GAS f32x4*)(xout + off) = v0; *(PG8_GAS f32x4*)(xout + off + 4) = v1;
                u32x4 w; w.x = cvt_pk_bf16(v0[0], v0[1]); w.y = cvt_pk_bf16(v0[2], v0[3]); w.z = cvt_pk_bf16(v1[0], v1[1]); w.w = cvt_pk_bf16(v1[2], v1[3]);
                *(PG8_GAS u32x4*)(xb + off) = w;
                sq += (v0[0] * v0[0] + v0[1] * v0[1]) + (v0[2] * v0[2] + v0[3] * v0[3]) + (v1[0] * v1[0] + v1[1] * v1[1]) + (v1[2] * v1[2] + v1[3] * v1[3]);
            }
            sq += __shfl_xor(sq, 16); sq += __shfl_xor(sq, 32);
            if (fq == 0) ((PG8_GAS float*)ssq)[(size_t)row * 16 + u.pn * 4 + wc] = sq;
#pragma unroll
            for (int bj = 0; bj < 2; ++bj) { cur[bj][0] = nxt[bj][0]; cur[bj][1] = nxt[bj][1]; }
        }
    }
};
struct EpiFfIn {
    static constexpr bool PERM = true, AFTER_DRAIN = false;
    RstdTab rt;
    __device__ __forceinline__ void operator()(const f32x4 (&acc)[2][2][4][2], const Unit& u, int wr, int wc, int fr, int fq) const {
        bf16_t* const hid = (bf16_t*)(rt.ws + WS_HID);
        const int row0 = u.pm * BM + wr * 64 + fr;
        const int colt = u.pn * BM + wc * 32 + 8 * fq;
#pragma unroll
        for (int ai = 0; ai < 2; ++ai)
#pragma unroll
            for (int m = 0; m < 4; ++m) {
                const int row = row0 + ai * HALF + m * 16;
                const float rs = rt.get(u.pm, wr * 64 + fr + ai * HALF + m * 16);
#pragma unroll
                for (int bj = 0; bj < 2; ++bj) {
                    f32x4 v0 = acc[ai][bj][m][0] * rs, v1 = acc[ai][bj][m][1] * rs;
#pragma unroll
                    for (int e = 0; e < 4; ++e) { const float a = fmaxf(v0[e], 0.f), b = fmaxf(v1[e], 0.f); v0[e] = a * a; v1[e] = b * b; }
                    u32x4 w; w.x = cvt_pk_bf16(v0[0], v0[1]); w.y = cvt_pk_bf16(v0[2], v0[3]); w.z = cvt_pk_bf16(v1[0], v1[1]); w.w = cvt_pk_bf16(v1[2], v1[3]);
                    *(PG8_GAS u32x4*)(hid + (size_t)row * 4096 + colt + bj * HALF) = w;
                }
            }
    }
};
template <class Epi, class Sched, bool ALIGN_EPI = false, bool SP2 = false>
__device__ __forceinline__ void gemm_phase(PG8_LAS unsigned char* lds, const Gemm g, const Sched& S, const Epi& E) {
    int tid_ = threadIdx.x; asm volatile("" : "+v"(tid_));
    const int tid = tid_, wid = __builtin_amdgcn_readfirstlane(tid >> 6), lane = tid & 63, wr = wid >> 2, wc = wid & 3, fr = lane & 15, fq = lane >> 4;
    const int K = g.K, nt = K / BK;
    unsigned voffA[2], voffB[2];
#pragma unroll
    for (int i = 0; i < 2; ++i) { int R, C; stage_rc(tid * 16 + i * 8192, R, C); const int Rb = Epi::PERM ? ((R & ~31) + perm32(R & 31)) : R;
        voffA[i] = (unsigned)(R * K + C) * 2u; voffB[i] = (unsigned)(Rb * K + C) * 2u; }
    const size_t kstep = (size_t)(BK * 2);
    const size_t hstep = (size_t)HALF * K * 2;
    const size_t tstep = 2 * hstep;
    const unsigned ldsw = (unsigned)wid * 1024u;
    const int aoff = lds_byte(wr * 64 + fr, fq * 8), boff = lds_byte(wc * 32 + fr, fq * 8);
#define PG8_SA(b, h) (((b) * 2 + (h)) * HTB)
#define PG8_SB(b, h) ((4 + (b) * 2 + (h)) * HTB)
#define PG8_STAGE(bufoff, gbase, voff) do { _Pragma("unroll") for (int _i = 0; _i < 2; ++_i) \
        __builtin_amdgcn_global_load_lds((const unsigned*)((const char*)(gbase) + (voff)[_i]), (PG8_LAS unsigned*)(lds + (bufoff) + ldsw + _i * 8192), 16, 0, 0); } while (0)
#define PG8_LDA(dst, b, h) do { _Pragma("unroll") for (int m = 0; m < 4; ++m) _Pragma("unroll") for (int k = 0; k < 2; ++k) dst[m][k] = *(const PG8_LAS bf16x8*)(lds + PG8_SA(b, h) + aoff + m * 2048 + k * 1024); } while (0)
#define PG8_LDB(dst, b, h) do { _Pragma("unroll") for (int n = 0; n < 2; ++n) _Pragma("unroll") for (int k = 0; k < 2; ++k) dst[n][k] = *(const PG8_LAS bf16x8*)(lds + PG8_SB(b, h) + boff + n * 2048 + k * 1024); } while (0)
#define PG8_MMA(ai, bj, At, Bt) do { __builtin_amdgcn_s_setprio(1); _Pragma("unroll") for (int m = 0; m < 4; ++m) _Pragma("unroll") for (int n = 0; n < 2; ++n) _Pragma("unroll") for (int k = 0; k < 2; ++k) \
        acc[ai][bj][m][n] = __builtin_amdgcn_mfma_f32_16x16x32_bf16(Bt[n][k], At[m][k], acc[ai][bj][m][n], 0, 0, 0); __builtin_amdgcn_s_setprio(0); } while (0)
#define PG8_WAIT_V(n) asm volatile("s_waitcnt vmcnt(" #n ")" ::: "memory")
#define PG8_WAIT_L(n) asm volatile("s_waitcnt lgkmcnt(" #n ")" ::: "memory")
#define PG8_BAR __builtin_amdgcn_s_barrier()
#define PG8_SCHED __builtin_amdgcn_sched_barrier(0)
    Unit cur, nxt; int ui = 0;
    if (!S.next(0, cur)) return;
    f32x4 acc[2][2][4][2];
#pragma unroll
    for (int a = 0; a < 2; ++a)
#pragma unroll
        for (int b = 0; b < 2; ++b)
#pragma unroll
            for (int m = 0; m < 4; ++m)
#pragma unroll
                for (int n = 0; n < 2; ++n) acc[a][b][m][n] = (f32x4){0.f, 0.f, 0.f, 0.f};
    bf16x8 At[4][2], B0[2][2], B1[2][2];
    const char* cA = (const char*)g.A + (size_t)cur.pm * tstep; const char* cB = (const char*)g.Bt + (size_t)cur.pn * tstep;
    S.a_ready(cur);
    if constexpr (SP2) {
        PG8_STAGE(PG8_SB(0, 0), cB, voffB); PG8_STAGE(PG8_SB(0, 1), cB + hstep, voffB); PG8_STAGE(PG8_SA(0, 0), cA, voffA); PG8_STAGE(PG8_SA(0, 1), cA + hstep, voffA);
        if (wr == 1) PG8_BAR;
        PG8_WAIT_V(2); PG8_BAR;
        PG8_STAGE(PG8_SB(1, 0), cB + kstep, voffB); PG8_STAGE(PG8_SA(1, 0), cA + kstep, voffA); PG8_STAGE(PG8_SB(1, 1), cB + hstep + kstep, voffB);
        PG8_WAIT_V(6); PG8_BAR;
    } else {
        PG8_STAGE(PG8_SB(0, 0), cB, voffB); PG8_STAGE(PG8_SA(0, 0), cA, voffA); PG8_STAGE(PG8_SB(0, 1), cB + hstep, voffB); PG8_STAGE(PG8_SA(0, 1), cA + hstep, voffA);
        if (wr == 1) PG8_BAR;
        PG8_WAIT_V(4); PG8_BAR;
        PG8_STAGE(PG8_SB(1, 0), cB + kstep, voffB); PG8_STAGE(PG8_SA(1, 0), cA + kstep, voffA); PG8_STAGE(PG8_SB(1, 1), cB + hstep + kstep, voffB);
        PG8_WAIT_V(6); PG8_BAR;
    }
    for (;;) {
        const bool has_next = S.next(ui + 1, nxt);
        const char* nA = has_next ? (const char*)g.A + (size_t)nxt.pm * tstep : cA; const char* nB = has_next ? (const char*)g.Bt + (size_t)nxt.pn * tstep : cB;
        for (int t = 0; t < nt; t += 2) {
            const bool last = (t == nt - 2);
            const char* a1 = cA + (size_t)(t + 1) * kstep;
            const char* a2 = last ? nA : cA + (size_t)(t + 2) * kstep; const char* b2 = last ? nB : cB + (size_t)(t + 2) * kstep;
            const char* a3 = a2 + kstep; const char* b3 = b2 + kstep;
            if (last && has_next) S.a_ready(nxt);
            if constexpr (SP2) {
            PG8_LDB(B0, 0, 0); PG8_LDB(B1, 0, 1); PG8_SCHED; PG8_LDA(At, 0, 0); PG8_STAGE(PG8_SA(1, 1), a1 + hstep, voffA);
            PG8_WAIT_V(8); PG8_WAIT_L(0); PG8_BAR; PG8_MMA(0, 0, At, B0); PG8_MMA(0, 1, At, B1); PG8_BAR; PG8_SCHED;
            PG8_LDA(At, 0, 1); PG8_STAGE(PG8_SB(0, 0), b2, voffB); PG8_STAGE(PG8_SB(0, 1), b2 + hstep, voffB); PG8_STAGE(PG8_SA(0, 0), a2, voffA);
            PG8_WAIT_V(8); PG8_WAIT_L(0); PG8_BAR; PG8_MMA(1, 0, At, B0); PG8_MMA(1, 1, At, B1); PG8_BAR; PG8_SCHED;
            PG8_LDB(B0, 1, 0); PG8_LDB(B1, 1, 1); PG8_SCHED; PG8_LDA(At, 1, 0); PG8_STAGE(PG8_SA(0, 1), a2 + hstep, voffA);
            PG8_WAIT_V(8); PG8_WAIT_L(0); PG8_BAR; PG8_MMA(0, 0, At, B0); PG8_MMA(0, 1, At, B1); PG8_BAR; PG8_SCHED;
            PG8_LDA(At, 1, 1); PG8_STAGE(PG8_SB(1, 0), b3, voffB); PG8_STAGE(PG8_SB(1, 1), b3 + hstep, voffB); PG8_STAGE(PG8_SA(1, 0), a3, voffA);
            PG8_WAIT_V(8); PG8_WAIT_L(0); PG8_BAR; PG8_MMA(1, 0, At, B0); PG8_MMA(1, 1, At, B1); PG8_BAR; PG8_SCHED;
            } else {
            PG8_LDB(B0, 0, 0); PG8_SCHED; PG8_LDA(At, 0, 0); PG8_STAGE(PG8_SA(1, 1), a1 + hstep, voffA);
            PG8_WAIT_L(8); PG8_BAR; PG8_WAIT_L(0); PG8_MMA(0, 0, At, B0); PG8_BAR; PG8_SCHED;
            PG8_LDB(B1, 0, 1); PG8_STAGE(PG8_SB(0, 0), b2, voffB);
            PG8_BAR; PG8_WAIT_L(0); PG8_MMA(0, 1, At, B1); PG8_BAR;
            PG8_LDA(At, 0, 1); PG8_STAGE(PG8_SA(0, 0), a2, voffA);
            PG8_BAR; PG8_WAIT_L(0); PG8_MMA(1, 0, At, B0); PG8_BAR; PG8_SCHED;
            PG8_STAGE(PG8_SB(0, 1), b2 + hstep, voffB);
            PG8_WAIT_V(6); PG8_BAR; PG8_MMA(1, 1, At, B1); PG8_BAR;
            PG8_LDB(B0, 1, 0); PG8_SCHED; PG8_LDA(At, 1, 0); PG8_STAGE(PG8_SA(0, 1), a2 + hstep, voffA);
            PG8_WAIT_L(8); PG8_BAR; PG8_WAIT_L(0); PG8_MMA(0, 0, At, B0); PG8_BAR; PG8_SCHED;
            PG8_LDB(B1, 1, 1); PG8_STAGE(PG8_SB(1, 0), b3, voffB);
            PG8_BAR; PG8_WAIT_L(0); PG8_MMA(0, 1, At, B1); PG8_BAR;
            PG8_LDA(At, 1, 1); PG8_STAGE(PG8_SA(1, 0), a3, voffA);
            PG8_BAR; PG8_WAIT_L(0); PG8_MMA(1, 0, At, B0); PG8_BAR; PG8_SCHED;
            PG8_STAGE(PG8_SB(1, 1), b3 + hstep, voffB);
            PG8_WAIT_V(6); PG8_BAR; PG8_MMA(1, 1, At, B1); PG8_BAR;
            }
        }
        if constexpr (ALIGN_EPI) { if (wr == 0) PG8_BAR; }
        if constexpr (!Epi::AFTER_DRAIN) { E(acc, cur, wr, wc, fr, fq); S.done(cur); }
        if (!has_next) break;
#pragma unroll
        for (int a = 0; a < 2; ++a)
#pragma unroll
            for (int b = 0; b < 2; ++b)
#pragma unroll
                for (int m = 0; m < 4; ++m)
#pragma unroll
                    for (int n = 0; n < 2; ++n) acc[a][b][m][n] = (f32x4){0.f, 0.f, 0.f, 0.f};
        cur = nxt; cA = nA; cB = nB; ++ui;
        if constexpr (ALIGN_EPI) { if (wr == 1) PG8_BAR; }
    }
    PG8_WAIT_V(0);
    if constexpr (!ALIGN_EPI) { if (wr == 0) PG8_BAR; }
    PG8_BAR;
    if constexpr (Epi::AFTER_DRAIN) { E.fused(acc, cur, wr, wc, fr, fq, lds, wid, lane); S.done(cur); }
#undef PG8_SA
#undef PG8_SB
#undef PG8_STAGE
#undef PG8_LDA
#undef PG8_LDB
#undef PG8_MMA
#undef PG8_WAIT_V
#undef PG8_WAIT_L
#undef PG8_BAR
#undef PG8_SCHED
}
}

constexpr int RING_OFF = 0, RING_BYTES = 131072;
constexpr int LDS_BYTES = 147456;
constexpr int LDSCTL_OFF = LDS_BYTES - 1024, MISC_OFF = LDSCTL_OFF + 320;

#define GAS __attribute__((address_space(1)))
#define LAS __attribute__((address_space(3)))
typedef unsigned short bf16;
typedef unsigned v4u __attribute__((ext_vector_type(4)));
typedef unsigned v2u __attribute__((ext_vector_type(2)));
typedef float f32x4 __attribute__((ext_vector_type(4)));
typedef GAS unsigned gu32;
#define RLX_AGENT __ATOMIC_RELAXED, __HIP_MEMORY_SCOPE_AGENT
#define LDS_WAIT() asm volatile("s_waitcnt lgkmcnt(0)" ::: "memory")
__device__ __forceinline__ unsigned f2bf(float f) { unsigned u = __builtin_bit_cast(unsigned, f); return (u + 0x7fffu + ((u >> 16) & 1u)) >> 16; }
__device__ __forceinline__ unsigned pk2(float lo, float hi) { return f2bf(lo) | (f2bf(hi) << 16); }
__device__ __forceinline__ float bf2f(unsigned short h) { return __builtin_bit_cast(float, (unsigned)h << 16); }
__device__ __forceinline__ float wave_sum(float v) {
#pragma unroll
    for (int o = 1; o < 64; o <<= 1) v += __shfl_xor(v, o);
    return v;
}
__device__ __forceinline__ float wave_max(float v) {
#pragma unroll
    for (int o = 1; o < 64; o <<= 1) v = fmaxf(v, __shfl_xor(v, o));
    return v;
}
#define XB_TMO      128
#define XB_XCNT(j)  (256  + 64 * (j))
#define XB_XSUB(j)  (1280 + 64 * (j))
#define XB_XGEN(j)  (2304 + 64 * (j))
#define XB_TOP      3328
#define XB_TOPGEN   3392
#define XCD_BAR_WORDS 3456
#define XB_SPIN_CAP (1u << 18)

__device__ __forceinline__ unsigned xb_ld(unsigned* p)              { return __hip_atomic_load(p, __ATOMIC_RELAXED, __HIP_MEMORY_SCOPE_AGENT); }
__device__ __forceinline__ unsigned xb_add(unsigned* p, unsigned v) { return __hip_atomic_fetch_add(p, v, __ATOMIC_RELAXED, __HIP_MEMORY_SCOPE_AGENT); }
__device__ __forceinline__ unsigned xb_xcc_id() { return (unsigned)__builtin_amdgcn_s_getreg((3 << 11) | 20) & 0xFu; }
#define XB_SPIN(cond, bar) do { unsigned _sp = 0; while (cond) { __builtin_amdgcn_s_sleep(1); \
    if ((++_sp & 255u) == 0u) { if (xb_ld(&(bar)[XB_TMO])) break; if (_sp > XB_SPIN_CAP) { atomicAdd(&(bar)[XB_TMO], 1u); break; } } } } while (0)

struct XcdBarrier {
    unsigned* bar; unsigned x;
    volatile LAS unsigned* st;
};

__device__ __forceinline__ XcdBarrier xcd_barrier_post(unsigned* bar, volatile LAS unsigned* st) {
    XcdBarrier b; b.bar = bar; b.x = xb_xcc_id(); b.st = st;
    if (threadIdx.x == 0) (void)xb_add(&bar[XB_XCNT(b.x)], 1u);
    return b;
}
__device__ __forceinline__ void xcd_barrier_complete(unsigned* bar, unsigned x, unsigned& nloc, unsigned& nx) {
    const unsigned G = gridDim.x * gridDim.y * gridDim.z;
    unsigned sum, cnt, mine, sp = 0u;
    for (;;) {
        sum = 0u; cnt = 0u; mine = 0u;
#pragma unroll
        for (unsigned j = 0; j < 16; ++j) { const unsigned c = xb_ld(&bar[XB_XCNT(j)]); sum += c; cnt += (c > 0u) ? 1u : 0u; mine = (j == x) ? c : mine; }
        if (sum == G) break;
        __builtin_amdgcn_s_sleep(1);
        if ((++sp & 255u) == 0u) { if (xb_ld(&bar[XB_TMO])) break; if (sp > XB_SPIN_CAP) { atomicAdd(&bar[XB_TMO], 1u); break; } }
    }
    nloc = mine > 0u ? mine : 1u; nx = cnt > 0u ? cnt : 1u;
}

__device__ __forceinline__ void xcd_barrier(const XcdBarrier& b) {
    asm volatile("s_waitcnt vmcnt(0)" ::: "memory");
    __syncthreads();
    if (threadIdx.x == 0) {
        unsigned* bar = b.bar;
        __builtin_amdgcn_s_waitcnt(0);
        unsigned nloc = b.st[0], nx = b.st[1];
        if (nloc == 0u) { xcd_barrier_complete(bar, b.x, nloc, nx); b.st[0] = nloc; b.st[1] = nx; }
        const unsigned old = xb_add(&bar[XB_XSUB(b.x)], 1u);
        const unsigned gen = old / nloc;
        if (old + 1u == (gen + 1u) * nloc) {
            __builtin_amdgcn_fence(__ATOMIC_RELEASE, "agent");
            asm volatile("s_waitcnt vmcnt(0)" ::: "memory");
            const unsigned og = xb_add(&bar[XB_TOP], 1u);
            const unsigned tg = og / nx;
            if (og + 1u == (tg + 1u) * nx) xb_add(&bar[XB_TOPGEN], 1u);
            else XB_SPIN(xb_ld(&bar[XB_TOPGEN]) == tg, bar);
            __builtin_amdgcn_fence(__ATOMIC_ACQUIRE, "agent");
            xb_add(&bar[XB_XGEN(b.x)], 1u);
            asm volatile("s_waitcnt vmcnt(0)" ::: "memory");
        } else {
            XB_SPIN(xb_ld(&bar[XB_XGEN(b.x)]) == gen, bar);
            __builtin_amdgcn_fence(__ATOMIC_ACQUIRE, "agent");
            asm volatile("s_waitcnt vmcnt(0)" ::: "memory");
        }
    }
    __syncthreads();
}


struct Frame {
    LAS unsigned char* lds;
    volatile LAS unsigned* MISC;
    gu32* ctl;
    int tid, lane, wave, G, bid;
    const float* x_in; const int* pos;
    const float *n1g, *w_in, *pool_w, *pool_scale, *lb_logits, *hgrn_g, *w_out, *n2g, *w_ff_in, *w_ff_out, *fng;
    float* xres;
    unsigned char* ws;
};
__constant__ float c_invf[8] = {1.0f, 0.19392274474868576f, 0.03760603093086393f, 0.007292664737217109f, 0.001414213562373095f, 0.0002742481756762073f, 5.318295896944988e-05f, 1.031338537721246e-05f};

typedef float f32x16 __attribute__((ext_vector_type(16)));
typedef short bf16x8v __attribute__((ext_vector_type(8)));
typedef float f32x2v __attribute__((ext_vector_type(2))); typedef __bf16 bf16x2v __attribute__((ext_vector_type(2)));
__device__ __forceinline__ unsigned cvtpk(float lo, float hi) { f32x2v v = {lo, hi}; bf16x2v b = __builtin_convertvector(v, bf16x2v); return __builtin_bit_cast(unsigned, b); }

__device__ __forceinline__ void cvt_item(const GAS float* W, const GAS float* g, int K, int N, bf16* WT, LAS float* scr, int kb, int nb, int lane) {
    const int k0 = 64 * kb, n0 = 32 * nb;
    const int n = n0 + (lane & 31);
    float v[32];
#pragma unroll
    for (int i = 0; i < 32; ++i) { const int kk = 2 * i + (lane >> 5); v[i] = (n < N) ? W[(size_t)(k0 + kk) * N + n] : 0.f; }
    const int c = lane & 7;
    f32x4 g0 = {1.f, 1.f, 1.f, 1.f}, g1 = g0;
    if (g) { g0 = *(const GAS f32x4*)(g + k0 + 8 * c); g1 = *(const GAS f32x4*)(g + k0 + 8 * c + 4); }
    __builtin_amdgcn_sched_barrier(0);
#pragma unroll
    for (int i = 0; i < 32; ++i) { const int kk = 2 * i + (lane >> 5); scr[kk * 33 + (lane & 31)] = v[i]; }
    LDS_WAIT(); asm volatile("" ::: "memory");
#pragma unroll
    for (int j = 0; j < 4; ++j) { const int nl = (lane >> 3) + 8 * j; const LAS float* sp = scr + (8 * c) * 33 + nl;
        v4u o; o.x = pk2(sp[0 * 33] * g0[0], sp[1 * 33] * g0[1]); o.y = pk2(sp[2 * 33] * g0[2], sp[3 * 33] * g0[3]); o.z = pk2(sp[4 * 33] * g1[0], sp[5 * 33] * g1[1]); o.w = pk2(sp[6 * 33] * g1[2], sp[7 * 33] * g1[3]);
        *(GAS v4u*)(WT + (size_t)(n0 + nl) * K + k0 + 8 * c) = o; }
    LDS_WAIT(); asm volatile("" ::: "memory");
}
__device__ __forceinline__ void cvt_matrix(Frame& F, const float* W_, const float* g_, int K, int N, int Npad, bf16* WT) {
    const GAS float* W = (const GAS float*)W_; const GAS float* g = (const GAS float*)g_;
    LAS float* scr = (LAS float*)(F.lds + RING_OFF + F.wave * 16384);
    const int gw = F.bid * NWAVES + F.wave, NGW = F.G * NWAVES;
    const int nblk = Npad / 32, nitems = (K / 64) * nblk;
    for (int it = gw; it < nitems; it += NGW) cvt_item(W, g, K, N, WT, scr, it / nblk, it % nblk, F.lane);
}
__device__ __forceinline__ void cvt_layer_rest(Frame& F, int layer, int gw, int NGW) {
    LAS float* scr = (LAS float*)(F.lds + RING_OFF + F.wave * 16384);
    constexpr int I0 = (DM / 64) * (DM / 32), I1 = (DM / 64) * (DFF / 32), I2 = (DFF / 64) * (DM / 32), I3 = (DM / 64) * (DINP / 32);
    const int total = I0 + I1 + I2 + ((layer + 1 < DEPTH) ? I3 : 0);
    for (int it = gw; it < total; it += NGW) {
        int r = it;
        if (r < I0) { cvt_item((const GAS float*)(F.w_out + (size_t)layer * DM * DM), nullptr, DM, DM, (bf16*)(F.ws + WS_WOUT), scr, r / (DM / 32), r % (DM / 32), F.lane); continue; } r -= I0;
        if (r < I1) { cvt_item((const GAS float*)(F.w_ff_in + (size_t)layer * DM * DFF), (const GAS float*)(F.n2g + layer * DM), DM, DFF, (bf16*)(F.ws + WS_WFI), scr, r / (DFF / 32), r % (DFF / 32), F.lane); continue; } r -= I1;
        if (r < I2) { cvt_item((const GAS float*)(F.w_ff_out + (size_t)layer * DFF * DM), nullptr, DFF, DM, (bf16*)(F.ws + WS_WFO), scr, r / (DM / 32), r % (DM / 32), F.lane); continue; } r -= I2;
        cvt_item((const GAS float*)(F.w_in + (size_t)(layer + 1) * DM * DIN), (const GAS float*)(F.n1g + (layer + 1) * DM), DM, DIN, (bf16*)(F.ws + (((layer + 1) & 1) ? WS_WIN1 : WS_WIN)), scr, r / (DINP / 32), r % (DINP / 32), F.lane);
    }
}

__device__ __forceinline__ void p_prologue(Frame& F) {
    const int gtid = F.bid * NTHR + F.tid, NT = F.G * NTHR;
    GAS float* tab = (GAS float*)(F.ws + WS_ROPE);
    for (int idx = gtid; idx < M * 8; idx += NT) {
        const int row = idx >> 3, i = idx & 7;
        const float angf = (float)((const GAS int*)F.pos)[row] * c_invf[i];
        double r = (double)angf * 0.15915494309189535; r -= floor(r);
        const float a = (float)(r * 6.283185307179586);
        tab[row * 16 + i] = cosf(a); tab[row * 16 + 8 + i] = sinf(a);
    }
    if (gtid < 256) {
        const int c = gtid; GAS float* lb = (GAS float*)(F.ws + WS_LB); const GAS float* lbl = (const GAS float*)F.lb_logits;
        const float l0 = lbl[c], l1 = lbl[256 + c], l2 = lbl[512 + c], l3 = lbl[768 + c];
        const float mx = fmaxf(fmaxf(l0, l1), fmaxf(l2, l3));
        const float e0 = expf(l0 - mx), e1 = expf(l1 - mx), e2 = expf(l2 - mx), e3 = expf(l3 - mx);
        const float inv = 1.0f / (e0 + e1 + e2 + e3);
        lb[c] = 0.f; lb[256 + c] = e1 * inv; lb[512 + c] = (e1 + e2) * inv; lb[768 + c] = (e1 + e2 + e3) * inv;
    }
    const int gw = F.bid * NWAVES + F.wave, NGW = F.G * NWAVES;
    GAS bf16* xb = (GAS bf16*)(F.ws + WS_XB); GAS float* ssq = (GAS float*)(F.ws + WS_SSQ);
    for (int row0 = gw * 4; row0 < M; row0 += NGW * 4) {
        f32x4 v[4][4]; float sq[4];
#pragma unroll
        for (int rr = 0; rr < 4; ++rr) { const GAS f32x4* xr = (const GAS f32x4*)(F.x_in + (size_t)(row0 + rr) * DM) + F.lane;
#pragma unroll
            for (int j = 0; j < 4; ++j) v[rr][j] = xr[64 * j]; }
#pragma unroll
        for (int rr = 0; rr < 4; ++rr) { float a = 0.f;
#pragma unroll
            for (int j = 0; j < 4; ++j) a += (v[rr][j][0] * v[rr][j][0] + v[rr][j][1] * v[rr][j][1]) + (v[rr][j][2] * v[rr][j][2] + v[rr][j][3] * v[rr][j][3]);
            sq[rr] = a; }
#pragma unroll
        for (int o = 1; o < 64; o <<= 1)
#pragma unroll
            for (int rr = 0; rr < 4; ++rr) sq[rr] += __shfl_xor(sq[rr], o);
#pragma unroll
        for (int rr = 0; rr < 4; ++rr) {
            GAS unsigned long long* o8 = (GAS unsigned long long*)(xb + (size_t)(row0 + rr) * DM) + F.lane;
#pragma unroll
            for (int j = 0; j < 4; ++j) o8[64 * j] = (unsigned long long)pk2(v[rr][j][0], v[rr][j][1]) | ((unsigned long long)pk2(v[rr][j][2], v[rr][j][3]) << 32);
            if (F.lane < 16) ssq[(size_t)(row0 + rr) * 16 + F.lane] = (F.lane == 0) ? sq[rr] : 0.f;
        }
    }
    cvt_matrix(F, F.w_in, F.n1g, DM, DIN, DINP, (bf16*)(F.ws + WS_WIN));
    { GAS bf16* pwt = (GAS bf16*)(F.ws + WS_PWT); const GAS float* pw = (const GAS float*)F.pool_w;
      for (int e = gtid; e < DEPTH * 4 * 64 * 64; e += NT) { const int lg = e >> 12, d = (e >> 6) & 63, c = e & 63; pwt[e] = (bf16)f2bf(pw[(size_t)lg * 4096 + c * 64 + d]); } }
}

constexpr int PW_ROW = 72;
template <int WIN> __device__ __forceinline__ void pool_core64(const GAS bf16* up, int tl0, LAS unsigned short* Pc) {
#pragma unroll
    for (int hf = 0; hf < 2; ++hf) {
        float uv[48];
#pragma unroll
        for (int i = 0; i < 48; ++i) { const int tl = tl0 + 32 * hf - 16 + i; uv[i] = (tl >= 0) ? bf2f(up[(long)(32 * hf + i - 16) * PROJ_LD]) : 0.f; }
        __builtin_amdgcn_sched_barrier(0);
        float ps[49]; ps[0] = 0.f;
#pragma unroll
        for (int i = 0; i < 48; ++i) ps[i + 1] = ps[i] + uv[i];
#pragma unroll
        for (int i = 16; i < 48; ++i) {
            const int tl = tl0 + 32 * hf - 16 + i; const int cnt = (tl + 1 < WIN) ? tl + 1 : WIN;
            const float mean = (ps[i + 1] - ps[i + 1 - WIN]) / (float)cnt;
            Pc[(32 * hf + i - 16) * PW_ROW] = (unsigned short)f2bf(mean - uv[i]);
        }
    }
}
__device__ __forceinline__ void p_pool_wave(Frame& F, int layer, int wv_, int NWV) {
    const int lane = F.lane, fr = lane & 15, kg = lane >> 4;
    LAS unsigned short* P = (LAS unsigned short*)(F.lds + RING_OFF + F.wave * 16384);
    const GAS bf16* proj = (const GAS bf16*)(F.ws + WS_PROJ); GAS bf16* mixed = (GAS bf16*)(F.ws + WS_MIXED);
    const GAS bf16* pwt = (const GAS bf16*)(F.ws + WS_PWT) + (size_t)layer * 4 * 64 * 64; const GAS float* ps_ = (const GAS float*)F.pool_scale + layer * 256;
    for (int unit = wv_ * F.G + F.bid; unit < (M / 64) * 4; unit += NWV * F.G) {
        const int tile = unit >> 2, g = unit & 3, t0 = tile * 64;
        bf16x8v bfr[4][2];
#pragma unroll
        for (int db = 0; db < 4; ++db)
#pragma unroll
            for (int ks = 0; ks < 2; ++ks) bfr[db][ks] = *(const GAS bf16x8v*)(pwt + ((size_t)(g * 64 + 16 * db + fr)) * 64 + 32 * ks + 8 * kg);
        { const GAS bf16* up = proj + (size_t)t0 * PROJ_LD + PC_POOL + g * 64 + lane; LAS unsigned short* Pc = P + lane; const int tl0 = t0 & (SEQ - 1);
          if (g == 0) pool_core64<2>(up, tl0, Pc); else if (g == 1) pool_core64<4>(up, tl0, Pc); else if (g == 2) pool_core64<8>(up, tl0, Pc); else pool_core64<16>(up, tl0, Pc); }
        LDS_WAIT(); asm volatile("" ::: "memory");
#pragma unroll
        for (int tb = 0; tb < 4; ++tb) {
            bf16x8v af[2];
#pragma unroll
            for (int ks = 0; ks < 2; ++ks) af[ks] = *(const LAS bf16x8v*)(P + (16 * tb + fr) * PW_ROW + 32 * ks + 8 * kg);
#pragma unroll
            for (int db = 0; db < 4; ++db) {
                f32x4 acc = {0.f, 0.f, 0.f, 0.f};
#pragma unroll
                for (int ks = 0; ks < 2; ++ks) acc = __builtin_amdgcn_mfma_f32_16x16x32_bf16(af[ks], bfr[db][ks], acc, 0, 0, 0);
                const int dcol = g * 64 + 16 * db + fr; const float sc = ps_[dcol];
                GAS bf16* op = mixed + (size_t)(t0 + 16 * tb + 4 * kg) * DM + MC_POOL + dcol;
#pragma unroll
                for (int r = 0; r < 4; ++r) op[(size_t)r * DM] = (bf16)f2bf(acc[r] * sc);
            }
        }
        LDS_WAIT(); asm volatile("" ::: "memory");
    }
}

__device__ __forceinline__ unsigned sort_key(float v) { if (v == 0.f) v = 0.f; const unsigned u = __builtin_bit_cast(unsigned, v); return (u & 0x80000000u) ? ~u : (u | 0x80000000u); }
__device__ __forceinline__ unsigned wave_total6(unsigned x) {
    unsigned t = 0;
#pragma unroll
    for (int b = 0; b < 6; ++b) t += (unsigned)__popcll(__ballot((x >> b) & 1u)) << b;
    return t;
}
template <int NI> __device__ __forceinline__ void emit_mask(const unsigned (&k)[NI], unsigned prefix, bool exact, GAS unsigned* mrow, int lane) {
    if (exact) {
#pragma unroll
        for (int i = 0; i < NI; ++i) { const unsigned long long sb = __ballot(k[i] >= prefix); if (lane == 0) *(GAS v2u*)(mrow + 2 * i) = (v2u){(unsigned)sb, (unsigned)(sb >> 32)}; }
    } else {
        const unsigned tau = prefix; unsigned c = 0u;
#pragma unroll
        for (int i = 0; i < NI; ++i) c += (unsigned)(k[i] > tau);
        const unsigned need = (unsigned)TOPK - wave_total6(c); unsigned base = 0u;
#pragma unroll
        for (int i = 0; i < NI; ++i) {
            const unsigned long long eqb = __ballot(k[i] == tau);
            const unsigned rank = base + (unsigned)__popcll(eqb & ((1ull << lane) - 1ull));
            const unsigned long long sb = __ballot((k[i] > tau) || ((k[i] == tau) && (rank < need)));
            if (lane == 0) *(GAS v2u*)(mrow + 2 * i) = (v2u){(unsigned)sb, (unsigned)(sb >> 32)};
            base += (unsigned)__popcll(eqb);
        }
    }
    if (NI < 32) { if (lane < 2 * (32 - NI)) mrow[2 * NI + lane] = 0u; }
}
__device__ __forceinline__ unsigned wave_max_u32(unsigned v) {
#pragma unroll
    for (int o = 1; o < 64; o <<= 1) { const unsigned t = (unsigned)__shfl_xor((int)v, o); v = v > t ? v : t; }
    return v;
}
template <int NI> __device__ __forceinline__ unsigned count_ge(const unsigned (&k)[NI], unsigned cand) {
    unsigned t = 0u;
#pragma unroll
    for (int i0 = 0; i0 < NI; i0 += 8) {
        unsigned long long mk[8];
#pragma unroll
        for (int i = 0; i < 8; ++i) mk[i] = __ballot(k[i0 + i] >= cand);
        __builtin_amdgcn_sched_barrier(0);
        unsigned t1 = 0u;
#pragma unroll
        for (int i = 0; i < 8; i += 2) { t += (unsigned)__popcll(mk[i]); t1 += (unsigned)__popcll(mk[i + 1]); }
        t += t1;
        __builtin_amdgcn_sched_barrier(0);
    }
    return t;
}
template <int NI> __device__ __forceinline__ void select2(const LAS unsigned* ka_, const LAS unsigned* kb_, int nk, GAS unsigned* mrowA, GAS unsigned* mrowB, int lane) {
    unsigned ka[NI], kb[NI];
#pragma unroll
    for (int i = 0; i < NI; ++i) { const int sidx = lane + 64 * i; ka[i] = (sidx < nk) ? ka_[sidx] : 0u; kb[i] = (sidx < nk) ? kb_[sidx] : 0u; }
    unsigned ma = 0u, mb = 0u;
#pragma unroll
    for (int i = 0; i < NI; ++i) { ma = ka[i] > ma ? ka[i] : ma; mb = kb[i] > mb ? kb[i] : mb; }
    ma = (unsigned)__builtin_amdgcn_readfirstlane((int)wave_max_u32(ma)); mb = (unsigned)__builtin_amdgcn_readfirstlane((int)wave_max_u32(mb));
    unsigned pa = 0u, pb = 0u; bool ea = false, eb = false;
    for (int bit = 31; bit >= 0; --bit) {
        const unsigned ca = pa | (1u << bit), cb = pb | (1u << bit);
        if (!ea && ca <= ma) { const unsigned ta = count_ge<NI>(ka, ca); if (ta >= (unsigned)TOPK) { pa = ca; ea = (ta == (unsigned)TOPK); } }
        if (!eb && cb <= mb) { const unsigned tb = count_ge<NI>(kb, cb); if (tb >= (unsigned)TOPK) { pb = cb; eb = (tb == (unsigned)TOPK); } }
        if (ea && eb) break;
    }
    emit_mask<NI>(ka, pa, ea, mrowA, lane);
    emit_mask<NI>(kb, pb, eb, mrowB, lane);
}
constexpr int MK_STRIDE = 2049;
__device__ __forceinline__ void p_mask(Frame& F) {
    LAS unsigned* keys = (LAS unsigned*)(F.lds + RING_OFF);
    const GAS bf16* qi_hl = (const GAS bf16*)(F.ws + WS_QIHL); const GAS bf16* ki_hl = (const GAS bf16*)(F.ws + WS_KIHL); const GAS float* wi = (const GAS float*)(F.ws + WS_WI); GAS unsigned* mask = (GAS unsigned*)(F.ws + WS_MASK);
    const int tid = F.tid, lane = F.lane, wave = F.wave, q = lane & 15, kg = lane >> 4;
#define MK_UNIT_PARAMS(ui_, b_, qb_) const int b_ = (c >> 6) * 2 + ((ui_) >> 1), qb_ = ((ui_) & 1) ? 127 - (c & 63) : (c & 63)
#define MK_UNIT_LOAD(b_, qb_, BH, WV, AH) do { const size_t rq_ = (size_t)(b_) * SEQ + (qb_) * 16 + q; \
        _Pragma("unroll") for (int h = 0; h < 4; ++h) _Pragma("unroll") for (int dh = 0; dh < 2; ++dh) BH[h][dh] = *(const GAS bf16x8v*)(qi_hl + rq_ * 512 + h * 64 + dh * 32 + kg * 8); \
        WV = *(const GAS f32x4*)(wi + rq_ * 4); \
        { const int kt0_ = wave < (qb_) + 1 ? wave : 0; \
          _Pragma("unroll") for (int dh = 0; dh < 2; ++dh) AH[dh] = *(const GAS bf16x8v*)(ki_hl + ((size_t)(b_) * SEQ + kt0_ * 16 + q) * 128 + dh * 32 + kg * 8); } } while (0)
    for (int c = F.bid; c < 256; c += F.G) {
        bf16x8v bh[4][2], bhn[4][2]; f32x4 wv, wvn; bf16x8v ah[2], ahq[2];
        { MK_UNIT_PARAMS(0, b0_, qb0_); MK_UNIT_LOAD(b0_, qb0_, bh, wv, ah); }
        for (int ui = 0; ui < 4; ++ui) {
            MK_UNIT_PARAMS(ui, b, qb);
            const int t0 = qb * 16; const size_t rowq0 = (size_t)b * SEQ + t0;
            const int uin = ui < 3 ? ui + 1 : 3;
            MK_UNIT_PARAMS(uin, bnx, qbnx);
            if (qb < 16) {
                for (int w = tid; w < 1024; w += NTHR) { const int qq = w >> 6, j = w & 63, n = t0 + qq + 1, lo = j * 32;
                    mask[(rowq0 + qq) * 64 + j] = (n >= lo + 32) ? 0xffffffffu : (n > lo ? ((1u << (n - lo)) - 1u) : 0u); }
                MK_UNIT_LOAD(bnx, qbnx, bh, wv, ah);
                continue;
            }
            const int ntile = qb + 1;
            for (int kt = wave; kt < ntile; kt += NWAVES) {
                const int s0 = kt * 16;
                bf16x8v ahn[2];
                { const int ktn = (kt + NWAVES < ntile) ? kt + NWAVES : kt;
#pragma unroll
                  for (int dh = 0; dh < 2; ++dh) { const GAS bf16* pk = ki_hl + ((size_t)b * SEQ + ktn * 16 + q) * 128 + dh * 32 + kg * 8;
                      ahn[dh] = *(const GAS bf16x8v*)pk; } }
                __builtin_amdgcn_sched_barrier(0);
                f32x4 acc[4];
#pragma unroll
                for (int h = 0; h < 4; ++h) { acc[h] = (f32x4){0.f, 0.f, 0.f, 0.f};
#pragma unroll
                    for (int dh = 0; dh < 2; ++dh) {
                        acc[h] = __builtin_amdgcn_mfma_f32_16x16x32_bf16(ah[dh], bh[h][dh], acc[h], 0, 0, 0);
                    } }
#pragma unroll
                for (int r = 0; r < 4; ++r) {
                    const float I = wv[0] * fmaxf(acc[0][r], 0.f) + wv[1] * fmaxf(acc[1][r], 0.f) + wv[2] * fmaxf(acc[2][r], 0.f) + wv[3] * fmaxf(acc[3][r], 0.f);
                    const int s = s0 + 4 * kg + r;
                    keys[q * MK_STRIDE + s] = (s <= t0 + q) ? sort_key(I) : 0u;
                }
                __builtin_amdgcn_sched_barrier(0);
#pragma unroll
                for (int dh = 0; dh < 2; ++dh) ah[dh] = ahn[dh];
            }
            MK_UNIT_LOAD(bnx, qbnx, bhn, wvn, ahq);
            __syncthreads();
            const int nk = t0 + 16;
            { const LAS unsigned* kA = keys + (2 * wave) * MK_STRIDE; const LAS unsigned* kB = kA + MK_STRIDE;
              GAS unsigned* mA = mask + (rowq0 + 2 * wave) * 64; GAS unsigned* mB = mA + 64;
              if (nk <= 512) select2<8>(kA, kB, nk, mA, mB, lane);
              else if (nk <= 1024) select2<16>(kA, kB, nk, mA, mB, lane);
              else if (nk <= 1536) select2<24>(kA, kB, nk, mA, mB, lane);
              else select2<32>(kA, kB, nk, mA, mB, lane); }
#pragma unroll
            for (int h = 0; h < 4; ++h) { bh[h][0] = bhn[h][0]; bh[h][1] = bhn[h][1]; }
            wv = wvn; ah[0] = ahq[0]; ah[1] = ahq[1];
            __syncthreads();
        }
    }
#undef MK_UNIT_PARAMS
#undef MK_UNIT_LOAD
}

typedef short s16x4 __attribute__((ext_vector_type(4)));
#define MFMA16(a, b, c) __builtin_amdgcn_mfma_f32_16x16x16bf16_1k((a), (b), (c), 0, 0, 0)
__device__ __forceinline__ s16x4 pack4(const f32x4 v) { v2u t; t.x = cvtpk(v[0], v[1]); t.y = cvtpk(v[2], v[3]); return __builtin_bit_cast(s16x4, t); }
constexpr int HG_QT = 0, HG_KT = 2176, HG_KH = 4352, HG_IT = 7424, HG_DF = 10496, HG_WAVE_LDS = 10752;
struct HgRaw { unsigned short z[16], i[16], q[16]; };
template <bool FULL> __device__ __forceinline__ void hgrn_load(const GAS bf16* pr, HgRaw& R) {
#pragma unroll
    for (int s_ = 0; s_ < 16; ++s_) { R.z[s_] = pr[(size_t)s_ * PROJ_LD + PC_HF]; R.i[s_] = pr[(size_t)s_ * PROJ_LD + PC_HI]; if (FULL) R.q[s_] = pr[(size_t)s_ * PROJ_LD + PC_HQ]; }
}
template <bool FULL> __device__ __forceinline__ float hgrn_stage(const HgRaw& R, float lbv, LAS unsigned char* W, int lane) {
    const unsigned short (&zr)[16] = R.z; const unsigned short (&ir)[16] = R.i; const unsigned short (&qr)[16] = R.q;
    float f[16], kk[16]; float P = 1.0f;
    LAS unsigned short* QT = (LAS unsigned short*)(W + HG_QT); LAS unsigned short* KT = (LAS unsigned short*)(W + HG_KT);
#pragma unroll
    for (int s_ = 0; s_ < 16; ++s_) {
        const float z = bf2f(zr[s_]);
        const float sig = 1.0f / (1.0f + __expf(-z));
        f[s_] = fmaxf(lbv + (1.0f - lbv) * sig, 1e-30f); kk[s_] = (1.0f - lbv) * (1.0f - sig);
        P *= f[s_];
        if (FULL) { const float q = bf2f(qr[s_]); const float qs = q / (1.0f + __expf(-q));
            QT[s_ * 68 + lane] = (unsigned short)f2bf(qs * P); KT[s_ * 68 + lane] = (unsigned short)f2bf(kk[s_] / fmaxf(P, 1e-30f)); }
    }
    float E = 1.0f; unsigned kh[8];
#pragma unroll
    for (int s_ = 15; s_ >= 0; s_ -= 2) {
        const float hi = kk[s_] * E; E *= f[s_];
        const float lo = kk[s_ - 1] * E; E *= f[s_ - 1];
        kh[s_ >> 1] = cvtpk(lo, hi);
    }
    LAS v4u* KH = (LAS v4u*)(W + HG_KH + lane * 48); LAS v4u* IT = (LAS v4u*)(W + HG_IT + lane * 48);
    KH[0] = (v4u){kh[0], kh[1], kh[2], kh[3]}; KH[1] = (v4u){kh[4], kh[5], kh[6], kh[7]};
    IT[0] = (v4u){(unsigned)ir[0] | ((unsigned)ir[1] << 16), (unsigned)ir[2] | ((unsigned)ir[3] << 16), (unsigned)ir[4] | ((unsigned)ir[5] << 16), (unsigned)ir[6] | ((unsigned)ir[7] << 16)};
    IT[1] = (v4u){(unsigned)ir[8] | ((unsigned)ir[9] << 16), (unsigned)ir[10] | ((unsigned)ir[11] << 16), (unsigned)ir[12] | ((unsigned)ir[13] << 16), (unsigned)ir[14] | ((unsigned)ir[15] << 16)};
    ((LAS float*)(W + HG_DF))[lane] = P;
    return P;
}
__device__ __forceinline__ void hgrn_update(f32x4 (&S)[4][4], const LAS unsigned char* W, int fr, int kg) {
    s16x4 khf[4], itf[4]; f32x4 df[4];
#pragma unroll
    for (int i = 0; i < 4; ++i) { khf[i] = *(const LAS s16x4*)(W + HG_KH + (16 * i + fr) * 48 + 8 * kg); itf[i] = *(const LAS s16x4*)(W + HG_IT + (16 * i + fr) * 48 + 8 * kg);
        df[i] = *(const LAS f32x4*)(W + HG_DF + (16 * i + 4 * kg) * 4); }
#pragma unroll
    for (int kb = 0; kb < 4; ++kb)
#pragma unroll
        for (int vb = 0; vb < 4; ++vb) S[kb][vb] = MFMA16(khf[kb], itf[vb], S[kb][vb] * df[kb]);
}
__device__ __forceinline__ void p_hgrn_local(Frame& F, int layer) {
    const int lane = F.lane, fr = lane & 15, kg = lane >> 4;
    LAS unsigned char* W = F.lds + RING_OFF + F.wave * 16384;
    const GAS bf16* proj = (const GAS bf16*)(F.ws + WS_PROJ); GAS float* hst = (GAS float*)(F.ws + WS_HST); GAS float* hdn = (GAS float*)(F.ws + WS_HDN);
    for (int unit = F.wave * F.G + F.bid; unit < BATCH * 4 * (SEQ / 64); unit += NWAVES * F.G) {
        const int bh = unit >> 5, chunk = unit & 31, b = bh >> 2, h = bh & 3;
        const float lbv = ((const GAS float*)(F.ws + WS_LB))[layer * 256 + h * 64 + lane];
        const size_t row0 = (size_t)b * SEQ + chunk * 64;
        f32x4 S[4][4];
#pragma unroll
        for (int i = 0; i < 4; ++i)
#pragma unroll
            for (int j = 0; j < 4; ++j) S[i][j] = (f32x4){0.f, 0.f, 0.f, 0.f};
        float dprod = 1.0f;
        HgRaw R;
        hgrn_load<false>(proj + row0 * PROJ_LD + h * 64 + lane, R);
        for (int sub = 0; sub < 4; ++sub) {
            dprod *= hgrn_stage<false>(R, lbv, W, lane);
            { const int sn = sub < 3 ? sub + 1 : 3; hgrn_load<false>(proj + (row0 + sn * 16) * PROJ_LD + h * 64 + lane, R); }
            LDS_WAIT(); asm volatile("" ::: "memory");
            hgrn_update(S, W, fr, kg);
            LDS_WAIT(); asm volatile("" ::: "memory");
        }
        GAS float* U = hst + (size_t)unit * 4096;
#pragma unroll
        for (int kb = 0; kb < 4; ++kb)
#pragma unroll
            for (int vb = 0; vb < 4; ++vb)
#pragma unroll
                for (int r = 0; r < 4; ++r) U[(16 * kb + 4 * kg + r) * 64 + 16 * vb + fr] = S[kb][vb][r];
        hdn[unit * 64 + lane] = dprod;
    }
}
__device__ __forceinline__ void p_hgrn_scan(Frame& F) {
    GAS float* hst = (GAS float*)(F.ws + WS_HST); const GAS float* hdn = (const GAS float*)(F.ws + WS_HDN);
    for (int e = F.bid * NTHR + F.tid; e < BATCH * 4 * 4096; e += F.G * NTHR) {
        const int bh = e >> 12, kv = e & 4095, k = kv >> 6;
        float S = 0.f;
        for (int n = 0; n < SEQ / 64; ++n) {
            const size_t idx = ((size_t)(bh * 32 + n) << 12) + kv;
            const float u = hst[idx]; hst[idx] = S;
            S = hdn[(bh * 32 + n) * 64 + k] * S + u;
        }
    }
}
constexpr int HG_LDS_OFF = 40960;
__device__ __forceinline__ void p_hgrn_out(Frame& F, int layer) {
    const int lane = F.lane, fr = lane & 15, kg = lane >> 4;
    LAS unsigned char* W = F.lds + RING_OFF + HG_LDS_OFF + F.wave * HG_WAVE_LDS;
    const GAS bf16* proj = (const GAS bf16*)(F.ws + WS_PROJ); GAS bf16* mixed = (GAS bf16*)(F.ws + WS_MIXED); const GAS float* hst = (const GAS float*)(F.ws + WS_HST);
    for (int unit = F.wave * F.G + F.bid; unit < BATCH * 4 * (SEQ / 64); unit += NWAVES * F.G) {
        const int bh = unit >> 5, chunk = unit & 31, b = bh >> 2, h = bh & 3;
        const float lbv = ((const GAS float*)(F.ws + WS_LB))[layer * 256 + h * 64 + lane];
        const size_t row0 = (size_t)b * SEQ + chunk * 64;
        f32x4 S[4][4];
        { const GAS float* U = hst + (size_t)unit * 4096;
#pragma unroll
          for (int kb = 0; kb < 4; ++kb)
#pragma unroll
              for (int vb = 0; vb < 4; ++vb)
#pragma unroll
                  for (int r = 0; r < 4; ++r) S[kb][vb][r] = U[(16 * kb + 4 * kg + r) * 64 + 16 * vb + fr]; }
        f32x4 ng4[4];
#pragma unroll
        for (int vb = 0; vb < 4; ++vb) ng4[vb] = *(const GAS f32x4*)((const GAS float*)F.hgrn_g + layer * 256 + h * 64 + 16 * vb + 4 * kg);
        for (int sub = 0; sub < 4; ++sub) {
            const size_t rs = row0 + sub * 16;
            { HgRaw R; hgrn_load<true>(proj + rs * PROJ_LD + h * 64 + lane, R); __builtin_amdgcn_sched_barrier(0); (void)hgrn_stage<true>(R, lbv, W, lane); }
            v2u g2[4];
#pragma unroll
            for (int vb = 0; vb < 4; ++vb) g2[vb] = *(const GAS v2u*)(proj + (rs + fr) * PROJ_LD + PC_HG + h * 64 + 16 * vb + 4 * kg);
            LDS_WAIT(); asm volatile("" ::: "memory");
            s16x4 qb[4];
#pragma unroll
            for (int kb = 0; kb < 4; ++kb) qb[kb] = *(const LAS s16x4*)(W + HG_QT + (fr * 68 + 16 * kb + 4 * kg) * 2);
            f32x4 o[4];
#pragma unroll
            for (int vb = 0; vb < 4; ++vb) { o[vb] = (f32x4){0.f, 0.f, 0.f, 0.f};
#pragma unroll
                for (int kb = 0; kb < 4; ++kb) o[vb] = MFMA16(pack4(S[kb][vb]), qb[kb], o[vb]); }
            f32x4 at = {0.f, 0.f, 0.f, 0.f};
#pragma unroll
            for (int kb = 0; kb < 4; ++kb) at = MFMA16(*(const LAS s16x4*)(W + HG_KT + (fr * 68 + 16 * kb + 4 * kg) * 2), qb[kb], at);
#pragma unroll
            for (int r = 0; r < 4; ++r) if (4 * kg + r > fr) at[r] = 0.f;
            const s16x4 ab = pack4(at);
#pragma unroll
            for (int vb = 0; vb < 4; ++vb) o[vb] = MFMA16(*(const LAS s16x4*)(W + HG_IT + (16 * vb + fr) * 48 + 8 * kg), ab, o[vb]);
            hgrn_update(S, W, fr, kg);
            float ssq = 0.f;
#pragma unroll
            for (int vb = 0; vb < 4; ++vb) ssq += (o[vb][0] * o[vb][0] + o[vb][1] * o[vb][1]) + (o[vb][2] * o[vb][2] + o[vb][3] * o[vb][3]);
            ssq += __shfl_xor(ssq, 16); ssq += __shfl_xor(ssq, 32);
            const float rstd = 1.0f / sqrtf(ssq * (1.0f / 64.0f) + 1e-5f);
#pragma unroll
            for (int vb = 0; vb < 4; ++vb) {
                const float g0 = __builtin_bit_cast(float, g2[vb].x << 16), g1 = __builtin_bit_cast(float, g2[vb].x & 0xffff0000u), g2f = __builtin_bit_cast(float, g2[vb].y << 16), g3 = __builtin_bit_cast(float, g2[vb].y & 0xffff0000u);
                const float y0 = o[vb][0] * rstd * ng4[vb][0] * (g0 / (1.0f + __expf(-g0))), y1 = o[vb][1] * rstd * ng4[vb][1] * (g1 / (1.0f + __expf(-g1)));
                const float y2 = o[vb][2] * rstd * ng4[vb][2] * (g2f / (1.0f + __expf(-g2f))), y3 = o[vb][3] * rstd * ng4[vb][3] * (g3 / (1.0f + __expf(-g3)));
                *(GAS v2u*)(mixed + (rs + fr) * DM + MC_HGRN + h * 64 + 16 * vb + 4 * kg) = (v2u){cvtpk(y0, y1), cvtpk(y2, y3)};
            }
            LDS_WAIT(); asm volatile("" ::: "memory");
        }
    }
}

__device__ __forceinline__ float max3f_(float a, float b, float c) { float r; asm("v_max3_f32 %0, %1, %2, %3" : "=v"(r) : "v"(a), "v"(b), "v"(c)); return r; }
__device__ __forceinline__ float and_f32(float e, int selmask) { asm volatile("" : "+v"(selmask)); return __builtin_bit_cast(float, __builtin_bit_cast(unsigned, e) & (unsigned)selmask); }
typedef float f32x2p __attribute__((ext_vector_type(2)));
constexpr int AT_KROW = 144, AT_VROW = 136, AT_KBYTES = 64 * AT_KROW, AT_VBYTES = 64 * AT_VROW, AT_BUF = AT_KBYTES + AT_VBYTES, AT_SCR = 2 * AT_BUF;
static_assert(AT_BUF % 16 == 0 && AT_SCR % 16 == 0, "attention LDS map alignment");
__device__ __forceinline__ void p_attn_flash(Frame& F) {
    const int tid = F.tid, lane = F.lane, wave = F.wave;
    const int r = lane & 31, hh = lane >> 5, g = wave & 3, qh = wave >> 2;
    LAS unsigned char* L = F.lds + RING_OFF;
    LAS float* scr = (LAS float*)(L + AT_SCR) + wave * 32;
    const GAS bf16* proj = (const GAS bf16*)(F.ws + WS_PROJ); const GAS bf16* vT = (const GAS bf16*)(F.ws + WS_VT); GAS bf16* mixed = (GAS bf16*)(F.ws + WS_MIXED);
    const GAS unsigned* mask = (const GAS unsigned*)(F.ws + WS_MASK);
    const int srow = tid >> 3, sch = tid & 7;
    const float C2 = 0.18033688011112042f, NEG = -1.0e30f;
    for (int pair = F.bid; pair < 256; pair += F.G) {
        const int bk = pair >> 4, b = bk >> 1, kvh = bk & 1, pp = pair & 15, h = kvh * 4 + g;
        for (int half = 0; half < 2; ++half) {
            const int qblk = half == 0 ? 31 - pp : pp;
            const int q0 = qblk * 64, nt = qblk + 1;
            const int tq = q0 + 32 * qh + r;
            bf16x8v qf[4];
            { const GAS bf16* qp = proj + (size_t)(b * SEQ + tq) * PROJ_LD + PC_Q + h * 64 + 8 * hh;
#pragma unroll
              for (int d0 = 0; d0 < 4; ++d0) qf[d0] = *(const GAS bf16x8v*)(qp + 16 * d0); }
            const GAS unsigned* mrow = mask + (size_t)(b * SEQ + tq) * 64;
            const GAS bf16* kg = proj + (size_t)(b * SEQ + srow) * PROJ_LD + PC_K + kvh * 64 + sch * 8;
            const GAS bf16* vg = vT + (size_t)(bk * 64 + srow) * SEQ + sch * 8;
            { const v4u kreg = *(const GAS v4u*)kg; const v4u vreg = *(const GAS v4u*)vg;
              *(LAS v4u*)(L + srow * AT_KROW + sch * 16) = kreg;
              LAS unsigned char* vd = L + AT_KBYTES + srow * AT_VROW + sch * 16;
              *(LAS v2u*)vd = (v2u){vreg.x, vreg.y}; *(LAS v2u*)(vd + 8) = (v2u){vreg.z, vreg.w}; }
            v2u mw = *(const GAS v2u*)mrow;
            __syncthreads();
            f32x16 o0, o1;
#pragma unroll
            for (int i = 0; i < 16; ++i) { o0[i] = 0.f; o1[i] = 0.f; }
            float m = -30000.0f, l = 0.f;
            for (int j = 0; j < nt; ++j) {
                LAS unsigned char* Kb = L + (j & 1) * AT_BUF; LAS unsigned char* Vb = Kb + AT_KBYTES;
                const bool more = (j + 1 < nt);
                const int jn = more ? j + 1 : j;
                const v4u kn = *(const GAS v4u*)(kg + (size_t)jn * 64 * PROJ_LD); const v4u vn = *(const GAS v4u*)(vg + jn * 64); const v2u mwn = *(const GAS v2u*)(mrow + 2 * jn);
                bf16x8v kf[8];
#pragma unroll
                for (int d0 = 0; d0 < 4; ++d0) { kf[2 * d0] = *(const LAS bf16x8v*)(Kb + r * AT_KROW + d0 * 32 + hh * 16); kf[2 * d0 + 1] = *(const LAS bf16x8v*)(Kb + (32 + r) * AT_KROW + d0 * 32 + hh * 16); }
                __builtin_amdgcn_sched_barrier(0);
                f32x16 p0, p1;
#pragma unroll
                for (int i = 0; i < 16; ++i) { p0[i] = 0.f; p1[i] = 0.f; }
#pragma unroll
                for (int d0 = 0; d0 < 4; ++d0) {
                    p0 = __builtin_amdgcn_mfma_f32_32x32x16_bf16(kf[2 * d0], qf[d0], p0, 0, 0, 0);
                    p1 = __builtin_amdgcn_mfma_f32_32x32x16_bf16(kf[2 * d0 + 1], qf[d0], p1, 0, 0, 0);
                }
                v2u vl[8], vh[8];
#pragma unroll
                for (int ks = 0; ks < 4; ++ks) {
                    const LAS unsigned char* vp = Vb + r * AT_VROW + (16 * ks + 4 * hh) * 2;
                    vl[2 * ks] = *(const LAS v2u*)vp; vh[2 * ks] = *(const LAS v2u*)(vp + 16);
                    vl[2 * ks + 1] = *(const LAS v2u*)(vp + 32 * AT_VROW); vh[2 * ks + 1] = *(const LAS v2u*)(vp + 32 * AT_VROW + 16);
                }
                __builtin_amdgcn_sched_barrier(0);
                const unsigned w0 = mw.x >> (4 * hh), w1 = mw.y >> (4 * hh);
                asm volatile("s_nop 15\n\ts_nop 7" : "+v"(p0), "+v"(p1));
                float mx;
                { float a = max3f_(p0[0], p0[1], p1[0]), b = max3f_(p0[2], p0[3], p1[1]); a = max3f_(a, p1[2], p1[3]);
#pragma unroll
                  for (int i = 4; i < 16; i += 4) { a = max3f_(a, p0[i], p0[i + 1]); b = max3f_(b, p0[i + 2], p0[i + 3]); a = max3f_(a, p1[i], p1[i + 1]); b = max3f_(b, p1[i + 2], p1[i + 3]); }
                  mx = max3f_(a, b, NEG); }
                mx = fmaxf(mx, __shfl_xor(mx, 32));
                const float mxs = mx * C2;
                const bool need = mxs > m + 8.0f;
                if (__any(need)) {
                    const float mnew = need ? mxs : m;
                    const float alpha = __builtin_amdgcn_exp2f(m - mnew); m = mnew; l *= alpha;
                    if (hh == 0) scr[r] = alpha;
#pragma unroll
                    for (int gq = 0; gq < 4; ++gq) {
                        const f32x4 a4 = *(const LAS f32x4*)(scr + 8 * gq + 4 * hh);
#pragma unroll
                        for (int e = 0; e < 4; ++e) { o0[4 * gq + e] *= a4[e]; o1[4 * gq + e] *= a4[e]; }
                    }
                }
                f32x2p rs2 = {0.f, 0.f};
                const f32x2p c2v = {C2, C2}, nm2 = {-m, -m};
#pragma unroll
                for (int i = 0; i < 16; i += 2) {
                    const int cr0 = (i & 3) + 8 * (i >> 2), cr1 = cr0 + 1;
                    f32x2p t0 = (f32x2p){p0[i], p0[i + 1]} * c2v + nm2, t1 = (f32x2p){p1[i], p1[i + 1]} * c2v + nm2;
                    t0.x = and_f32(__builtin_amdgcn_exp2f(t0.x), __builtin_amdgcn_sbfe((int)w0, cr0, 1)); t0.y = and_f32(__builtin_amdgcn_exp2f(t0.y), __builtin_amdgcn_sbfe((int)w0, cr1, 1));
                    t1.x = and_f32(__builtin_amdgcn_exp2f(t1.x), __builtin_amdgcn_sbfe((int)w1, cr0, 1)); t1.y = and_f32(__builtin_amdgcn_exp2f(t1.y), __builtin_amdgcn_sbfe((int)w1, cr1, 1));
                    p0[i] = t0.x; p0[i + 1] = t0.y; p1[i] = t1.x; p1[i + 1] = t1.y;
                    rs2 += t0; rs2 += t1;
                }
                l += rs2.x + rs2.y;
                bf16x8v pf[4];
                { v4u t;
                  t.x = cvtpk(p0[0], p0[1]); t.y = cvtpk(p0[2], p0[3]); t.z = cvtpk(p0[4], p0[5]); t.w = cvtpk(p0[6], p0[7]); pf[0] = __builtin_bit_cast(bf16x8v, t);
                  t.x = cvtpk(p0[8], p0[9]); t.y = cvtpk(p0[10], p0[11]); t.z = cvtpk(p0[12], p0[13]); t.w = cvtpk(p0[14], p0[15]); pf[1] = __builtin_bit_cast(bf16x8v, t);
                  t.x = cvtpk(p1[0], p1[1]); t.y = cvtpk(p1[2], p1[3]); t.z = cvtpk(p1[4], p1[5]); t.w = cvtpk(p1[6], p1[7]); pf[2] = __builtin_bit_cast(bf16x8v, t);
                  t.x = cvtpk(p1[8], p1[9]); t.y = cvtpk(p1[10], p1[11]); t.z = cvtpk(p1[12], p1[13]); t.w = cvtpk(p1[14], p1[15]); pf[3] = __builtin_bit_cast(bf16x8v, t); }
                __builtin_amdgcn_sched_barrier(0);
#pragma unroll
                for (int ks = 0; ks < 4; ++ks) {
                    const bf16x8v vf0 = __builtin_bit_cast(bf16x8v, (v4u){vl[2 * ks].x, vl[2 * ks].y, vh[2 * ks].x, vh[2 * ks].y});
                    const bf16x8v vf1 = __builtin_bit_cast(bf16x8v, (v4u){vl[2 * ks + 1].x, vl[2 * ks + 1].y, vh[2 * ks + 1].x, vh[2 * ks + 1].y});
                    o0 = __builtin_amdgcn_mfma_f32_32x32x16_bf16(pf[ks], vf0, o0, 0, 0, 0);
                    o1 = __builtin_amdgcn_mfma_f32_32x32x16_bf16(pf[ks], vf1, o1, 0, 0, 0);
                }
                __builtin_amdgcn_sched_barrier(0);
                if (more) {
                    LAS unsigned char* Kn = L + ((j + 1) & 1) * AT_BUF;
                    *(LAS v4u*)(Kn + srow * AT_KROW + sch * 16) = kn;
                    LAS unsigned char* vd = Kn + AT_KBYTES + srow * AT_VROW + sch * 16;
                    *(LAS v2u*)vd = (v2u){vn.x, vn.y}; *(LAS v2u*)(vd + 8) = (v2u){vn.z, vn.w};
                }
                mw = mwn;
                __syncthreads();
            }
            l += __shfl_xor(l, 32);
            if (hh == 0) scr[r] = 1.0f / l;
            GAS bf16* op = mixed + (size_t)(b * SEQ + q0 + 32 * qh) * DM + MC_ATTN + h * 64 + r;
#pragma unroll
            for (int gq = 0; gq < 4; ++gq) {
                const f32x4 a4 = *(const LAS f32x4*)(scr + 8 * gq + 4 * hh);
#pragma unroll
                for (int e = 0; e < 4; ++e) {
                    const int q = 8 * gq + 4 * hh + e;
                    op[(size_t)q * DM] = (bf16)f2bf(o0[4 * gq + e] * a4[e]); op[(size_t)q * DM + 32] = (bf16)f2bf(o1[4 * gq + e] * a4[e]);
                }
            }
        }
    }
}

__device__ __forceinline__ void p_final(Frame& F) {
    const int gw = F.bid * NWAVES + F.wave, NGW = F.G * NWAVES;
    const GAS f32x4* gr = (const GAS f32x4*)F.fng + F.lane;
    f32x4 gv[4];
#pragma unroll
    for (int j = 0; j < 4; ++j) gv[j] = gr[64 * j];
    for (int row0 = gw * 4; row0 < M; row0 += NGW * 4) {
        f32x4 v[4][4]; float sq[4];
#pragma unroll
        for (int rr = 0; rr < 4; ++rr) { const GAS f32x4* xr = (const GAS f32x4*)(F.xres + (size_t)(row0 + rr) * DM) + F.lane;
#pragma unroll
            for (int j = 0; j < 4; ++j) v[rr][j] = xr[64 * j]; }
#pragma unroll
        for (int rr = 0; rr < 4; ++rr) { float a = 0.f;
#pragma unroll
            for (int j = 0; j < 4; ++j) a += (v[rr][j][0] * v[rr][j][0] + v[rr][j][1] * v[rr][j][1]) + (v[rr][j][2] * v[rr][j][2] + v[rr][j][3] * v[rr][j][3]);
            sq[rr] = a; }
#pragma unroll
        for (int o = 1; o < 64; o <<= 1)
#pragma unroll
            for (int rr = 0; rr < 4; ++rr) sq[rr] += __shfl_xor(sq[rr], o);
#pragma unroll
        for (int rr = 0; rr < 4; ++rr) {
            const float rs = 1.0f / sqrtf(sq[rr] * (1.0f / 1024.0f) + 1e-5f);
            GAS f32x4* xo = (GAS f32x4*)(F.xres + (size_t)(row0 + rr) * DM) + F.lane;
#pragma unroll
            for (int j = 0; j < 4; ++j) xo[64 * j] = v[rr][j] * rs * gv[j];
        }
    }
}

#ifndef MK_SINGLE
#define MK_SINGLE 1
#endif
constexpr int NPL = 7;
constexpr int NPHASE = 1 + DEPTH * NPL + 1;
struct Args { const float* x; const int* pos; const float *n1g, *w_in, *pool_w, *pool_scale, *lb_logits, *hgrn_g, *w_out, *n2g, *w_ff_in, *w_ff_out, *fng; float* out; unsigned char* ws; int ph_lo, ph_hi; };
static_assert(sizeof(Args) == 15 * 8 + 8, "Args has no padding");


#define PHASE_BEGIN() do { int t_ = threadIdx.x; asm volatile("" : "+v"(t_)); F.tid = t_; F.lane = t_ & 63; F.wave = __builtin_amdgcn_readfirstlane(t_ >> 6); \
    unsigned char* w_ = args.ws; asm volatile("" : "+s"(w_)); F.ws = w_; int b_ = blockIdx.x; asm volatile("" : "+s"(b_)); F.bid = b_; } while (0)

#define RSTD_TAB_OFF RING_BYTES
#define FILL_RSTD(S_, pm_out) do { PHASE_BEGIN(); pg8::Unit u0_; pm_out = S_.next(0, u0_) ? u0_.pm : -1; \
    if (pm_out >= 0 && F.tid < 256) ((LAS float*)(F.lds + RSTD_TAB_OFF))[F.tid] = pg8::row_rstd((const float*)(F.ws + WS_SSQ), pm_out * 256 + F.tid); \
    __syncthreads(); } while (0)
__global__ void __launch_bounds__(NTHR, 2) fwd(Args args) {
    extern __shared__ __attribute__((aligned(16))) unsigned char lds[];
    Frame F;
    F.lds = (LAS unsigned char*)lds;
    F.MISC = (volatile LAS unsigned*)(F.lds + MISC_OFF);
    F.tid = threadIdx.x; F.lane = F.tid & 63; F.wave = __builtin_amdgcn_readfirstlane(F.tid >> 6);
    F.G = gridDim.x; F.bid = blockIdx.x;
    F.ws = args.ws; F.ctl = (gu32*)(args.ws + WS_CTL);
    F.x_in = args.x; F.pos = args.pos; F.n1g = args.n1g; F.w_in = args.w_in; F.pool_w = args.pool_w; F.pool_scale = args.pool_scale; F.lb_logits = args.lb_logits;
    F.hgrn_g = args.hgrn_g; F.w_out = args.w_out; F.n2g = args.n2g; F.w_ff_in = args.w_ff_in; F.w_ff_out = args.w_ff_out; F.fng = args.fng; F.xres = args.out;
    for (int u = F.tid; u < (LDS_BYTES - LDSCTL_OFF) / 4; u += NTHR) ((LAS unsigned*)(F.lds + LDSCTL_OFF))[u] = 0u;
    __syncthreads();
    XcdBarrier bar; bar.bar = (unsigned*)(F.ctl + CW_BAR); bar.x = 0; bar.st = nullptr;
    if (MK_SINGLE) bar = xcd_barrier_post((unsigned*)(F.ctl + CW_BAR), F.MISC + 8);
    const int lo = args.ph_lo, hi = args.ph_hi;
#define IN(k) (lo <= (k) && (k) < hi)
#define SEAM(k) do { if (MK_SINGLE && IN(k) && IN((k) + 1)) xcd_barrier(bar); } while (0)
    bf16* const xb = (bf16*)(F.ws + WS_XB); float* const ssq = (float*)(F.ws + WS_SSQ);
    bf16* const proj = (bf16*)(F.ws + WS_PROJ); bf16* const mixed = (bf16*)(F.ws + WS_MIXED); bf16* const hid = (bf16*)(F.ws + WS_HID);

    if (IN(0)) { PHASE_BEGIN(); p_prologue(F); } SEAM(0);
    for (int layer = 0; layer < DEPTH; ++layer) {
        const int pb = 1 + layer * NPL;
        if (IN(pb + 0)) {
            PHASE_BEGIN(); pg8::Gemm g{xb, (const bf16*)(F.ws + ((layer & 1) ? WS_WIN1 : WS_WIN)), M, DINP, DM}; pg8::StaticOrder S; S.init(M, DINP, F.G, F.bid);
            int pm0; { pg8::Unit u0_; pm0 = S.next(0, u0_) ? u0_.pm : -1; }
            const pg8::TabOrder ST{S, (const float*)(F.ws + WS_SSQ), (LAS float*)(F.lds + RSTD_TAB_OFF), pm0};
            pg8::EpiIn E{F.ws, pg8::RstdTab{(const LAS float*)(F.lds + RSTD_TAB_OFF), pm0, F.ws}};
            pg8::gemm_phase<pg8::EpiIn, pg8::TabOrder, true, true>(F.lds + RING_OFF, g, ST, E);
            PHASE_BEGIN(); if (F.bid >= 128) cvt_layer_rest(F, layer, (F.bid - 128) * NWAVES + F.wave, 128 * NWAVES);
        } SEAM(pb + 0);
        if (IN(pb + 1)) { PHASE_BEGIN(); if (F.wave < 4) p_hgrn_local(F, layer); else p_pool_wave(F, layer, F.wave - 4, 4); } SEAM(pb + 1);
        if (IN(pb + 2)) { PHASE_BEGIN(); p_mask(F); PHASE_BEGIN(); p_hgrn_scan(F); } SEAM(pb + 2);
        if (IN(pb + 3)) { PHASE_BEGIN(); p_hgrn_out(F, layer); PHASE_BEGIN(); p_attn_flash(F); } SEAM(pb + 3);
        if (IN(pb + 4)) {
            PHASE_BEGIN(); pg8::Gemm g{mixed, (const bf16*)(F.ws + WS_WOUT), M, DM, DM}; pg8::StaticOrder S; S.init(M, DM, F.G, F.bid);
            pg8::EpiRes E{layer == 0 ? F.x_in : (const float*)F.xres, F.xres, F.ws};
            pg8::gemm_phase<pg8::EpiRes, pg8::StaticOrder, true, true>(F.lds + RING_OFF, g, S, E);
        } SEAM(pb + 4);
        if (IN(pb + 5)) {
            PHASE_BEGIN(); pg8::Gemm g{xb, (const bf16*)(F.ws + WS_WFI), M, DFF, DM}; pg8::StaticOrder S; S.init(M, DFF, F.G, F.bid);
            int pm0; { pg8::Unit u0_; pm0 = S.next(0, u0_) ? u0_.pm : -1; }
            const pg8::TabOrder ST{S, (const float*)(F.ws + WS_SSQ), (LAS float*)(F.lds + RSTD_TAB_OFF), pm0};
            pg8::EpiFfIn E{pg8::RstdTab{(const LAS float*)(F.lds + RSTD_TAB_OFF), pm0, F.ws}};
            pg8::gemm_phase<pg8::EpiFfIn, pg8::TabOrder, true, true>(F.lds + RING_OFF, g, ST, E);
        } SEAM(pb + 5);
        if (IN(pb + 6)) {
            PHASE_BEGIN(); pg8::Gemm g{hid, (const bf16*)(F.ws + WS_WFO), M, DM, DFF}; pg8::StaticOrder S; S.init(M, DM, F.G, F.bid);
            pg8::EpiRes E{(const float*)F.xres, F.xres, F.ws};
            pg8::gemm_phase<pg8::EpiRes, pg8::StaticOrder, true, true>(F.lds + RING_OFF, g, S, E);
        } SEAM(pb + 6);
    }
    if (IN(NPHASE - 1)) { PHASE_BEGIN(); p_final(F); }
#undef IN
#undef SEAM
}

extern "C" void kernel_launch(void* const* d_in, const int* in_sizes, int n_in, void* d_out, int out_size, void* d_ws, size_t ws_size, hipStream_t stream) {
    static int grid = 0;
    if (grid == 0) {
        if (n_in != 13 || out_size != M * DM || ws_size < WS_END) { fprintf(stderr, "kernel_launch: unexpected shapes (n_in %d, out %d, ws %zu)\n", n_in, out_size, ws_size); grid = -1; return; }
        int dev = 0, cus = 0, per_cu = 0;
        if (hipGetDevice(&dev) != hipSuccess || hipDeviceGetAttribute(&cus, hipDeviceAttributeMultiprocessorCount, dev) != hipSuccess) { grid = -1; return; }
        if (hipFuncSetAttribute((const void*)fwd, hipFuncAttributeMaxDynamicSharedMemorySize, LDS_BYTES) != hipSuccess) { fprintf(stderr, "kernel_launch: hipFuncSetAttribute failed\n"); grid = -1; return; }
        if (hipOccupancyMaxActiveBlocksPerMultiprocessor(&per_cu, (const void*)fwd, NTHR, LDS_BYTES) != hipSuccess || per_cu < 1) { fprintf(stderr, "kernel_launch: occupancy query says %d\n", per_cu); }
        (void)hipGetLastError();
        grid = cus;
        if (grid != 256) { fprintf(stderr, "kernel_launch: built for a 256-CU device (got %d)\n", cus); grid = -1; return; }
    }
    if (grid <= 0) return;
    (void)hipMemsetAsync((char*)d_ws + WS_CTL, 0, CTL_ZERO_BYTES, stream);
    Args a{};
    a.x = (const float*)d_in[0]; a.pos = (const int*)d_in[1]; a.n1g = (const float*)d_in[2]; a.w_in = (const float*)d_in[3]; a.pool_w = (const float*)d_in[4];
    a.pool_scale = (const float*)d_in[5]; a.lb_logits = (const float*)d_in[6]; a.hgrn_g = (const float*)d_in[7]; a.w_out = (const float*)d_in[8]; a.n2g = (const float*)d_in[9];
    a.w_ff_in = (const float*)d_in[10]; a.w_ff_out = (const float*)d_in[11]; a.fng = (const float*)d_in[12];
    a.out = (float*)d_out; a.ws = (unsigned char*)d_ws;
    if (MK_SINGLE) {
        a.ph_lo = 0; a.ph_hi = NPHASE;
        hipLaunchKernelGGL(fwd, dim3(grid), dim3(NTHR), LDS_BYTES, stream, a);
    } else {
        for (int p = 0; p < NPHASE; ++p) { a.ph_lo = p; a.ph_hi = p + 1; hipLaunchKernelGGL(fwd, dim3(grid), dim3(NTHR), LDS_BYTES, stream, a); }
    }
}
```

```cpp
#include <hip/hip_runtime.h>
#include <cstdio>
#include <cstdint>

constexpr int BATCH = 8, SEQ = 2048, DM = 1024, DEPTH = 4, M = BATCH * SEQ, DIN = 2372, DINP = 2560, DFF = 4096;
constexpr int NWAVES = 8, NTHR = NWAVES * 64;
constexpr int TOPK = 256;
constexpr int PC_POOL = 0, PC_HQ = 256, PC_HF = 512, PC_HI = 768, PC_HG = 1024, PC_Q = 1280, PC_K = 1792, PC_V = 1920, PROJ_LD = 2048;
constexpr int MC_POOL = 0, MC_HGRN = 256, MC_ATTN = 512;

constexpr size_t MiB = 1u << 20;
constexpr size_t WS_CTL = 0, CTL_ZERO_BYTES = 1 * MiB;
constexpr size_t WS_ROPE = 1 * MiB;
constexpr size_t WS_SSQ = 2 * MiB;
constexpr size_t WS_LB = 3 * MiB;
constexpr size_t WS_MASK = 4 * MiB;
constexpr size_t WS_WIN = 8 * MiB;
constexpr size_t WS_WOUT = 13 * MiB;
constexpr size_t WS_WFI = 15 * MiB;
constexpr size_t WS_WFO = 23 * MiB;
constexpr size_t WS_XB = 32 * MiB;
constexpr size_t WS_HID = 64 * MiB;
constexpr size_t WS_PROJ = 64 * MiB;
constexpr size_t WS_MIXED = 128 * MiB;
constexpr size_t WS_HST = 160 * MiB;
constexpr size_t WS_HDN = 176 * MiB;
constexpr size_t WS_QIHL = 192 * MiB;
constexpr size_t WS_KIHL = 208 * MiB;
constexpr size_t WS_WI = 212 * MiB;
constexpr size_t WS_VT = 224 * MiB;
constexpr size_t WS_WIN1 = 232 * MiB;
constexpr size_t WS_PWT = 245 * MiB;
constexpr size_t WS_END = 256 * MiB;
constexpr int CW_TMO = 0, CW_BAR = 4096;

namespace pg8 {
#define PG8_LAS __attribute__((address_space(3)))
typedef unsigned short bf16_t;
typedef short bf16x8 __attribute__((ext_vector_type(8)));
typedef float f32x4 __attribute__((ext_vector_type(4)));
typedef unsigned u32x4 __attribute__((ext_vector_type(4)));
constexpr int BM = 256, BK = 64, HALF = 128, HTB = HALF * BK * 2  , STAGE_BYTES = 8 * HTB, NXCD = 8, WGM = 8;

__host__ __device__ __forceinline__ int lds_byte(int r, int c) { const int st = (r >> 4) * 2 + (c >> 5), rr = r & 15, cc = c & 31, ob = rr * 64 + cc * 2; return st * 1024 + (ob ^ (((ob >> 9) & 1) << 5)); }
__host__ __device__ __forceinline__ void stage_rc(int b, int& R, int& C) { const int st = b / 1024, sb = b % 1024, swz = sb ^ (((sb >> 9) & 1) << 5); R = (st >> 1) * 16 + swz / 64; C = (st & 1) * 32 + (swz % 64) / 2; }
__host__ __device__ __forceinline__ int perm32(int rho) { const int n = rho >> 4, i = rho & 15; return 8 * (i >> 2) + 4 * n + (i & 3); }

struct Unit { int pm, pn; };
struct Gemm { const bf16_t* A; const bf16_t* Bt; int M, N, K; };

struct StaticOrder {
    int nM, nN, nwg, G, c;
    __host__ __device__ void init(int M, int N, int G_, int c_) { nM = M / BM; nN = N / BM; nwg = nM * nN; G = G_; c = c_; }
    __host__ __device__ __forceinline__ bool next(int i, Unit& u) const {
        const long L = (long)i * G + c; if (L >= nwg) return false;
        int wgid = (int)L; { const int q = nwg / NXCD, r = nwg % NXCD, xcd = wgid % NXCD, off = wgid / NXCD; wgid = (xcd < r ? xcd * (q + 1) : r * (q + 1) + (xcd - r) * q) + off; }
        const int nig = WGM * nN, gid = wgid / nig, fm = gid * WGM, gsz = (nM - fm) < WGM ? (nM - fm) : WGM;
        u.pm = fm + ((wgid % nig) % gsz); u.pn = (wgid % nig) / gsz; return true;
    }
    __device__ __forceinline__ void a_ready(const Unit&) const {}
    __device__ __forceinline__ void done(const Unit&) const {}
};

__device__ __forceinline__ unsigned cvt_pk_bf16(float lo, float hi) { unsigned r; asm volatile("v_cvt_pk_bf16_f32 %0, %1, %2" : "=v"(r) : "v"(lo), "v"(hi)); return r; }
typedef float f32x2 __attribute__((ext_vector_type(2)));

constexpr float RMS_EPS_F = 1e-5f;
#define PG8_GAS __attribute__((address_space(1)))
__device__ __forceinline__ float row_rstd(const float* ssq, int row) {
    const PG8_GAS f32x4* p = (const PG8_GAS f32x4*)(ssq + (size_t)row * 16);
    const f32x4 a = p[0], b = p[1], c = p[2], d = p[3];
    const float s = ((a[0] + a[1]) + (a[2] + a[3])) + ((b[0] + b[1]) + (b[2] + b[3])) + ((c[0] + c[1]) + (c[2] + c[3])) + ((d[0] + d[1]) + (d[2] + d[3]));
    return 1.0f / sqrtf(s * (1.0f / 1024.0f) + RMS_EPS_F);
}
struct RstdTab { const PG8_LAS float* tab; int pm; unsigned char* ws;
    __device__ __forceinline__ float get(int, int rloc) const { return tab[rloc]; } };
__constant__ float c_rot16[2][8] = {{-0.95765948f, -0.999246258f, 0.824376517f, 0.993200301f, 0.999744011f, 0.999990373f, 0.999999638f, 0.999999986f}, {-0.287903317f, 0.0388190063f, 0.566041835f, 0.116418045f, 0.0226254862f, 0.00438795693f, 0.000850927215f, 0.000165014163f}};
__constant__ float c_rot80[2][8] = {{-0.110387244f, -0.981213211f, -0.991153911f, 0.834587283f, 0.993606824f, 0.999759331f, 0.999990949f, 0.99999966f}, {-0.993888654f, 0.192926503f, 0.132717464f, 0.550875727f, 0.11289588f, 0.021938095f, 0.00425462375f, 0.000825070726f}};
__device__ __forceinline__ unsigned cvt_pk_rne(float lo, float hi) { typedef float f2 __attribute__((ext_vector_type(2))); typedef __bf16 b2 __attribute__((ext_vector_type(2))); f2 v = {lo, hi}; b2 b = __builtin_convertvector(v, b2); return __builtin_bit_cast(unsigned, b); }
struct EpiIn {
    static constexpr bool PERM = true, AFTER_DRAIN = false;
    unsigned char* ws; RstdTab rt;
    __device__ __forceinline__ void operator()(const f32x4 (&acc)[2][2][4][2], const Unit& u, int wr, int wc, int fr, int fq) const {
        bf16_t* const proj = (bf16_t*)(ws + WS_PROJ); bf16_t* const qi_hl = (bf16_t*)(ws + WS_QIHL); bf16_t* const ki_hl = (bf16_t*)(ws + WS_KIHL); float* const wi = (float*)(ws + WS_WI);
        bf16_t* const vT = (bf16_t*)(ws + WS_VT); const float* const rope = (const float*)(ws + WS_ROPE);
        const int rloc0 = wr * 64 + fr, row0 = u.pm * BM + rloc0, pn = u.pn;
        const bool rot_lane = ((wc & 1) == 0) && (fq < 2);
        const float sgn = (fq == 0) ? -1.f : 1.f;
        f32x4 c0 = {1.f, 1.f, 1.f, 1.f}, c1 = c0, s0 = {0.f, 0.f, 0.f, 0.f}, s1 = s0;
        if (pn >= 5) { const PG8_GAS f32x4* tp = (const PG8_GAS f32x4*)(rope + (size_t)row0 * 16); c0 = tp[0]; c1 = tp[1]; s0 = tp[2]; s1 = tp[3]; }
#pragma unroll
        for (int ai = 0; ai < 2; ++ai)
#pragma unroll
            for (int m = 0; m < 4; ++m) {
                const int row = row0 + ai * HALF + m * 16;
                const float rs = rt.get(u.pm, rloc0 + ai * HALF + m * 16);
#pragma unroll
                for (int bj = 0; bj < 2; ++bj) {
                    f32x4 v0 = acc[ai][bj][m][0] * rs, v1 = acc[ai][bj][m][1] * rs;
                    const bool rope_tile = (pn == 5) || (pn == 6) || (pn == 8) || (pn == 7 && bj == 0) || (pn == 9 && bj == 0 && wc < 2);
                    if (rope_tile) {
                        f32x4 p0, p1;
#pragma unroll
                        for (int e = 0; e < 4; ++e) { p0[e] = __shfl_xor(v0[e], 16); p1[e] = __shfl_xor(v1[e], 16); }
                        if (rot_lane) { v0 = v0 * c0 + (p0 * s0) * sgn; v1 = v1 * c1 + (p1 * s1) * sgn; }
                    }
                    const int cl = bj * HALF + wc * 32 + 8 * fq;
                    if (pn < 7 || (pn == 7 && bj == 0)) {
                        u32x4 w; w.x = cvt_pk_bf16(v0[0], v0[1]); w.y = cvt_pk_bf16(v0[2], v0[3]); w.z = cvt_pk_bf16(v1[0], v1[1]); w.w = cvt_pk_bf16(v1[2], v1[3]);
                        *(PG8_GAS u32x4*)(proj + (size_t)row * 2048 + pn * BM + cl) = w;
                    } else if (pn == 7) {
                        const int vc = cl - HALF, kvh = vc >> 6, d = vc & 63, b = row >> 11, t = row & 2047;
                        PG8_GAS bf16_t* o = (PG8_GAS bf16_t*)vT + ((size_t)((b * 2 + kvh) * 64 + d)) * 2048 + t;
                        const u32x4 w = (u32x4){cvt_pk_bf16(v0[0], v0[1]), cvt_pk_bf16(v0[2], v0[3]), cvt_pk_bf16(v1[0], v1[1]), cvt_pk_bf16(v1[2], v1[3])};
                        o[0 * 2048] = (bf16_t)(w.x & 0xffffu); o[1 * 2048] = (bf16_t)(w.x >> 16); o[2 * 2048] = (bf16_t)(w.y & 0xffffu); o[3 * 2048] = (bf16_t)(w.y >> 16);
                        o[4 * 2048] = (bf16_t)(w.z & 0xffffu); o[5 * 2048] = (bf16_t)(w.z >> 16); o[6 * 2048] = (bf16_t)(w.w & 0xffffu); o[7 * 2048] = (bf16_t)(w.w >> 16);
                    } else if (pn == 8) {
                        const u32x4 h = (u32x4){cvt_pk_bf16(v0[0], v0[1]), cvt_pk_bf16(v0[2], v0[3]), cvt_pk_bf16(v1[0], v1[1]), cvt_pk_bf16(v1[2], v1[3])};
                        *(PG8_GAS u32x4*)(qi_hl + (size_t)row * 512 + cl) = h;
                    } else if (bj == 0) {
                        if (wc < 2) { const u32x4 h = (u32x4){cvt_pk_bf16(v0[0], v0[1]), cvt_pk_bf16(v0[2], v0[3]), cvt_pk_bf16(v1[0], v1[1]), cvt_pk_bf16(v1[2], v1[3])}; *(PG8_GAS u32x4*)(ki_hl + (size_t)row * 128 + cl) = h; }
                        else if (wc == 2 && fq == 0) { *(PG8_GAS f32x4*)(wi + (size_t)row * 4) = v0; }
                    }
                }
                if (pn >= 5 && (ai * 4 + m) < 7) {
#pragma unroll
                    for (int e = 0; e < 4; ++e) {
                        const float dc0 = (m == 3) ? c_rot80[0][e] : c_rot16[0][e], ds0 = (m == 3) ? c_rot80[1][e] : c_rot16[1][e];
                        const float dc1 = (m == 3) ? c_rot80[0][4 + e] : c_rot16[0][4 + e], ds1 = (m == 3) ? c_rot80[1][4 + e] : c_rot16[1][4 + e];
                        const float a0 = c0[e], a1 = c1[e];
                        c0[e] = a0 * dc0 - s0[e] * ds0; s0[e] = s0[e] * dc0 + a0 * ds0;
                        c1[e] = a1 * dc1 - s1[e] * ds1; s1[e] = s1[e] * dc1 + a1 * ds1;
                    }
                }
            }
    }
};
struct EpiRes {
    static constexpr bool PERM = true, AFTER_DRAIN = false;
    const float* xin; float* xout; unsigned char* ws;
    __device__ __forceinline__ void operator()(const f32x4 (&acc)[2][2][4][2], const Unit& u, int wr, int wc, int fr, int fq) const {
        bf16_t* const xb = (bf16_t*)(ws + WS_XB); float* const ssq = (float*)(ws + WS_SSQ);
        const int row0 = u.pm * BM + wr * 64 + fr;
        const int colt = u.pn * BM + wc * 32 + 8 * fq;
        f32x4 cur[2][2], nxt[2][2];
#pragma unroll
        for (int bj = 0; bj < 2; ++bj) { const size_t off = (size_t)row0 * 1024 + colt + bj * HALF; cur[bj][0] = *(const PG8_GAS f32x4*)(xin + off); cur[bj][1] = *(const PG8_GAS f32x4*)(xin + off + 4); }
#pragma unroll
        for (int g = 0; g < 8; ++g) {
            const int ai = g >> 2, m = g & 3;
            const int row = row0 + ai * HALF + m * 16;
            if (g + 1 < 8) { const int rown = row0 + ((g + 1) >> 2) * HALF + ((g + 1) & 3) * 16;
#pragma unroll
                for (int bj = 0; bj < 2; ++bj) { const size_t off = (size_t)rown * 1024 + colt + bj * HALF; nxt[bj][0] = *(const PG8_GAS f32x4*)(xin + off); nxt[bj][1] = *(const PG8_GAS f32x4*)(xin + off + 4); } }
            float sq = 0.f;
#pragma unroll
            for (int bj = 0; bj < 2; ++bj) {
                const size_t off = (size_t)row * 1024 + colt + bj * HALF;
                const f32x4 v0 = cur[bj][0] + acc[ai][bj][m][0], v1 = cur[bj][1] + acc[ai][bj][m][1];
                *(PG8_GAS f32x4*)(xout + off) = v0; *(PG8_GAS f32x4*)(xout + off + 4) = v1;
                u32x4 w; w.x = cvt_pk_bf16(v0[0], v0[1]); w.y = cvt_pk_bf16(v0[2], v0[3]); w.z = cvt_pk_bf16(v1[0], v1[1]); w.w = cvt_pk_bf16(v1[2], v1[3]);
                *(PG8_GAS u32x4*)(xb + off) = w;
                sq += (v0[0] * v0[0] + v0[1] * v0[1]) + (v0[2] * v0[2] + v0[3] * v0[3]) + (v1[0] * v1[0] + v1[1] * v1[1]) + (v1[2] * v1[2] + v1[3] * v1[3]);
            }
            sq += __shfl_xor(sq, 16); sq += __shfl_xor(sq, 32);
            if (fq == 0) ((PG8_GAS float*)ssq)[(size_t)row * 16 + u.pn * 4 + wc] = sq;
#pragma unroll
            for (int bj = 0; bj < 2; ++bj) { cur[bj][0] = nxt[bj][0]; cur[bj][1] = nxt[bj][1]; }
        }
    }
};
struct EpiFfIn {
    static constexpr bool PERM = true, AFTER_DRAIN = false;
    RstdTab rt;
    __device__ __forceinline__ void operator()(const f32x4 (&acc)[2][2][4][2], const Unit& u, int wr, int wc, int fr, int fq) const {
        bf16_t* const hid = (bf16_t*)(rt.ws + WS_HID);
        const int row0 = u.pm * BM + wr * 64 + fr;
        const int colt = u.pn * BM + wc * 32 + 8 * fq;
#pragma unroll
        for (int ai = 0; ai < 2; ++ai)
#pragma unroll
            for (int m = 0; m < 4; ++m) {
                const int row = row0 + ai * HALF + m * 16;
                const float rs = rt.get(u.pm, wr * 64 + fr + ai * HALF + m * 16);
#pragma unroll
                for (int bj = 0; bj < 2; ++bj) {
                    f32x4 v0 = acc[ai][bj][m][0] * rs, v1 = acc[ai][bj][m][1] * rs;
#pragma unroll
                    for (int e = 0; e < 4; ++e) { const float a = fmaxf(v0[e], 0.f), b = fmaxf(v1[e], 0.f); v0[e] = a * a; v1[e] = b * b; }
                    u32x4 w; w.x = cvt_pk_bf16(v0[0], v0[1]); w.y = cvt_pk_bf16(v0[2], v0[3]); w.z = cvt_pk_bf16(v1[0], v1[1]); w.w = cvt_pk_bf16(v1[2], v1[3]);
                    *(PG8_GAS u32x4*)(hid + (size_t)row * 4096 + colt + bj * HALF) = w;
                }
            }
    }
};
template <class Epi, class Sched, bool ALIGN_EPI = false, bool SP2 = false>
__device__ __forceinline__ void gemm_phase(PG8_LAS unsigned char* lds, const Gemm g, const Sched& S, const Epi& E) {
    int tid_ = threadIdx.x; asm volatile("" : "+v"(tid_));
    const int tid = tid_, wid = __builtin_amdgcn_readfirstlane(tid >> 6), lane = tid & 63, wr = wid >> 2, wc = wid & 3, fr = lane & 15, fq = lane >> 4;
    const int K = g.K, nt = K / BK;
    unsigned voffA[2], voffB[2];
#pragma unroll
    for (int i = 0; i < 2; ++i) { int R, C; stage_rc(tid * 16 + i * 8192, R, C); const int Rb = Epi::PERM ? ((R & ~31) + perm32(R & 31)) : R;
        voffA[i] = (unsigned)(R * K + C) * 2u; voffB[i] = (unsigned)(Rb * K + C) * 2u; }
    const size_t kstep = (size_t)(BK * 2);
    const size_t hstep = (size_t)HALF * K * 2;
    const size_t tstep = 2 * hstep;
    const unsigned ldsw = (unsigned)wid * 1024u;
    const int aoff = lds_byte(wr * 64 + fr, fq * 8), boff = lds_byte(wc * 32 + fr, fq * 8);
#define PG8_SA(b, h) (((b) * 2 + (h)) * HTB)
#define PG8_SB(b, h) ((4 + (b) * 2 + (h)) * HTB)
#define PG8_STAGE(bufoff, gbase, voff) do { _Pragma("unroll") for (int _i = 0; _i < 2; ++_i) \
        __builtin_amdgcn_global_load_lds((const unsigned*)((const char*)(gbase) + (voff)[_i]), (PG8_LAS unsigned*)(lds + (bufoff) + ldsw + _i * 8192), 16, 0, 0); } while (0)
#define PG8_LDA(dst, b, h) do { _Pragma("unroll") for (int m = 0; m < 4; ++m) _Pragma("unroll") for (int k = 0; k < 2; ++k) dst[m][k] = *(const PG8_LAS bf16x8*)(lds + PG8_SA(b, h) + aoff + m * 2048 + k * 1024); } while (0)
#define PG8_LDB(dst, b, h) do { _Pragma("unroll") for (int n = 0; n < 2; ++n) _Pragma("unroll") for (int k = 0; k < 2; ++k) dst[n][k] = *(const PG8_LAS bf16x8*)(lds + PG8_SB(b, h) + boff + n * 2048 + k * 1024); } while (0)
#define PG8_MMA(ai, bj, At, Bt) do { __builtin_amdgcn_s_setprio(1); _Pragma("unroll") for (int m = 0; m < 4; ++m) _Pragma("unroll") for (int n = 0; n < 2; ++n) _Pragma("unroll") for (int k = 0; k < 2; ++k) \
        acc[ai][bj][m][n] = __builtin_amdgcn_mfma_f32_16x16x32_bf16(Bt[n][k], At[m][k], acc[ai][bj][m][n], 0, 0, 0); __builtin_amdgcn_s_setprio(0); } while (0)
#define PG8_WAIT_V(n) asm volatile("s_waitcnt vmcnt(" #n ")" ::: "memory")
#define PG8_WAIT_L(n) asm volatile("s_waitcnt lgkmcnt(" #n ")" ::: "memory")
#define PG8_BAR __builtin_amdgcn_s_barrier()
#define PG8_SCHED __builtin_amdgcn_sched_barrier(0)
    Unit cur, nxt; int ui = 0;
    if (!S.next(0, cur)) return;
    f32x4 acc[2][2][4][2];
#pragma unroll
    for (int a = 0; a < 2; ++a)
#pragma unroll
        for (int b = 0; b < 2; ++b)
#pragma unroll
            for (int m = 0; m < 4; ++m)
#pragma unroll
                for (int n = 0; n < 2; ++n) acc[a][b][m][n] = (f32x4){0.f, 0.f, 0.f, 0.f};
    bf16x8 At[4][2], B0[2][2], B1[2][2];
    const char* cA = (const char*)g.A + (size_t)cur.pm * tstep; const char* cB = (const char*)g.Bt + (size_t)cur.pn * tstep;
    S.a_ready(cur);
    if constexpr (SP2) {
        PG8_STAGE(PG8_SB(0, 0), cB, voffB); PG8_STAGE(PG8_SB(0, 1), cB + hstep, voffB); PG8_STAGE(PG8_SA(0, 0), cA, voffA); PG8_STAGE(PG8_SA(0, 1), cA + hstep, voffA);
        if (wr == 1) PG8_BAR;
        PG8_WAIT_V(2); PG8_BAR;
        PG8_STAGE(PG8_SB(1, 0), cB + kstep, voffB); PG8_STAGE(PG8_SA(1, 0), cA + kstep, voffA); PG8_STAGE(PG8_SB(1, 1), cB + hstep + kstep, voffB);
        PG8_WAIT_V(6); PG8_BAR;
    } else {
        PG8_STAGE(PG8_SB(0, 0), cB, voffB); PG8_STAGE(PG8_SA(0, 0), cA, voffA); PG8_STAGE(PG8_SB(0, 1), cB + hstep, voffB); PG8_STAGE(PG8_SA(0, 1), cA + hstep, voffA);
        if (wr == 1) PG8_BAR;
        PG8_WAIT_V(4); PG8_BAR;
        PG8_STAGE(PG8_SB(1, 0), cB + kstep, voffB); PG8_STAGE(PG8_SA(1, 0), cA + kstep, voffA); PG8_STAGE(PG8_SB(1, 1), cB + hstep + kstep, voffB);
        PG8_WAIT_V(6); PG8_BAR;
    }
    for (;;) {
        const bool has_next = S.next(ui + 1, nxt);
        const char* nA = has_next ? (const char*)g.A + (size_t)nxt.pm * tstep : cA; const char* nB = has_next ? (const char*)g.Bt + (size_t)nxt.pn * tstep : cB;
        for (int t = 0; t < nt; t += 2) {
            const bool last = (t == nt - 2);
            const char* a1 = cA + (size_t)(t + 1) * kstep;
            const char* a2 = last ? nA : cA + (size_t)(t + 2) * kstep; const char* b2 = last ? nB : cB + (size_t)(t + 2) * kstep;
            const char* a3 = a2 + kstep; const char* b3 = b2 + kstep;
            if (last && has_next) S.a_ready(nxt);
            if constexpr (SP2) {
            PG8_LDB(B0, 0, 0); PG8_LDB(B1, 0, 1); PG8_SCHED; PG8_LDA(At, 0, 0); PG8_STAGE(PG8_SA(1, 1), a1 + hstep, voffA);
            PG8_WAIT_V(8); PG8_WAIT_L(0); PG8_BAR; PG8_MMA(0, 0, At, B0); PG8_MMA(0, 1, At, B1); PG8_BAR; PG8_SCHED;
            PG8_LDA(At, 0, 1); PG8_STAGE(PG8_SB(0, 0), b2, voffB); PG8_STAGE(PG8_SB(0, 1), b2 + hstep, voffB); PG8_STAGE(PG8_SA(0, 0), a2, voffA);
            PG8_WAIT_V(8); PG8_WAIT_L(0); PG8_BAR; PG8_MMA(1, 0, At, B0); PG8_MMA(1, 1, At, B1); PG8_BAR; PG8_SCHED;
            PG8_LDB(B0, 1, 0); PG8_LDB(B1, 1, 1); PG8_SCHED; PG8_LDA(At, 1, 0); PG8_STAGE(PG8_SA(0, 1), a2 + hstep, voffA);
            PG8_WAIT_V(8); PG8_WAIT_L(0); PG8_BAR; PG8_MMA(0, 0, At, B0); PG8_MMA(0, 1, At, B1); PG8_BAR; PG8_SCHED;
            PG8_LDA(At, 1, 1); PG8_STAGE(PG8_SB(1, 0), b3, voffB); PG8_STAGE(PG8_SB(1, 1), b3 + hstep, voffB); PG8_STAGE(PG8_SA(1, 0), a3, voffA);
            PG8_WAIT_V(8); PG8_WAIT_L(0); PG8_BAR; PG8_MMA(1, 0, At, B0); PG8_MMA(1, 1, At, B1); PG8_BAR; PG8_SCHED;
            } else {
            PG8_LDB(B0, 0, 0); PG8_SCHED; PG8_LDA(At, 0, 0); PG8_STAGE(PG8_SA(1, 1), a1 + hstep, voffA);
            PG8_WAIT_L(8); PG8_BAR; PG8_WAIT_L(0); PG8_MMA(0, 0, At, B0); PG8_BAR; PG8_SCHED;
            PG8_LDB(B1, 0, 1); PG8_STAGE(PG8_SB(0, 0), b2, voffB);
            PG8_BAR; PG8_WAIT_L(0); PG8_MMA(0, 1, At, B1); PG8_BAR;
            PG8_LDA(At, 0, 1); PG8_STAGE(PG8_SA(0, 0), a2, voffA);
            PG8_BAR; PG8_WAIT_L(0); PG8_MMA(1, 0, At, B0); PG8_BAR; PG8_SCHED;
            PG8_STAGE(PG8_SB(0, 1), b2 + hstep, voffB);
            PG8_WAIT_V(6); PG8_BAR; PG8_MMA(1, 1, At, B1); PG8_BAR;
            PG8_LDB(B0, 1, 0); PG8_SCHED; PG8_LDA(At, 1, 0); PG8_STAGE(PG8_SA(0, 1), a2 + hstep, voffA);
            PG8_WAIT_L(8); PG8_BAR; PG8_WAIT_L(0); PG8_MMA(0, 0, At, B0); PG8_BAR; PG8_SCHED;
            PG8_LDB(B1, 1, 1); PG8_STAGE(PG8_SB(1, 0), b3, voffB);
            PG8_BAR; PG8_WAIT_L(0); PG8_MMA(0, 1, At, B1); PG8_BAR;
            PG8_LDA(At, 1, 1); PG8_STAGE(PG8_SA(1, 0), a3, voffA);
            PG8_BAR; PG8_WAIT_L(0); PG8_MMA(1, 0, At, B0); PG8_BAR; PG8_SCHED;
            PG8_STAGE(PG8_SB(1, 1), b3 + hstep, voffB);
            PG8_WAIT_V(6); PG8_BAR; PG8_MMA(1, 1, At, B1); PG8_BAR;
            }
        }
        if constexpr (ALIGN_EPI) { if (wr == 0) PG8_BAR; }
        if constexpr (!Epi::AFTER_DRAIN) { E(acc, cur, wr, wc, fr, fq); S.done(cur); }
        if (!has_next) break;
#pragma unroll
        for (int a = 0; a < 2; ++a)
#pragma unroll
            for (int b = 0; b < 2; ++b)
#pragma unroll
                for (int m = 0; m < 4; ++m)
#pragma unroll
                    for (int n = 0; n < 2; ++n) acc[a][b][m][n] = (f32x4){0.f, 0.f, 0.f, 0.f};
        cur = nxt; cA = nA; cB = nB; ++ui;
        if constexpr (ALIGN_EPI) { if (wr == 1) PG8_BAR; }
    }
    PG8_WAIT_V(0);
    if constexpr (!ALIGN_EPI) { if (wr == 0) PG8_BAR; }
    PG8_BAR;
    if constexpr (Epi::AFTER_DRAIN) { E.fused(acc, cur, wr, wc, fr, fq, lds, wid, lane); S.done(cur); }
#undef PG8_SA
#undef PG8_SB
#undef PG8_STAGE
#undef PG8_LDA
#undef PG8_LDB
#undef PG8_MMA
#undef PG8_WAIT_V
#undef PG8_WAIT_L
#undef PG8_BAR
#undef PG8_SCHED
}
}

constexpr int RING_OFF = 0, RING_BYTES = 131072;
constexpr int LDS_BYTES = 147456;
constexpr int LDSCTL_OFF = LDS_BYTES - 1024, MISC_OFF = LDSCTL_OFF + 320;

#define GAS __attribute__((address_space(1)))
#define LAS __attribute__((address_space(3)))
typedef unsigned short bf16;
typedef unsigned v4u __attribute__((ext_vector_type(4)));
typedef unsigned v2u __attribute__((ext_vector_type(2)));
typedef float f32x4 __attribute__((ext_vector_type(4)));
typedef GAS unsigned gu32;
#define RLX_AGENT __ATOMIC_RELAXED, __HIP_MEMORY_SCOPE_AGENT
#define LDS_WAIT() asm volatile("s_waitcnt lgkmcnt(0)" ::: "memory")
__device__ __forceinline__ unsigned f2bf(float f) { unsigned u = __builtin_bit_cast(unsigned, f); return (u + 0x7fffu + ((u >> 16) & 1u)) >> 16; }
__device__ __forceinline__ unsigned pk2(float lo, float hi) { return f2bf(lo) | (f2bf(hi) << 16); }
__device__ __forceinline__ float bf2f(unsigned short h) { return __builtin_bit_cast(float, (unsigned)h << 16); }
__device__ __forceinline__ float wave_sum(float v) {
#pragma unroll
    for (int o = 1; o < 64; o <<= 1) v += __shfl_xor(v, o);
    return v;
}
__device__ __forceinline__ float wave_max(float v) {
#pragma unroll
    for (int o = 1; o < 64; o <<= 1) v = fmaxf(v, __shfl_xor(v, o));
    return v;
}
#define XB_TMO      128
#define XB_XCNT(j)  (256  + 64 * (j))
#define XB_XSUB(j)  (1280 + 64 * (j))
#define XB_XGEN(j)  (2304 + 64 * (j))
#define XB_TOP      3328
#define XB_TOPGEN   3392
#define XCD_BAR_WORDS 3456
#define XB_SPIN_CAP (1u << 18)

__device__ __forceinline__ unsigned xb_ld(unsigned* p)              { return __hip_atomic_load(p, __ATOMIC_RELAXED, __HIP_MEMORY_SCOPE_AGENT); }
__device__ __forceinline__ unsigned xb_add(unsigned* p, unsigned v) { return __hip_atomic_fetch_add(p, v, __ATOMIC_RELAXED, __HIP_MEMORY_SCOPE_AGENT); }
__device__ __forceinline__ unsigned xb_xcc_id() { return (unsigned)__builtin_amdgcn_s_getreg((3 << 11) | 20) & 0xFu; }
#define XB_SPIN(cond, bar) do { unsigned _sp = 0; while (cond) { __builtin_amdgcn_s_sleep(1); \
    if ((++_sp & 255u) == 0u) { if (xb_ld(&(bar)[XB_TMO])) break; if (_sp > XB_SPIN_CAP) { atomicAdd(&(bar)[XB_TMO], 1u); break; } } } } while (0)

struct XcdBarrier {
    unsigned* bar; unsigned x;
    volatile LAS unsigned* st;
};

__device__ __forceinline__ XcdBarrier xcd_barrier_post(unsigned* bar, volatile LAS unsigned* st) {
    XcdBarrier b; b.bar = bar; b.x = xb_xcc_id(); b.st = st;
    if (threadIdx.x == 0) (void)xb_add(&bar[XB_XCNT(b.x)], 1u);
    return b;
}
__device__ __forceinline__ void xcd_barrier_complete(unsigned* bar, unsigned x, unsigned& nloc, unsigned& nx) {
    const unsigned G = gridDim.x * gridDim.y * gridDim.z;
    unsigned sum, cnt, mine, sp = 0u;
    for (;;) {
        sum = 0u; cnt = 0u; mine = 0u;
#pragma unroll
        for (unsigned j = 0; j < 16; ++j) { const unsigned c = xb_ld(&bar[XB_XCNT(j)]); sum += c; cnt += (c > 0u) ? 1u : 0u; mine = (j == x) ? c : mine; }
        if (sum == G) break;
        __builtin_amdgcn_s_sleep(1);
        if ((++sp & 255u) == 0u) { if (xb_ld(&bar[XB_TMO])) break; if (sp > XB_SPIN_CAP) { atomicAdd(&bar[XB_TMO], 1u); break; } }
    }
    nloc = mine > 0u ? mine : 1u; nx = cnt > 0u ? cnt : 1u;
}

__device__ __forceinline__ void xcd_barrier(const XcdBarrier& b) {
    asm volatile("s_waitcnt vmcnt(0)" ::: "memory");
    __syncthreads();
    if (threadIdx.x == 0) {
        unsigned* bar = b.bar;
        __builtin_amdgcn_s_waitcnt(0);
        unsigned nloc = b.st[0], nx = b.st[1];
        if (nloc == 0u) { xcd_barrier_complete(bar, b.x, nloc, nx); b.st[0] = nloc; b.st[1] = nx; }
        const unsigned old = xb_add(&bar[XB_XSUB(b.x)], 1u);
        const unsigned gen = old / nloc;
        if (old + 1u == (gen + 1u) * nloc) {
            __builtin_amdgcn_fence(__ATOMIC_RELEASE, "agent");
            asm volatile("s_waitcnt vmcnt(0)" ::: "memory");
            const unsigned og = xb_add(&bar[XB_TOP], 1u);
            const unsigned tg = og / nx;
            if (og + 1u == (tg + 1u) * nx) xb_add(&bar[XB_TOPGEN], 1u);
            else XB_SPIN(xb_ld(&bar[XB_TOPGEN]) == tg, bar);
            __builtin_amdgcn_fence(__ATOMIC_ACQUIRE, "agent");
            xb_add(&bar[XB_XGEN(b.x)], 1u);
            asm volatile("s_waitcnt vmcnt(0)" ::: "memory");
        } else {
            XB_SPIN(xb_ld(&bar[XB_XGEN(b.x)]) == gen, bar);
            __builtin_amdgcn_fence(__ATOMIC_ACQUIRE, "agent");
            asm volatile("s_waitcnt vmcnt(0)" ::: "memory");
        }
    }
    __syncthreads();
}


struct Frame {
    LAS unsigned char* lds;
    volatile LAS unsigned* MISC;
    gu32* ctl;
    int tid, lane, wave, G, bid;
    const float* x_in; const int* pos;
    const float *n1g, *w_in, *pool_w, *pool_scale, *lb_logits, *hgrn_g, *w_out, *n2g, *w_ff_in, *w_ff_out, *fng;
    float* xres;
    unsigned char* ws;
};
__constant__ float c_invf[8] = {1.0f, 0.19392274474868576f, 0.03760603093086393f, 0.007292664737217109f, 0.001414213562373095f, 0.0002742481756762073f, 5.318295896944988e-05f, 1.031338537721246e-05f};

typedef float f32x16 __attribute__((ext_vector_type(16)));
typedef short bf16x8v __attribute__((ext_vector_type(8)));
typedef float f32x2v __attribute__((ext_vector_type(2))); typedef __bf16 bf16x2v __attribute__((ext_vector_type(2)));
__device__ __forceinline__ unsigned cvtpk(float lo, float hi) { f32x2v v = {lo, hi}; bf16x2v b = __builtin_convertvector(v, bf16x2v); return __builtin_bit_cast(unsigned, b); }

__device__ __forceinline__ void cvt_item(const GAS float* W, const GAS float* g, int K, int N, bf16* WT, LAS float* scr, int kb, int nb, int lane) {
    const int k0 = 64 * kb, n0 = 32 * nb;
    const int n = n0 + (lane & 31);
    float v[32];
#pragma unroll
    for (int i = 0; i < 32; ++i) { const int kk = 2 * i + (lane >> 5); v[i] = (n < N) ? W[(size_t)(k0 + kk) * N + n] : 0.f; }
    const int c = lane & 7;
    f32x4 g0 = {1.f, 1.f, 1.f, 1.f}, g1 = g0;
    if (g) { g0 = *(const GAS f32x4*)(g + k0 + 8 * c); g1 = *(const GAS f32x4*)(g + k0 + 8 * c + 4); }
    __builtin_amdgcn_sched_barrier(0);
#pragma unroll
    for (int i = 0; i < 32; ++i) { const int kk = 2 * i + (lane >> 5); scr[kk * 33 + (lane & 31)] = v[i]; }
    LDS_WAIT(); asm volatile("" ::: "memory");
#pragma unroll
    for (int j = 0; j < 4; ++j) { const int nl = (lane >> 3) + 8 * j; const LAS float* sp = scr + (8 * c) * 33 + nl;
        v4u o; o.x = pk2(sp[0 * 33] * g0[0], sp[1 * 33] * g0[1]); o.y = pk2(sp[2 * 33] * g0[2], sp[3 * 33] * g0[3]); o.z = pk2(sp[4 * 33] * g1[0], sp[5 * 33] * g1[1]); o.w = pk2(sp[6 * 33] * g1[2], sp[7 * 33] * g1[3]);
        *(GAS v4u*)(WT + (size_t)(n0 + nl) * K + k0 + 8 * c) = o; }
    LDS_WAIT(); asm volatile("" ::: "memory");
}
__device__ __forceinline__ void cvt_matrix(Frame& F, const float* W_, const float* g_, int K, int N, int Npad, bf16* WT) {
    const GAS float* W = (const GAS float*)W_; const GAS float* g = (const GAS float*)g_;
    LAS float* scr = (LAS float*)(F.lds + RING_OFF + F.wave * 16384);
    const int gw = F.bid * NWAVES + F.wave, NGW = F.G * NWAVES;
    const int nblk = Npad / 32, nitems = (K / 64) * nblk;
    for (int it = gw; it < nitems; it += NGW) cvt_item(W, g, K, N, WT, scr, it / nblk, it % nblk, F.lane);
}
__device__ __forceinline__ void cvt_layer_rest(Frame& F, int layer, int gw, int NGW) {
    LAS float* scr = (LAS float*)(F.lds + RING_OFF + F.wave * 16384);
    constexpr int I0 = (DM / 64) * (DM / 32), I1 = (DM / 64) * (DFF / 32), I2 = (DFF / 64) * (DM / 32), I3 = (DM / 64) * (DINP / 32);
    const int total = I0 + I1 + I2 + ((layer + 1 < DEPTH) ? I3 : 0);
    for (int it = gw; it < total; it += NGW) {
        int r = it;
        if (r < I0) { cvt_item((const GAS float*)(F.w_out + (size_t)layer * DM * DM), nullptr, DM, DM, (bf16*)(F.ws + WS_WOUT), scr, r / (DM / 32), r % (DM / 32), F.lane); continue; } r -= I0;
        if (r < I1) { cvt_item((const GAS float*)(F.w_ff_in + (size_t)layer * DM * DFF), (const GAS float*)(F.n2g + layer * DM), DM, DFF, (bf16*)(F.ws + WS_WFI), scr, r / (DFF / 32), r % (DFF / 32), F.lane); continue; } r -= I1;
        if (r < I2) { cvt_item((const GAS float*)(F.w_ff_out + (size_t)layer * DFF * DM), nullptr, DFF, DM, (bf16*)(F.ws + WS_WFO), scr, r / (DM / 32), r % (DM / 32), F.lane); continue; } r -= I2;
        cvt_item((const GAS float*)(F.w_in + (size_t)(layer + 1) * DM * DIN), (const GAS float*)(F.n1g + (layer + 1) * DM), DM, DIN, (bf16*)(F.ws + (((layer + 1) & 1) ? WS_WIN1 : WS_WIN)), scr, r / (DINP / 32), r % (DINP / 32), F.lane);
    }
}

__device__ __forceinline__ void p_prologue(Frame& F) {
    const int gtid = F.bid * NTHR + F.tid, NT = F.G * NTHR;
    GAS float* tab = (GAS float*)(F.ws + WS_ROPE);
    for (int idx = gtid; idx < M * 8; idx += NT) {
        const int row = idx >> 3, i = idx & 7;
        const float angf = (float)((const GAS int*)F.pos)[row] * c_invf[i];
        double r = (double)angf * 0.15915494309189535; r -= floor(r);
        const float a = (float)(r * 6.283185307179586);
        tab[row * 16 + i] = cosf(a); tab[row * 16 + 8 + i] = sinf(a);
    }
    if (gtid < 256) {
        const int c = gtid; GAS float* lb = (GAS float*)(F.ws + WS_LB); const GAS float* lbl = (const GAS float*)F.lb_logits;
        const float l0 = lbl[c], l1 = lbl[256 + c], l2 = lbl[512 + c], l3 = lbl[768 + c];
        const float mx = fmaxf(fmaxf(l0, l1), fmaxf(l2, l3));
        const float e0 = expf(l0 - mx), e1 = expf(l1 - mx), e2 = expf(l2 - mx), e3 = expf(l3 - mx);
        const float inv = 1.0f / (e0 + e1 + e2 + e3);
        lb[c] = 0.f; lb[256 + c] = e1 * inv; lb[512 + c] = (e1 + e2) * inv; lb[768 + c] = (e1 + e2 + e3) * inv;
    }
    const int gw = F.bid * NWAVES + F.wave, NGW = F.G * NWAVES;
    GAS bf16* xb = (GAS bf16*)(F.ws + WS_XB); GAS float* ssq = (GAS float*)(F.ws + WS_SSQ);
    for (int row0 = gw * 4; row0 < M; row0 += NGW * 4) {
        f32x4 v[4][4]; float sq[4];
#pragma unroll
        for (int rr = 0; rr < 4; ++rr) { const GAS f32x4* xr = (const GAS f32x4*)(F.x_in + (size_t)(row0 + rr) * DM) + F.lane;
#pragma unroll
            for (int j = 0; j < 4; ++j) v[rr][j] = xr[64 * j]; }
#pragma unroll
        for (int rr = 0; rr < 4; ++rr) { float a = 0.f;
#pragma unroll
            for (int j = 0; j < 4; ++j) a += (v[rr][j][0] * v[rr][j][0] + v[rr][j][1] * v[rr][j][1]) + (v[rr][j][2] * v[rr][j][2] + v[rr][j][3] * v[rr][j][3]);
            sq[rr] = a; }
#pragma unroll
        for (int o = 1; o < 64; o <<= 1)
#pragma unroll
            for (int rr = 0; rr < 4; ++rr) sq[rr] += __shfl_xor(sq[rr], o);
#pragma unroll
        for (int rr = 0; rr < 4; ++rr) {
            GAS unsigned long long* o8 = (GAS unsigned long long*)(xb + (size_t)(row0 + rr) * DM) + F.lane;
#pragma unroll
            for (int j = 0; j < 4; ++j) o8[64 * j] = (unsigned long long)pk2(v[rr][j][0], v[rr][j][1]) | ((unsigned long long)pk2(v[rr][j][2], v[rr][j][3]) << 32);
            if (F.lane < 16) ssq[(size_t)(row0 + rr) * 16 + F.lane] = (F.lane == 0) ? sq[rr] : 0.f;
        }
    }
    cvt_matrix(F, F.w_in, F.n1g, DM, DIN, DINP, (bf16*)(F.ws + WS_WIN));
    { GAS bf16* pwt = (GAS bf16*)(F.ws + WS_PWT); const GAS float* pw = (const GAS float*)F.pool_w;
      for (int e = gtid; e < DEPTH * 4 * 64 * 64; e += NT) { const int lg = e >> 12, d = (e >> 6) & 63, c = e & 63; pwt[e] = (bf16)f2bf(pw[(size_t)lg * 4096 + c * 64 + d]); } }
}

constexpr int PW_ROW = 72;
template <int WIN> __device__ __forceinline__ void pool_core64(const GAS bf16* up, int tl0, LAS unsigned short* Pc) {
#pragma unroll
    for (int hf = 0; hf < 2; ++hf) {
        float uv[48];
#pragma unroll
        for (int i = 0; i < 48; ++i) { const int tl = tl0 + 32 * hf - 16 + i; uv[i] = (tl >= 0) ? bf2f(up[(long)(32 * hf + i - 16) * PROJ_LD]) : 0.f; }
        __builtin_amdgcn_sched_barrier(0);
        float ps[49]; ps[0] = 0.f;
#pragma unroll
        for (int i = 0; i < 48; ++i) ps[i + 1] = ps[i] + uv[i];
#pragma unroll
        for (int i = 16; i < 48; ++i) {
            const int tl = tl0 + 32 * hf - 16 + i; const int cnt = (tl + 1 < WIN) ? tl + 1 : WIN;
            const float mean = (ps[i + 1] - ps[i + 1 - WIN]) / (float)cnt;
            Pc[(32 * hf + i - 16) * PW_ROW] = (unsigned short)f2bf(mean - uv[i]);
        }
    }
}
__device__ __forceinline__ void p_pool_wave(Frame& F, int layer, int wv_, int NWV) {
    const int lane = F.lane, fr = lane & 15, kg = lane >> 4;
    LAS unsigned short* P = (LAS unsigned short*)(F.lds + RING_OFF + F.wave * 16384);
    const GAS bf16* proj = (const GAS bf16*)(F.ws + WS_PROJ); GAS bf16* mixed = (GAS bf16*)(F.ws + WS_MIXED);
    const GAS bf16* pwt = (const GAS bf16*)(F.ws + WS_PWT) + (size_t)layer * 4 * 64 * 64; const GAS float* ps_ = (const GAS float*)F.pool_scale + layer * 256;
    for (int unit = wv_ * F.G + F.bid; unit < (M / 64) * 4; unit += NWV * F.G) {
        const int tile = unit >> 2, g = unit & 3, t0 = tile * 64;
        bf16x8v bfr[4][2];
#pragma unroll
        for (int db = 0; db < 4; ++db)
#pragma unroll
            for (int ks = 0; ks < 2; ++ks) bfr[db][ks] = *(const GAS bf16x8v*)(pwt + ((size_t)(g * 64 + 16 * db + fr)) * 64 + 32 * ks + 8 * kg);
        { const GAS bf16* up = proj + (size_t)t0 * PROJ_LD + PC_POOL + g * 64 + lane; LAS unsigned short* Pc = P + lane; const int tl0 = t0 & (SEQ - 1);
          if (g == 0) pool_core64<2>(up, tl0, Pc); else if (g == 1) pool_core64<4>(up, tl0, Pc); else if (g == 2) pool_core64<8>(up, tl0, Pc); else pool_core64<16>(up, tl0, Pc); }
        LDS_WAIT(); asm volatile("" ::: "memory");
#pragma unroll
        for (int tb = 0; tb < 4; ++tb) {
            bf16x8v af[2];
#pragma unroll
            for (int ks = 0; ks < 2; ++ks) af[ks] = *(const LAS bf16x8v*)(P + (16 * tb + fr) * PW_ROW + 32 * ks + 8 * kg);
#pragma unroll
            for (int db = 0; db < 4; ++db) {
                f32x4 acc = {0.f, 0.f, 0.f, 0.f};
#pragma unroll
                for (int ks = 0; ks < 2; ++ks) acc = __builtin_amdgcn_mfma_f32_16x16x32_bf16(af[ks], bfr[db][ks], acc, 0, 0, 0);
                const int dcol = g * 64 + 16 * db + fr; const float sc = ps_[dcol];
                GAS bf16* op = mixed + (size_t)(t0 + 16 * tb + 4 * kg) * DM + MC_POOL + dcol;
#pragma unroll
                for (int r = 0; r < 4; ++r) op[(size_t)r * DM] = (bf16)f2bf(acc[r] * sc);
            }
        }
        LDS_WAIT(); asm volatile("" ::: "memory");
    }
}

__device__ __forceinline__ unsigned sort_key(float v) { if (v == 0.f) v = 0.f; const unsigned u = __builtin_bit_cast(unsigned, v); return (u & 0x80000000u) ? ~u : (u | 0x80000000u); }
__device__ __forceinline__ unsigned wave_total6(unsigned x) {
    unsigned t = 0;
#pragma unroll
    for (int b = 0; b < 6; ++b) t += (unsigned)__popcll(__ballot((x >> b) & 1u)) << b;
    return t;
}
template <int NI> __device__ __forceinline__ void emit_mask(const unsigned (&k)[NI], unsigned prefix, bool exact, GAS unsigned* mrow, int lane) {
    if (exact) {
#pragma unroll
        for (int i = 0; i < NI; ++i) { const unsigned long long sb = __ballot(k[i] >= prefix); if (lane == 0) *(GAS v2u*)(mrow + 2 * i) = (v2u){(unsigned)sb, (unsigned)(sb >> 32)}; }
    } else {
        const unsigned tau = prefix; unsigned c = 0u;
#pragma unroll
        for (int i = 0; i < NI; ++i) c += (unsigned)(k[i] > tau);
        const unsigned need = (unsigned)TOPK - wave_total6(c); unsigned base = 0u;
#pragma unroll
        for (int i = 0; i < NI; ++i) {
            const unsigned long long eqb = __ballot(k[i] == tau);
            const unsigned rank = base + (unsigned)__popcll(eqb & ((1ull << lane) - 1ull));
            const unsigned long long sb = __ballot((k[i] > tau) || ((k[i] == tau) && (rank < need)));
            if (lane == 0) *(GAS v2u*)(mrow + 2 * i) = (v2u){(unsigned)sb, (unsigned)(sb >> 32)};
            base += (unsigned)__popcll(eqb);
        }
    }
    if (NI < 32) { if (lane < 2 * (32 - NI)) mrow[2 * NI + lane] = 0u; }
}
__device__ __forceinline__ unsigned wave_max_u32(unsigned v) {
#pragma unroll
    for (int o = 1; o < 64; o <<= 1) { const unsigned t = (unsigned)__shfl_xor((int)v, o); v = v > t ? v : t; }
    return v;
}
template <int NI> __device__ __forceinline__ unsigned count_ge(const unsigned (&k)[NI], unsigned cand) {
    unsigned t = 0u;
#pragma unroll
    for (int i0 = 0; i0 < NI; i0 += 8) {
        unsigned long long mk[8];
#pragma unroll
        for (int i = 0; i < 8; ++i) mk[i] = __ballot(k[i0 + i] >= cand);
        __builtin_amdgcn_sched_barrier(0);
        unsigned t1 = 0u;
#pragma unroll
        for (int i = 0; i < 8; i += 2) { t += (unsigned)__popcll(mk[i]); t1 += (unsigned)__popcll(mk[i + 1]); }
        t += t1;
        __builtin_amdgcn_sched_barrier(0);
    }
    return t;
}
template <int NI> __device__ __forceinline__ void select2(const LAS unsigned* ka_, const LAS unsigned* kb_, int nk, GAS unsigned* mrowA, GAS unsigned* mrowB, int lane) {
    unsigned ka[NI], kb[NI];
#pragma unroll
    for (int i = 0; i < NI; ++i) { const int sidx = lane + 64 * i; ka[i] = (sidx < nk) ? ka_[sidx] : 0u; kb[i] = (sidx < nk) ? kb_[sidx] : 0u; }
    unsigned ma = 0u, mb = 0u;
#pragma unroll
    for (int i = 0; i < NI; ++i) { ma = ka[i] > ma ? ka[i] : ma; mb = kb[i] > mb ? kb[i] : mb; }
    ma = (unsigned)__builtin_amdgcn_readfirstlane((int)wave_max_u32(ma)); mb = (unsigned)__builtin_amdgcn_readfirstlane((int)wave_max_u32(mb));
    unsigned pa = 0u, pb = 0u; bool ea = false, eb = false;
    for (int bit = 31; bit >= 0; --bit) {
        const unsigned ca = pa | (1u << bit), cb = pb | (1u << bit);
        if (!ea && ca <= ma) { const unsigned ta = count_ge<NI>(ka, ca); if (ta >= (unsigned)TOPK) { pa = ca; ea = (ta == (unsigned)TOPK); } }
        if (!eb && cb <= mb) { const unsigned tb = count_ge<NI>(kb, cb); if (tb >= (unsigned)TOPK) { pb = cb; eb = (tb == (unsigned)TOPK); } }
        if (ea && eb) break;
    }
    emit_mask<NI>(ka, pa, ea, mrowA, lane);
    emit_mask<NI>(kb, pb, eb, mrowB, lane);
}
constexpr int MK_STRIDE = 2049;
__device__ __forceinline__ void p_mask(Frame& F) {
    LAS unsigned* keys = (LAS unsigned*)(F.lds + RING_OFF);
    const GAS bf16* qi_hl = (const GAS bf16*)(F.ws + WS_QIHL); const GAS bf16* ki_hl = (const GAS bf16*)(F.ws + WS_KIHL); const GAS float* wi = (const GAS float*)(F.ws + WS_WI); GAS unsigned* mask = (GAS unsigned*)(F.ws + WS_MASK);
    const int tid = F.tid, lane = F.lane, wave = F.wave, q = lane & 15, kg = lane >> 4;
#define MK_UNIT_PARAMS(ui_, b_, qb_) const int b_ = (c >> 6) * 2 + ((ui_) >> 1), qb_ = ((ui_) & 1) ? 127 - (c & 63) : (c & 63)
#define MK_UNIT_LOAD(b_, qb_, BH, WV, AH) do { const size_t rq_ = (size_t)(b_) * SEQ + (qb_) * 16 + q; \
        _Pragma("unroll") for (int h = 0; h < 4; ++h) _Pragma("unroll") for (int dh = 0; dh < 2; ++dh) BH[h][dh] = *(const GAS bf16x8v*)(qi_hl + rq_ * 512 + h * 64 + dh * 32 + kg * 8); \
        WV = *(const GAS f32x4*)(wi + rq_ * 4); \
        { const int kt0_ = wave < (qb_) + 1 ? wave : 0; \
          _Pragma("unroll") for (int dh = 0; dh < 2; ++dh) AH[dh] = *(const GAS bf16x8v*)(ki_hl + ((size_t)(b_) * SEQ + kt0_ * 16 + q) * 128 + dh * 32 + kg * 8); } } while (0)
    for (int c = F.bid; c < 256; c += F.G) {
        bf16x8v bh[4][2], bhn[4][2]; f32x4 wv, wvn; bf16x8v ah[2], ahq[2];
        { MK_UNIT_PARAMS(0, b0_, qb0_); MK_UNIT_LOAD(b0_, qb0_, bh, wv, ah); }
        for (int ui = 0; ui < 4; ++ui) {
            MK_UNIT_PARAMS(ui, b, qb);
            const int t0 = qb * 16; const size_t rowq0 = (size_t)b * SEQ + t0;
            const int uin = ui < 3 ? ui + 1 : 3;
            MK_UNIT_PARAMS(uin, bnx, qbnx);
            if (qb < 16) {
                for (int w = tid; w < 1024; w += NTHR) { const int qq = w >> 6, j = w & 63, n = t0 + qq + 1, lo = j * 32;
                    mask[(rowq0 + qq) * 64 + j] = (n >= lo + 32) ? 0xffffffffu : (n > lo ? ((1u << (n - lo)) - 1u) : 0u); }
                MK_UNIT_LOAD(bnx, qbnx, bh, wv, ah);
                continue;
            }
            const int ntile = qb + 1;
            for (int kt = wave; kt < ntile; kt += NWAVES) {
                const int s0 = kt * 16;
                bf16x8v ahn[2];
                { const int ktn = (kt + NWAVES < ntile) ? kt + NWAVES : kt;
#pragma unroll
                  for (int dh = 0; dh < 2; ++dh) { const GAS bf16* pk = ki_hl + ((size_t)b * SEQ + ktn * 16 + q) * 128 + dh * 32 + kg * 8;
                      ahn[dh] = *(const GAS bf16x8v*)pk; } }
                __builtin_amdgcn_sched_barrier(0);
                f32x4 acc[4];
#pragma unroll
                for (int h = 0; h < 4; ++h) { acc[h] = (f32x4){0.f, 0.f, 0.f, 0.f};
#pragma unroll
                    for (int dh = 0; dh < 2; ++dh) {
                        acc[h] = __builtin_amdgcn_mfma_f32_16x16x32_bf16(ah[dh], bh[h][dh], acc[h], 0, 0, 0);
                    } }
#pragma unroll
                for (int r = 0; r < 4; ++r) {
                    const float I = wv[0] * fmaxf(acc[0][r], 0.f) + wv[1] * fmaxf(acc[1][r], 0.f) + wv[2] * fmaxf(acc[2][r], 0.f) + wv[3] * fmaxf(acc[3][r], 0.f);
                    const int s = s0 + 4 * kg + r;
                    keys[q * MK_STRIDE + s] = (s <= t0 + q) ? sort_key(I) : 0u;
                }
                __builtin_amdgcn_sched_barrier(0);
#pragma unroll
                for (int dh = 0; dh < 2; ++dh) ah[dh] = ahn[dh];
            }
            MK_UNIT_LOAD(bnx, qbnx, bhn, wvn, ahq);
            __syncthreads();
            const int nk = t0 + 16;
            { const LAS unsigned* kA = keys + (2 * wave) * MK_STRIDE; const LAS unsigned* kB = kA + MK_STRIDE;
              GAS unsigned* mA = mask + (rowq0 + 2 * wave) * 64; GAS unsigned* mB = mA + 64;
              if (nk <= 512) select2<8>(kA, kB, nk, mA, mB, lane);
              else if (nk <= 1024) select2<16>(kA, kB, nk, mA, mB, lane);
              else if (nk <= 1536) select2<24>(kA, kB, nk, mA, mB, lane);
              else select2<32>(kA, kB, nk, mA, mB, lane); }
#pragma unroll
            for (int h = 0; h < 4; ++h) { bh[h][0] = bhn[h][0]; bh[h][1] = bhn[h][1]; }
            wv = wvn; ah[0] = ahq[0]; ah[1] = ahq[1];
            __syncthreads();
        }
    }
#undef MK_UNIT_PARAMS
#undef MK_UNIT_LOAD
}

typedef short s16x4 __attribute__((ext_vector_type(4)));
#define MFMA16(a, b, c) __builtin_amdgcn_mfma_f32_16x16x16bf16_1k((a), (b), (c), 0, 0, 0)
__device__ __forceinline__ s16x4 pack4(const f32x4 v) { v2u t; t.x = cvtpk(v[0], v[1]); t.y = cvtpk(v[2], v[3]); return __builtin_bit_cast(s16x4, t); }
constexpr int HG_QT = 0, HG_KT = 2176, HG_KH = 4352, HG_IT = 7424, HG_DF = 10496, HG_WAVE_LDS = 10752;
struct HgRaw { unsigned short z[16], q[16]; };
template <bool FULL> __device__ __forceinline__ void hgrn_load(const GAS bf16* pr, HgRaw& R) {
#pragma unroll
    for (int s_ = 0; s_ < 16; ++s_) { R.z[s_] = pr[(size_t)s_ * PROJ_LD + PC_HF]; if (FULL) R.q[s_] = pr[(size_t)s_ * PROJ_LD + PC_HQ]; }
}
template <bool FULL> __device__ __forceinline__ float hgrn_stage(const HgRaw& R, const GAS bf16* pr, float lbv, LAS unsigned char* W, int lane) {
    const unsigned short (&zr)[16] = R.z; const unsigned short (&qr)[16] = R.q;
    unsigned short ir[16];
#pragma unroll
    for (int s_ = 0; s_ < 16; ++s_) ir[s_] = pr[(size_t)s_ * PROJ_LD + PC_HI];
    float f[16], kk[16]; float P = 1.0f;
    LAS unsigned short* QT = (LAS unsigned short*)(W + HG_QT); LAS unsigned short* KT = (LAS unsigned short*)(W + HG_KT);
#pragma unroll
    for (int s_ = 0; s_ < 16; ++s_) {
        const float z = bf2f(zr[s_]);
        const float sig = 1.0f / (1.0f + __expf(-z));
        f[s_] = fmaxf(lbv + (1.0f - lbv) * sig, 1e-30f); kk[s_] = (1.0f - lbv) * (1.0f - sig);
        P *= f[s_];
        if (FULL) { const float q = bf2f(qr[s_]); const float qs = q / (1.0f + __expf(-q));
            QT[s_ * 68 + lane] = (unsigned short)f2bf(qs * P); KT[s_ * 68 + lane] = (unsigned short)f2bf(kk[s_] / fmaxf(P, 1e-30f)); }
    }
    float E = 1.0f; unsigned kh[8];
#pragma unroll
    for (int s_ = 15; s_ >= 0; s_ -= 2) {
        const float hi = kk[s_] * E; E *= f[s_];
        const float lo = kk[s_ - 1] * E; E *= f[s_ - 1];
        kh[s_ >> 1] = cvtpk(lo, hi);
    }
    LAS v4u* KH = (LAS v4u*)(W + HG_KH + lane * 48); LAS v4u* IT = (LAS v4u*)(W + HG_IT + lane * 48);
    KH[0] = (v4u){kh[0], kh[1], kh[2], kh[3]}; KH[1] = (v4u){kh[4], kh[5], kh[6], kh[7]};
    IT[0] = (v4u){(unsigned)ir[0] | ((unsigned)ir[1] << 16), (unsigned)ir[2] | ((unsigned)ir[3] << 16), (unsigned)ir[4] | ((unsigned)ir[5] << 16), (unsigned)ir[6] | ((unsigned)ir[7] << 16)};
    IT[1] = (v4u){(unsigned)ir[8] | ((unsigned)ir[9] << 16), (unsigned)ir[10] | ((unsigned)ir[11] << 16), (unsigned)ir[12] | ((unsigned)ir[13] << 16), (unsigned)ir[14] | ((unsigned)ir[15] << 16)};
    ((LAS float*)(W + HG_DF))[lane] = P;
    return P;
}
__device__ __forceinline__ void hgrn_update(f32x4 (&S)[4][4], const LAS unsigned char* W, int fr, int kg) {
    s16x4 khf[4], itf[4]; f32x4 df[4];
#pragma unroll
    for (int i = 0; i < 4; ++i) { khf[i] = *(const LAS s16x4*)(W + HG_KH + (16 * i + fr) * 48 + 8 * kg); itf[i] = *(const LAS s16x4*)(W + HG_IT + (16 * i + fr) * 48 + 8 * kg);
        df[i] = *(const LAS f32x4*)(W + HG_DF + (16 * i + 4 * kg) * 4); }
#pragma unroll
    for (int kb = 0; kb < 4; ++kb)
#pragma unroll
        for (int vb = 0; vb < 4; ++vb) S[kb][vb] = MFMA16(khf[kb], itf[vb], S[kb][vb] * df[kb]);
}
__device__ __forceinline__ void p_hgrn_local(Frame& F, int layer) {
    const int lane = F.lane, fr = lane & 15, kg = lane >> 4;
    LAS unsigned char* W = F.lds + RING_OFF + F.wave * 16384;
    const GAS bf16* proj = (const GAS bf16*)(F.ws + WS_PROJ); GAS float* hst = (GAS float*)(F.ws + WS_HST); GAS float* hdn = (GAS float*)(F.ws + WS_HDN);
    for (int unit = F.wave * F.G + F.bid; unit < BATCH * 4 * (SEQ / 64); unit += NWAVES * F.G) {
        const int bh = unit >> 5, chunk = unit & 31, b = bh >> 2, h = bh & 3;
        const float lbv = ((const GAS float*)(F.ws + WS_LB))[layer * 256 + h * 64 + lane];
        const size_t row0 = (size_t)b * SEQ + chunk * 64;
        f32x4 S[4][4];
#pragma unroll
        for (int i = 0; i < 4; ++i)
#pragma unroll
            for (int j = 0; j < 4; ++j) S[i][j] = (f32x4){0.f, 0.f, 0.f, 0.f};
        float dprod = 1.0f;
        HgRaw R;
        hgrn_load<false>(proj + row0 * PROJ_LD + h * 64 + lane, R);
        for (int sub = 0; sub < 4; ++sub) {
            dprod *= hgrn_stage<false>(R, proj + (row0 + sub * 16) * PROJ_LD + h * 64 + lane, lbv, W, lane);
            { const int sn = sub < 3 ? sub + 1 : 3; hgrn_load<false>(proj + (row0 + sn * 16) * PROJ_LD + h * 64 + lane, R); }
            LDS_WAIT(); asm volatile("" ::: "memory");
            hgrn_update(S, W, fr, kg);
            LDS_WAIT(); asm volatile("" ::: "memory");
        }
        GAS float* U = hst + (size_t)unit * 4096;
#pragma unroll
        for (int kb = 0; kb < 4; ++kb)
#pragma unroll
            for (int vb = 0; vb < 4; ++vb)
#pragma unroll
                for (int r = 0; r < 4; ++r) U[(16 * kb + 4 * kg + r) * 64 + 16 * vb + fr] = S[kb][vb][r];
        hdn[unit * 64 + lane] = dprod;
    }
}
__device__ __forceinline__ void p_hgrn_scan(Frame& F) {
    GAS float* hst = (GAS float*)(F.ws + WS_HST); const GAS float* hdn = (const GAS float*)(F.ws + WS_HDN);
    for (int e = F.bid * NTHR + F.tid; e < BATCH * 4 * 4096; e += F.G * NTHR) {
        const int bh = e >> 12, kv = e & 4095, k = kv >> 6;
        float S = 0.f;
        for (int n = 0; n < SEQ / 64; ++n) {
            const size_t idx = ((size_t)(bh * 32 + n) << 12) + kv;
            const float u = hst[idx]; hst[idx] = S;
            S = hdn[(bh * 32 + n) * 64 + k] * S + u;
        }
    }
}
constexpr int HG_LDS_OFF = 40960;
__device__ __forceinline__ void p_hgrn_out(Frame& F, int layer) {
    const int lane = F.lane, fr = lane & 15, kg = lane >> 4;
    LAS unsigned char* W = F.lds + RING_OFF + HG_LDS_OFF + F.wave * HG_WAVE_LDS;
    const GAS bf16* proj = (const GAS bf16*)(F.ws + WS_PROJ); GAS bf16* mixed = (GAS bf16*)(F.ws + WS_MIXED); const GAS float* hst = (const GAS float*)(F.ws + WS_HST);
    for (int unit = F.wave * F.G + F.bid; unit < BATCH * 4 * (SEQ / 64); unit += NWAVES * F.G) {
        const int bh = unit >> 5, chunk = unit & 31, b = bh >> 2, h = bh & 3;
        const float lbv = ((const GAS float*)(F.ws + WS_LB))[layer * 256 + h * 64 + lane];
        const size_t row0 = (size_t)b * SEQ + chunk * 64;
        f32x4 S[4][4];
        { const GAS float* U = hst + (size_t)unit * 4096;
#pragma unroll
          for (int kb = 0; kb < 4; ++kb)
#pragma unroll
              for (int vb = 0; vb < 4; ++vb)
#pragma unroll
                  for (int r = 0; r < 4; ++r) S[kb][vb][r] = U[(16 * kb + 4 * kg + r) * 64 + 16 * vb + fr]; }
        HgRaw R;
        hgrn_load<true>(proj + row0 * PROJ_LD + h * 64 + lane, R);
        for (int sub = 0; sub < 4; ++sub) {
            const size_t rs = row0 + sub * 16;
            (void)hgrn_stage<true>(R, proj + rs * PROJ_LD + h * 64 + lane, lbv, W, lane);
            { const size_t rn = row0 + (sub < 3 ? sub + 1 : 3) * 16; hgrn_load<true>(proj + rn * PROJ_LD + h * 64 + lane, R); }
            v2u g2[4];
#pragma unroll
            for (int vb = 0; vb < 4; ++vb) g2[vb] = *(const GAS v2u*)(proj + (rs + fr) * PROJ_LD + PC_HG + h * 64 + 16 * vb + 4 * kg);
            LDS_WAIT(); asm volatile("" ::: "memory");
            s16x4 qb[4];
#pragma unroll
            for (int kb = 0; kb < 4; ++kb) qb[kb] = *(const LAS s16x4*)(W + HG_QT + (fr * 68 + 16 * kb + 4 * kg) * 2);
            f32x4 o[4];
#pragma unroll
            for (int vb = 0; vb < 4; ++vb) { o[vb] = (f32x4){0.f, 0.f, 0.f, 0.f};
#pragma unroll
                for (int kb = 0; kb < 4; ++kb) o[vb] = MFMA16(pack4(S[kb][vb]), qb[kb], o[vb]); }
            f32x4 at = {0.f, 0.f, 0.f, 0.f};
#pragma unroll
            for (int kb = 0; kb < 4; ++kb) at = MFMA16(*(const LAS s16x4*)(W + HG_KT + (fr * 68 + 16 * kb + 4 * kg) * 2), qb[kb], at);
#pragma unroll
            for (int r = 0; r < 4; ++r) if (4 * kg + r > fr) at[r] = 0.f;
            const s16x4 ab = pack4(at);
#pragma unroll
            for (int vb = 0; vb < 4; ++vb) o[vb] = MFMA16(*(const LAS s16x4*)(W + HG_IT + (16 * vb + fr) * 48 + 8 * kg), ab, o[vb]);
            hgrn_update(S, W, fr, kg);
            float ssq = 0.f;
#pragma unroll
            for (int vb = 0; vb < 4; ++vb) ssq += (o[vb][0] * o[vb][0] + o[vb][1] * o[vb][1]) + (o[vb][2] * o[vb][2] + o[vb][3] * o[vb][3]);
            ssq += __shfl_xor(ssq, 16); ssq += __shfl_xor(ssq, 32);
            const float rstd = 1.0f / sqrtf(ssq * (1.0f / 64.0f) + 1e-5f);
            f32x4 ng4[4];
#pragma unroll
            for (int vb = 0; vb < 4; ++vb) ng4[vb] = *(const GAS f32x4*)((const GAS float*)F.hgrn_g + layer * 256 + h * 64 + 16 * vb + 4 * kg);
#pragma unroll
            for (int vb = 0; vb < 4; ++vb) {
                const float g0 = __builtin_bit_cast(float, g2[vb].x << 16), g1 = __builtin_bit_cast(float, g2[vb].x & 0xffff0000u), g2f = __builtin_bit_cast(float, g2[vb].y << 16), g3 = __builtin_bit_cast(float, g2[vb].y & 0xffff0000u);
                const float y0 = o[vb][0] * rstd * ng4[vb][0] * (g0 / (1.0f + __expf(-g0))), y1 = o[vb][1] * rstd * ng4[vb][1] * (g1 / (1.0f + __expf(-g1)));
                const float y2 = o[vb][2] * rstd * ng4[vb][2] * (g2f / (1.0f + __expf(-g2f))), y3 = o[vb][3] * rstd * ng4[vb][3] * (g3 / (1.0f + __expf(-g3)));
                *(GAS v2u*)(mixed + (rs + fr) * DM + MC_HGRN + h * 64 + 16 * vb + 4 * kg) = (v2u){cvtpk(y0, y1), cvtpk(y2, y3)};
            }
            LDS_WAIT(); asm volatile("" ::: "memory");
        }
    }
}

__device__ __forceinline__ float max3f_(float a, float b, float c) { float r; asm("v_max3_f32 %0, %1, %2, %3" : "=v"(r) : "v"(a), "v"(b), "v"(c)); return r; }
__device__ __forceinline__ float and_f32(float e, int selmask) { asm volatile("" : "+v"(selmask)); return __builtin_bit_cast(float, __builtin_bit_cast(unsigned, e) & (unsigned)selmask); }
typedef float f32x2p __attribute__((ext_vector_type(2)));
constexpr int AT_KROW = 144, AT_VROW = 136, AT_KBYTES = 64 * AT_KROW, AT_VBYTES = 64 * AT_VROW, AT_BUF = AT_KBYTES + AT_VBYTES, AT_SCR = 2 * AT_BUF;
static_assert(AT_BUF % 16 == 0 && AT_SCR % 16 == 0, "attention LDS map alignment");
__device__ __forceinline__ void p_attn_flash(Frame& F) {
    const int tid = F.tid, lane = F.lane, wave = F.wave;
    const int r = lane & 31, hh = lane >> 5, g = wave & 3, qh = wave >> 2;
    LAS unsigned char* L = F.lds + RING_OFF;
    LAS float* scr = (LAS float*)(L + AT_SCR) + wave * 32;
    const GAS bf16* proj = (const GAS bf16*)(F.ws + WS_PROJ); const GAS bf16* vT = (const GAS bf16*)(F.ws + WS_VT); GAS bf16* mixed = (GAS bf16*)(F.ws + WS_MIXED);
    const GAS unsigned* mask = (const GAS unsigned*)(F.ws + WS_MASK);
    const int srow = tid >> 3, sch = tid & 7;
    const float C2 = 0.18033688011112042f, NEG = -1.0e30f;
    for (int pair = F.bid; pair < 256; pair += F.G) {
        const int bk = pair >> 4, b = bk >> 1, kvh = bk & 1, pp = pair & 15, h = kvh * 4 + g;
        for (int half = 0; half < 2; ++half) {
            const int qblk = half == 0 ? 31 - pp : pp;
            const int q0 = qblk * 64, nt = qblk + 1;
            const int tq = q0 + 32 * qh + r;
            bf16x8v qf[4];
            { const GAS bf16* qp = proj + (size_t)(b * SEQ + tq) * PROJ_LD + PC_Q + h * 64 + 8 * hh;
#pragma unroll
              for (int d0 = 0; d0 < 4; ++d0) qf[d0] = *(const GAS bf16x8v*)(qp + 16 * d0); }
            const GAS unsigned* mrow = mask + (size_t)(b * SEQ + tq) * 64;
            const GAS bf16* kg = proj + (size_t)(b * SEQ + srow) * PROJ_LD + PC_K + kvh * 64 + sch * 8;
            const GAS bf16* vg = vT + (size_t)(bk * 64 + srow) * SEQ + sch * 8;
            { const v4u kreg = *(const GAS v4u*)kg; const v4u vreg = *(const GAS v4u*)vg;
              *(LAS v4u*)(L + srow * AT_KROW + sch * 16) = kreg;
              LAS unsigned char* vd = L + AT_KBYTES + srow * AT_VROW + sch * 16;
              *(LAS v2u*)vd = (v2u){vreg.x, vreg.y}; *(LAS v2u*)(vd + 8) = (v2u){vreg.z, vreg.w}; }
            v2u mw = *(const GAS v2u*)mrow;
            __syncthreads();
            f32x16 o0, o1;
#pragma unroll
            for (int i = 0; i < 16; ++i) { o0[i] = 0.f; o1[i] = 0.f; }
            float m = -30000.0f, l = 0.f;
            for (int j = 0; j < nt; ++j) {
                LAS unsigned char* Kb = L + (j & 1) * AT_BUF; LAS unsigned char* Vb = Kb + AT_KBYTES;
                const bool more = (j + 1 < nt);
                const int jn = more ? j + 1 : j;
                const v4u kn = *(const GAS v4u*)(kg + (size_t)jn * 64 * PROJ_LD); const v4u vn = *(const GAS v4u*)(vg + jn * 64); const v2u mwn = *(const GAS v2u*)(mrow + 2 * jn);
                bf16x8v kf[8];
#pragma unroll
                for (int d0 = 0; d0 < 4; ++d0) { kf[2 * d0] = *(const LAS bf16x8v*)(Kb + r * AT_KROW + d0 * 32 + hh * 16); kf[2 * d0 + 1] = *(const LAS bf16x8v*)(Kb + (32 + r) * AT_KROW + d0 * 32 + hh * 16); }
                __builtin_amdgcn_sched_barrier(0);
                f32x16 p0, p1;
#pragma unroll
                for (int i = 0; i < 16; ++i) { p0[i] = 0.f; p1[i] = 0.f; }
#pragma unroll
                for (int d0 = 0; d0 < 4; ++d0) {
                    p0 = __builtin_amdgcn_mfma_f32_32x32x16_bf16(kf[2 * d0], qf[d0], p0, 0, 0, 0);
                    p1 = __builtin_amdgcn_mfma_f32_32x32x16_bf16(kf[2 * d0 + 1], qf[d0], p1, 0, 0, 0);
                }
                v2u vl[8], vh[8];
#pragma unroll
                for (int ks = 0; ks < 4; ++ks) {
                    const LAS unsigned char* vp = Vb + r * AT_VROW + (16 * ks + 4 * hh) * 2;
                    vl[2 * ks] = *(const LAS v2u*)vp; vh[2 * ks] = *(const LAS v2u*)(vp + 16);
                    vl[2 * ks + 1] = *(const LAS v2u*)(vp + 32 * AT_VROW); vh[2 * ks + 1] = *(const LAS v2u*)(vp + 32 * AT_VROW + 16);
                }
                __builtin_amdgcn_sched_barrier(0);
                const unsigned w0 = mw.x >> (4 * hh), w1 = mw.y >> (4 * hh);
                asm volatile("s_nop 15\n\ts_nop 7" : "+v"(p0), "+v"(p1));
                float mx;
                { float a = max3f_(p0[0], p0[1], p1[0]), b = max3f_(p0[2], p0[3], p1[1]); a = max3f_(a, p1[2], p1[3]);
#pragma unroll
                  for (int i = 4; i < 16; i += 4) { a = max3f_(a, p0[i], p0[i + 1]); b = max3f_(b, p0[i + 2], p0[i + 3]); a = max3f_(a, p1[i], p1[i + 1]); b = max3f_(b, p1[i + 2], p1[i + 3]); }
                  mx = max3f_(a, b, NEG); }
                mx = fmaxf(mx, __shfl_xor(mx, 32));
                const float mxs = mx * C2;
                const bool need = mxs > m + 8.0f;
                if (__any(need)) {
                    const float mnew = need ? mxs : m;
                    const float alpha = __builtin_amdgcn_exp2f(m - mnew); m = mnew; l *= alpha;
                    if (hh == 0) scr[r] = alpha;
#pragma unroll
                    for (int gq = 0; gq < 4; ++gq) {
                        const f32x4 a4 = *(const LAS f32x4*)(scr + 8 * gq + 4 * hh);
#pragma unroll
                        for (int e = 0; e < 4; ++e) { o0[4 * gq + e] *= a4[e]; o1[4 * gq + e] *= a4[e]; }
                    }
                }
                f32x2p rs2 = {0.f, 0.f};
                const f32x2p c2v = {C2, C2}, nm2 = {-m, -m};
#pragma unroll
                for (int i = 0; i < 16; i += 2) {
                    const int cr0 = (i & 3) + 8 * (i >> 2), cr1 = cr0 + 1;
                    f32x2p t0 = (f32x2p){p0[i], p0[i + 1]} * c2v + nm2, t1 = (f32x2p){p1[i], p1[i + 1]} * c2v + nm2;
                    t0.x = and_f32(__builtin_amdgcn_exp2f(t0.x), __builtin_amdgcn_sbfe((int)w0, cr0, 1)); t0.y = and_f32(__builtin_amdgcn_exp2f(t0.y), __builtin_amdgcn_sbfe((int)w0, cr1, 1));
                    t1.x = and_f32(__builtin_amdgcn_exp2f(t1.x), __builtin_amdgcn_sbfe((int)w1, cr0, 1)); t1.y = and_f32(__builtin_amdgcn_exp2f(t1.y), __builtin_amdgcn_sbfe((int)w1, cr1, 1));
                    p0[i] = t0.x; p0[i + 1] = t0.y; p1[i] = t1.x; p1[i + 1] = t1.y;
                    rs2 += t0; rs2 += t1;
                }
                l += rs2.x + rs2.y;
                bf16x8v pf[4];
                { v4u t;
                  t.x = cvtpk(p0[0], p0[1]); t.y = cvtpk(p0[2], p0[3]); t.z = cvtpk(p0[4], p0[5]); t.w = cvtpk(p0[6], p0[7]); pf[0] = __builtin_bit_cast(bf16x8v, t);
                  t.x = cvtpk(p0[8], p0[9]); t.y = cvtpk(p0[10], p0[11]); t.z = cvtpk(p0[12], p0[13]); t.w = cvtpk(p0[14], p0[15]); pf[1] = __builtin_bit_cast(bf16x8v, t);
                  t.x = cvtpk(p1[0], p1[1]); t.y = cvtpk(p1[2], p1[3]); t.z = cvtpk(p1[4], p1[5]); t.w = cvtpk(p1[6], p1[7]); pf[2] = __builtin_bit_cast(bf16x8v, t);
                  t.x = cvtpk(p1[8], p1[9]); t.y = cvtpk(p1[10], p1[11]); t.z = cvtpk(p1[12], p1[13]); t.w = cvtpk(p1[14], p1[15]); pf[3] = __builtin_bit_cast(bf16x8v, t); }
                __builtin_amdgcn_sched_barrier(0);
#pragma unroll
                for (int ks = 0; ks < 4; ++ks) {
                    const bf16x8v vf0 = __builtin_bit_cast(bf16x8v, (v4u){vl[2 * ks].x, vl[2 * ks].y, vh[2 * ks].x, vh[2 * ks].y});
                    const bf16x8v vf1 = __builtin_bit_cast(bf16x8v, (v4u){vl[2 * ks + 1].x, vl[2 * ks + 1].y, vh[2 * ks + 1].x, vh[2 * ks + 1].y});
                    o0 = __builtin_amdgcn_mfma_f32_32x32x16_bf16(pf[ks], vf0, o0, 0, 0, 0);
                    o1 = __builtin_amdgcn_mfma_f32_32x32x16_bf16(pf[ks], vf1, o1, 0, 0, 0);
                }
                __builtin_amdgcn_sched_barrier(0);
                if (more) {
                    LAS unsigned char* Kn = L + ((j + 1) & 1) * AT_BUF;
                    *(LAS v4u*)(Kn + srow * AT_KROW + sch * 16) = kn;
                    LAS unsigned char* vd = Kn + AT_KBYTES + srow * AT_VROW + sch * 16;
                    *(LAS v2u*)vd = (v2u){vn.x, vn.y}; *(LAS v2u*)(vd + 8) = (v2u){vn.z, vn.w};
                }
                mw = mwn;
                __syncthreads();
            }
            l += __shfl_xor(l, 32);
            if (hh == 0) scr[r] = 1.0f / l;
            GAS bf16* op = mixed + (size_t)(b * SEQ + q0 + 32 * qh) * DM + MC_ATTN + h * 64 + r;
#pragma unroll
            for (int gq = 0; gq < 4; ++gq) {
                const f32x4 a4 = *(const LAS f32x4*)(scr + 8 * gq + 4 * hh);
#pragma unroll
                for (int e = 0; e < 4; ++e) {
                    const int q = 8 * gq + 4 * hh + e;
                    op[(size_t)q * DM] = (bf16)f2bf(o0[4 * gq + e] * a4[e]); op[(size_t)q * DM + 32] = (bf16)f2bf(o1[4 * gq + e] * a4[e]);
                }
            }
        }
    }
}

__device__ __forceinline__ void p_final(Frame& F) {
    const int gw = F.bid * NWAVES + F.wave, NGW = F.G * NWAVES;
    const GAS f32x4* gr = (const GAS f32x4*)F.fng + F.lane;
    f32x4 gv[4];
#pragma unroll
    for (int j = 0; j < 4; ++j) gv[j] = gr[64 * j];
    for (int row0 = gw * 4; row0 < M; row0 += NGW * 4) {
        f32x4 v[4][4]; float sq[4];
#pragma unroll
        for (int rr = 0; rr < 4; ++rr) { const GAS f32x4* xr = (const GAS f32x4*)(F.xres + (size_t)(row0 + rr) * DM) + F.lane;
#pragma unroll
            for (int j = 0; j < 4; ++j) v[rr][j] = xr[64 * j]; }
#pragma unroll
        for (int rr = 0; rr < 4; ++rr) { float a = 0.f;
#pragma unroll
            for (int j = 0; j < 4; ++j) a += (v[rr][j][0] * v[rr][j][0] + v[rr][j][1] * v[rr][j][1]) + (v[rr][j][2] * v[rr][j][2] + v[rr][j][3] * v[rr][j][3]);
            sq[rr] = a; }
#pragma unroll
        for (int o = 1; o < 64; o <<= 1)
#pragma unroll
            for (int rr = 0; rr < 4; ++rr) sq[rr] += __shfl_xor(sq[rr], o);
#pragma unroll
        for (int rr = 0; rr < 4; ++rr) {
            const float rs = 1.0f / sqrtf(sq[rr] * (1.0f / 1024.0f) + 1e-5f);
            GAS f32x4* xo = (GAS f32x4*)(F.xres + (size_t)(row0 + rr) * DM) + F.lane;
#pragma unroll
            for (int j = 0; j < 4; ++j) xo[64 * j] = v[rr][j] * rs * gv[j];
        }
    }
}

#ifndef MK_SINGLE
#define MK_SINGLE 1
#endif
constexpr int NPL = 7;
constexpr int NPHASE = 1 + DEPTH * NPL + 1;
struct Args { const float* x; const int* pos; const float *n1g, *w_in, *pool_w, *pool_scale, *lb_logits, *hgrn_g, *w_out, *n2g, *w_ff_in, *w_ff_out, *fng; float* out; unsigned char* ws; int ph_lo, ph_hi; };
static_assert(sizeof(Args) == 15 * 8 + 8, "Args has no padding");


#define PHASE_BEGIN() do { int t_ = threadIdx.x; asm volatile("" : "+v"(t_)); F.tid = t_; F.lane = t_ & 63; F.wave = __builtin_amdgcn_readfirstlane(t_ >> 6); \
    unsigned char* w_ = args.ws; asm volatile("" : "+s"(w_)); F.ws = w_; int b_ = blockIdx.x; asm volatile("" : "+s"(b_)); F.bid = b_; } while (0)

#define RSTD_TAB_OFF RING_BYTES
#define FILL_RSTD(S_, pm_out) do { PHASE_BEGIN(); pg8::Unit u0_; pm_out = S_.next(0, u0_) ? u0_.pm : -1; \
    if (pm_out >= 0 && F.tid < 256) ((LAS float*)(F.lds + RSTD_TAB_OFF))[F.tid] = pg8::row_rstd((const float*)(F.ws + WS_SSQ), pm_out * 256 + F.tid); \
    __syncthreads(); } while (0)
__global__ void __launch_bounds__(NTHR, 2) fwd(Args args) {
    extern __shared__ __attribute__((aligned(16))) unsigned char lds[];
    Frame F;
    F.lds = (LAS unsigned char*)lds;
    F.MISC = (volatile LAS unsigned*)(F.lds + MISC_OFF);
    F.tid = threadIdx.x; F.lane = F.tid & 63; F.wave = __builtin_amdgcn_readfirstlane(F.tid >> 6);
    F.G = gridDim.x; F.bid = blockIdx.x;
    F.ws = args.ws; F.ctl = (gu32*)(args.ws + WS_CTL);
    F.x_in = args.x; F.pos = args.pos; F.n1g = args.n1g; F.w_in = args.w_in; F.pool_w = args.pool_w; F.pool_scale = args.pool_scale; F.lb_logits = args.lb_logits;
    F.hgrn_g = args.hgrn_g; F.w_out = args.w_out; F.n2g = args.n2g; F.w_ff_in = args.w_ff_in; F.w_ff_out = args.w_ff_out; F.fng = args.fng; F.xres = args.out;
    for (int u = F.tid; u < (LDS_BYTES - LDSCTL_OFF) / 4; u += NTHR) ((LAS unsigned*)(F.lds + LDSCTL_OFF))[u] = 0u;
    __syncthreads();
    XcdBarrier bar; bar.bar = (unsigned*)(F.ctl + CW_BAR); bar.x = 0; bar.st = nullptr;
    if (MK_SINGLE) bar = xcd_barrier_post((unsigned*)(F.ctl + CW_BAR), F.MISC + 8);
    const int lo = args.ph_lo, hi = args.ph_hi;
#define IN(k) (lo <= (k) && (k) < hi)
#define SEAM(k) do { if (MK_SINGLE && IN(k) && IN((k) + 1)) xcd_barrier(bar); } while (0)
    bf16* const xb = (bf16*)(F.ws + WS_XB); float* const ssq = (float*)(F.ws + WS_SSQ);
    bf16* const proj = (bf16*)(F.ws + WS_PROJ); bf16* const mixed = (bf16*)(F.ws + WS_MIXED); bf16* const hid = (bf16*)(F.ws + WS_HID);

    if (IN(0)) { PHASE_BEGIN(); p_prologue(F); } SEAM(0);
    for (int layer = 0; layer < DEPTH; ++layer) {
        const int pb = 1 + layer * NPL;
        if (IN(pb + 0)) {
            PHASE_BEGIN(); pg8::Gemm g{xb, (const bf16*)(F.ws + ((layer & 1) ? WS_WIN1 : WS_WIN)), M, DINP, DM}; pg8::StaticOrder S; S.init(M, DINP, F.G, F.bid);
            int pm0; FILL_RSTD(S, pm0);
            pg8::EpiIn E{F.ws, pg8::RstdTab{(const LAS float*)(F.lds + RSTD_TAB_OFF), pm0, F.ws}};
            pg8::gemm_phase<pg8::EpiIn, pg8::StaticOrder, true, true>(F.lds + RING_OFF, g, S, E);
            PHASE_BEGIN(); if (F.bid >= 128) cvt_layer_rest(F, layer, (F.bid - 128) * NWAVES + F.wave, 128 * NWAVES);
        } SEAM(pb + 0);
        if (IN(pb + 1)) { PHASE_BEGIN(); if (F.wave < 4) p_hgrn_local(F, layer); else p_pool_wave(F, layer, F.wave - 4, 4); } SEAM(pb + 1);
        if (IN(pb + 2)) { PHASE_BEGIN(); p_mask(F); PHASE_BEGIN(); p_hgrn_scan(F); } SEAM(pb + 2);
        if (IN(pb + 3)) { PHASE_BEGIN(); p_hgrn_out(F, layer); PHASE_BEGIN(); p_attn_flash(F); } SEAM(pb + 3);
        if (IN(pb + 4)) {
            PHASE_BEGIN(); pg8::Gemm g{mixed, (const bf16*)(F.ws + WS_WOUT), M, DM, DM}; pg8::StaticOrder S; S.init(M, DM, F.G, F.bid);
            pg8::EpiRes E{layer == 0 ? F.x_in : (const float*)F.xres, F.xres, F.ws};
            pg8::gemm_phase<pg8::EpiRes, pg8::StaticOrder, true, true>(F.lds + RING_OFF, g, S, E);
        } SEAM(pb + 4);
        if (IN(pb + 5)) {
            PHASE_BEGIN(); pg8::Gemm g{xb, (const bf16*)(F.ws + WS_WFI), M, DFF, DM}; pg8::StaticOrder S; S.init(M, DFF, F.G, F.bid);
            int pm0; FILL_RSTD(S, pm0);
            pg8::EpiFfIn E{pg8::RstdTab{(const LAS float*)(F.lds + RSTD_TAB_OFF), pm0, F.ws}};
            pg8::gemm_phase<pg8::EpiFfIn, pg8::StaticOrder, true, true>(F.lds + RING_OFF, g, S, E);
        } SEAM(pb + 5);
        if (IN(pb + 6)) {
            PHASE_BEGIN(); pg8::Gemm g{hid, (const bf16*)(F.ws + WS_WFO), M, DM, DFF}; pg8::StaticOrder S; S.init(M, DM, F.G, F.bid);
            pg8::EpiRes E{(const float*)F.xres, F.xres, F.ws};
            pg8::gemm_phase<pg8::EpiRes, pg8::StaticOrder, true, true>(F.lds + RING_OFF, g, S, E);
        } SEAM(pb + 6);
    }
    if (IN(NPHASE - 1)) { PHASE_BEGIN(); p_final(F); }
#undef IN
#undef SEAM
}

extern "C" void kernel_launch(void* const* d_in, const int* in_sizes, int n_in, void* d_out, int out_size, void* d_ws, size_t ws_size, hipStream_t stream) {
    static int grid = 0;
    if (grid == 0) {
        if (n_in != 13 || out_size != M * DM || ws_size < WS_END) { fprintf(stderr, "kernel_launch: unexpected shapes (n_in %d, out %d, ws %zu)\n", n_in, out_size, ws_size); grid = -1; return; }
        int dev = 0, cus = 0, per_cu = 0;
        if (hipGetDevice(&dev) != hipSuccess || hipDeviceGetAttribute(&cus, hipDeviceAttributeMultiprocessorCount, dev) != hipSuccess) { grid = -1; return; }
        if (hipFuncSetAttribute((const void*)fwd, hipFuncAttributeMaxDynamicSharedMemorySize, LDS_BYTES) != hipSuccess) { fprintf(stderr, "kernel_launch: hipFuncSetAttribute failed\n"); grid = -1; return; }
        if (hipOccupancyMaxActiveBlocksPerMultiprocessor(&per_cu, (const void*)fwd, NTHR, LDS_BYTES) != hipSuccess || per_cu < 1) { fprintf(stderr, "kernel_launch: occupancy query says %d\n", per_cu); }
        (void)hipGetLastError();
        grid = cus;
        if (grid != 256) { fprintf(stderr, "kernel_launch: built for a 256-CU device (got %d)\n", cus); grid = -1; return; }
    }
    if (grid <= 0) return;
    (void)hipMemsetAsync((char*)d_ws + WS_CTL, 0, CTL_ZERO_BYTES, stream);
    Args a{};
    a.x = (const float*)d_in[0]; a.pos = (const int*)d_in[1]; a.n1g = (const float*)d_in[2]; a.w_in = (const float*)d_in[3]; a.pool_w = (const float*)d_in[4];
    a.pool_scale = (const float*)d_in[5]; a.lb_logits = (const float*)d_in[6]; a.hgrn_g = (const float*)d_in[7]; a.w_out = (const float*)d_in[8]; a.n2g = (const float*)d_in[9];
    a.w_ff_in = (const float*)d_in[10]; a.w_ff_out = (const float*)d_in[11]; a.fng = (const float*)d_in[12];
    a.out = (float*)d_out; a.ws = (unsigned char*)d_ws;
    if (MK_SINGLE) {
        a.ph_lo = 0; a.ph_hi = NPHASE;
        hipLaunchKernelGGL(fwd, dim3(grid), dim3(NTHR), LDS_BYTES, stream, a);
    } else {
        for (int p = 0; p < NPHASE; ++p) { a.ph_lo = p; a.ph_hi = p + 1; hipLaunchKernelGGL(fwd, dim3(grid), dim3(NTHR), LDS_BYTES, stream, a); }
    }
}
```
